# Optimizing an MI355X kernel written in HIP

```python
import math, functools
import jax, jax.numpy as jnp
from jax import lax
import numpy as np

D_MODEL = 1024
BATCH = 16
SEQ = 2048
DEPTH = 2

GRID_W = 64
CTX_LEN = 256
D_MIX = D_MODEL
MIX_W = D_MIX // 4
EPS = 1e-6
GLA_HEADS = 4
GLA_DK = MIX_W // GLA_HEADS // 2
GLA_DV = MIX_W // GLA_HEADS
GLA_RANK = 16
GLA_GATE_NORM = 16.0
GLA_CHUNK = 16
RET_HEADS = 4
RET_DK = MIX_W // RET_HEADS
RET_DV = MIX_W // RET_HEADS
RET_CHUNK = 64
ROPE_BASE = 10000.0
S5_GROUP_CH = 16
S5_GROUPS = MIX_W // S5_GROUP_CH
S5_STATE = 64
DN_HEADS = 4
DN_DK = MIX_W // DN_HEADS
DN_DV = MIX_W // DN_HEADS
DN_CONV = 5
DN_CHUNK = 64
N_EXPERTS = 16
N_GROUPS = 4
EXPERTS_PER_GROUP = N_EXPERTS // N_GROUPS
TOP_K = 2
D_FF_EXPERT = D_MODEL // 2
N_MOD = 6
IN_SIZES = (
    GLA_HEADS * GLA_DK, GLA_HEADS * GLA_DK, GLA_HEADS * GLA_DV, GLA_HEADS * GLA_DV, GLA_RANK, GLA_RANK,
    RET_HEADS * RET_DK, RET_HEADS * RET_DK, RET_HEADS * RET_DV, RET_HEADS * RET_DV,
    MIX_W,
    DN_HEADS * DN_DK, DN_HEADS * DN_DK, DN_HEADS * DN_DV, DN_HEADS * DN_DV, 2 * DN_HEADS, 2 * DN_HEADS,
)
D_IN = sum(IN_SIZES)
F32 = jnp.float32

kernel_name = 'hybrid_dit_gla_ret_s5_gdn_moe'


def _rmsnorm(x, g=None):
    xf = x.astype(F32)
    y = xf * lax.rsqrt(jnp.mean(xf * xf, axis=-1, keepdims=True) + EPS)
    if g is not None:
        y = y * g.astype(F32)
    return y.astype(x.dtype)


def _groupnorm(x):
    xf = x.astype(F32)
    mu = jnp.mean(xf, axis=-1, keepdims=True)
    var = jnp.mean(jnp.square(xf - mu), axis=-1, keepdims=True)
    return (xf - mu) * lax.rsqrt(var + EPS)


def _l2norm(x):
    xf = x.astype(F32)
    return xf * lax.rsqrt(jnp.sum(xf * xf, axis=-1, keepdims=True) + EPS)


def _modulate(t, g, shift, scale):
    return _rmsnorm(t, g) * (1.0 + scale) + shift


def _split_seq(ts, lc):
    return tuple(t[:, :lc] for t in ts), tuple(t[:, lc:] for t in ts)


def _flip(ts):
    return tuple(jnp.flip(t, axis=1) for t in ts)


def _prefix_scan(run, ctx_args, lat_args, s0):
    o_ctx, s_ctx = run(*ctx_args, s0)
    o_lat, _ = run(*lat_args, s_ctx)
    return o_ctx, o_lat


def _bidirectional(run_f, run_b, ctx_f, lat_f, ctx_b, lat_b, s0):
    of_c, of_l = _prefix_scan(run_f, ctx_f, lat_f, s0)
    ob_c, ob_l = _prefix_scan(run_b, _flip(ctx_b), _flip(lat_b), s0)
    return jnp.concatenate([of_c + jnp.flip(ob_c, 1), of_l + jnp.flip(ob_l, 1)], axis=1)


def _chunks(t, c):
    b, l, h, d = t.shape
    return t.astype(F32).reshape(b, l // c, c, h, d).transpose(0, 1, 3, 2, 4)


def _unchunk(t):
    b, n, h, c, d = t.shape
    return t.transpose(0, 1, 3, 2, 4).reshape(b, n * c, h, d)


def _gla_chunk(q, k, v, log_a, s0):
    C = GLA_CHUNK
    qc, kc, vc, lac = (_chunks(t, C) for t in (q, k, v, log_a))
    b = jnp.cumsum(lac, axis=3)
    incl = jnp.tril(jnp.ones((C, C), bool))[:, :, None]
    rel = b[:, :, :, :, None, :] - b[:, :, :, None, :, :]
    dec = jnp.exp(jnp.where(incl, rel, -jnp.inf))
    scores = jnp.einsum('bnhrd,bnhsd,bnhrsd->bnhrs', qc, kc, dec)
    o_intra = jnp.einsum('bnhrs,bnhsv->bnhrv', scores, vc)
    b_last = b[:, :, :, -1:]
    q_in = qc * jnp.exp(b)
    k_out = kc * jnp.exp(b_last - b)

    def step(S, xs):
        qi, ki, vi, bl = xs
        o = jnp.einsum('bhrd,bhdv->bhrv', qi, S)
        S = jnp.exp(bl[:, :, 0, :, None]) * S + jnp.einsum('bhsd,bhsv->bhdv', ki, vi)
        return S, o

    xs = tuple(jnp.moveaxis(t, 1, 0) for t in (q_in, k_out, vc, b_last))
    s_fin, o_inter = lax.scan(step, s0, xs)
    return _unchunk(o_intra + jnp.moveaxis(o_inter, 0, 1)), s_fin


def _ret_chunk(q, k, v, s0, log_gamma):
    C = RET_CHUNK
    qc, kc, vc = (_chunks(t, C) for t in (q, k, v))
    lg = log_gamma.astype(F32)[:, None, None]
    pos = jnp.arange(C, dtype=F32)
    rel = pos[:, None] - pos[None, :]
    dmat = jnp.exp(jnp.where(rel >= 0, rel * lg, -jnp.inf))
    scores = jnp.einsum('bnhrd,bnhsd->bnhrs', qc, kc) * dmat
    o_intra = jnp.einsum('bnhrs,bnhsv->bnhrv', scores, vc)
    q_in = qc * jnp.exp((pos + 1.0)[:, None] * lg)
    k_out = kc * jnp.exp((C - 1.0 - pos)[:, None] * lg)
    chunk_dec = jnp.exp(C * lg)

    def step(S, xs):
        qi, ki, vi = xs
        o = jnp.einsum('bhrd,bhdv->bhrv', qi, S)
        S = chunk_dec * S + jnp.einsum('bhsd,bhsv->bhdv', ki, vi)
        return S, o

    xs = tuple(jnp.moveaxis(t, 1, 0) for t in (q_in, k_out, vc))
    s_fin, o_inter = lax.scan(step, s0, xs)
    return _unchunk(o_intra + jnp.moveaxis(o_inter, 0, 1)), s_fin


def _delta_chunk(q, k, v, beta, log_a, s0):
    C = DN_CHUNK
    dk = q.shape[-1]
    qc, kc, vc = (_chunks(t, C) for t in (q, k, v))
    bc = _chunks(beta[..., None], C)[..., 0]
    g = jnp.cumsum(_chunks(log_a[..., None], C)[..., 0], axis=-1)
    pos = jnp.arange(C)
    strict = pos[:, None] > pos[None, :]
    incl = pos[:, None] >= pos[None, :]
    rel = g[..., :, None] - g[..., None, :]
    kk = jnp.einsum('bnhrd,bnhsd->bnhrs', kc, kc)
    a_mat = jnp.eye(C, dtype=F32) + bc[..., None] * kk * jnp.exp(jnp.where(strict, rel, -jnp.inf))
    rhs = jnp.concatenate([(bc * jnp.exp(g))[..., None] * kc, bc[..., None] * vc], axis=-1)
    sol = lax.linalg.triangular_solve(a_mat, rhs, left_side=True, lower=True, unit_diagonal=True)
    w, u0 = sol[..., :dk], sol[..., dk:]
    qk = jnp.einsum('bnhrd,bnhsd->bnhrs', qc, kc) * jnp.exp(jnp.where(incl, rel, -jnp.inf))
    q_in = qc * jnp.exp(g)[..., None]
    k_out = kc * jnp.exp(g[..., -1:] - g)[..., None]
    g_last = g[..., -1]

    def step(S, xs):
        qi, ki, wi, ui, qki, gl = xs
        u = ui - jnp.einsum('bhrd,bhdv->bhrv', wi, S)
        o = jnp.einsum('bhrd,bhdv->bhrv', qi, S) + jnp.einsum('bhrs,bhsv->bhrv', qki, u)
        S = jnp.exp(gl)[..., None, None] * S + jnp.einsum('bhsd,bhsv->bhdv', ki, u)
        return S, o

    xs = tuple(jnp.moveaxis(t, 1, 0) for t in (q_in, k_out, w, u0, qk, g_last))
    s_fin, o_inter = lax.scan(step, s0, xs)
    return _unchunk(jnp.moveaxis(o_inter, 0, 1)), s_fin


def _s5_scan(bu, h0, lam_bar):
    a = jnp.broadcast_to(lam_bar, (1,) + bu.shape[1:])

    def combine(e1, e2):
        a1, b1 = e1
        a2, b2 = e2
        return a1 * a2, a2 * b1 + b2

    a_cum, b_cum = lax.associative_scan(combine, (a, bu), axis=1)
    h = b_cum + a_cum * h0[:, None]
    return h, h[:, -1]


def _axial_rope(t, rows, cols):
    nf = t.shape[-1] // 4
    inv = ROPE_BASE ** (-jnp.arange(nf, dtype=F32) / nf)
    ang = jnp.concatenate([rows[:, None] * inv, cols[:, None] * inv], axis=-1)[None, :, None, :]
    cos, sin = jnp.cos(ang), jnp.sin(ang)
    tf = t.astype(F32).reshape(t.shape[:-1] + (t.shape[-1] // 2, 2))
    t1, t2 = tf[..., 0], tf[..., 1]
    return jnp.stack([t1 * cos - t2 * sin, t1 * sin + t2 * cos], axis=-1).reshape(t.shape)


def _short_conv(t, w):
    return lax.conv_general_dilated(t, w.astype(t.dtype)[:, None, :], window_strides=(1,),
                                    padding=[(DN_CONV // 2, DN_CONV // 2)],
                                    dimension_numbers=('NWC', 'WIO', 'NWC'),
                                    feature_group_count=t.shape[-1])


def _gla_mixer(q, k, v, g, gz_f, gz_b, lc, gk_w, gk_b):
    B_, T, _ = q.shape
    qh = q.astype(F32).reshape(B_, T, GLA_HEADS, GLA_DK) * GLA_DK ** -0.5
    kh = k.astype(F32).reshape(B_, T, GLA_HEADS, GLA_DK)
    vh = v.astype(F32).reshape(B_, T, GLA_HEADS, GLA_DV)

    def log_decay(z, d):
        logit = z.astype(F32) @ gk_w[d].astype(F32) + gk_b[d].astype(F32)
        return (jax.nn.log_sigmoid(logit) / GLA_GATE_NORM).reshape(B_, T, GLA_HEADS, GLA_DK)

    ctx_f, lat_f = _split_seq((qh, kh, vh, log_decay(gz_f, 0)), lc)
    ctx_b, lat_b = _split_seq((qh, kh, vh, log_decay(gz_b, 1)), lc)
    s0 = jnp.zeros((B_, GLA_HEADS, GLA_DK, GLA_DV), F32)
    o = _bidirectional(_gla_chunk, _gla_chunk, ctx_f, lat_f, ctx_b, lat_b, s0)
    o = _rmsnorm(o) * jax.nn.silu(g.astype(F32).reshape(B_, T, GLA_HEADS, GLA_DV))
    return o.reshape(B_, T, MIX_W)


def _ret_mixer(q, k, v, g, lc, rows, cols, decay_logit):
    B_, T, _ = q.shape
    qh = q.astype(F32).reshape(B_, T, RET_HEADS, RET_DK) * RET_DK ** -0.5
    kh = k.astype(F32).reshape(B_, T, RET_HEADS, RET_DK)
    vh = v.astype(F32).reshape(B_, T, RET_HEADS, RET_DV)
    (qc, kc, vc), (ql, kl, vl) = _split_seq((qh, kh, vh), lc)
    ctx_args = (qc, kc, vc)
    lat_args = (_axial_rope(ql, rows, cols), _axial_rope(kl, rows, cols), vl)
    log_gamma = jax.nn.log_sigmoid(decay_logit.astype(F32))
    run_f = functools.partial(_ret_chunk, log_gamma=log_gamma[0])
    run_b = functools.partial(_ret_chunk, log_gamma=log_gamma[1])
    s0 = jnp.zeros((B_, RET_HEADS, RET_DK, RET_DV), F32)
    o = _bidirectional(run_f, run_b, ctx_args, lat_args, ctx_args, lat_args, s0)
    o = _groupnorm(o) * jax.nn.silu(g.astype(F32).reshape(B_, T, RET_HEADS, RET_DV))
    return o.reshape(B_, T, MIX_W)


def _s5_mixer(u, lc, lam_re, lam_im, log_dt, b_re, b_im, c_re, c_im, d_skip, glu_w, glu_b):
    B_, T, _ = u.shape
    uf = u.astype(F32)
    ug = uf.reshape(B_, T, S5_GROUPS, S5_GROUP_CH)
    bu = lax.complex(jnp.einsum('gpc,btgc->btgp', b_re.astype(F32), ug),
                     jnp.einsum('gpc,btgc->btgp', b_im.astype(F32), ug))
    lam = lax.complex(lam_re.astype(F32), lam_im.astype(F32))
    dt = jnp.exp(log_dt.astype(F32))[..., None]
    lam_bar = jnp.exp(lam * dt)
    b_scale = (lam_bar - 1.0) / lam
    bu_f, bu_b = b_scale[0] * bu, b_scale[1] * bu
    ctx_f, lat_f = _split_seq((bu_f,), lc)
    ctx_b, lat_b = _split_seq((bu_b,), lc)
    run_f = functools.partial(_s5_scan, lam_bar=lam_bar[0])
    run_b = functools.partial(_s5_scan, lam_bar=lam_bar[1])
    h0 = jnp.zeros((B_, S5_GROUPS, S5_STATE), jnp.complex64)
    h = _bidirectional(run_f, run_b, ctx_f, lat_f, ctx_b, lat_b, h0)
    cmat = lax.complex(c_re.astype(F32), c_im.astype(F32))
    y = jnp.real(jnp.einsum('gcp,btgp->btgc', cmat, h)).reshape(B_, T, MIX_W) + d_skip.astype(F32) * uf
    y = jax.nn.gelu(y)
    return y * jax.nn.sigmoid(y @ glu_w.astype(F32) + glu_b.astype(F32))


def _dn_mixer(q, k, v, g, a, b, lc, conv_w, a_log, dt_bias):
    B_, T, _ = q.shape
    qkv = jnp.concatenate([q, k, v], axis=-1)
    qkv = jax.nn.silu(jnp.concatenate([_short_conv(qkv[:, :lc], conv_w),
                                       _short_conv(qkv[:, lc:], conv_w)], axis=1))
    q, k, v = jnp.split(qkv, [DN_HEADS * DN_DK, 2 * DN_HEADS * DN_DK], axis=-1)
    qh = _l2norm(q.reshape(B_, T, DN_HEADS, DN_DK)) * DN_DK ** -0.5
    kh = _l2norm(k.reshape(B_, T, DN_HEADS, DN_DK))
    vh = v.astype(F32).reshape(B_, T, DN_HEADS, DN_DV)
    a = a.astype(F32).reshape(B_, T, 2, DN_HEADS)
    b = b.astype(F32).reshape(B_, T, 2, DN_HEADS)
    log_a = -jnp.exp(a_log.astype(F32)) * jax.nn.softplus(a + dt_bias.astype(F32))
    beta = jax.nn.sigmoid(b)
    ctx_f, lat_f = _split_seq((qh, kh, vh, beta[:, :, 0], log_a[:, :, 0]), lc)
    ctx_b, lat_b = _split_seq((qh, kh, vh, beta[:, :, 1], log_a[:, :, 1]), lc)
    s0 = jnp.zeros((B_, DN_HEADS, DN_DK, DN_DV), F32)
    o = _bidirectional(_delta_chunk, _delta_chunk, ctx_f, lat_f, ctx_b, lat_b, s0)
    o = _rmsnorm(o) * jax.nn.silu(g.astype(F32).reshape(B_, T, DN_HEADS, DN_DV))
    return o.reshape(B_, T, MIX_W)


def _token_mixers(h, lc, rows, cols, w_in, gla_gk_w, gla_gk_b, ret_decay_logit, s5_lambda_re, s5_lambda_im,
                  s5_log_dt, s5_b_re, s5_b_im, s5_c_re, s5_c_im, s5_d, s5_glu_w, s5_glu_b,
                  dn_conv_w, dn_a_log, dn_dt_bias):
    p = h @ w_in
    cuts = np.cumsum(IN_SIZES)[:-1].tolist()
    (gq, gk, gv, gg, gz_f, gz_b, rq, rk, rv, rg, su,
     dq, dk, dv, dg, da, db) = jnp.split(p, cuts, axis=-1)
    o_gla = _gla_mixer(gq, gk, gv, gg, gz_f, gz_b, lc, gla_gk_w, gla_gk_b)
    o_ret = _ret_mixer(rq, rk, rv, rg, lc, rows, cols, ret_decay_logit)
    o_s5 = _s5_mixer(su, lc, s5_lambda_re, s5_lambda_im, s5_log_dt, s5_b_re, s5_b_im, s5_c_re, s5_c_im,
                     s5_d, s5_glu_w, s5_glu_b)
    o_dn = _dn_mixer(dq, dk, dv, dg, da, db, lc, dn_conv_w, dn_a_log, dn_dt_bias)
    return jnp.concatenate([o_gla, o_ret, o_s5, o_dn], axis=-1).astype(h.dtype)


def _moe(h, router_w, router_b, w_gate, w_up, w_down):
    scores = jax.nn.sigmoid(h.astype(F32) @ router_w.astype(F32))
    sel = scores + router_b.astype(F32)
    grp_score = lax.top_k(sel.reshape(-1, N_GROUPS, EXPERTS_PER_GROUP), TOP_K)[0].sum(-1)
    best = jnp.argmax(grp_score, axis=-1)
    in_grp = (jnp.arange(N_EXPERTS) // EXPERTS_PER_GROUP)[None, :] == best[:, None]
    _, idx = lax.top_k(jnp.where(in_grp, sel, -jnp.inf), TOP_K)
    w = jnp.take_along_axis(scores, idx, axis=-1)
    w = w / jnp.sum(w, axis=-1, keepdims=True)
    combine = jnp.sum(jax.nn.one_hot(idx, N_EXPERTS, dtype=F32) * w[..., None], axis=1)
    out = jnp.zeros(h.shape, F32)
    for e in range(N_EXPERTS):
        act = jax.nn.silu(h @ w_gate[e]) * (h @ w_up[e])
        out = out + combine[:, e:e + 1] * (act @ w_down[e])
    return out.astype(h.dtype)


def setup_inputs(seed: int = 0) -> dict:
    key = jax.random.key(seed)
    ks = jax.random.split(key, 31)

    def nrm(k, shape, scale):
        return jax.random.normal(k, shape, F32) * scale

    gammas = 1.0 - 2.0 ** (-5.0 - jnp.arange(RET_HEADS, dtype=F32))
    ret_logit = jnp.log(gammas) - jnp.log1p(-gammas)
    s5_n = jnp.arange(S5_STATE, dtype=F32)
    dt_dn = jnp.exp(jax.random.uniform(ks[24], (DEPTH, 2, DN_HEADS), F32, math.log(1e-3), math.log(1e-1)))
    return {
        'x': nrm(ks[0], (BATCH, SEQ, D_MODEL), 1.0),
        'c': nrm(ks[1], (BATCH, D_MODEL), 1.0),
        'ctx': nrm(ks[2], (BATCH, CTX_LEN, D_MODEL), 1.0),
        'c_ctx': nrm(ks[3], (D_MODEL,), 1.0),
        'w_ada': nrm(ks[4], (DEPTH, D_MODEL, N_MOD * D_MODEL), 0.5 * D_MODEL ** -0.5),
        'b_ada': nrm(ks[5], (DEPTH, N_MOD * D_MODEL), 0.02),
        'norm_g': 1.0 + nrm(ks[6], (DEPTH, 2, D_MODEL), 0.02),
        'w_in': nrm(ks[7], (DEPTH, D_MODEL, D_IN), D_MODEL ** -0.5),
        'w_out': nrm(ks[8], (DEPTH, D_MIX, D_MODEL), D_MIX ** -0.5),
        'gla_gk_w': nrm(ks[9], (DEPTH, 2, GLA_RANK, GLA_HEADS * GLA_DK), GLA_RANK ** -0.5),
        'gla_gk_b': nrm(ks[10], (DEPTH, 2, GLA_HEADS * GLA_DK), 0.1),
        'ret_decay_logit': ret_logit + nrm(ks[11], (DEPTH, 2, RET_HEADS), 0.01),
        's5_lambda_re': -0.5 + nrm(ks[12], (DEPTH, 2, S5_GROUPS, S5_STATE), 0.01),
        's5_lambda_im': math.pi * s5_n + nrm(ks[13], (DEPTH, 2, S5_GROUPS, S5_STATE), 0.01),
        's5_log_dt': jax.random.uniform(ks[14], (DEPTH, 2, S5_GROUPS), F32, math.log(1e-3), math.log(1e-1)),
        's5_b_re': nrm(ks[15], (DEPTH, S5_GROUPS, S5_STATE, S5_GROUP_CH), (2 * S5_GROUP_CH) ** -0.5),
        's5_b_im': nrm(ks[16], (DEPTH, S5_GROUPS, S5_STATE, S5_GROUP_CH), (2 * S5_GROUP_CH) ** -0.5),
        's5_c_re': nrm(ks[17], (DEPTH, S5_GROUPS, S5_GROUP_CH, S5_STATE), (2 * S5_STATE) ** -0.5),
        's5_c_im': nrm(ks[18], (DEPTH, S5_GROUPS, S5_GROUP_CH, S5_STATE), (2 * S5_STATE) ** -0.5),
        's5_d': nrm(ks[19], (DEPTH, MIX_W), 1.0),
        's5_glu_w': nrm(ks[20], (DEPTH, MIX_W, MIX_W), MIX_W ** -0.5),
        's5_glu_b': nrm(ks[21], (DEPTH, MIX_W), 0.02),
        'dn_conv_w': nrm(ks[22], (DEPTH, DN_CONV, 3 * DN_HEADS * DN_DK), DN_CONV ** -0.5),
        'dn_a_log': jnp.log(jax.random.uniform(ks[23], (DEPTH, 2, DN_HEADS), F32, 1.0, 16.0)),
        'dn_dt_bias': dt_dn + jnp.log(-jnp.expm1(-dt_dn)),
        'router_w': nrm(ks[25], (D_MODEL, N_EXPERTS), D_MODEL ** -0.5),
        'router_b': nrm(ks[26], (N_EXPERTS,), 0.01),
        'moe_w_gate': nrm(ks[27], (DEPTH, N_EXPERTS, D_MODEL, D_FF_EXPERT), D_MODEL ** -0.5),
        'moe_w_up': nrm(ks[28], (DEPTH, N_EXPERTS, D_MODEL, D_FF_EXPERT), D_MODEL ** -0.5),
        'moe_w_down': nrm(ks[29], (DEPTH, N_EXPERTS, D_FF_EXPERT, D_MODEL), D_FF_EXPERT ** -0.5),
        'final_norm_g': 1.0 + nrm(ks[30], (D_MODEL,), 0.02),
    }


def reference(x, c, ctx, c_ctx, w_ada, b_ada, norm_g, w_in, w_out, gla_gk_w, gla_gk_b, ret_decay_logit,
              s5_lambda_re, s5_lambda_im, s5_log_dt, s5_b_re, s5_b_im, s5_c_re, s5_c_im, s5_d, s5_glu_w,
              s5_glu_b, dn_conv_w, dn_a_log, dn_dt_bias, router_w, router_b, moe_w_gate, moe_w_up,
              moe_w_down, final_norm_g):
    B_, L, D = x.shape
    lc = ctx.shape[1]
    n_rows = L // GRID_W
    pos = jnp.arange(n_rows * GRID_W)
    rows = (pos // GRID_W).astype(F32)
    cols = (pos % GRID_W).astype(F32)
    silu_c = jax.nn.silu(c)
    silu_cc = jax.nn.silu(c_ctx)
    z = ctx
    for i in range(DEPTH):
        last = i == DEPTH - 1
        mod_l = (silu_c @ w_ada[i] + b_ada[i]).reshape(B_, N_MOD, 1, D)
        mod_c = (silu_cc @ w_ada[i] + b_ada[i]).reshape(N_MOD, 1, D)
        h = jnp.concatenate([_modulate(z, norm_g[i, 0], mod_c[0], mod_c[1]),
                             _modulate(x, norm_g[i, 0], mod_l[:, 0], mod_l[:, 1])], axis=1)
        mix = _token_mixers(h, lc, rows, cols, w_in[i], gla_gk_w[i], gla_gk_b[i], ret_decay_logit[i],
                            s5_lambda_re[i], s5_lambda_im[i], s5_log_dt[i], s5_b_re[i], s5_b_im[i],
                            s5_c_re[i], s5_c_im[i], s5_d[i], s5_glu_w[i], s5_glu_b[i],
                            dn_conv_w[i], dn_a_log[i], dn_dt_bias[i])
        if last:
            mix = mix[:, lc:]
        mix = mix @ w_out[i]
        x = x + mod_l[:, 2] * mix[:, -L:]
        if last:
            h2 = _modulate(x, norm_g[i, 1], mod_l[:, 3], mod_l[:, 4])
        else:
            z = z + mod_c[2] * mix[:, :lc]
            h2 = jnp.concatenate([_modulate(z, norm_g[i, 1], mod_c[3], mod_c[4]),
                                  _modulate(x, norm_g[i, 1], mod_l[:, 3], mod_l[:, 4])], axis=1)
        f = _moe(h2.reshape(-1, D), router_w, router_b, moe_w_gate[i], moe_w_up[i],
                 moe_w_down[i]).reshape(h2.shape)
        x = x + mod_l[:, 5] * f[:, -L:]
        if not last:
            z = z + mod_c[5] * f[:, :lc]
    return _rmsnorm(x, final_norm_g)
```

```cpp
#include <hip/hip_runtime.h>
#include <cstdio>
#include <cstdint>

#define LAS __attribute__((address_space(3)))
typedef unsigned short bf16_t;
typedef short bf16x8 __attribute__((ext_vector_type(8)));
typedef float f32x4 __attribute__((ext_vector_type(4)));
typedef float f32x2 __attribute__((ext_vector_type(2)));
typedef unsigned u32x4 __attribute__((ext_vector_type(4)));
typedef unsigned u32x2 __attribute__((ext_vector_type(2)));

constexpr int D = 1024, NB = 16, SEQ = 2048, LC = 256, TT = 2304, NTOK = NB * TT;
constexpr int DIN = 3120, NWIN = 3328, NPANEL = 13, NVB = 256;
constexpr float EPS = 1e-6f;
constexpr size_t PANEL_EL = (size_t)NTOK * 256;
constexpr int MAXTILES = 168, MAXSLOT = MAXTILES * 256;

constexpr size_t WS_CTL = 0;
constexpr size_t WS_MOD = 65536;
constexpr size_t WS_Z = WS_MOD + 1048576;
constexpr size_t WS_WIN = WS_Z + (size_t)NB * LC * D * 4;
constexpr size_t WS_WOUT = WS_WIN + (size_t)2 * NWIN * D * 2;
constexpr size_t WS_WGU = WS_WOUT + (size_t)2 * D * D * 2;
constexpr size_t WS_WDN = WS_WGU + (size_t)16 * 1024 * 1024 * 2;
constexpr size_t WS_P = WS_WDN + (size_t)16 * 1024 * 512 * 2;
constexpr size_t WS_ABUF = WS_P + NPANEL * PANEL_EL * 2;
constexpr size_t WS_GDEC = WS_ABUF + (size_t)NTOK * D * 2;
constexpr size_t WS_DNAB = WS_GDEC + (size_t)NTOK * 256 * 4;
constexpr size_t WS_O = WS_DNAB + (size_t)NTOK * 16 * 4;
constexpr size_t WS_ROUTE = WS_O + 4 * PANEL_EL * 2;
constexpr size_t WS_HIST = WS_ROUTE + (size_t)NTOK * 16;
constexpr size_t WS_LIST = WS_HIST + 256 * 32 * 4;
constexpr size_t WS_SLOTW = WS_LIST + 196608;
constexpr size_t WS_TILE = WS_SLOTW + 393216;
constexpr size_t WS_END = WS_TILE + 4096;
static_assert(WS_END <= (size_t)512 * 1024 * 1024, "workspace");
static_assert((size_t)MAXSLOT * 4 <= 196608 && (size_t)MAXSLOT * 8 <= 393216 && (size_t)MAXSLOT * D * 2 <= NPANEL * PANEL_EL * 2, "moe buffers");

constexpr int LDS_WAVE = 18432;
constexpr int LDS_BAR_OFF = 8 * LDS_WAVE;
constexpr int LDS_BYTES = LDS_BAR_OFF + 256;

#ifndef PHASE_MASK
#define PHASE_MASK 0xFFFF
#endif
struct Params { const float* in[31]; float* out; unsigned char* ws; };
typedef const Params __attribute__((address_space(4)))* KP;
__device__ __forceinline__ KP kp_launder(KP p) { asm volatile("" : "+s"(p)); return p; }
__device__ __forceinline__ int bid_launder() { int b = blockIdx.x; asm volatile("" : "+s"(b)); return b; }
__device__ __forceinline__ int tid_launder() { int t = threadIdx.x; asm volatile("" : "+v"(t)); return t; }
enum { I_X = 0, I_C, I_CTX, I_CCTX, I_WADA, I_BADA, I_NORMG, I_WIN, I_WOUT, I_GKW, I_GKB, I_RETD, I_S5LRE, I_S5LIM, I_S5DT, I_S5BRE, I_S5BIM, I_S5CRE, I_S5CIM,
       I_S5D, I_GLUW, I_GLUB, I_CONVW, I_ALOG, I_DTB, I_RW, I_RB, I_WG, I_WU, I_WD, I_FNG };

__device__ __forceinline__ float bf2f(unsigned v) { return __uint_as_float(v << 16); }
__device__ __forceinline__ float bflo(unsigned v) { return __uint_as_float(v << 16); }
__device__ __forceinline__ float bfhi(unsigned v) { return __uint_as_float(v & 0xffff0000u); }
typedef __bf16 bf16v2 __attribute__((ext_vector_type(2)));
__device__ __forceinline__ unsigned pk_bf16(float lo, float hi) { const f32x2 v = {lo, hi}; return __builtin_bit_cast(unsigned, __builtin_convertvector(v, bf16v2)); }
__device__ __forceinline__ float sigmoidf_(float x) { return 1.f / (1.f + __expf(-x)); }
__device__ __forceinline__ float siluf_(float x) { return x / (1.f + __expf(-x)); }
__device__ __forceinline__ float softplusf_(float x) { return fmaxf(x, 0.f) + log1pf(__expf(-fabsf(x))); }
__device__ __forceinline__ float wave_sum(float v) {
#pragma unroll
    for (int o = 32; o >= 1; o >>= 1) v += __shfl_xor(v, o, 64);
    return v;
}
__device__ __forceinline__ float half_sum32(float v) {
#pragma unroll
    for (int o = 16; o >= 1; o >>= 1) v += __shfl_xor(v, o, 64);
    return v;
}
__device__ __forceinline__ float quad_sum(float v) {
    v += __builtin_bit_cast(float, __builtin_amdgcn_update_dpp(0, __builtin_bit_cast(int, v), 0xB1, 0xF, 0xF, true));
    v += __builtin_bit_cast(float, __builtin_amdgcn_update_dpp(0, __builtin_bit_cast(int, v), 0x4E, 0xF, 0xF, true));
    return v;
}
#define WAVE_LDS_SYNC() asm volatile("s_waitcnt lgkmcnt(0)" ::: "memory")
__device__ __forceinline__ const float* res_row_c(const float* lat, const float* ctx, int m) { const int b = m / TT, t = m - b * TT; return t < LC ? ctx + (size_t)(b * LC + t) * D : lat + (size_t)(b * SEQ + t - LC) * D; }
__device__ __forceinline__ float* res_row(float* lat, float* ctx, int m) { const int b = m / TT, t = m - b * TT; return t < LC ? ctx + (size_t)(b * LC + t) * D : lat + (size_t)(b * SEQ + t - LC) * D; }

#define XB_TMO      128
#define XB_XCNT(j)  (256  + 64 * (j))
#define XB_XSUB(j)  (1280 + 64 * (j))
#define XB_XGEN(j)  (2304 + 64 * (j))
#define XB_TOP      3328
#define XB_TOPGEN   3392
#define XCD_BAR_WORDS 3456
#define XB_SPIN_CAP (1u << 18)

__device__ __forceinline__ unsigned xb_ld(unsigned* p)              { return __hip_atomic_load(p, __ATOMIC_RELAXED, __HIP_MEMORY_SCOPE_AGENT); }
__device__ __forceinline__ unsigned xb_add(unsigned* p, unsigned v) { return __hip_atomic_fetch_add(p, v, __ATOMIC_RELAXED, __HIP_MEMORY_SCOPE_AGENT); }
__device__ __forceinline__ unsigned xb_xcc_id() { return (unsigned)__builtin_amdgcn_s_getreg((3 << 11) | 20) & 0xFu; }
#define XB_SPIN(cond, bar) do { unsigned _sp = 0; while (cond) { __builtin_amdgcn_s_sleep(1); \
    if ((++_sp & 255u) == 0u) { if (xb_ld(&(bar)[XB_TMO])) break; if (_sp > XB_SPIN_CAP) { atomicAdd(&(bar)[XB_TMO], 1u); break; } } } } while (0)

struct XcdBarrier { unsigned* bar; unsigned x; volatile LAS unsigned* st; };

__device__ __forceinline__ XcdBarrier xcd_barrier_post(unsigned* bar, volatile LAS unsigned* st) {
    XcdBarrier b; b.bar = bar; b.x = xb_xcc_id(); b.st = st;
    if (threadIdx.x == 0) (void)xb_add(&bar[XB_XCNT(b.x)], 1u);
    return b;
}
__device__ __forceinline__ void xcd_barrier_complete(unsigned* bar, unsigned x, unsigned& nloc, unsigned& nx) {
    const unsigned G = gridDim.x * gridDim.y * gridDim.z;
    unsigned sum, cnt, mine, sp = 0u;
    for (;;) {
        sum = 0u; cnt = 0u; mine = 0u;
#pragma unroll
        for (unsigned j = 0; j < 16; ++j) { const unsigned c = xb_ld(&bar[XB_XCNT(j)]); sum += c; cnt += (c > 0u) ? 1u : 0u; mine = (j == x) ? c : mine; }
        if (sum == G) break;
        __builtin_amdgcn_s_sleep(1);
        if ((++sp & 255u) == 0u) { if (xb_ld(&bar[XB_TMO])) break; if (sp > XB_SPIN_CAP) { atomicAdd(&bar[XB_TMO], 1u); break; } }
    }
    nloc = mine > 0u ? mine : 1u; nx = cnt > 0u ? cnt : 1u;
}
__device__ __forceinline__ void xcd_barrier(const XcdBarrier& b) {
    asm volatile("s_waitcnt vmcnt(0)" ::: "memory");
    __syncthreads();
    if (threadIdx.x == 0) {
        unsigned* bar = b.bar;
        __builtin_amdgcn_s_waitcnt(0);
        unsigned nloc = b.st[0], nx = b.st[1];
        if (nloc == 0u) { xcd_barrier_complete(bar, b.x, nloc, nx); b.st[0] = nloc; b.st[1] = nx; }
        const unsigned old = xb_add(&bar[XB_XSUB(b.x)], 1u);
        const unsigned gen = old / nloc;
        if (old + 1u == (gen + 1u) * nloc) {
            __builtin_amdgcn_fence(__ATOMIC_RELEASE, "agent");
            asm volatile("s_waitcnt vmcnt(0)" ::: "memory");
            const unsigned og = xb_add(&bar[XB_TOP], 1u);
            const unsigned tg = og / nx;
            if (og + 1u == (tg + 1u) * nx) xb_add(&bar[XB_TOPGEN], 1u);
            else XB_SPIN(xb_ld(&bar[XB_TOPGEN]) == tg, bar);
            __builtin_amdgcn_fence(__ATOMIC_ACQUIRE, "agent");
            xb_add(&bar[XB_XGEN(b.x)], 1u);
            asm volatile("s_waitcnt vmcnt(0)" ::: "memory");
        } else {
            XB_SPIN(xb_ld(&bar[XB_XGEN(b.x)]) == gen, bar);
            __builtin_amdgcn_fence(__ATOMIC_ACQUIRE, "agent");
            asm volatile("s_waitcnt vmcnt(0)" ::: "memory");
        }
    }
    __syncthreads();
}

namespace pg8 {
constexpr int BM = 256, BK = 64, HALF = 128, HTB = HALF * BK * 2, STAGE_BYTES = 8 * HTB, NXCD = 8, WGM = 8;
__device__ __forceinline__ int lds_byte(int r, int c) { const int st = (r >> 4) * 2 + (c >> 5), rr = r & 15, cc = c & 31, ob = rr * 64 + cc * 2; return st * 1024 + (ob ^ (((ob >> 9) & 1) << 5)); }
__device__ __forceinline__ void stage_rc(int b, int& R, int& C) { const int st = b / 1024, sb = b % 1024, swz = sb ^ (((sb >> 9) & 1) << 5); R = (st >> 1) * 16 + swz / 64; C = (st & 1) * 32 + (swz % 64) / 2; }
__device__ __forceinline__ int perm32(int rho) { const int n = rho >> 4, i = rho & 15; return 8 * (i >> 2) + 4 * n + (i & 3); }

__device__ __forceinline__ bool static_order(int i, int G, int c, int nM, int nN, int& pm, int& pn) {
    const int nwg = nM * nN; const long L = (long)i * G + c; if (L >= nwg) return false;
    int wgid = (int)L; { const int q = nwg / NXCD, r = nwg % NXCD, xcd = wgid % NXCD, off = wgid / NXCD; wgid = (xcd < r ? xcd * (q + 1) : r * (q + 1) + (xcd - r) * q) + off; }
    const int nig = WGM * nN, gid = wgid / nig, fm = gid * WGM, gsz = (nM - fm) < WGM ? (nM - fm) : WGM;
    pm = fm + ((wgid % nig) % gsz); pn = (wgid % nig) / gsz; return true;
}

template <class DSC>
__device__ __forceinline__ void gemm_phase(LAS unsigned char* lds, const DSC& S) {
    const int tid = tid_launder(), wid = __builtin_amdgcn_readfirstlane(tid >> 6), lane = tid & 63, wr = wid >> 2, wc = wid & 3, fr = lane & 15, fq = lane >> 4;
    constexpr int K = DSC::K, nt = K / BK, LDB = DSC::LDB;
    int sR[2], sC[2]; unsigned voffB[2];
#pragma unroll
    for (int i = 0; i < 2; ++i) { int R, C; stage_rc(tid * 16 + i * 8192, R, C); sR[i] = R; sC[i] = C; const int Rb = DSC::PERM ? ((R & ~31) + perm32(R & 31)) : R; voffB[i] = (unsigned)(Rb * LDB + C) * 2u; }
    constexpr size_t kstep = (size_t)(BK * 2);
    constexpr size_t hstepB = (size_t)HALF * LDB * 2;
    const unsigned ldsw = (unsigned)wid * 1024u;
    const int aoff = lds_byte(wr * 64 + fr, fq * 8), boff = lds_byte(wc * 32 + fr, fq * 8);
#define PG8_SA(b, h) (((b) * 2 + (h)) * HTB)
#define PG8_SB(b, h) ((4 + (b) * 2 + (h)) * HTB)
#define PG8_STAGE(bufoff, gbase, voff) do { _Pragma("unroll") for (int _i = 0; _i < 2; ++_i) \
        __builtin_amdgcn_global_load_lds((const unsigned*)((const char*)(gbase) + (voff)[_i]), (LAS unsigned*)(lds + (bufoff) + ldsw + _i * 8192), 16, 0, 0); } while (0)
#define PG8_LDA(dst, b, h) do { _Pragma("unroll") for (int m = 0; m < 4; ++m) _Pragma("unroll") for (int k = 0; k < 2; ++k) dst[m][k] = *(const LAS bf16x8*)(lds + PG8_SA(b, h) + aoff + m * 2048 + k * 1024); } while (0)
#define PG8_LDB(dst, b, h) do { _Pragma("unroll") for (int n = 0; n < 2; ++n) _Pragma("unroll") for (int k = 0; k < 2; ++k) dst[n][k] = *(const LAS bf16x8*)(lds + PG8_SB(b, h) + boff + n * 2048 + k * 1024); } while (0)
#define PG8_MMA(ai, bj, At, Bt) do { __builtin_amdgcn_s_setprio(1); _Pragma("unroll") for (int m = 0; m < 4; ++m) _Pragma("unroll") for (int n = 0; n < 2; ++n) _Pragma("unroll") for (int k = 0; k < 2; ++k) \
        acc[ai][bj][m][n] = __builtin_amdgcn_mfma_f32_16x16x32_bf16(Bt[n][k], At[m][k], acc[ai][bj][m][n], 0, 0, 0); __builtin_amdgcn_s_setprio(0); } while (0)
#define PG8_WAIT_V(n) asm volatile("s_waitcnt vmcnt(" #n ")" ::: "memory")
#define PG8_WAIT_L(n) asm volatile("s_waitcnt lgkmcnt(" #n ")" ::: "memory")
#define PG8_BAR __builtin_amdgcn_s_barrier()
#define PG8_SCHED __builtin_amdgcn_sched_barrier(0)
    typename DSC::Unit cur, nxt; int ui = 0;
    if (!S.next(0, cur)) return;
    f32x4 acc[2][2][4][2];
#pragma unroll
    for (int a = 0; a < 2; ++a)
#pragma unroll
        for (int b = 0; b < 2; ++b)
#pragma unroll
            for (int m = 0; m < 4; ++m)
#pragma unroll
                for (int n = 0; n < 2; ++n) acc[a][b][m][n] = (f32x4){0.f, 0.f, 0.f, 0.f};
    bf16x8 At[4][2], B0[2][2], B1[2][2];
    constexpr size_t hstepA = (size_t)HALF * 1024 * 2;
    unsigned va[2][2], vn[2][2];
#define PG8_STAGE_A(bufoff, h, gb, V) do { if constexpr (DSC::GATHER) { PG8_STAGE(bufoff, gb, V[h]); } else { PG8_STAGE(bufoff, (gb) + (h) * hstepA, V[0]); } } while (0)
    const char* cA = S.a_base(cur); S.a_off(cur, sR, sC, va);
    const char* cBl = S.b_lo(cur); const char* cBh = S.b_hi(cur);
    PG8_STAGE(PG8_SB(0, 0), cBl, voffB); PG8_STAGE_A(PG8_SA(0, 0), 0, cA, va); PG8_STAGE(PG8_SB(0, 1), cBl + hstepB, voffB); PG8_STAGE_A(PG8_SA(0, 1), 1, cA, va);
    if (wr == 1) PG8_BAR;
    PG8_WAIT_V(4); PG8_BAR;
    PG8_STAGE(PG8_SB(1, 0), cBl + kstep, voffB); PG8_STAGE_A(PG8_SA(1, 0), 0, cA + kstep, va); PG8_STAGE(PG8_SB(1, 1), cBl + hstepB + kstep, voffB);
    PG8_WAIT_V(6); PG8_BAR;
    for (;;) {
        const bool has_next = S.next(ui + 1, nxt);
        const char* nA; const char* nBl; const char* nBh;
        if (has_next) { nA = S.a_base(nxt); nBl = S.b_lo(nxt); nBh = S.b_hi(nxt); if constexpr (DSC::GATHER) S.a_off(nxt, sR, sC, vn); }
        else { nA = cA; nBl = cBl; nBh = cBh;
            if constexpr (DSC::GATHER) {
#pragma unroll
                for (int h = 0; h < 2; ++h)
#pragma unroll
                    for (int i = 0; i < 2; ++i) vn[h][i] = va[h][i]; } }
        for (int t = 0; t < nt; t += 2) {
            const bool last = (t == nt - 2);
            const char* a1 = cA + (size_t)(t + 1) * kstep;
            const char* a2 = last ? nA : cA + (size_t)(t + 2) * kstep;
            const char* b2 = last ? nBl : ((t + 2) < nt / 2 ? cBl : cBh) + (size_t)(t + 2) * kstep;
            const char* a3 = a2 + kstep; const char* b3 = b2 + kstep;
            unsigned vs[2][2];
#pragma unroll
            for (int h = 0; h < 2; ++h)
#pragma unroll
                for (int i = 0; i < 2; ++i) vs[h][i] = (DSC::GATHER && last) ? vn[h][i] : va[h][i];
            PG8_LDB(B0, 0, 0); PG8_SCHED; PG8_LDA(At, 0, 0); PG8_STAGE_A(PG8_SA(1, 1), 1, a1, va);
            PG8_WAIT_L(8); PG8_BAR; PG8_WAIT_L(0); PG8_MMA(0, 0, At, B0); PG8_BAR; PG8_SCHED;
            PG8_LDB(B1, 0, 1); PG8_STAGE(PG8_SB(0, 0), b2, voffB);
            PG8_BAR; PG8_WAIT_L(0); PG8_MMA(0, 1, At, B1); PG8_BAR;
            PG8_LDA(At, 0, 1); PG8_STAGE_A(PG8_SA(0, 0), 0, a2, vs);
            PG8_BAR; PG8_WAIT_L(0); PG8_MMA(1, 0, At, B0); PG8_BAR; PG8_SCHED;
            PG8_STAGE(PG8_SB(0, 1), b2 + hstepB, voffB);
            PG8_WAIT_V(6); PG8_BAR; PG8_MMA(1, 1, At, B1); PG8_BAR;
            PG8_LDB(B0, 1, 0); PG8_SCHED; PG8_LDA(At, 1, 0); PG8_STAGE_A(PG8_SA(0, 1), 1, a2, vs);
            PG8_WAIT_L(8); PG8_BAR; PG8_WAIT_L(0); PG8_MMA(0, 0, At, B0); PG8_BAR; PG8_SCHED;
            PG8_LDB(B1, 1, 1); PG8_STAGE(PG8_SB(1, 0), b3, voffB);
            PG8_BAR; PG8_WAIT_L(0); PG8_MMA(0, 1, At, B1); PG8_BAR;
            PG8_LDA(At, 1, 1); PG8_STAGE_A(PG8_SA(1, 0), 0, a3, vs);
            PG8_BAR; PG8_WAIT_L(0); PG8_MMA(1, 0, At, B0); PG8_BAR; PG8_SCHED;
            PG8_STAGE(PG8_SB(1, 1), b3 + hstepB, voffB);
            PG8_WAIT_V(6); PG8_BAR; PG8_MMA(1, 1, At, B1); PG8_BAR;
        }
        S.epi(acc, cur, wr, wc, fr, fq);
        if (!has_next) break;
#pragma unroll
        for (int a = 0; a < 2; ++a)
#pragma unroll
            for (int b = 0; b < 2; ++b)
#pragma unroll
                for (int m = 0; m < 4; ++m)
#pragma unroll
                    for (int n = 0; n < 2; ++n) acc[a][b][m][n] = (f32x4){0.f, 0.f, 0.f, 0.f};
        cur = nxt; cA = nA; cBl = nBl; cBh = nBh; ++ui;
        if constexpr (DSC::GATHER) {
#pragma unroll
            for (int h = 0; h < 2; ++h)
#pragma unroll
                for (int i = 0; i < 2; ++i) va[h][i] = vn[h][i]; }
    }
    PG8_WAIT_V(0);
    if (wr == 0) PG8_BAR;
    PG8_BAR;
#undef PG8_SA
#undef PG8_SB
#undef PG8_STAGE
#undef PG8_STAGE_A
#undef PG8_LDA
#undef PG8_LDB
#undef PG8_MMA
#undef PG8_WAIT_V
#undef PG8_WAIT_L
#undef PG8_BAR
#undef PG8_SCHED
}
}

__device__ __forceinline__ void std_a_off(const int (&sR)[2], const int (&sC)[2], unsigned (&v)[2][2]) {
#pragma unroll
    for (int h = 0; h < 2; ++h)
#pragma unroll
        for (int i = 0; i < 2; ++i) v[h][i] = (unsigned)((sR[i] + 128 * h) * 1024 + sC[i]) * 2u;
}
struct Dsc1 {
    static constexpr int K = 1024, LDB = 1024; static constexpr bool PERM = true, GATHER = false;
    struct Unit { int pm, pn; };
    const bf16_t* A; const bf16_t* Bt; bf16_t* P; int G, c;
    __device__ __forceinline__ bool next(int i, Unit& u) const { return pg8::static_order(i, G, c, NTOK / 256, NPANEL, u.pm, u.pn); }
    __device__ __forceinline__ const char* a_base(const Unit& u) const { return (const char*)A + (size_t)u.pm * 256 * 1024 * 2; }
    __device__ __forceinline__ void a_off(const Unit&, const int (&sR)[2], const int (&sC)[2], unsigned (&v)[2][2]) const { std_a_off(sR, sC, v); }
    __device__ __forceinline__ const char* b_lo(const Unit& u) const { return (const char*)Bt + (size_t)u.pn * 256 * 1024 * 2; }
    __device__ __forceinline__ const char* b_hi(const Unit& u) const { return b_lo(u); }
    __device__ __forceinline__ void epi(const f32x4 (&acc)[2][2][4][2], const Unit& u, int wr, int wc, int fr, int fq) const {
        bf16_t* base = P + (size_t)u.pn * PANEL_EL + (size_t)(u.pm * 256 + wr * 64 + fr) * 256 + wc * 32 + 8 * fq;
#pragma unroll
        for (int ai = 0; ai < 2; ++ai)
#pragma unroll
            for (int m = 0; m < 4; ++m) { bf16_t* rowp = base + (size_t)(ai * 128 + m * 16) * 256;
#pragma unroll
                for (int bj = 0; bj < 2; ++bj) { const f32x4 v0 = acc[ai][bj][m][0], v1 = acc[ai][bj][m][1];
                    *(u32x4*)(rowp + bj * 128) = (u32x4){pk_bf16(v0[0], v0[1]), pk_bf16(v0[2], v0[3]), pk_bf16(v1[0], v1[1]), pk_bf16(v1[2], v1[3])}; } }
    }
};
struct Dsc2 {
    static constexpr int K = 1024, LDB = 1024; static constexpr bool PERM = false, GATHER = false;
    struct Unit { int pm, pn; };
    const bf16_t* A; const bf16_t* Bt; const float* lat_in; const float* ctx_in; float* lat_out; float* ctx_out; const float* mod; int G, c, last;
    __device__ __forceinline__ bool next(int i, Unit& u) const {
        int pm, pn; if (!pg8::static_order(i, G, c, last ? 128 : 144, 4, pm, pn)) return false;
        u.pm = last ? (pm >> 3) * 9 + 1 + (pm & 7) : pm; u.pn = pn; return true; }
    __device__ __forceinline__ const char* a_base(const Unit& u) const { return (const char*)A + (size_t)u.pm * 256 * 1024 * 2; }
    __device__ __forceinline__ void a_off(const Unit&, const int (&sR)[2], const int (&sC)[2], unsigned (&v)[2][2]) const { std_a_off(sR, sC, v); }
    __device__ __forceinline__ const char* b_lo(const Unit& u) const { return (const char*)Bt + (size_t)u.pn * 256 * 1024 * 2; }
    __device__ __forceinline__ const char* b_hi(const Unit& u) const { return b_lo(u); }
    __device__ __forceinline__ void epi(const f32x4 (&acc)[2][2][4][2], const Unit& u, int wr, int wc, int fr, int fq) const {
        const int b = u.pm / 9, pp = u.pm - b * 9;
        const size_t ro = pp == 0 ? (size_t)b * LC * D : ((size_t)b * SEQ + (size_t)(pp - 1) * 256) * D;
        const float* inb = (pp == 0 ? ctx_in : lat_in) + ro; float* outb = (pp == 0 ? ctx_out : lat_out) + ro;
        const int col0 = u.pn * 256 + wc * 32 + 4 * fq, row0 = wr * 64 + fr;
        const float* gate = mod + (size_t)(pp == 0 ? 16 : b) * 6144 + 2 * 1024 + col0;
        f32x4 gv[2][2];
#pragma unroll
        for (int bj = 0; bj < 2; ++bj)
#pragma unroll
            for (int n = 0; n < 2; ++n) gv[bj][n] = *(const f32x4*)(gate + bj * 128 + n * 16);
#pragma unroll
        for (int ai = 0; ai < 2; ++ai)
#pragma unroll
            for (int m = 0; m < 4; ++m) { const size_t o = (size_t)(row0 + ai * 128 + m * 16) * D + col0;
#pragma unroll
                for (int bj = 0; bj < 2; ++bj)
#pragma unroll
                    for (int n = 0; n < 2; ++n) { const f32x4 x = *(const f32x4*)(inb + o + bj * 128 + n * 16);
                        *(f32x4*)(outb + o + bj * 128 + n * 16) = x + gv[bj][n] * acc[ai][bj][m][n]; } }
    }
};
__device__ __forceinline__ void bucket_experts(int bk, int& elo, int& ehi) {
    const int gr = bk / 6, pr = bk - gr * 6;
    const int i = pr < 3 ? 0 : (pr < 5 ? 1 : 2), j = pr < 3 ? pr + 1 : (pr < 5 ? pr - 1 : 3);
    elo = gr * 4 + i; ehi = gr * 4 + j;
}
struct Dsc3 {
    static constexpr int K = 1024, LDB = 1024; static constexpr bool PERM = true, GATHER = true;
    struct Unit { int ti, pn, elo, ehi; };
    const bf16_t* A; const bf16_t* Wgu; bf16_t* ACT; const int* list; const float* slotw; const int* tile; int G, c, nt_;
    __device__ __forceinline__ bool next(int i, Unit& u) const {
        if (!pg8::static_order(i, G, c, nt_, 8, u.ti, u.pn)) return false;
        const int bk = __builtin_amdgcn_readfirstlane(tile[8 + u.ti]); bucket_experts(bk, u.elo, u.ehi); return true; }
    __device__ __forceinline__ const char* a_base(const Unit&) const { return (const char*)A; }
    __device__ __forceinline__ void a_off(const Unit& u, const int (&sR)[2], const int (&sC)[2], unsigned (&v)[2][2]) const {
#pragma unroll
        for (int h = 0; h < 2; ++h)
#pragma unroll
            for (int i = 0; i < 2; ++i) { int tok = list[u.ti * 256 + sR[i] + 128 * h]; tok = tok < 0 ? 0 : tok; v[h][i] = (unsigned)(tok * 1024 + sC[i]) * 2u; }
    }
    __device__ __forceinline__ const char* b_lo(const Unit& u) const { const int e = u.pn < 4 ? u.elo : u.ehi; return (const char*)Wgu + ((size_t)e * 1024 + (size_t)(u.pn & 3) * 256) * 1024 * 2; }
    __device__ __forceinline__ const char* b_hi(const Unit& u) const { return b_lo(u); }
    __device__ __forceinline__ void epi(const f32x4 (&acc)[2][2][4][2], const Unit& u, int wr, int wc, int fr, int fq) const {
        const int slot0 = u.ti * 256 + wr * 64 + fr, wsel = u.pn < 4 ? 0 : 1;
        bf16_t* base = ACT + (size_t)slot0 * 1024 + (u.pn < 4 ? 0 : 512) + (u.pn & 3) * 128 + wc * 32 + 8 * fq;
#pragma unroll
        for (int ai = 0; ai < 2; ++ai)
#pragma unroll
            for (int m = 0; m < 4; ++m) { const int dr = ai * 128 + m * 16; const float w = slotw[(size_t)(slot0 + dr) * 2 + wsel];
                const f32x4 g0 = acc[ai][0][m][0], g1 = acc[ai][0][m][1], u0 = acc[ai][1][m][0], u1 = acc[ai][1][m][1];
                float r[8];
#pragma unroll
                for (int q = 0; q < 4; ++q) { r[q] = w * siluf_(g0[q]) * u0[q]; r[4 + q] = w * siluf_(g1[q]) * u1[q]; }
                *(u32x4*)(base + (size_t)dr * 1024) = (u32x4){pk_bf16(r[0], r[1]), pk_bf16(r[2], r[3]), pk_bf16(r[4], r[5]), pk_bf16(r[6], r[7])}; }
    }
};
struct Dsc4 {
    static constexpr int K = 1024, LDB = 512; static constexpr bool PERM = false, GATHER = false;
    struct Unit { int ti, pn, elo, ehi; };
    const bf16_t* A; const bf16_t* Wdn; float* lat; float* ctx; const float* mod; const int* list; const int* tile; int G, c, nt_;
    __device__ __forceinline__ bool next(int i, Unit& u) const {
        if (!pg8::static_order(i, G, c, nt_, 4, u.ti, u.pn)) return false;
        const int bk = __builtin_amdgcn_readfirstlane(tile[8 + u.ti]); bucket_experts(bk, u.elo, u.ehi); return true; }
    __device__ __forceinline__ const char* a_base(const Unit& u) const { return (const char*)A + (size_t)u.ti * 256 * 1024 * 2; }
    __device__ __forceinline__ void a_off(const Unit&, const int (&sR)[2], const int (&sC)[2], unsigned (&v)[2][2]) const { std_a_off(sR, sC, v); }
    __device__ __forceinline__ const char* b_lo(const Unit& u) const { return (const char*)Wdn + ((size_t)u.elo * 1024 + (size_t)u.pn * 256) * 512 * 2; }
    __device__ __forceinline__ const char* b_hi(const Unit& u) const { return (const char*)Wdn + ((size_t)u.ehi * 1024 + (size_t)u.pn * 256) * 512 * 2 - (size_t)(K / 128) * 128; }
    __device__ __forceinline__ void epi(const f32x4 (&acc)[2][2][4][2], const Unit& u, int wr, int wc, int fr, int fq) const {
        const int slot0 = u.ti * 256 + wr * 64 + fr, col0 = u.pn * 256 + wc * 32 + 4 * fq;
#pragma unroll
        for (int ai = 0; ai < 2; ++ai)
#pragma unroll
            for (int m = 0; m < 4; ++m) { const int tok = list[slot0 + ai * 128 + m * 16];
                if (tok >= 0) { const int b = tok / TT, t = tok - b * TT;
                    float* rp = (t < LC ? ctx + (size_t)(b * LC + t) * D : lat + (size_t)(b * SEQ + t - LC) * D) + col0;
                    const float* gate = mod + (size_t)(t < LC ? 16 : b) * 6144 + 5 * 1024 + col0;
#pragma unroll
                    for (int bj = 0; bj < 2; ++bj)
#pragma unroll
                        for (int n = 0; n < 2; ++n) { const f32x4 gv = *(const f32x4*)(gate + bj * 128 + n * 16); const f32x4 x = *(const f32x4*)(rp + bj * 128 + n * 16);
                            *(f32x4*)(rp + bj * 128 + n * 16) = x + gv * acc[ai][bj][m][n]; } } }
    }
};

__device__ __forceinline__ void tr_tile(LAS float* tl, const float* src, int ld, int scol, float scale, bf16_t* dst, int lddst) {
    const int tid = tid_launder(), n = tid & 63, kq = tid >> 6;
#pragma unroll
    for (int i = 0; i < 8; ++i) { const int k = kq + 8 * i; tl[k * 65 + n] = scol >= 0 ? src[(size_t)k * ld + scol] * scale : 0.f; }
    __syncthreads();
    const int nn = tid >> 3, k8 = (tid & 7) * 8;
    u32x4 w;
#pragma unroll
    for (int j = 0; j < 4; ++j) w[j] = pk_bf16(tl[(k8 + 2 * j) * 65 + nn], tl[(k8 + 2 * j + 1) * 65 + nn]);
    *(u32x4*)(dst + (size_t)nn * lddst + k8) = w;
    __syncthreads();
}
__device__ __forceinline__ void convert_moe(KP p, LAS unsigned char* lds, int l) {
    LAS float* tl = (LAS float*)lds;
    bf16_t* WGU = (bf16_t*)(p->ws + WS_WGU); bf16_t* WDN = (bf16_t*)(p->ws + WS_WDN);
    const int n = tid_launder() & 63;
    for (int idx = bid_launder(); idx < 4096 + 2048; idx += gridDim.x) {
        if (idx < 4096) { const int e = idx >> 8, rt = (idx >> 4) & 15, kt = idx & 15, q = rt >> 2, sub = rt & 3;
            const float* src = p->in[sub < 2 ? I_WG : I_WU] + ((size_t)(l * 16 + e) * 1024 + kt * 64) * 512;
            tr_tile(tl, src, 512, q * 128 + (sub & 1) * 64 + n, 1.f, WGU + ((size_t)e * 1024 + rt * 64) * 1024 + kt * 64, 1024);
        } else { const int j = idx - 4096, e = j >> 7, ntile = (j >> 3) & 15, kt = j & 7;
            const float* src = p->in[I_WD] + ((size_t)(l * 16 + e) * 512 + kt * 64) * 1024;
            tr_tile(tl, src, 1024, ntile * 64 + n, 1.f, WDN + ((size_t)e * 1024 + ntile * 64) * 512 + kt * 64, 512); }
    }
}
__device__ __forceinline__ void phase_prologue(KP p, LAS unsigned char* lds) {
    const int tid = tid_launder(), lane = tid & 63, wave = tid >> 6;
    {
        LAS float* SC = (LAS float*)lds; LAS float* RED = (LAS float*)(lds + 17 * 1024 * 4);
        for (int i = tid; i < 17 * 1024; i += 512) { const int r = i >> 10, k = i & 1023; const float v = r < 16 ? p->in[I_C][r * 1024 + k] : p->in[I_CCTX][k]; SC[i] = siluf_(v); }
        __syncthreads();
        float* MOD = (float*)(p->ws + WS_MOD);
        for (int unit = bid_launder(); unit < 192; unit += gridDim.x) {
            const int l = unit / 96, cg = unit - l * 96;
            const float* W = p->in[I_WADA] + (size_t)l * 1024 * 6144 + cg * 64 + lane;
            float acc[17];
#pragma unroll
            for (int r = 0; r < 17; ++r) acc[r] = 0.f;
            for (int k = wave * 128; k < wave * 128 + 128; k += 4) {
                const float w0 = W[(size_t)k * 6144], w1 = W[(size_t)(k + 1) * 6144], w2 = W[(size_t)(k + 2) * 6144], w3 = W[(size_t)(k + 3) * 6144];
#pragma unroll
                for (int r = 0; r < 17; ++r) { const f32x4 s = *(const LAS f32x4*)(SC + r * 1024 + k); acc[r] += s[0] * w0 + s[1] * w1 + s[2] * w2 + s[3] * w3; }
            }
#pragma unroll
            for (int r = 0; r < 17; ++r) RED[(wave * 17 + r) * 64 + lane] = acc[r];
            __syncthreads();
            for (int i = tid; i < 17 * 64; i += 512) { const int r = i >> 6, cc = i & 63; float s = 0.f;
#pragma unroll
                for (int w = 0; w < 8; ++w) s += RED[(w * 17 + r) * 64 + cc];
                MOD[(size_t)(l * 17 + r) * 6144 + cg * 64 + cc] = s + p->in[I_BADA][l * 6144 + cg * 64 + cc]; }
            __syncthreads();
        }
        __syncthreads();
    }
    {
        LAS float* tl = (LAS float*)lds;
        bf16_t* WIN = (bf16_t*)(p->ws + WS_WIN); bf16_t* WOUT = (bf16_t*)(p->ws + WS_WOUT);
        const int n = tid & 63;
        for (int idx = bid_launder(); idx < 1664 + 512; idx += gridDim.x) {
            if (idx < 1664) { const int l = idx / 832, r = idx - l * 832, ntile = r >> 4, kt = r & 15, np = ntile * 64 + n;
                int scol; if (np < 768) scol = np; else if (np < 3072) scol = np + 32; else { const int j = np - 3072; scol = j < 32 ? 768 + j : (j < 48 ? 3104 + (j - 32) : -1); }
                const float scale = np < 128 ? 0.17677669529663687f : ((np >= 768 && np < 1024) ? 0.125f : 1.f);
                tr_tile(tl, p->in[I_WIN] + ((size_t)l * 1024 + kt * 64) * DIN, DIN, scol, scale, WIN + ((size_t)l * NWIN + ntile * 64) * 1024 + kt * 64, 1024);
            } else { const int j = idx - 1664, l = j >> 8, ntile = (j >> 4) & 15, kt = j & 15;
                tr_tile(tl, p->in[I_WOUT] + ((size_t)l * 1024 + kt * 64) * 1024, 1024, ntile * 64 + n, 1.f, WOUT + ((size_t)l * 1024 + ntile * 64) * 1024 + kt * 64, 1024); }
        }
    }
    convert_moe(p, lds, 0);
}

__device__ __forceinline__ void route16(const float (&lg)[16], const float* rb, int& bucket, float& wlo, float& whi) {
    float bestgs = -INFINITY, bs1 = 0.f, bs2 = 0.f; int bestg = 0, bi1 = 0, bi2 = 1;
#pragma unroll
    for (int g = 0; g < 4; ++g) {
        float sc[4], sl[4];
#pragma unroll
        for (int j = 0; j < 4; ++j) { sc[j] = sigmoidf_(lg[4 * g + j]); sl[j] = sc[j] + rb[4 * g + j]; }
        int i1 = 0; float v1 = sl[0], s1 = sc[0];
#pragma unroll
        for (int j = 1; j < 4; ++j) if (sl[j] > v1) { v1 = sl[j]; s1 = sc[j]; i1 = j; }
        int i2 = 0; float v2 = -INFINITY, s2 = 0.f;
#pragma unroll
        for (int j = 0; j < 4; ++j) if (j != i1 && sl[j] > v2) { v2 = sl[j]; s2 = sc[j]; i2 = j; }
        const float gs = v1 + v2;
        if (gs > bestgs) { bestgs = gs; bestg = g; bi1 = i1; bi2 = i2; bs1 = s1; bs2 = s2; }
    }
    const int lo = bi1 < bi2 ? bi1 : bi2, hi = bi1 < bi2 ? bi2 : bi1;
    const float slo = bi1 < bi2 ? bs1 : bs2, shi = bi1 < bi2 ? bs2 : bs1;
    const int pr = lo == 0 ? hi - 1 : (lo == 1 ? hi + 1 : 5);
    bucket = bestg * 6 + pr; const float inv = 1.f / (bs1 + bs2); wlo = slo * inv; whi = shi * inv;
}
template <bool ROUTER>
__device__ __forceinline__ void phase_prep(KP p, LAS unsigned char* lds, int l, const float* lat, const float* ctx, int latent_only) {
    const int tid = tid_launder(), lane = tid & 63, wave = tid >> 6;
    const float* MOD = (const float*)(p->ws + WS_MOD) + (size_t)l * 17 * 6144;
    const float* g = p->in[I_NORMG] + (l * 2 + (ROUTER ? 1 : 0)) * 1024;
    bf16_t* H = (bf16_t*)(p->ws + WS_ABUF);
    LAS float* RWT = (LAS float*)lds; LAS int* hist = (LAS int*)(lds + 65536);
    if (ROUTER) { for (int i = tid; i < 16384; i += 512) { const int e = i >> 10, k = i & 1023; RWT[i] = p->in[I_RW][k * 16 + e]; } __syncthreads(); }
    const int n_per = latent_only ? 128 : 144;
    for (int vb = bid_launder(); vb < NVB; vb += gridDim.x) {
        if (ROUTER) { if (tid < 32) hist[tid] = 0; __syncthreads(); }
        for (int i = wave; i < n_per; i += 8) {
            const int m = latent_only ? (vb >> 4) * TT + LC + (vb & 15) * 128 + i : vb * 144 + i;
            const int b = m / TT, t = m - b * TT, rb = t < LC ? 16 : b;
            const float* xr = res_row_c(lat, ctx, m);
            f32x4 xv[4]; float ss = 0.f;
#pragma unroll
            for (int j = 0; j < 4; ++j) { xv[j] = *(const f32x4*)(xr + 4 * lane + 256 * j); ss += xv[j][0] * xv[j][0] + xv[j][1] * xv[j][1] + xv[j][2] * xv[j][2] + xv[j][3] * xv[j][3]; }
            ss = wave_sum(ss);
            const float rstd = rsqrtf(ss * (1.f / 1024.f) + EPS);
            const float* sh = MOD + (size_t)rb * 6144 + (ROUTER ? 3 : 0) * 1024; const float* sc = sh + 1024;
            f32x4 hv[4];
#pragma unroll
            for (int j = 0; j < 4; ++j) { const int idx = 4 * lane + 256 * j;
                const f32x4 gv = *(const f32x4*)(g + idx), shv = *(const f32x4*)(sh + idx), scv = *(const f32x4*)(sc + idx);
                hv[j] = xv[j] * rstd * gv * (1.f + scv) + shv;
                *(u32x2*)(H + (size_t)m * 1024 + idx) = (u32x2){pk_bf16(hv[j][0], hv[j][1]), pk_bf16(hv[j][2], hv[j][3])}; }
            if (ROUTER) {
                float lg[16];
#pragma unroll
                for (int e = 0; e < 16; ++e) { float s = 0.f;
#pragma unroll
                    for (int j = 0; j < 4; ++j) { const f32x4 w = *(const LAS f32x4*)(RWT + e * 1024 + 4 * lane + 256 * j); s += hv[j][0] * w[0] + hv[j][1] * w[1] + hv[j][2] * w[2] + hv[j][3] * w[3]; }
                    lg[e] = wave_sum(s); }
                int bucket; float wlo, whi; route16(lg, p->in[I_RB], bucket, wlo, whi);
                if (lane == 0) { *(f32x4*)(p->ws + WS_ROUTE + (size_t)m * 16) = (f32x4){__int_as_float(bucket), wlo, whi, 0.f};
                    __hip_atomic_fetch_add(hist + bucket, 1, __ATOMIC_RELAXED, __HIP_MEMORY_SCOPE_WORKGROUP); }
            }
        }
        if (ROUTER) { __syncthreads(); if (tid < 32) ((int*)(p->ws + WS_HIST))[vb * 32 + tid] = tid < 24 ? hist[tid] : 0; __syncthreads(); }
    }
}

__device__ __forceinline__ void phase_moe_offsets(KP p, LAS unsigned char* lds, int latent_only) {
    const int tid = tid_launder(), lane = tid & 63, wave = tid >> 6;
    LAS int* PT = (LAS int*)lds; LAS int* tot = PT + 384; LAS int* tbase = tot + 32; LAS int* wsum = tbase + 32;
    const int* HIST = (const int*)(p->ws + WS_HIST); int* LIST = (int*)(p->ws + WS_LIST); f32x2* SLOTW = (f32x2*)(p->ws + WS_SLOTW); int* TILE = (int*)(p->ws + WS_TILE);
    for (int j = bid_launder(); j < 24; j += gridDim.x) {
        if (tid < 384) { const int jj = tid % 24, pi = tid / 24; int sacc = 0; for (int w = pi * 16; w < pi * 16 + 16; ++w) sacc += HIST[w * 32 + jj]; PT[pi * 24 + jj] = sacc; }
        __syncthreads();
        if (tid < 24) { int sacc = 0; for (int i = 0; i < 16; ++i) sacc += PT[i * 24 + tid]; tot[tid] = sacc; }
        __syncthreads();
        if (tid == 0) { int run = 0; for (int q = 0; q < 24; ++q) { tbase[q] = run; run += (tot[q] + 255) >> 8; } tbase[24] = run; }
        __syncthreads();
        const int base = tbase[j] * 256, cnt = tot[j], ntile = (cnt + 255) >> 8;
        if (j == 0) { if (tid == 0) TILE[0] = tbase[24]; if (tid < 24) { const int nq = (tot[tid] + 255) >> 8; for (int i = 0; i < nq; ++i) TILE[8 + tbase[tid] + i] = tid; } }
        int mycnt = 0;
        for (int i = 0; i < 72; ++i) { const int m = tid * 72 + i; const int t = m % TT;
            if (!latent_only || t >= LC) { const int bk = __float_as_int(*(const float*)(p->ws + WS_ROUTE + (size_t)m * 16)); mycnt += (bk == j) ? 1 : 0; } }
        int incl = mycnt;
#pragma unroll
        for (int o = 1; o < 64; o <<= 1) { const int v = __shfl_up(incl, o, 64); if (lane >= o) incl += v; }
        if (lane == 63) wsum[wave] = incl;
        __syncthreads();
        int woff = 0;
#pragma unroll
        for (int w = 0; w < 8; ++w) woff += (w < wave) ? wsum[w] : 0;
        int pos = base + woff + incl - mycnt;
        for (int i = 0; i < 72; ++i) { const int m = tid * 72 + i; const int t = m % TT;
            if (!latent_only || t >= LC) { const f32x4 r = *(const f32x4*)(p->ws + WS_ROUTE + (size_t)m * 16);
                if (__float_as_int(r[0]) == j) { LIST[pos] = m; SLOTW[pos] = (f32x2){r[1], r[2]}; ++pos; } } }
        for (int sidx = base + cnt + tid; sidx < base + ntile * 256; sidx += 512) { LIST[sidx] = -1; SLOTW[sidx] = (f32x2){0.f, 0.f}; }
        __syncthreads();
    }
}

__device__ __forceinline__ bf16_t* obuf(unsigned char* ws, int k) {
    const int panel = k == 4 ? 8 : (k == 5 ? 9 : (k == 6 ? 10 : 12));
    return k < 4 ? (bf16_t*)(ws + WS_O) + (size_t)k * PANEL_EL : (bf16_t*)(ws + WS_P) + (size_t)panel * PANEL_EL;
}
__device__ __forceinline__ void phase_mixprep(KP p, int l) {
    const int tid = tid_launder();
    bf16_t* P = (bf16_t*)(p->ws + WS_P); bf16_t* DNP = (bf16_t*)(p->ws + WS_ABUF);
    float* GDEC = (float*)(p->ws + WS_GDEC); float* DNAB = (float*)(p->ws + WS_DNAB);
    float cw[5][2] = {{0.f, 0.f}, {0.f, 0.f}, {0.f, 0.f}, {0.f, 0.f}, {0.f, 0.f}};
    const int sec = tid >> 7, cp = (tid & 127) * 2;
    if (tid < 384) {
#pragma unroll
        for (int j = 0; j < 5; ++j) { cw[j][0] = p->in[I_CONVW][(l * 5 + j) * 768 + sec * 256 + cp]; cw[j][1] = p->in[I_CONVW][(l * 5 + j) * 768 + sec * 256 + cp + 1]; }
    }
    float nalog = 0.f, dtb = 0.f;
    if (tid >= 384 && tid < 392) { nalog = -__expf(p->in[I_ALOG][l * 8 + tid - 384]); dtb = p->in[I_DTB][l * 8 + tid - 384]; }
    float gw[16], gb = 0.f, invf = 0.f; int userow = 0;
#pragma unroll
    for (int r = 0; r < 16; ++r) gw[r] = 0.f;
    if (tid < 256) { const int dir = tid >> 7, c = tid & 127;
#pragma unroll
        for (int r = 0; r < 16; ++r) gw[r] = p->in[I_GKW][((l * 2 + dir) * 16 + r) * 128 + c];
        gb = p->in[I_GKB][(l * 2 + dir) * 128 + c];
    } else { const int i = (tid - 256) & 31; invf = exp2f(-(float)(i & 15) * (13.287712379549449f / 16.f)); userow = i < 16; }
    for (int vb = bid_launder(); vb < NVB; vb += gridDim.x) {
        const int b = vb >> 4, t0 = (vb & 15) * 144;
        for (int it = 0; it < 144; ++it) {
            const int t = t0 + it, m = b * TT + t, lo = t < LC ? 0 : LC, hi = t < LC ? LC : TT;
            if (tid < 384) {
                const bf16_t* src = P + (size_t)(8 + sec) * PANEL_EL + cp;
                float a0 = 0.f, a1 = 0.f;
#pragma unroll
                for (int j = 0; j < 5; ++j) { const int tt = t + j - 2;
                    if (tt >= lo && tt < hi) { const unsigned raw = *(const unsigned*)(src + (size_t)(b * TT + tt) * 256); a0 += cw[j][0] * bflo(raw); a1 += cw[j][1] * bfhi(raw); } }
                a0 = siluf_(a0); a1 = siluf_(a1);
                if (sec < 2) { const float ss = half_sum32(a0 * a0 + a1 * a1); const float rn = rsqrtf(ss + EPS) * (sec == 0 ? 0.125f : 1.f); a0 *= rn; a1 *= rn; }
                *(unsigned*)(DNP + (size_t)sec * PANEL_EL + (size_t)m * 256 + cp) = pk_bf16(a0, a1);
            } else if (tid < 392) {
                const int j = tid - 384; const bf16_t* s12 = P + (size_t)12 * PANEL_EL + (size_t)m * 256;
                const float da = bf2f(s12[32 + j]), db = bf2f(s12[40 + j]);
                DNAB[(size_t)m * 16 + j] = __expf(nalog * softplusf_(da + dtb)); DNAB[(size_t)m * 16 + 8 + j] = sigmoidf_(db);
            }
            if (tid < 256) {
                const int dir = tid >> 7; const bf16_t* zp = P + (size_t)12 * PANEL_EL + (size_t)m * 256 + dir * 16;
                const u32x4 z0 = *(const u32x4*)zp, z1 = *(const u32x4*)(zp + 8);
                float logit = gb;
#pragma unroll
                for (int q = 0; q < 4; ++q) { logit += bflo(z0[q]) * gw[2 * q] + bfhi(z0[q]) * gw[2 * q + 1] + bflo(z1[q]) * gw[8 + 2 * q] + bfhi(z1[q]) * gw[8 + 2 * q + 1]; }
                const float ls = fminf(logit, 0.f) - log1pf(__expf(-fabsf(logit)));
                GDEC[(size_t)m * 256 + tid] = __expf(ls * 0.0625f);
            } else if (t >= LC) {
                const int pi = tid - 256, rs = pi >> 7, pr = pi & 127, pos = t - LC;
                bf16_t* ap = P + (size_t)(3 + rs) * PANEL_EL + (size_t)m * 256 + 2 * pr;
                const unsigned raw = *(const unsigned*)ap; const float t1 = bflo(raw), t2 = bfhi(raw);
                float sn, cs; sincosf((float)(userow ? (pos >> 6) : (pos & 63)) * invf, &sn, &cs);
                *(unsigned*)ap = pk_bf16(t1 * cs - t2 * sn, t1 * sn + t2 * cs);
            }
        }
    }
}

__device__ __forceinline__ int blk_tok0(int dir, int blk) { return dir == 0 ? 16 * blk : (blk < 16 ? LC - 16 * (blk + 1) : TT - 16 * (blk - 15)); }
__device__ __forceinline__ void cvt8(const u32x4 r, LAS float* d) {
    *(LAS f32x4*)d = (f32x4){bflo(r[0]), bfhi(r[0]), bflo(r[1]), bfhi(r[1])}; *(LAS f32x4*)(d + 4) = (f32x4){bflo(r[2]), bfhi(r[2]), bflo(r[3]), bfhi(r[3])};
}
__device__ __forceinline__ void store_out16(const LAS float* LO, bf16_t* Og, int tcur, int lane) {
    if (lane < 32) { const int row = lane >> 1, half = lane & 1; const f32x4 o0 = *(const LAS f32x4*)(LO + row * 16 + half * 8), o1 = *(const LAS f32x4*)(LO + row * 16 + half * 8 + 4);
        *(u32x4*)(Og + (size_t)(tcur + row) * 16 + half * 8) = (u32x4){pk_bf16(o0[0], o0[1]), pk_bf16(o0[2], o0[3]), pk_bf16(o1[0], o1[1]), pk_bf16(o1[2], o1[3])}; }
}
__device__ __forceinline__ void scan_dn(KP p, LAS float* L, int idx) {
    const int lane = tid_launder() & 63, vl = lane >> 2, dg = lane & 3;
    const int cq = idx & 3, dir = (idx >> 2) & 1, h = (idx >> 3) & 3, b = idx >> 5;
    const bf16_t* Qg = (const bf16_t*)(p->ws + WS_ABUF) + (size_t)b * TT * 256 + h * 64; const bf16_t* Kg = Qg + PANEL_EL; const bf16_t* Vg = Qg + 2 * PANEL_EL + cq * 16;
    const float* ABg = (const float*)(p->ws + WS_DNAB) + (size_t)b * TT * 16 + dir * 4 + h;
    bf16_t* Og = obuf(p->ws, 4 + dir) + (size_t)((b * 4 + h) * 4 + cq) * TT * 16;
    LAS float* LQ = L; LAS float* LK = L + 1024; LAS float* LV = L + 2048; LAS float* LAB = L + 2304; LAS float* LO = L + 2336;
    float S[16];
#pragma unroll
    for (int i = 0; i < 16; ++i) S[i] = 0.f;
    const int lrow = lane >> 2, lseg = lane & 3, vrow = (lane >> 1) & 15, vhalf = lane & 1;
    u32x4 rq0, rq1, rk0, rk1, rv; float ra, rb;
    int tb = blk_tok0(dir, 0);
#define DN_LOAD(T0) do { const size_t ro = (size_t)((T0) + lrow) * 256 + lseg * 16; rq0 = *(const u32x4*)(Qg + ro); rq1 = *(const u32x4*)(Qg + ro + 8); rk0 = *(const u32x4*)(Kg + ro); rk1 = *(const u32x4*)(Kg + ro + 8); \
        rv = *(const u32x4*)(Vg + (size_t)((T0) + vrow) * 256 + vhalf * 8); ra = ABg[(size_t)((T0) + (lane & 15)) * 16]; rb = ABg[(size_t)((T0) + (lane & 15)) * 16 + 8]; } while (0)
    DN_LOAD(tb);
    for (int blk = 0; blk < 144; ++blk) {
        cvt8(rq0, LQ + lrow * 64 + lseg * 16); cvt8(rq1, LQ + lrow * 64 + lseg * 16 + 8); cvt8(rk0, LK + lrow * 64 + lseg * 16); cvt8(rk1, LK + lrow * 64 + lseg * 16 + 8);
        if (lane < 32) cvt8(rv, LV + vrow * 16 + vhalf * 8);
        if (lane < 16) { LAB[lane * 2] = ra; LAB[lane * 2 + 1] = rb; }
        const int tcur = tb;
        if (blk + 1 < 144) { tb = blk_tok0(dir, blk + 1); DN_LOAD(tb); }
        WAVE_LDS_SYNC();
#pragma unroll
        for (int s = 0; s < 16; ++s) {
            const int ls = dir ? 15 - s : s;
            float k[16], q[16];
#pragma unroll
            for (int j = 0; j < 4; ++j) { const f32x4 kk = *(const LAS f32x4*)(LK + ls * 64 + dg * 16 + 4 * j), qq = *(const LAS f32x4*)(LQ + ls * 64 + dg * 16 + 4 * j);
                k[4 * j] = kk[0]; k[4 * j + 1] = kk[1]; k[4 * j + 2] = kk[2]; k[4 * j + 3] = kk[3]; q[4 * j] = qq[0]; q[4 * j + 1] = qq[1]; q[4 * j + 2] = qq[2]; q[4 * j + 3] = qq[3]; }
            const float v = LV[ls * 16 + vl], a = LAB[ls * 2], bt = LAB[ls * 2 + 1];
            float r0 = 0.f, r1 = 0.f;
#pragma unroll
            for (int i = 0; i < 16; i += 2) { r0 += k[i] * S[i]; r1 += k[i + 1] * S[i + 1]; }
            const float r = quad_sum(r0 + r1);
            const float c = bt * (v - a * r);
            float o0 = 0.f, o1 = 0.f;
#pragma unroll
            for (int i = 0; i < 16; i += 2) { S[i] = a * S[i] + k[i] * c; S[i + 1] = a * S[i + 1] + k[i + 1] * c; o0 += q[i] * S[i]; o1 += q[i + 1] * S[i + 1]; }
            const float o = quad_sum(o0 + o1);
            if (dg == 0) LO[ls * 16 + vl] = o;
        }
        WAVE_LDS_SYNC();
        store_out16(LO, Og, tcur, lane);
    }
#undef DN_LOAD
}
__device__ __forceinline__ void scan_ret(KP p, LAS float* L, int idx, int l) {
    const int lane = tid_launder() & 63, vl = lane >> 2, dg = lane & 3;
    const int cq = idx & 3, dir = (idx >> 2) & 1, h = (idx >> 3) & 3, b = idx >> 5;
    const bf16_t* P = (const bf16_t*)(p->ws + WS_P);
    const bf16_t* Qg = P + 3 * PANEL_EL + (size_t)b * TT * 256 + h * 64; const bf16_t* Kg = Qg + PANEL_EL; const bf16_t* Vg = Qg + 2 * PANEL_EL + cq * 16;
    bf16_t* Og = obuf(p->ws, 2 + dir) + (size_t)((b * 4 + h) * 4 + cq) * TT * 16;
    const float gamma = sigmoidf_(p->in[I_RETD][(l * 2 + dir) * 4 + h]);
    LAS float* LQ = L; LAS float* LK = L + 1024; LAS float* LV = L + 2048; LAS float* LO = L + 2304;
    float S[16];
#pragma unroll
    for (int i = 0; i < 16; ++i) S[i] = 0.f;
    const int lrow = lane >> 2, lseg = lane & 3, vrow = (lane >> 1) & 15, vhalf = lane & 1;
    u32x4 rq0, rq1, rk0, rk1, rv;
    int tb = blk_tok0(dir, 0);
#define RT_LOAD(T0) do { const size_t ro = (size_t)((T0) + lrow) * 256 + lseg * 16; rq0 = *(const u32x4*)(Qg + ro); rq1 = *(const u32x4*)(Qg + ro + 8); rk0 = *(const u32x4*)(Kg + ro); rk1 = *(const u32x4*)(Kg + ro + 8); \
        rv = *(const u32x4*)(Vg + (size_t)((T0) + vrow) * 256 + vhalf * 8); } while (0)
    RT_LOAD(tb);
    for (int blk = 0; blk < 144; ++blk) {
        cvt8(rq0, LQ + lrow * 64 + lseg * 16); cvt8(rq1, LQ + lrow * 64 + lseg * 16 + 8); cvt8(rk0, LK + lrow * 64 + lseg * 16); cvt8(rk1, LK + lrow * 64 + lseg * 16 + 8);
        if (lane < 32) cvt8(rv, LV + vrow * 16 + vhalf * 8);
        const int tcur = tb;
        if (blk + 1 < 144) { tb = blk_tok0(dir, blk + 1); RT_LOAD(tb); }
        WAVE_LDS_SYNC();
#pragma unroll
        for (int s = 0; s < 16; ++s) {
            const int ls = dir ? 15 - s : s;
            const float v = LV[ls * 16 + vl];
            float o0 = 0.f, o1 = 0.f;
#pragma unroll
            for (int j = 0; j < 4; ++j) { const f32x4 kk = *(const LAS f32x4*)(LK + ls * 64 + dg * 16 + 4 * j), qq = *(const LAS f32x4*)(LQ + ls * 64 + dg * 16 + 4 * j);
                S[4 * j] = gamma * S[4 * j] + kk[0] * v; S[4 * j + 1] = gamma * S[4 * j + 1] + kk[1] * v; S[4 * j + 2] = gamma * S[4 * j + 2] + kk[2] * v; S[4 * j + 3] = gamma * S[4 * j + 3] + kk[3] * v;
                o0 += qq[0] * S[4 * j] + qq[2] * S[4 * j + 2]; o1 += qq[1] * S[4 * j + 1] + qq[3] * S[4 * j + 3]; }
            const float o = quad_sum(o0 + o1);
            if (dg == 0) LO[ls * 16 + vl] = o;
        }
        WAVE_LDS_SYNC();
        store_out16(LO, Og, tcur, lane);
    }
#undef RT_LOAD
}
__device__ __forceinline__ void scan_gla(KP p, LAS float* L, int idx) {
    const int lane = tid_launder() & 63, vl = lane >> 2, dg = lane & 3;
    const int cq = idx & 3, dir = (idx >> 2) & 1, h = (idx >> 3) & 3, b = idx >> 5;
    const bf16_t* P = (const bf16_t*)(p->ws + WS_P);
    const bf16_t* Qg = P + (size_t)b * TT * 256 + h * 32; const bf16_t* Kg = Qg + 128; const bf16_t* Vg = P + PANEL_EL + (size_t)b * TT * 256 + h * 64 + cq * 16;
    const float* Ag = (const float*)(p->ws + WS_GDEC) + (size_t)b * TT * 256 + dir * 128 + h * 32;
    bf16_t* Og = obuf(p->ws, dir) + (size_t)((b * 4 + h) * 4 + cq) * TT * 16;
    LAS float* LQ = L; LAS float* LK = L + 512; LAS float* LA = L + 1024; LAS float* LV = L + 1536; LAS float* LO = L + 1792;
    float S[8];
#pragma unroll
    for (int i = 0; i < 8; ++i) S[i] = 0.f;
    const int lrow = lane >> 2, lseg = lane & 3, vrow = (lane >> 1) & 15, vhalf = lane & 1;
    u32x4 rq, rk, rv; f32x4 ra0, ra1;
    int tb = blk_tok0(dir, 0);
#define GL_LOAD(T0) do { const size_t ro = (size_t)((T0) + lrow) * 256 + lseg * 8; rq = *(const u32x4*)(Qg + ro); rk = *(const u32x4*)(Kg + ro); ra0 = *(const f32x4*)(Ag + ro); ra1 = *(const f32x4*)(Ag + ro + 4); \
        rv = *(const u32x4*)(Vg + (size_t)((T0) + vrow) * 256 + vhalf * 8); } while (0)
    GL_LOAD(tb);
    for (int blk = 0; blk < 144; ++blk) {
        cvt8(rq, LQ + lrow * 32 + lseg * 8); cvt8(rk, LK + lrow * 32 + lseg * 8);
        *(LAS f32x4*)(LA + lrow * 32 + lseg * 8) = ra0; *(LAS f32x4*)(LA + lrow * 32 + lseg * 8 + 4) = ra1;
        if (lane < 32) cvt8(rv, LV + vrow * 16 + vhalf * 8);
        const int tcur = tb;
        if (blk + 1 < 144) { tb = blk_tok0(dir, blk + 1); GL_LOAD(tb); }
        WAVE_LDS_SYNC();
#pragma unroll
        for (int s = 0; s < 16; ++s) {
            const int ls = dir ? 15 - s : s;
            const float v = LV[ls * 16 + vl];
            float o0 = 0.f, o1 = 0.f;
#pragma unroll
            for (int j = 0; j < 2; ++j) { const f32x4 kk = *(const LAS f32x4*)(LK + ls * 32 + dg * 8 + 4 * j), qq = *(const LAS f32x4*)(LQ + ls * 32 + dg * 8 + 4 * j), aa = *(const LAS f32x4*)(LA + ls * 32 + dg * 8 + 4 * j);
                S[4 * j] = aa[0] * S[4 * j] + kk[0] * v; S[4 * j + 1] = aa[1] * S[4 * j + 1] + kk[1] * v; S[4 * j + 2] = aa[2] * S[4 * j + 2] + kk[2] * v; S[4 * j + 3] = aa[3] * S[4 * j + 3] + kk[3] * v;
                o0 += qq[0] * S[4 * j] + qq[2] * S[4 * j + 2]; o1 += qq[1] * S[4 * j + 1] + qq[3] * S[4 * j + 3]; }
            const float o = quad_sum(o0 + o1);
            if (dg == 0) LO[ls * 16 + vl] = o;
        }
        WAVE_LDS_SYNC();
        store_out16(LO, Og, tcur, lane);
    }
#undef GL_LOAD
}
__device__ __forceinline__ void scan_s5(KP p, LAS float* L, int idx, int l) {
    const int lane = tid_launder() & 63;
    const int dir = idx & 1, g = (idx >> 1) & 15, b = idx >> 5;
    const bf16_t* Ug = (const bf16_t*)(p->ws + WS_P) + 7 * PANEL_EL + (size_t)b * TT * 256 + g * 16;
    bf16_t* Og = obuf(p->ws, 6 + dir) + (size_t)(b * 16 + g) * TT * 16;
    LAS float* LU = L; LAS unsigned* HB = (LAS unsigned*)(L + 256);
    const float lre = p->in[I_S5LRE][((l * 2 + dir) * 16 + g) * 64 + lane], lim = p->in[I_S5LIM][((l * 2 + dir) * 16 + g) * 64 + lane];
    const float dt = expf(p->in[I_S5DT][(l * 2 + dir) * 16 + g]);
    float sn, cs; sincosf(lim * dt, &sn, &cs);
    const float mag = expf(lre * dt), lbr = mag * cs, lbi = mag * sn;
    const float nr = lbr - 1.f, ni = lbi, den = 1.f / (lre * lre + lim * lim);
    const float bsr = (nr * lre + ni * lim) * den, bsi = (ni * lre - nr * lim) * den;
    float Br[16], Bi[16];
#pragma unroll
    for (int q = 0; q < 4; ++q) { const f32x4 br = *(const f32x4*)(p->in[I_S5BRE] + (size_t)((l * 16 + g) * 64 + lane) * 16 + 4 * q), bi = *(const f32x4*)(p->in[I_S5BIM] + (size_t)((l * 16 + g) * 64 + lane) * 16 + 4 * q);
#pragma unroll
        for (int e = 0; e < 4; ++e) { Br[4 * q + e] = bsr * br[e] - bsi * bi[e]; Bi[4 * q + e] = bsr * bi[e] + bsi * br[e]; } }
    bf16x8 Cf[4];
    { const int n = lane & 15, kq = lane >> 4; const float* cre = p->in[I_S5CRE] + (size_t)((l * 16 + g) * 16 + n) * 64; const float* cim = p->in[I_S5CIM] + (size_t)((l * 16 + g) * 16 + n) * 64;
#pragma unroll
        for (int kk = 0; kk < 4; ++kk) { const int p0 = 16 * kk + 4 * kq; const f32x4 r = *(const f32x4*)(cre + p0), im = *(const f32x4*)(cim + p0);
            const u32x4 w = (u32x4){pk_bf16(r[0], -im[0]), pk_bf16(r[1], -im[1]), pk_bf16(r[2], -im[2]), pk_bf16(r[3], -im[3])}; Cf[kk] = __builtin_bit_cast(bf16x8, w); } }
    float hre = 0.f, him = 0.f;
    const int vrow = (lane >> 1) & 15, vhalf = lane & 1;
    u32x4 ru;
    int tb = blk_tok0(dir, 0);
    ru = *(const u32x4*)(Ug + (size_t)(tb + vrow) * 256 + vhalf * 8);
    for (int blk = 0; blk < 144; ++blk) {
        if (lane < 32) cvt8(ru, LU + vrow * 16 + vhalf * 8);
        const int tcur = tb;
        if (blk + 1 < 144) { tb = blk_tok0(dir, blk + 1); ru = *(const u32x4*)(Ug + (size_t)(tb + vrow) * 256 + vhalf * 8); }
        WAVE_LDS_SYNC();
#pragma unroll
        for (int s = 0; s < 16; ++s) {
            const int ls = dir ? 15 - s : s;
            float br0 = 0.f, bi0 = 0.f, br1 = 0.f, bi1 = 0.f;
#pragma unroll
            for (int q = 0; q < 4; ++q) { const f32x4 u = *(const LAS f32x4*)(LU + ls * 16 + 4 * q);
                br0 += Br[4 * q] * u[0] + Br[4 * q + 2] * u[2]; br1 += Br[4 * q + 1] * u[1] + Br[4 * q + 3] * u[3];
                bi0 += Bi[4 * q] * u[0] + Bi[4 * q + 2] * u[2]; bi1 += Bi[4 * q + 1] * u[1] + Bi[4 * q + 3] * u[3]; }
            const float nre = lbr * hre - lbi * him + (br0 + br1), nim = lbr * him + lbi * hre + (bi0 + bi1);
            hre = nre; him = nim;
            HB[ls * 68 + lane] = pk_bf16(nre, nim);
        }
        WAVE_LDS_SYNC();
        f32x4 acc = (f32x4){0.f, 0.f, 0.f, 0.f};
#pragma unroll
        for (int kk = 0; kk < 4; ++kk) { const bf16x8 a = *(const LAS bf16x8*)(HB + (lane & 15) * 68 + 16 * kk + 4 * (lane >> 4)); acc = __builtin_amdgcn_mfma_f32_16x16x32_bf16(a, Cf[kk], acc, 0, 0, 0); }
#pragma unroll
        for (int i = 0; i < 4; ++i) Og[(size_t)(tcur + 4 * (lane >> 4) + i) * 16 + (lane & 15)] = (bf16_t)(pk_bf16(acc[i], 0.f) & 0xffffu);
        WAVE_LDS_SYNC();
    }
}
__device__ __forceinline__ void phase_scan(KP p, LAS unsigned char* lds, int l) {
    const int wave = __builtin_amdgcn_readfirstlane(tid_launder() >> 6);
    LAS float* L = (LAS float*)(lds + wave * LDS_WAVE);
    for (int vb = bid_launder(); vb < NVB; vb += gridDim.x) {
        const int idx = vb * 2 + (wave & 1);
        if (wave < 2) scan_dn(p, L, idx);
        else if (wave < 4) scan_ret(p, L, idx, l);
        else if (wave < 6) scan_gla(p, L, idx);
        else scan_s5(p, L, idx, l);
    }
}

__device__ __forceinline__ float gelu_tanh(float y) { const float x = 0.7978845608028654f * (y + 0.044715f * y * y * y); const float th = 1.f - 2.f / (__expf(2.f * x) + 1.f); return 0.5f * y * (1.f + th); }
__device__ __forceinline__ void phase_mixpost(KP p, LAS unsigned char* lds, int l) {
    const int tid = tid_launder(), lane = tid & 63, wave = tid >> 6;
    const bf16_t* P = (const bf16_t*)(p->ws + WS_P); bf16_t* MIX = (bf16_t*)(p->ws + WS_ABUF);
    LAS float* YF = (LAS float*)lds; LAS bf16_t* YB = (LAS bf16_t*)(lds + 16384);
    bf16x8 bfr[2][8];
    { const float* gw = p->in[I_GLUW] + (size_t)l * 256 * 256;
#pragma unroll
        for (int nt = 0; nt < 2; ++nt)
#pragma unroll
            for (int kk = 0; kk < 8; ++kk) { const int n = wave * 32 + nt * 16 + (lane & 15), k0 = 32 * kk + 8 * (lane >> 4); u32x4 w;
#pragma unroll
                for (int j = 0; j < 4; ++j) w[j] = pk_bf16(gw[(size_t)(k0 + 2 * j) * 256 + n], gw[(size_t)(k0 + 2 * j + 1) * 256 + n]);
                bfr[nt][kk] = __builtin_bit_cast(bf16x8, w); } }
    const float* s5d = p->in[I_S5D] + l * 256; const float* glub = p->in[I_GLUB] + l * 256;
    for (int vb = bid_launder(); vb < NVB; vb += gridDim.x) {
        for (int tile = 0; tile < 9; ++tile) {
            const int m0 = vb * 144 + tile * 16;
            for (int ps = 0; ps < 12; ++ps) {
                const int c = ps * 16 + wave * 2 + (lane >> 5), tk = c / 12, hh = c - tk * 12, mixer = hh >> 2, head = hh & 3, l32 = lane & 31;
                const size_t off = (size_t)(m0 + tk) * 256 + head * 64 + 2 * l32;
                const size_t ooff = ((size_t)(((vb >> 4) * 4 + head) * 4 + (l32 >> 3)) * TT + (size_t)((vb & 15) * 144 + tile * 16 + tk)) * 16 + ((2 * l32) & 15);
                const int ob = mixer == 0 ? 0 : (mixer == 1 ? 2 : 4), gp = mixer == 0 ? 2 : (mixer == 1 ? 6 : 11);
                const unsigned rf = *(const unsigned*)(obuf(p->ws, ob) + ooff), rbk = *(const unsigned*)(obuf(p->ws, ob + 1) + ooff), rg = *(const unsigned*)(P + (size_t)gp * PANEL_EL + off);
                float o0 = bflo(rf) + bflo(rbk), o1 = bfhi(rf) + bfhi(rbk);
                if (mixer == 1) { const float mean = half_sum32(o0 + o1) * (1.f / 64.f); o0 -= mean; o1 -= mean; }
                const float var = half_sum32(o0 * o0 + o1 * o1) * (1.f / 64.f);
                const float rn = rsqrtf(var + EPS);
                o0 = o0 * rn * siluf_(bflo(rg)); o1 = o1 * rn * siluf_(bfhi(rg));
                *(unsigned*)(MIX + (size_t)(m0 + tk) * 1024 + (mixer == 2 ? 768 : mixer * 256) + head * 64 + 2 * l32) = pk_bf16(o0, o1);
            }
            { const int tk = tid >> 5, c8 = (tid & 31) * 8; const size_t off = (size_t)(m0 + tk) * 256 + c8;
                const size_t yoff = ((size_t)((vb >> 4) * 16 + (c8 >> 4)) * TT + (size_t)((vb & 15) * 144 + tile * 16 + tk)) * 16 + (c8 & 15);
                const u32x4 yf = *(const u32x4*)(obuf(p->ws, 6) + yoff), yb = *(const u32x4*)(obuf(p->ws, 7) + yoff), uu = *(const u32x4*)(P + (size_t)7 * PANEL_EL + off);
                const f32x4 d0 = *(const f32x4*)(s5d + c8), d1 = *(const f32x4*)(s5d + c8 + 4);
                float y[8];
#pragma unroll
                for (int q = 0; q < 4; ++q) { y[2 * q] = bflo(yf[q]) + bflo(yb[q]) + (q < 2 ? d0[2 * q] : d1[2 * q - 4]) * bflo(uu[q]); y[2 * q + 1] = bfhi(yf[q]) + bfhi(yb[q]) + (q < 2 ? d0[2 * q + 1] : d1[2 * q - 3]) * bfhi(uu[q]); }
#pragma unroll
                for (int q = 0; q < 8; ++q) y[q] = gelu_tanh(y[q]);
                *(LAS f32x4*)(YF + tk * 256 + c8) = (f32x4){y[0], y[1], y[2], y[3]}; *(LAS f32x4*)(YF + tk * 256 + c8 + 4) = (f32x4){y[4], y[5], y[6], y[7]};
                *(LAS u32x4*)(YB + tk * 264 + c8) = (u32x4){pk_bf16(y[0], y[1]), pk_bf16(y[2], y[3]), pk_bf16(y[4], y[5]), pk_bf16(y[6], y[7])}; }
            __syncthreads();
#pragma unroll
            for (int nt = 0; nt < 2; ++nt) { f32x4 acc = (f32x4){0.f, 0.f, 0.f, 0.f};
#pragma unroll
                for (int kk = 0; kk < 8; ++kk) { const bf16x8 a = *(const LAS bf16x8*)(YB + (lane & 15) * 264 + 32 * kk + 8 * (lane >> 4)); acc = __builtin_amdgcn_mfma_f32_16x16x32_bf16(a, bfr[nt][kk], acc, 0, 0, 0); }
                const int n = wave * 32 + nt * 16 + (lane & 15); const float gb = glub[n];
#pragma unroll
                for (int i = 0; i < 4; ++i) { const int tk = 4 * (lane >> 4) + i; const float yv = YF[tk * 256 + n];
                    MIX[(size_t)(m0 + tk) * 1024 + 512 + n] = (bf16_t)(pk_bf16(yv * sigmoidf_(acc[i] + gb), 0.f) & 0xffffu); } }
            __syncthreads();
        }
    }
}

__device__ __forceinline__ void phase_final(KP p) {
    const int tid = tid_launder(), lane = tid & 63, gw = bid_launder() * 8 + (tid >> 6), nw = gridDim.x * 8;
    const float* g = p->in[I_FNG];
    const bool poison = xb_ld((unsigned*)(p->ws + WS_CTL) + XB_TMO) != 0u;
    for (int r = gw; r < NB * SEQ; r += nw) {
        float* xr = p->out + (size_t)r * D;
        f32x4 xv[4]; float ss = 0.f;
#pragma unroll
        for (int j = 0; j < 4; ++j) { xv[j] = *(const f32x4*)(xr + 4 * lane + 256 * j); ss += xv[j][0] * xv[j][0] + xv[j][1] * xv[j][1] + xv[j][2] * xv[j][2] + xv[j][3] * xv[j][3]; }
        ss = wave_sum(ss);
        const float rstd = rsqrtf(ss * (1.f / 1024.f) + EPS);
#pragma unroll
        for (int j = 0; j < 4; ++j) { const f32x4 gv = *(const f32x4*)(g + 4 * lane + 256 * j); *(f32x4*)(xr + 4 * lane + 256 * j) = poison ? (f32x4){NAN, NAN, NAN, NAN} : xv[j] * rstd * gv; }
    }
}

__global__ void __launch_bounds__(512, 2) fwd_kernel(Params parg) {
    KP p = (KP)__builtin_amdgcn_kernarg_segment_ptr();
    extern __shared__ __attribute__((aligned(16))) unsigned char lds_raw[];
    LAS unsigned char* lds = (LAS unsigned char*)lds_raw;
    if (threadIdx.x == 0) *(LAS u32x4*)(lds + LDS_BAR_OFF) = (u32x4){0u, 0u, 0u, 0u};
    __syncthreads();
    const unsigned bar_x = xcd_barrier_post((unsigned*)(p->ws + WS_CTL), (volatile LAS unsigned*)(lds + LDS_BAR_OFF)).x;
#define NEXT_PHASE() do { p = kp_launder(p); XcdBarrier bb_; { unsigned* bp_ = (unsigned*)(p->ws + WS_CTL); asm volatile("" : "+s"(bp_)); unsigned bx_ = bar_x; asm volatile("" : "+s"(bx_)); \
        unsigned lo_ = LDS_BAR_OFF; asm volatile("" : "+s"(lo_)); bb_.bar = bp_; bb_.x = bx_; bb_.st = (volatile LAS unsigned*)(lds + lo_); } xcd_barrier(bb_); p = kp_launder(p); } while (0)
    if (PHASE_MASK & 1) phase_prologue(p, lds);
    NEXT_PHASE();
    for (int l = 0; l < 2; ++l) {
        const int last = l == 1;
        if (PHASE_MASK & 2) { phase_prep<false>(p, lds, l, l == 0 ? p->in[I_X] : p->out, l == 0 ? p->in[I_CTX] : (const float*)(p->ws + WS_Z), 0);
            if (l == 1) { __syncthreads(); convert_moe(p, lds, 1); } }
        NEXT_PHASE();
        if (PHASE_MASK & 4) { Dsc1 S{(const bf16_t*)(p->ws + WS_ABUF), (const bf16_t*)(p->ws + WS_WIN) + (size_t)l * NWIN * 1024, (bf16_t*)(p->ws + WS_P), (int)gridDim.x, bid_launder()}; pg8::gemm_phase(lds, S); }
        NEXT_PHASE();
        if (PHASE_MASK & 8) phase_mixprep(p, l);
        NEXT_PHASE();
        if (PHASE_MASK & 16) phase_scan(p, lds, l);
        NEXT_PHASE();
        if (PHASE_MASK & 32) phase_mixpost(p, lds, l);
        NEXT_PHASE();
        if (PHASE_MASK & 64) { Dsc2 S{(const bf16_t*)(p->ws + WS_ABUF), (const bf16_t*)(p->ws + WS_WOUT) + (size_t)l * 1024 * 1024, l == 0 ? p->in[I_X] : p->out, l == 0 ? p->in[I_CTX] : (const float*)(p->ws + WS_Z),
                                     p->out, (float*)(p->ws + WS_Z), (const float*)(p->ws + WS_MOD) + (size_t)l * 17 * 6144, (int)gridDim.x, bid_launder(), last}; pg8::gemm_phase(lds, S); }
        NEXT_PHASE();
        if (PHASE_MASK & 128) phase_prep<true>(p, lds, l, p->out, (const float*)(p->ws + WS_Z), last);
        NEXT_PHASE();
        if (PHASE_MASK & 256) phase_moe_offsets(p, lds, last);
        NEXT_PHASE();
        if (PHASE_MASK & 512) { const int ntl = __builtin_amdgcn_readfirstlane(((const int*)(p->ws + WS_TILE))[0]);
            Dsc3 S{(const bf16_t*)(p->ws + WS_ABUF), (const bf16_t*)(p->ws + WS_WGU), (bf16_t*)(p->ws + WS_P), (const int*)(p->ws + WS_LIST), (const float*)(p->ws + WS_SLOTW), (const int*)(p->ws + WS_TILE), (int)gridDim.x, bid_launder(), ntl}; pg8::gemm_phase(lds, S); }
        NEXT_PHASE();
        if (PHASE_MASK & 1024) { const int ntl = __builtin_amdgcn_readfirstlane(((const int*)(p->ws + WS_TILE))[0]);
            Dsc4 S{(const bf16_t*)(p->ws + WS_P), (const bf16_t*)(p->ws + WS_WDN), p->out, (float*)(p->ws + WS_Z), (const float*)(p->ws + WS_MOD) + (size_t)l * 17 * 6144, (const int*)(p->ws + WS_LIST), (const int*)(p->ws + WS_TILE), (int)gridDim.x, bid_launder(), ntl}; pg8::gemm_phase(lds, S); }
        NEXT_PHASE();
    }
    if (PHASE_MASK & 2048) phase_final(p);
#undef NEXT_PHASE
}

extern "C" void kernel_launch(void* const* d_in, const int* in_sizes, int n_in, void* d_out, int out_size, void* d_ws, size_t ws_size, hipStream_t stream) {
    static int grid = 0;
    if (grid == 0) {
        if (n_in != 31 || out_size != NB * SEQ * D || ws_size < WS_END) { fprintf(stderr, "kernel_launch: unexpected problem shape (n_in %d, out %d, ws %zu)\n", n_in, out_size, ws_size); grid = -1; return; }
        int dev = 0, cus = 0, per_cu = 0;
        if (hipGetDevice(&dev) != hipSuccess || hipDeviceGetAttribute(&cus, hipDeviceAttributeMultiprocessorCount, dev) != hipSuccess) { grid = -1; return; }
        if (hipFuncSetAttribute((const void*)fwd_kernel, hipFuncAttributeMaxDynamicSharedMemorySize, LDS_BYTES) != hipSuccess) { fprintf(stderr, "kernel_launch: hipFuncSetAttribute failed\n"); grid = -1; return; }
        if (hipOccupancyMaxActiveBlocksPerMultiprocessor(&per_cu, (const void*)fwd_kernel, 512, LDS_BYTES) != hipSuccess || per_cu < 1) fprintf(stderr, "kernel_launch: occupancy query reports %d\n", per_cu);
        (void)hipGetLastError();
        grid = cus > 256 ? 256 : cus;
    }
    if (grid < 0) return;
    (void)hipMemsetAsync((char*)d_ws + WS_CTL, 0, 65536, stream);
    Params p{};
    for (int i = 0; i < 31; ++i) p.in[i] = (const float*)d_in[i];
    p.out = (float*)d_out; p.ws = (unsigned char*)d_ws;
    hipLaunchKernelGGL(fwd_kernel, dim3(grid), dim3(512), LDS_BYTES, stream, p);
}
```

```cpp
#include <hip/hip_runtime.h>
#include <cstdio>
#include <cstdint>

#define LAS __attribute__((address_space(3)))
typedef unsigned short bf16_t;
typedef short bf16x8 __attribute__((ext_vector_type(8)));
typedef float f32x4 __attribute__((ext_vector_type(4)));
typedef float f32x2 __attribute__((ext_vector_type(2)));
typedef unsigned u32x4 __attribute__((ext_vector_type(4)));
typedef unsigned u32x2 __attribute__((ext_vector_type(2)));

constexpr int D = 1024, NB = 16, SEQ = 2048, LC = 256, TT = 2304, NTOK = NB * TT;
constexpr int DIN = 3120, NWIN = 3328, NPANEL = 13, NVB = 256;
constexpr float EPS = 1e-6f;
constexpr size_t PANEL_EL = (size_t)NTOK * 256;
constexpr int MAXTILES = 168, MAXSLOT = MAXTILES * 256;

constexpr size_t WS_CTL = 0;
constexpr size_t WS_MOD = 65536;
constexpr size_t WS_Z = WS_MOD + 1048576;
constexpr size_t WS_WIN = WS_Z + (size_t)NB * LC * D * 4;
constexpr size_t WS_WOUT = WS_WIN + (size_t)2 * NWIN * D * 2;
constexpr size_t WS_WGU = WS_WOUT + (size_t)2 * D * D * 2;
constexpr size_t WS_WDN = WS_WGU + (size_t)16 * 1024 * 1024 * 2;
constexpr size_t WS_P = WS_WDN + (size_t)16 * 1024 * 512 * 2;
constexpr size_t WS_ABUF = WS_P + NPANEL * PANEL_EL * 2;
constexpr size_t WS_GDEC = WS_ABUF + (size_t)NTOK * D * 2;
constexpr size_t WS_DNAB = WS_GDEC + (size_t)NTOK * 256 * 4;
constexpr size_t WS_O = WS_DNAB + (size_t)NTOK * 16 * 4;
constexpr size_t WS_ROUTE = WS_O + 4 * PANEL_EL * 2;
constexpr size_t WS_HIST = WS_ROUTE + (size_t)NTOK * 16;
constexpr size_t WS_LIST = WS_HIST + 256 * 32 * 4;
constexpr size_t WS_SLOTW = WS_LIST + 196608;
constexpr size_t WS_TILE = WS_SLOTW + 393216;
constexpr size_t WS_SMALL = WS_TILE + 4096;
constexpr size_t WS_END = WS_SMALL + (size_t)NTOK * 64 * 2;
static_assert(WS_END <= (size_t)512 * 1024 * 1024, "workspace");
static_assert((size_t)MAXSLOT * 4 <= 196608 && (size_t)MAXSLOT * 8 <= 393216 && (size_t)MAXSLOT * D * 2 <= NPANEL * PANEL_EL * 2, "moe buffers");

constexpr int LDS_WAVE = 18432;
constexpr int LDS_BAR_OFF = 8 * LDS_WAVE;
constexpr int LDS_BYTES = LDS_BAR_OFF + 256;

#ifndef SCAN_PROBE
#define SCAN_PROBE 15
#endif
#ifndef REPEAT_MASK
#define REPEAT_MASK 0
#endif
#ifndef PHASE_MASK
#define PHASE_MASK 0xFFFF
#endif
struct Params { const float* in[31]; float* out; unsigned char* ws; };
typedef const Params __attribute__((address_space(4)))* KP;
__device__ __forceinline__ KP kp_launder(KP p) { asm volatile("" : "+s"(p)); return p; }
__device__ __forceinline__ int bid_launder() { int b = blockIdx.x; asm volatile("" : "+s"(b)); return b; }
__device__ __forceinline__ int tid_launder(int wv) { unsigned m = ~0u; asm volatile("" : "+s"(wv), "+s"(m)); int t = wv * 64 + (int)__builtin_amdgcn_mbcnt_hi(m, __builtin_amdgcn_mbcnt_lo(m, 0u)); asm volatile("" : "+v"(t)); return t; }
enum { I_X = 0, I_C, I_CTX, I_CCTX, I_WADA, I_BADA, I_NORMG, I_WIN, I_WOUT, I_GKW, I_GKB, I_RETD, I_S5LRE, I_S5LIM, I_S5DT, I_S5BRE, I_S5BIM, I_S5CRE, I_S5CIM,
       I_S5D, I_GLUW, I_GLUB, I_CONVW, I_ALOG, I_DTB, I_RW, I_RB, I_WG, I_WU, I_WD, I_FNG };

__device__ __forceinline__ float bf2f(unsigned v) { return __uint_as_float(v << 16); }
__device__ __forceinline__ float bflo(unsigned v) { return __uint_as_float(v << 16); }
__device__ __forceinline__ float bfhi(unsigned v) { return __uint_as_float(v & 0xffff0000u); }
typedef __bf16 bf16v2 __attribute__((ext_vector_type(2)));
__device__ __forceinline__ unsigned pk_bf16(float lo, float hi) { const f32x2 v = {lo, hi}; return __builtin_bit_cast(unsigned, __builtin_convertvector(v, bf16v2)); }
__device__ __forceinline__ float sigmoidf_(float x) { return 1.f / (1.f + __expf(-x)); }
__device__ __forceinline__ float siluf_(float x) { return x / (1.f + __expf(-x)); }
__device__ __forceinline__ float softplusf_(float x) { return fmaxf(x, 0.f) + log1pf(__expf(-fabsf(x))); }
__device__ __forceinline__ float wave_sum(float v) {
#pragma unroll
    for (int o = 32; o >= 1; o >>= 1) v += __shfl_xor(v, o, 64);
    return v;
}
__device__ __forceinline__ float half_sum32(float v) {
#pragma unroll
    for (int o = 16; o >= 1; o >>= 1) v += __shfl_xor(v, o, 64);
    return v;
}
__device__ __forceinline__ float quad_sum(float v) {
    v += __builtin_bit_cast(float, __builtin_amdgcn_update_dpp(0, __builtin_bit_cast(int, v), 0xB1, 0xF, 0xF, true));
    v += __builtin_bit_cast(float, __builtin_amdgcn_update_dpp(0, __builtin_bit_cast(int, v), 0x4E, 0xF, 0xF, true));
    return v;
}
#define WAVE_LDS_SYNC() asm volatile("s_waitcnt lgkmcnt(0)" ::: "memory")
__device__ __forceinline__ const float* res_row_c(const float* lat, const float* ctx, int m) { const int b = m / TT, t = m - b * TT; return t < LC ? ctx + (size_t)(b * LC + t) * D : lat + (size_t)(b * SEQ + t - LC) * D; }
__device__ __forceinline__ float* res_row(float* lat, float* ctx, int m) { const int b = m / TT, t = m - b * TT; return t < LC ? ctx + (size_t)(b * LC + t) * D : lat + (size_t)(b * SEQ + t - LC) * D; }

#define XB_TMO      128
#define XB_XCNT(j)  (256  + 64 * (j))
#define XB_XSUB(j)  (1280 + 64 * (j))
#define XB_XGEN(j)  (2304 + 64 * (j))
#define XB_TOP      3328
#define XB_TOPGEN   3392
#define XCD_BAR_WORDS 3456
#define XB_SPIN_CAP (1u << 18)

__device__ __forceinline__ unsigned xb_ld(unsigned* p)              { return __hip_atomic_load(p, __ATOMIC_RELAXED, __HIP_MEMORY_SCOPE_AGENT); }
__device__ __forceinline__ unsigned xb_add(unsigned* p, unsigned v) { return __hip_atomic_fetch_add(p, v, __ATOMIC_RELAXED, __HIP_MEMORY_SCOPE_AGENT); }
__device__ __forceinline__ unsigned xb_xcc_id() { return (unsigned)__builtin_amdgcn_s_getreg((3 << 11) | 20) & 0xFu; }
#define XB_SPIN(cond, bar) do { unsigned _sp = 0; while (cond) { __builtin_amdgcn_s_sleep(1); \
    if ((++_sp & 255u) == 0u) { if (xb_ld(&(bar)[XB_TMO])) break; if (_sp > XB_SPIN_CAP) { atomicAdd(&(bar)[XB_TMO], 1u); break; } } } } while (0)

struct XcdBarrier { unsigned* bar; unsigned x; volatile LAS unsigned* st; };

__device__ __forceinline__ XcdBarrier xcd_barrier_post(unsigned* bar, volatile LAS unsigned* st, int tid) {
    XcdBarrier b; b.bar = bar; b.x = xb_xcc_id(); b.st = st;
    if (tid == 0) (void)xb_add(&bar[XB_XCNT(b.x)], 1u);
    return b;
}
__device__ __forceinline__ void xcd_barrier_complete(unsigned* bar, unsigned x, unsigned& nloc, unsigned& nx) {
    const unsigned G = gridDim.x * gridDim.y * gridDim.z;
    unsigned sum, cnt, mine, sp = 0u;
    for (;;) {
        sum = 0u; cnt = 0u; mine = 0u;
#pragma unroll
        for (unsigned j = 0; j < 16; ++j) { const unsigned c = xb_ld(&bar[XB_XCNT(j)]); sum += c; cnt += (c > 0u) ? 1u : 0u; mine = (j == x) ? c : mine; }
        if (sum == G) break;
        __builtin_amdgcn_s_sleep(1);
        if ((++sp & 255u) == 0u) { if (xb_ld(&bar[XB_TMO])) break; if (sp > XB_SPIN_CAP) { atomicAdd(&bar[XB_TMO], 1u); break; } }
    }
    nloc = mine > 0u ? mine : 1u; nx = cnt > 0u ? cnt : 1u;
}
__device__ __forceinline__ void xcd_barrier(const XcdBarrier& b, int tid) {
    asm volatile("s_waitcnt vmcnt(0)" ::: "memory");
    __syncthreads();
    if (tid == 0) {
        unsigned* bar = b.bar;
        __builtin_amdgcn_s_waitcnt(0);
        unsigned nloc = b.st[0], nx = b.st[1];
        if (nloc == 0u) { xcd_barrier_complete(bar, b.x, nloc, nx); b.st[0] = nloc; b.st[1] = nx; }
        const unsigned old = xb_add(&bar[XB_XSUB(b.x)], 1u);
        const unsigned gen = old / nloc;
        if (old + 1u == (gen + 1u) * nloc) {
            __builtin_amdgcn_fence(__ATOMIC_RELEASE, "agent");
            asm volatile("s_waitcnt vmcnt(0)" ::: "memory");
            const unsigned og = xb_add(&bar[XB_TOP], 1u);
            const unsigned tg = og / nx;
            if (og + 1u == (tg + 1u) * nx) xb_add(&bar[XB_TOPGEN], 1u);
            else XB_SPIN(xb_ld(&bar[XB_TOPGEN]) == tg, bar);
            __builtin_amdgcn_fence(__ATOMIC_ACQUIRE, "agent");
            xb_add(&bar[XB_XGEN(b.x)], 1u);
            asm volatile("s_waitcnt vmcnt(0)" ::: "memory");
        } else {
            XB_SPIN(xb_ld(&bar[XB_XGEN(b.x)]) == gen, bar);
            __builtin_amdgcn_fence(__ATOMIC_ACQUIRE, "agent");
            asm volatile("s_waitcnt vmcnt(0)" ::: "memory");
        }
    }
    __syncthreads();
}

namespace pg8 {
constexpr int BM = 256, BK = 64, HALF = 128, HTB = HALF * BK * 2, STAGE_BYTES = 8 * HTB, NXCD = 8, WGM = 8;
__device__ __forceinline__ int lds_byte(int r, int c) { const int st = (r >> 4) * 2 + (c >> 5), rr = r & 15, cc = c & 31, ob = rr * 64 + cc * 2; return st * 1024 + (ob ^ (((ob >> 9) & 1) << 5)); }
__device__ __forceinline__ void stage_rc(int b, int& R, int& C) { const int st = b / 1024, sb = b % 1024, swz = sb ^ (((sb >> 9) & 1) << 5); R = (st >> 1) * 16 + swz / 64; C = (st & 1) * 32 + (swz % 64) / 2; }
__device__ __forceinline__ int perm32(int rho) { const int n = rho >> 4, i = rho & 15; return 8 * (i >> 2) + 4 * n + (i & 3); }

__device__ __forceinline__ bool static_order(int i, int G, int c, int nM, int nN, int& pm, int& pn) {
    const int nwg = nM * nN; const long L = (long)i * G + c; if (L >= nwg) return false;
    int wgid = (int)L; { const int q = nwg / NXCD, r = nwg % NXCD, xcd = wgid % NXCD, off = wgid / NXCD; wgid = (xcd < r ? xcd * (q + 1) : r * (q + 1) + (xcd - r) * q) + off; }
    const int nig = WGM * nN, gid = wgid / nig, fm = gid * WGM, gsz = (nM - fm) < WGM ? (nM - fm) : WGM;
    pm = fm + ((wgid % nig) % gsz); pn = (wgid % nig) / gsz; return true;
}

template <class DSC>
__device__ __forceinline__ void gemm_phase(LAS unsigned char* lds, const DSC& S, int wv) {
    const int tid = tid_launder(wv), wid = __builtin_amdgcn_readfirstlane(tid >> 6), lane = tid & 63, wr = wid >> 2, wc = wid & 3, fr = lane & 15, fq = lane >> 4;
    constexpr int K = DSC::K, nt = K / BK, LDB = DSC::LDB;
    int sR[2], sC[2]; unsigned voffB[2];
#pragma unroll
    for (int i = 0; i < 2; ++i) { int R, C; stage_rc(tid * 16 + i * 8192, R, C); sR[i] = R; sC[i] = C; const int Rb = DSC::PERM ? ((R & ~31) + perm32(R & 31)) : R; voffB[i] = (unsigned)(Rb * LDB + C) * 2u; }
    constexpr size_t kstep = (size_t)(BK * 2);
    constexpr size_t hstepB = (size_t)HALF * LDB * 2;
    const unsigned ldsw = (unsigned)wid * 1024u;
    const int aoff = lds_byte(wr * 64 + fr, fq * 8), boff = lds_byte(wc * 32 + fr, fq * 8);
#define PG8_SA(b, h) (((b) * 2 + (h)) * HTB)
#define PG8_SB(b, h) ((4 + (b) * 2 + (h)) * HTB)
#define PG8_STAGE(bufoff, gbase, voff) do { _Pragma("unroll") for (int _i = 0; _i < 2; ++_i) \
        __builtin_amdgcn_global_load_lds((const unsigned*)((const char*)(gbase) + (voff)[_i]), (LAS unsigned*)(lds + (bufoff) + ldsw + _i * 8192), 16, 0, 0); } while (0)
#define PG8_LDA(dst, b, h) do { _Pragma("unroll") for (int m = 0; m < 4; ++m) _Pragma("unroll") for (int k = 0; k < 2; ++k) dst[m][k] = *(const LAS bf16x8*)(lds + PG8_SA(b, h) + aoff + m * 2048 + k * 1024); } while (0)
#define PG8_LDB(dst, b, h) do { _Pragma("unroll") for (int n = 0; n < 2; ++n) _Pragma("unroll") for (int k = 0; k < 2; ++k) dst[n][k] = *(const LAS bf16x8*)(lds + PG8_SB(b, h) + boff + n * 2048 + k * 1024); } while (0)
#define PG8_MMA(ai, bj, At, Bt) do { __builtin_amdgcn_s_setprio(1); _Pragma("unroll") for (int m = 0; m < 4; ++m) _Pragma("unroll") for (int n = 0; n < 2; ++n) _Pragma("unroll") for (int k = 0; k < 2; ++k) \
        acc[ai][bj][m][n] = __builtin_amdgcn_mfma_f32_16x16x32_bf16(Bt[n][k], At[m][k], acc[ai][bj][m][n], 0, 0, 0); __builtin_amdgcn_s_setprio(0); } while (0)
#define PG8_WAIT_V(n) asm volatile("s_waitcnt vmcnt(" #n ")" ::: "memory")
#define PG8_WAIT_L(n) asm volatile("s_waitcnt lgkmcnt(" #n ")" ::: "memory")
#define PG8_BAR __builtin_amdgcn_s_barrier()
#define PG8_SCHED __builtin_amdgcn_sched_barrier(0)
    typename DSC::Unit cur, nxt; int ui = 0;
    if (!S.next(0, cur)) return;
    f32x4 acc[2][2][4][2];
#pragma unroll
    for (int a = 0; a < 2; ++a)
#pragma unroll
        for (int b = 0; b < 2; ++b)
#pragma unroll
            for (int m = 0; m < 4; ++m)
#pragma unroll
                for (int n = 0; n < 2; ++n) acc[a][b][m][n] = (f32x4){0.f, 0.f, 0.f, 0.f};
    bf16x8 At[4][2], B0[2][2], B1[2][2];
    constexpr size_t hstepA = (size_t)HALF * 1024 * 2;
    unsigned va[2][2], vn[2][2];
#define PG8_STAGE_A(bufoff, h, gb, V) do { if constexpr (DSC::GATHER) { PG8_STAGE(bufoff, gb, V[h]); } else { PG8_STAGE(bufoff, (gb) + (h) * hstepA, V[0]); } } while (0)
    const char* cA = S.a_base(cur); S.a_off(cur, sR, sC, va);
    const char* cBl = S.b_lo(cur); const char* cBh = S.b_hi(cur);
    PG8_STAGE(PG8_SB(0, 0), cBl, voffB); PG8_STAGE_A(PG8_SA(0, 0), 0, cA, va); PG8_STAGE(PG8_SB(0, 1), cBl + hstepB, voffB); PG8_STAGE_A(PG8_SA(0, 1), 1, cA, va);
    if (wr == 1) PG8_BAR;
    PG8_WAIT_V(4); PG8_BAR;
    PG8_STAGE(PG8_SB(1, 0), cBl + kstep, voffB); PG8_STAGE_A(PG8_SA(1, 0), 0, cA + kstep, va); PG8_STAGE(PG8_SB(1, 1), cBl + hstepB + kstep, voffB);
    PG8_WAIT_V(6); PG8_BAR;
    for (;;) {
        const bool has_next = S.next(ui + 1, nxt);
        const char* nA; const char* nBl; const char* nBh;
        if (has_next) { nA = S.a_base(nxt); nBl = S.b_lo(nxt); nBh = S.b_hi(nxt); if constexpr (DSC::GATHER) S.a_off(nxt, sR, sC, vn); }
        else { nA = cA; nBl = cBl; nBh = cBh;
            if constexpr (DSC::GATHER) {
#pragma unroll
                for (int h = 0; h < 2; ++h)
#pragma unroll
                    for (int i = 0; i < 2; ++i) vn[h][i] = va[h][i]; } }
        for (int t = 0; t < nt; t += 2) {
            const bool last = (t == nt - 2);
            const char* a1 = cA + (size_t)(t + 1) * kstep;
            const char* a2 = last ? nA : cA + (size_t)(t + 2) * kstep;
            const char* b2 = last ? nBl : ((t + 2) < nt / 2 ? cBl : cBh) + (size_t)(t + 2) * kstep;
            const char* a3 = a2 + kstep; const char* b3 = b2 + kstep;
            unsigned vs[2][2];
#pragma unroll
            for (int h = 0; h < 2; ++h)
#pragma unroll
                for (int i = 0; i < 2; ++i) vs[h][i] = (DSC::GATHER && last) ? vn[h][i] : va[h][i];
            PG8_LDB(B0, 0, 0); PG8_SCHED; PG8_LDA(At, 0, 0); PG8_STAGE_A(PG8_SA(1, 1), 1, a1, va);
            PG8_WAIT_L(8); PG8_BAR; PG8_WAIT_L(0); PG8_MMA(0, 0, At, B0); PG8_BAR; PG8_SCHED;
            PG8_LDB(B1, 0, 1); PG8_STAGE(PG8_SB(0, 0), b2, voffB);
            PG8_BAR; PG8_WAIT_L(0); PG8_MMA(0, 1, At, B1); PG8_BAR;
            PG8_LDA(At, 0, 1); PG8_STAGE_A(PG8_SA(0, 0), 0, a2, vs);
            PG8_BAR; PG8_WAIT_L(0); PG8_MMA(1, 0, At, B0); PG8_BAR; PG8_SCHED;
            PG8_STAGE(PG8_SB(0, 1), b2 + hstepB, voffB);
            PG8_WAIT_V(6); PG8_BAR; PG8_MMA(1, 1, At, B1); PG8_BAR;
            PG8_LDB(B0, 1, 0); PG8_SCHED; PG8_LDA(At, 1, 0); PG8_STAGE_A(PG8_SA(0, 1), 1, a2, vs);
            PG8_WAIT_L(8); PG8_BAR; PG8_WAIT_L(0); PG8_MMA(0, 0, At, B0); PG8_BAR; PG8_SCHED;
            PG8_LDB(B1, 1, 1); PG8_STAGE(PG8_SB(1, 0), b3, voffB);
            PG8_BAR; PG8_WAIT_L(0); PG8_MMA(0, 1, At, B1); PG8_BAR;
            PG8_LDA(At, 1, 1); PG8_STAGE_A(PG8_SA(1, 0), 0, a3, vs);
            PG8_BAR; PG8_WAIT_L(0); PG8_MMA(1, 0, At, B0); PG8_BAR; PG8_SCHED;
            PG8_STAGE(PG8_SB(1, 1), b3 + hstepB, voffB);
            PG8_WAIT_V(6); PG8_BAR; PG8_MMA(1, 1, At, B1); PG8_BAR;
        }
        S.epi(acc, cur, wr, wc, fr, fq);
        if (!has_next) break;
#pragma unroll
        for (int a = 0; a < 2; ++a)
#pragma unroll
            for (int b = 0; b < 2; ++b)
#pragma unroll
                for (int m = 0; m < 4; ++m)
#pragma unroll
                    for (int n = 0; n < 2; ++n) acc[a][b][m][n] = (f32x4){0.f, 0.f, 0.f, 0.f};
        cur = nxt; cA = nA; cBl = nBl; cBh = nBh; ++ui;
        if constexpr (DSC::GATHER) {
#pragma unroll
            for (int h = 0; h < 2; ++h)
#pragma unroll
                for (int i = 0; i < 2; ++i) va[h][i] = vn[h][i]; }
    }
    PG8_WAIT_V(0);
    if (wr == 0) PG8_BAR;
    PG8_BAR;
#undef PG8_SA
#undef PG8_SB
#undef PG8_STAGE
#undef PG8_STAGE_A
#undef PG8_LDA
#undef PG8_LDB
#undef PG8_MMA
#undef PG8_WAIT_V
#undef PG8_WAIT_L
#undef PG8_BAR
#undef PG8_SCHED
}
}

__device__ __forceinline__ void std_a_off(const int (&sR)[2], const int (&sC)[2], unsigned (&v)[2][2]) {
#pragma unroll
    for (int h = 0; h < 2; ++h)
#pragma unroll
        for (int i = 0; i < 2; ++i) v[h][i] = (unsigned)((sR[i] + 128 * h) * 1024 + sC[i]) * 2u;
}
struct Dsc1 {
    static constexpr int K = 1024, LDB = 1024; static constexpr bool PERM = true, GATHER = false;
    struct Unit { int pm, pn; };
    const bf16_t* A; const bf16_t* Bt; bf16_t* P; int G, c;
    __device__ __forceinline__ bool next(int i, Unit& u) const { return pg8::static_order(i, G, c, NTOK / 256, 12, u.pm, u.pn); }
    __device__ __forceinline__ const char* a_base(const Unit& u) const { return (const char*)A + (size_t)u.pm * 256 * 1024 * 2; }
    __device__ __forceinline__ void a_off(const Unit&, const int (&sR)[2], const int (&sC)[2], unsigned (&v)[2][2]) const { std_a_off(sR, sC, v); }
    __device__ __forceinline__ const char* b_lo(const Unit& u) const { return (const char*)Bt + (size_t)u.pn * 256 * 1024 * 2; }
    __device__ __forceinline__ const char* b_hi(const Unit& u) const { return b_lo(u); }
    __device__ __forceinline__ void epi(const f32x4 (&acc)[2][2][4][2], const Unit& u, int wr, int wc, int fr, int fq) const {
        bf16_t* base = P + (size_t)u.pn * PANEL_EL + (size_t)(u.pm * 256 + wr * 64 + fr) * 256 + wc * 32 + 8 * fq;
#pragma unroll
        for (int ai = 0; ai < 2; ++ai)
#pragma unroll
            for (int m = 0; m < 4; ++m) { bf16_t* rowp = base + (size_t)(ai * 128 + m * 16) * 256;
#pragma unroll
                for (int bj = 0; bj < 2; ++bj) { const f32x4 v0 = acc[ai][bj][m][0], v1 = acc[ai][bj][m][1];
                    *(u32x4*)(rowp + bj * 128) = (u32x4){pk_bf16(v0[0], v0[1]), pk_bf16(v0[2], v0[3]), pk_bf16(v1[0], v1[1]), pk_bf16(v1[2], v1[3])}; } }
    }
};
struct Dsc2 {
    static constexpr int K = 1024, LDB = 1024; static constexpr bool PERM = false, GATHER = false;
    struct Unit { int pm, pn; };
    const bf16_t* A; const bf16_t* Bt; const float* lat_in; const float* ctx_in; float* lat_out; float* ctx_out; const float* mod; int G, c, last, dry;
    __device__ __forceinline__ bool next(int i, Unit& u) const {
        int pm, pn; if (!pg8::static_order(i, G, c, last ? 128 : 144, 4, pm, pn)) return false;
        u.pm = last ? (pm >> 3) * 9 + 1 + (pm & 7) : pm; u.pn = pn; return true; }
    __device__ __forceinline__ const char* a_base(const Unit& u) const { return (const char*)A + (size_t)u.pm * 256 * 1024 * 2; }
    __device__ __forceinline__ void a_off(const Unit&, const int (&sR)[2], const int (&sC)[2], unsigned (&v)[2][2]) const { std_a_off(sR, sC, v); }
    __device__ __forceinline__ const char* b_lo(const Unit& u) const { return (const char*)Bt + (size_t)u.pn * 256 * 1024 * 2; }
    __device__ __forceinline__ const char* b_hi(const Unit& u) const { return b_lo(u); }
    __device__ __forceinline__ void epi(const f32x4 (&acc)[2][2][4][2], const Unit& u, int wr, int wc, int fr, int fq) const {
        const int b = u.pm / 9, pp = u.pm - b * 9;
        const size_t ro = pp == 0 ? (size_t)b * LC * D : ((size_t)b * SEQ + (size_t)(pp - 1) * 256) * D;
        const float* inb = (pp == 0 ? ctx_in : lat_in) + ro; float* outb = (pp == 0 ? ctx_out : lat_out) + ro;
        const int col0 = u.pn * 256 + wc * 32 + 4 * fq, row0 = wr * 64 + fr;
        const float* gate = mod + (size_t)(pp == 0 ? 16 : b) * 6144 + 2 * 1024 + col0;
        f32x4 gv[2][2];
#pragma unroll
        for (int bj = 0; bj < 2; ++bj)
#pragma unroll
            for (int n = 0; n < 2; ++n) gv[bj][n] = *(const f32x4*)(gate + bj * 128 + n * 16);
#pragma unroll
        for (int ai = 0; ai < 2; ++ai)
#pragma unroll
            for (int m = 0; m < 4; ++m) { const size_t o = (size_t)(row0 + ai * 128 + m * 16) * D + col0;
#pragma unroll
                for (int bj = 0; bj < 2; ++bj)
#pragma unroll
                    for (int n = 0; n < 2; ++n) { const f32x4 x = *(const f32x4*)(inb + o + bj * 128 + n * 16);
                        if (!dry) *(f32x4*)(outb + o + bj * 128 + n * 16) = x + gv[bj][n] * acc[ai][bj][m][n]; else asm volatile("" :: "v"(x + gv[bj][n] * acc[ai][bj][m][n])); } }
    }
};
__device__ __forceinline__ void bucket_experts(int bk, int& elo, int& ehi) {
    const int gr = bk / 6, pr = bk - gr * 6;
    const int i = pr < 3 ? 0 : (pr < 5 ? 1 : 2), j = pr < 3 ? pr + 1 : (pr < 5 ? pr - 1 : 3);
    elo = gr * 4 + i; ehi = gr * 4 + j;
}
struct Dsc3 {
    static constexpr int K = 1024, LDB = 1024; static constexpr bool PERM = true, GATHER = true;
    struct Unit { int ti, pn, elo, ehi; };
    const bf16_t* A; const bf16_t* Wgu; bf16_t* ACT; const int* list; const float* slotw; const int* tile; int G, c, nt_;
    __device__ __forceinline__ bool next(int i, Unit& u) const {
        if (!pg8::static_order(i, G, c, nt_, 8, u.ti, u.pn)) return false;
        const int bk = __builtin_amdgcn_readfirstlane(tile[8 + u.ti]); bucket_experts(bk, u.elo, u.ehi); return true; }
    __device__ __forceinline__ const char* a_base(const Unit&) const { return (const char*)A; }
    __device__ __forceinline__ void a_off(const Unit& u, const int (&sR)[2], const int (&sC)[2], unsigned (&v)[2][2]) const {
#pragma unroll
        for (int h = 0; h < 2; ++h)
#pragma unroll
            for (int i = 0; i < 2; ++i) { int tok = list[u.ti * 256 + sR[i] + 128 * h]; tok = tok < 0 ? 0 : tok; v[h][i] = (unsigned)(tok * 1024 + sC[i]) * 2u; }
    }
    __device__ __forceinline__ const char* b_lo(const Unit& u) const { const int e = u.pn < 4 ? u.elo : u.ehi; return (const char*)Wgu + ((size_t)e * 1024 + (size_t)(u.pn & 3) * 256) * 1024 * 2; }
    __device__ __forceinline__ const char* b_hi(const Unit& u) const { return b_lo(u); }
    __device__ __forceinline__ void epi(const f32x4 (&acc)[2][2][4][2], const Unit& u, int wr, int wc, int fr, int fq) const {
        const int slot0 = u.ti * 256 + wr * 64 + fr, wsel = u.pn < 4 ? 0 : 1;
        bf16_t* base = ACT + (size_t)slot0 * 1024 + (u.pn < 4 ? 0 : 512) + (u.pn & 3) * 128 + wc * 32 + 8 * fq;
#pragma unroll
        for (int ai = 0; ai < 2; ++ai)
#pragma unroll
            for (int m = 0; m < 4; ++m) { const int dr = ai * 128 + m * 16; const float w = slotw[(size_t)(slot0 + dr) * 2 + wsel];
                const f32x4 g0 = acc[ai][0][m][0], g1 = acc[ai][0][m][1], u0 = acc[ai][1][m][0], u1 = acc[ai][1][m][1];
                float r[8];
#pragma unroll
                for (int q = 0; q < 4; ++q) { r[q] = w * siluf_(g0[q]) * u0[q]; r[4 + q] = w * siluf_(g1[q]) * u1[q]; }
                *(u32x4*)(base + (size_t)dr * 1024) = (u32x4){pk_bf16(r[0], r[1]), pk_bf16(r[2], r[3]), pk_bf16(r[4], r[5]), pk_bf16(r[6], r[7])}; }
    }
};
struct Dsc4 {
    static constexpr int K = 1024, LDB = 512; static constexpr bool PERM = false, GATHER = false;
    struct Unit { int ti, pn, elo, ehi; };
    const bf16_t* A; const bf16_t* Wdn; float* lat; float* ctx; const float* mod; const int* list; const int* tile; int G, c, nt_, dry;
    __device__ __forceinline__ bool next(int i, Unit& u) const {
        if (!pg8::static_order(i, G, c, nt_, 4, u.ti, u.pn)) return false;
        const int bk = __builtin_amdgcn_readfirstlane(tile[8 + u.ti]); bucket_experts(bk, u.elo, u.ehi); return true; }
    __device__ __forceinline__ const char* a_base(const Unit& u) const { return (const char*)A + (size_t)u.ti * 256 * 1024 * 2; }
    __device__ __forceinline__ void a_off(const Unit&, const int (&sR)[2], const int (&sC)[2], unsigned (&v)[2][2]) const { std_a_off(sR, sC, v); }
    __device__ __forceinline__ const char* b_lo(const Unit& u) const { return (const char*)Wdn + ((size_t)u.elo * 1024 + (size_t)u.pn * 256) * 512 * 2; }
    __device__ __forceinline__ const char* b_hi(const Unit& u) const { return (const char*)Wdn + ((size_t)u.ehi * 1024 + (size_t)u.pn * 256) * 512 * 2 - (size_t)(K / 128) * 128; }
    __device__ __forceinline__ void epi(const f32x4 (&acc)[2][2][4][2], const Unit& u, int wr, int wc, int fr, int fq) const {
        const int slot0 = u.ti * 256 + wr * 64 + fr, col0 = u.pn * 256 + wc * 32 + 4 * fq;
#pragma unroll
        for (int ai = 0; ai < 2; ++ai)
#pragma unroll
            for (int m = 0; m < 4; ++m) { const int tok = list[slot0 + ai * 128 + m * 16];
                if (tok >= 0) { const int b = tok / TT, t = tok - b * TT;
                    float* rp = (t < LC ? ctx + (size_t)(b * LC + t) * D : lat + (size_t)(b * SEQ + t - LC) * D) + col0;
                    const float* gate = mod + (size_t)(t < LC ? 16 : b) * 6144 + 5 * 1024 + col0;
#pragma unroll
                    for (int bj = 0; bj < 2; ++bj)
#pragma unroll
                        for (int n = 0; n < 2; ++n) { const f32x4 gv = *(const f32x4*)(gate + bj * 128 + n * 16); const f32x4 x = *(const f32x4*)(rp + bj * 128 + n * 16);
                            if (!dry) *(f32x4*)(rp + bj * 128 + n * 16) = x + gv * acc[ai][bj][m][n]; else asm volatile("" :: "v"(x + gv * acc[ai][bj][m][n])); } } }
    }
};

__device__ __forceinline__ void tr_tile(LAS float* tl, const float* src, int ld, int scol, float scale, bf16_t* dst, int lddst, int wv) {
    const int tid = tid_launder(wv), n = tid & 63, kq = tid >> 6;
#pragma unroll
    for (int i = 0; i < 8; ++i) { const int k = kq + 8 * i; tl[k * 65 + n] = scol >= 0 ? src[(size_t)k * ld + scol] * scale : 0.f; }
    __syncthreads();
    const int nn = tid >> 3, k8 = (tid & 7) * 8;
    u32x4 w;
#pragma unroll
    for (int j = 0; j < 4; ++j) w[j] = pk_bf16(tl[(k8 + 2 * j) * 65 + nn], tl[(k8 + 2 * j + 1) * 65 + nn]);
    *(u32x4*)(dst + (size_t)nn * lddst + k8) = w;
    __syncthreads();
}
__device__ __forceinline__ void convert_moe(KP p, LAS unsigned char* lds, int l, int wv) {
    LAS float* tl = (LAS float*)lds;
    bf16_t* WGU = (bf16_t*)(p->ws + WS_WGU); bf16_t* WDN = (bf16_t*)(p->ws + WS_WDN);
    const int n = tid_launder(wv) & 63;
    for (int idx = bid_launder(); idx < 4096 + 2048; idx += gridDim.x) {
        if (idx < 4096) { const int e = idx >> 8, rt = (idx >> 4) & 15, kt = idx & 15, q = rt >> 2, sub = rt & 3;
            const float* src = p->in[sub < 2 ? I_WG : I_WU] + ((size_t)(l * 16 + e) * 1024 + kt * 64) * 512;
            tr_tile(tl, src, 512, q * 128 + (sub & 1) * 64 + n, 1.f, WGU + ((size_t)e * 1024 + rt * 64) * 1024 + kt * 64, 1024, wv);
        } else { const int j = idx - 4096, e = j >> 7, ntile = (j >> 3) & 15, kt = j & 7;
            const float* src = p->in[I_WD] + ((size_t)(l * 16 + e) * 512 + kt * 64) * 1024;
            tr_tile(tl, src, 1024, ntile * 64 + n, 1.f, WDN + ((size_t)e * 1024 + ntile * 64) * 512 + kt * 64, 512, wv); }
    }
}
__device__ __forceinline__ void phase_prologue(KP p, LAS unsigned char* lds, int wv) {
    const int tid = tid_launder(wv), lane = tid & 63, wave = tid >> 6;
    {
        LAS float* SC = (LAS float*)lds; LAS float* RED = (LAS float*)(lds + 17 * 1024 * 4);
        for (int i = tid; i < 17 * 1024; i += 512) { const int r = i >> 10, k = i & 1023; const float v = r < 16 ? p->in[I_C][r * 1024 + k] : p->in[I_CCTX][k]; SC[i] = siluf_(v); }
        __syncthreads();
        float* MOD = (float*)(p->ws + WS_MOD);
        for (int unit = bid_launder(); unit < 192; unit += gridDim.x) {
            const int l = unit / 96, cg = unit - l * 96;
            const float* W = p->in[I_WADA] + (size_t)l * 1024 * 6144 + cg * 64 + lane;
            float acc[17];
#pragma unroll
            for (int r = 0; r < 17; ++r) acc[r] = 0.f;
            for (int k = wave * 128; k < wave * 128 + 128; k += 4) {
                const float w0 = W[(size_t)k * 6144], w1 = W[(size_t)(k + 1) * 6144], w2 = W[(size_t)(k + 2) * 6144], w3 = W[(size_t)(k + 3) * 6144];
#pragma unroll
                for (int r = 0; r < 17; ++r) { const f32x4 s = *(const LAS f32x4*)(SC + r * 1024 + k); acc[r] += s[0] * w0 + s[1] * w1 + s[2] * w2 + s[3] * w3; }
            }
#pragma unroll
            for (int r = 0; r < 17; ++r) RED[(wave * 17 + r) * 64 + lane] = acc[r];
            __syncthreads();
            for (int i = tid; i < 17 * 64; i += 512) { const int r = i >> 6, cc = i & 63; float s = 0.f;
#pragma unroll
                for (int w = 0; w < 8; ++w) s += RED[(w * 17 + r) * 64 + cc];
                MOD[(size_t)(l * 17 + r) * 6144 + cg * 64 + cc] = s + p->in[I_BADA][l * 6144 + cg * 64 + cc]; }
            __syncthreads();
        }
        __syncthreads();
    }
    {
        LAS float* tl = (LAS float*)lds;
        bf16_t* WIN = (bf16_t*)(p->ws + WS_WIN); bf16_t* WOUT = (bf16_t*)(p->ws + WS_WOUT);
        const int n = tid & 63;
        for (int idx = bid_launder(); idx < 1664 + 512; idx += gridDim.x) {
            if (idx < 1664) { const int l = idx / 832, r = idx - l * 832, ntile = r >> 4, kt = r & 15, np = ntile * 64 + n;
                int scol; if (np < 768) scol = np; else if (np < 3072) scol = np + 32; else { const int j = np - 3072; scol = j < 32 ? 768 + j : (j < 48 ? 3104 + (j - 32) : -1); }
                const float scale = np < 128 ? 0.17677669529663687f : ((np >= 768 && np < 1024) ? 0.125f : 1.f);
                tr_tile(tl, p->in[I_WIN] + ((size_t)l * 1024 + kt * 64) * DIN, DIN, scol, scale, WIN + ((size_t)l * NWIN + ntile * 64) * 1024 + kt * 64, 1024, wv);
            } else { const int j = idx - 1664, l = j >> 8, ntile = (j >> 4) & 15, kt = j & 15;
                tr_tile(tl, p->in[I_WOUT] + ((size_t)l * 1024 + kt * 64) * 1024, 1024, ntile * 64 + n, 1.f, WOUT + ((size_t)l * 1024 + ntile * 64) * 1024 + kt * 64, 1024, wv); }
        }
    }
    convert_moe(p, lds, 0, wv);
}

__device__ __forceinline__ void route16(const float (&lg)[16], const float* rb, int& bucket, float& wlo, float& whi) {
    float bestgs = -INFINITY, bs1 = 0.f, bs2 = 0.f; int bestg = 0, bi1 = 0, bi2 = 1;
#pragma unroll
    for (int g = 0; g < 4; ++g) {
        float sc[4], sl[4];
#pragma unroll
        for (int j = 0; j < 4; ++j) { sc[j] = sigmoidf_(lg[4 * g + j]); sl[j] = sc[j] + rb[4 * g + j]; }
        int i1 = 0; float v1 = sl[0], s1 = sc[0];
#pragma unroll
        for (int j = 1; j < 4; ++j) if (sl[j] > v1) { v1 = sl[j]; s1 = sc[j]; i1 = j; }
        int i2 = 0; float v2 = -INFINITY, s2 = 0.f;
#pragma unroll
        for (int j = 0; j < 4; ++j) if (j != i1 && sl[j] > v2) { v2 = sl[j]; s2 = sc[j]; i2 = j; }
        const float gs = v1 + v2;
        if (gs > bestgs) { bestgs = gs; bestg = g; bi1 = i1; bi2 = i2; bs1 = s1; bs2 = s2; }
    }
    const int lo = bi1 < bi2 ? bi1 : bi2, hi = bi1 < bi2 ? bi2 : bi1;
    const float slo = bi1 < bi2 ? bs1 : bs2, shi = bi1 < bi2 ? bs2 : bs1;
    const int pr = lo == 0 ? hi - 1 : (lo == 1 ? hi + 1 : 5);
    bucket = bestg * 6 + pr; const float inv = 1.f / (bs1 + bs2); wlo = slo * inv; whi = shi * inv;
}
template <bool ROUTER>
__device__ __forceinline__ void phase_prep(KP p, LAS unsigned char* lds, int l, const float* lat, const float* ctx, int latent_only, int wv) {
    const int tid = tid_launder(wv), lane = tid & 63, wave = tid >> 6, fr = lane & 15, kq = lane >> 4;
    const float* MOD = (const float*)(p->ws + WS_MOD) + (size_t)l * 17 * 6144;
    const float* g = p->in[I_NORMG] + (l * 2 + (ROUTER ? 1 : 0)) * 1024;
    bf16_t* H = (bf16_t*)(p->ws + WS_ABUF);
    constexpr int NT = ROUTER ? 1 : 3, AST = 1032;
    LAS bf16_t* AH = (LAS bf16_t*)lds; LAS bf16_t* AL = AH + 16 * AST; LAS float* PART = (LAS float*)(lds + 2 * 16 * AST * 2); LAS float* LG = PART + 8 * NT * 256; LAS int* hist = (LAS int*)(LG + 256);
    bf16x8 Bh[NT][4], Bl[4];
    if (ROUTER) {
#pragma unroll
        for (int kk = 0; kk < 4; ++kk) { const int k0 = 128 * wave + 32 * kk + 8 * kq; u32x4 wh, wl;
#pragma unroll
            for (int e = 0; e < 4; ++e) { const float w0 = p->in[I_RW][(size_t)(k0 + 2 * e) * 16 + fr], w1 = p->in[I_RW][(size_t)(k0 + 2 * e + 1) * 16 + fr];
                const unsigned hh = pk_bf16(w0, w1); wh[e] = hh; wl[e] = pk_bf16(w0 - bflo(hh), w1 - bfhi(hh)); }
            Bh[0][kk] = __builtin_bit_cast(bf16x8, wh); Bl[kk] = __builtin_bit_cast(bf16x8, wl); }
    } else {
        const bf16_t* WS_ = (const bf16_t*)(p->ws + WS_WIN) + ((size_t)l * NWIN + 3072) * 1024;
#pragma unroll
        for (int nt = 0; nt < NT; ++nt)
#pragma unroll
            for (int kk = 0; kk < 4; ++kk) { Bh[nt][kk] = *(const bf16x8*)(WS_ + (size_t)(16 * nt + fr) * 1024 + 128 * wave + 32 * kk + 8 * kq); }
#pragma unroll
        for (int kk = 0; kk < 4; ++kk) Bl[kk] = Bh[0][kk];
    }
    const int n_per = latent_only ? 128 : 144, ngrp = n_per / 16;
    for (int vb = bid_launder(); vb < NVB; vb += gridDim.x) {
        if (ROUTER) { if (tid < 32) hist[tid] = 0; }
        const int mbase = latent_only ? (vb >> 4) * TT + LC + (vb & 15) * 128 : vb * 144;
        f32x4 xn[2][4];
#pragma unroll
        for (int r = 0; r < 2; ++r) { const float* xr0 = res_row_c(lat, ctx, mbase + 2 * wave + r);
#pragma unroll
            for (int j = 0; j < 4; ++j) xn[r][j] = *(const f32x4*)(xr0 + 4 * lane + 256 * j); }
        for (int grp = 0; grp < ngrp; ++grp) {
            f32x4 xv[2][4];
#pragma unroll
            for (int r = 0; r < 2; ++r)
#pragma unroll
                for (int j = 0; j < 4; ++j) xv[r][j] = xn[r][j];
            if (grp + 1 < ngrp) {
#pragma unroll
                for (int r = 0; r < 2; ++r) { const float* xrn = res_row_c(lat, ctx, mbase + 16 * (grp + 1) + 2 * wave + r);
#pragma unroll
                    for (int j = 0; j < 4; ++j) xn[r][j] = *(const f32x4*)(xrn + 4 * lane + 256 * j); } }
#pragma unroll
            for (int r = 0; r < 2; ++r) {
                const int m = mbase + 16 * grp + 2 * wave + r, b = m / TT, t = m - b * TT, rb = t < LC ? 16 : b;
                float ss = 0.f;
#pragma unroll
                for (int j = 0; j < 4; ++j) ss += xv[r][j][0] * xv[r][j][0] + xv[r][j][1] * xv[r][j][1] + xv[r][j][2] * xv[r][j][2] + xv[r][j][3] * xv[r][j][3];
                ss = wave_sum(ss);
                const float rstd = rsqrtf(ss * (1.f / 1024.f) + EPS);
                const float* sh = MOD + (size_t)rb * 6144 + (ROUTER ? 3 : 0) * 1024; const float* sc = sh + 1024;
#pragma unroll
                for (int j = 0; j < 4; ++j) { const int idx = 4 * lane + 256 * j;
                    const f32x4 gv = *(const f32x4*)(g + idx), shv = *(const f32x4*)(sh + idx), scv = *(const f32x4*)(sc + idx);
                    const f32x4 hv = xv[r][j] * rstd * gv * (1.f + scv) + shv;
                    const unsigned h0 = pk_bf16(hv[0], hv[1]), h1 = pk_bf16(hv[2], hv[3]);
                    *(u32x2*)(H + (size_t)m * 1024 + idx) = (u32x2){h0, h1};
                    *(LAS u32x2*)(AH + (2 * wave + r) * AST + idx) = (u32x2){h0, h1};
                    if (ROUTER) *(LAS u32x2*)(AL + (2 * wave + r) * AST + idx) = (u32x2){pk_bf16(hv[0] - bflo(h0), hv[1] - bfhi(h0)), pk_bf16(hv[2] - bflo(h1), hv[3] - bfhi(h1))}; }
            }
            __syncthreads();
            { f32x4 acc[NT];
#pragma unroll
                for (int nt = 0; nt < NT; ++nt) acc[nt] = (f32x4){0.f, 0.f, 0.f, 0.f};
#pragma unroll
                for (int kk = 0; kk < 4; ++kk) { const bf16x8 ah = *(const LAS bf16x8*)(AH + fr * AST + 128 * wave + 32 * kk + 8 * kq);
#pragma unroll
                    for (int nt = 0; nt < NT; ++nt) acc[nt] = __builtin_amdgcn_mfma_f32_16x16x32_bf16(ah, Bh[nt][kk], acc[nt], 0, 0, 0);
                    if (ROUTER) { const bf16x8 al = *(const LAS bf16x8*)(AL + fr * AST + 128 * wave + 32 * kk + 8 * kq);
                        acc[0] = __builtin_amdgcn_mfma_f32_16x16x32_bf16(ah, Bl[kk], acc[0], 0, 0, 0); acc[0] = __builtin_amdgcn_mfma_f32_16x16x32_bf16(al, Bh[0][kk], acc[0], 0, 0, 0); } }
#pragma unroll
                for (int nt = 0; nt < NT; ++nt)
#pragma unroll
                    for (int i = 0; i < 4; ++i) PART[(wave * NT + nt) * 256 + (4 * kq + i) * 16 + fr] = acc[nt][i]; }
            __syncthreads();
            for (int e2 = tid; e2 < NT * 256; e2 += 512) { const int nt = e2 >> 8, e = e2 & 255; float sacc = 0.f;
#pragma unroll
                for (int w = 0; w < 8; ++w) sacc += PART[(w * NT + nt) * 256 + e];
                if (ROUTER) LG[e] = sacc;
                else ((bf16_t*)(p->ws + WS_SMALL))[(size_t)(mbase + 16 * grp + (e >> 4)) * 64 + 16 * nt + (e & 15)] = (bf16_t)(pk_bf16(sacc, 0.f) & 0xffffu); }
            if (ROUTER) {
                __syncthreads();
                if (tid < 16) { float lg[16];
#pragma unroll
                    for (int q = 0; q < 4; ++q) { const f32x4 v = *(const LAS f32x4*)(LG + tid * 16 + 4 * q); lg[4 * q] = v[0]; lg[4 * q + 1] = v[1]; lg[4 * q + 2] = v[2]; lg[4 * q + 3] = v[3]; }
                    int bucket; float wlo, whi; route16(lg, p->in[I_RB], bucket, wlo, whi);
                    *(f32x4*)(p->ws + WS_ROUTE + (size_t)(mbase + 16 * grp + tid) * 16) = (f32x4){__int_as_float(bucket), wlo, whi, 0.f};
                    __hip_atomic_fetch_add(hist + bucket, 1, __ATOMIC_RELAXED, __HIP_MEMORY_SCOPE_WORKGROUP); }
            }
        }
        if (ROUTER) { __syncthreads(); if (tid < 32) ((int*)(p->ws + WS_HIST))[vb * 32 + tid] = tid < 24 ? hist[tid] : 0; }
        __syncthreads();
    }
}

__device__ __forceinline__ void phase_moe_offsets(KP p, LAS unsigned char* lds, int latent_only, int wv) {
    const int tid = tid_launder(wv), lane = tid & 63, wave = tid >> 6;
    LAS int* PT = (LAS int*)lds; LAS int* tot = PT + 384; LAS int* tbase = tot + 32; LAS int* wsum = tbase + 32;
    const int* HIST = (const int*)(p->ws + WS_HIST); int* LIST = (int*)(p->ws + WS_LIST); f32x2* SLOTW = (f32x2*)(p->ws + WS_SLOTW); int* TILE = (int*)(p->ws + WS_TILE);
    for (int j = bid_launder(); j < 24; j += gridDim.x) {
        if (tid < 384) { const int jj = tid % 24, pi = tid / 24; int sacc = 0; for (int w = pi * 16; w < pi * 16 + 16; ++w) sacc += HIST[w * 32 + jj]; PT[pi * 24 + jj] = sacc; }
        __syncthreads();
        if (tid < 24) { int sacc = 0; for (int i = 0; i < 16; ++i) sacc += PT[i * 24 + tid]; tot[tid] = sacc; }
        __syncthreads();
        if (tid == 0) { int run = 0; for (int q = 0; q < 24; ++q) { tbase[q] = run; run += (tot[q] + 255) >> 8; } tbase[24] = run; }
        __syncthreads();
        const int base = tbase[j] * 256, cnt = tot[j], ntile = (cnt + 255) >> 8;
        if (j == 0) { if (tid == 0) TILE[0] = tbase[24]; if (tid < 24) { const int nq = (tot[tid] + 255) >> 8; for (int i = 0; i < nq; ++i) TILE[8 + tbase[tid] + i] = tid; } }
        int mycnt = 0;
        for (int i = 0; i < 72; ++i) { const int m = tid * 72 + i; const int t = m % TT;
            if (!latent_only || t >= LC) { const int bk = __float_as_int(*(const float*)(p->ws + WS_ROUTE + (size_t)m * 16)); mycnt += (bk == j) ? 1 : 0; } }
        int incl = mycnt;
#pragma unroll
        for (int o = 1; o < 64; o <<= 1) { const int v = __shfl_up(incl, o, 64); if (lane >= o) incl += v; }
        if (lane == 63) wsum[wave] = incl;
        __syncthreads();
        int woff = 0;
#pragma unroll
        for (int w = 0; w < 8; ++w) woff += (w < wave) ? wsum[w] : 0;
        int pos = base + woff + incl - mycnt;
        for (int i = 0; i < 72; ++i) { const int m = tid * 72 + i; const int t = m % TT;
            if (!latent_only || t >= LC) { const f32x4 r = *(const f32x4*)(p->ws + WS_ROUTE + (size_t)m * 16);
                if (__float_as_int(r[0]) == j) { LIST[pos] = m; SLOTW[pos] = (f32x2){r[1], r[2]}; ++pos; } } }
        for (int sidx = base + cnt + tid; sidx < base + ntile * 256; sidx += 512) { LIST[sidx] = -1; SLOTW[sidx] = (f32x2){0.f, 0.f}; }
        __syncthreads();
    }
}

__device__ __forceinline__ bf16_t* obuf(unsigned char* ws, int k) {
    const int panel = k == 4 ? 8 : (k == 5 ? 9 : (k == 6 ? 10 : 12));
    return k < 4 ? (bf16_t*)(ws + WS_O) + (size_t)k * PANEL_EL : (bf16_t*)(ws + WS_P) + (size_t)panel * PANEL_EL;
}
__device__ __forceinline__ void phase_mixprep(KP p, int l, int skip_rope, int wv) {
    const int tid = tid_launder(wv);
    bf16_t* P = (bf16_t*)(p->ws + WS_P); bf16_t* DNP = (bf16_t*)(p->ws + WS_ABUF);
    float* GDEC = (float*)(p->ws + WS_GDEC); float* DNAB = (float*)(p->ws + WS_DNAB);
    float cw[5][2] = {{0.f, 0.f}, {0.f, 0.f}, {0.f, 0.f}, {0.f, 0.f}, {0.f, 0.f}};
    const int sec = tid >> 7, cp = (tid & 127) * 2;
    if (tid < 384) {
#pragma unroll
        for (int j = 0; j < 5; ++j) { cw[j][0] = p->in[I_CONVW][(l * 5 + j) * 768 + sec * 256 + cp]; cw[j][1] = p->in[I_CONVW][(l * 5 + j) * 768 + sec * 256 + cp + 1]; }
    }
    float nalog = 0.f, dtb = 0.f;
    if (tid >= 384 && tid < 392) { nalog = -__expf(p->in[I_ALOG][l * 8 + tid - 384]); dtb = p->in[I_DTB][l * 8 + tid - 384]; }
    float gw[16], gb = 0.f, invf = 0.f; int userow = 0;
#pragma unroll
    for (int r = 0; r < 16; ++r) gw[r] = 0.f;
    const int t2 = tid & 255;
    if (tid >= 256) { const int dir = t2 >> 7, c = t2 & 127;
#pragma unroll
        for (int r = 0; r < 16; ++r) gw[r] = p->in[I_GKW][((l * 2 + dir) * 16 + r) * 128 + c];
        gb = p->in[I_GKB][(l * 2 + dir) * 128 + c];
    } else { const int i = t2 & 31; invf = exp2f(-(float)(i & 15) * (13.287712379549449f / 16.f)); userow = i < 16; }
    for (int vb = bid_launder(); vb < NVB; vb += gridDim.x) {
        const int b = vb >> 4, t0 = (vb & 15) * 144;
        unsigned nA[8]; float nda[4], ndb[4]; u32x4 nz0[4], nz1[4]; unsigned nC[4];
#define MP_LOADS(C0) do { const int t_ = t0 + (C0), m_ = b * TT + t_, lo_ = t_ < LC ? 0 : LC, hi_ = t_ < LC ? LC : TT; \
            if (tid < 384) { const bf16_t* src = P + (size_t)(8 + sec) * PANEL_EL + cp; \
                _Pragma("unroll") for (int j = 0; j < 8; ++j) { const int tt = t_ - 2 + j; nA[j] = (tt >= lo_ && tt < hi_) ? *(const unsigned*)(src + (size_t)(b * TT + tt) * 256) : 0u; } } \
            else if (tid < 392) { const int j = tid - 384; const bf16_t* s12 = (const bf16_t*)(p->ws + WS_SMALL) + (size_t)m_ * 64; \
                _Pragma("unroll") for (int q = 0; q < 4; ++q) { nda[q] = bf2f(s12[q * 64 + 32 + j]); ndb[q] = bf2f(s12[q * 64 + 40 + j]); } } \
            if (tid >= 256) { const bf16_t* zp = (const bf16_t*)(p->ws + WS_SMALL) + (size_t)m_ * 64 + (t2 >> 7) * 16; \
                _Pragma("unroll") for (int q = 0; q < 4; ++q) { nz0[q] = *(const u32x4*)(zp + q * 64); nz1[q] = *(const u32x4*)(zp + q * 64 + 8); } } \
            else if (t_ >= LC && !skip_rope) { const bf16_t* ap = P + (size_t)(3 + (t2 >> 7)) * PANEL_EL + (size_t)m_ * 256 + 2 * (t2 & 127); \
                _Pragma("unroll") for (int q = 0; q < 4; ++q) nC[q] = *(const unsigned*)(ap + q * 256); } } while (0)
        MP_LOADS(0);
        for (int c0 = 0; c0 < 144; c0 += 4) {
            const int t = t0 + c0, m = b * TT + t;
            unsigned raw[8]; float da[4], db[4]; u32x4 z0[4], z1[4]; unsigned rc[4];
#pragma unroll
            for (int j = 0; j < 8; ++j) raw[j] = nA[j];
#pragma unroll
            for (int q = 0; q < 4; ++q) { da[q] = nda[q]; db[q] = ndb[q]; z0[q] = nz0[q]; z1[q] = nz1[q]; rc[q] = nC[q]; }
            if (c0 + 4 < 144) MP_LOADS(c0 + 4);
            if (tid < 384) {
                unsigned outv[4];
#pragma unroll
                for (int q = 0; q < 4; ++q) { float a0 = 0.f, a1 = 0.f;
#pragma unroll
                    for (int j = 0; j < 5; ++j) { a0 += cw[j][0] * bflo(raw[q + j]); a1 += cw[j][1] * bfhi(raw[q + j]); }
                    a0 = siluf_(a0); a1 = siluf_(a1);
                    if (sec < 2) { const float ss = half_sum32(a0 * a0 + a1 * a1); const float rn = rsqrtf(ss + EPS) * (sec == 0 ? 0.125f : 1.f); a0 *= rn; a1 *= rn; }
                    outv[q] = pk_bf16(a0, a1); }
#pragma unroll
                for (int q = 0; q < 4; ++q) *(unsigned*)(DNP + (size_t)sec * PANEL_EL + (size_t)(m + q) * 256 + cp) = outv[q];
            } else if (tid < 392) {
                const int j = tid - 384;
#pragma unroll
                for (int q = 0; q < 4; ++q) { DNAB[(size_t)(m + q) * 16 + j] = nalog * softplusf_(da[q] + dtb);     DNAB[(size_t)(m + q) * 16 + 8 + j] = sigmoidf_(db[q]); }
            }
            if (tid >= 256) {
#pragma unroll
                for (int q = 0; q < 4; ++q) { float logit = gb;
#pragma unroll
                    for (int e = 0; e < 4; ++e) { logit += bflo(z0[q][e]) * gw[2 * e] + bfhi(z0[q][e]) * gw[2 * e + 1] + bflo(z1[q][e]) * gw[8 + 2 * e] + bfhi(z1[q][e]) * gw[8 + 2 * e + 1]; }
                    const float ls = fminf(logit, 0.f) - __logf(1.f + __expf(-fabsf(logit)));
                    GDEC[(size_t)(m + q) * 256 + t2] = ls * 0.0625f; }
            } else if (t >= LC && !skip_rope) {
                bf16_t* ap = P + (size_t)(3 + (t2 >> 7)) * PANEL_EL + (size_t)m * 256 + 2 * (t2 & 127);
#pragma unroll
                for (int q = 0; q < 4; ++q) { const int pos = t + q - LC; const float t1 = bflo(rc[q]), tq = bfhi(rc[q]);
                    const float ang = (float)(userow ? (pos >> 6) : (pos & 63)) * invf; const float sn = __sinf(ang), cs = __cosf(ang);
                    rc[q] = pk_bf16(t1 * cs - tq * sn, t1 * sn + tq * cs); }
#pragma unroll
                for (int q = 0; q < 4; ++q) *(unsigned*)(ap + q * 256) = rc[q];
            }
        }
#undef MP_LOADS
    }
}

__device__ __forceinline__ int blk_tok0(int dir, int blk) { return dir == 0 ? 16 * blk : (blk < 16 ? LC - 16 * (blk + 1) : TT - 16 * (blk - 15)); }
__device__ __forceinline__ void cvt8(const u32x4 r, LAS float* d) {
    *(LAS f32x4*)d = (f32x4){bflo(r[0]), bfhi(r[0]), bflo(r[1]), bfhi(r[1])}; *(LAS f32x4*)(d + 4) = (f32x4){bflo(r[2]), bfhi(r[2]), bflo(r[3]), bfhi(r[3])};
}
__device__ __forceinline__ void store_out16(const LAS float* LO, bf16_t* Og, int tcur, int lane) {
    if (lane < 32) { const int row = lane >> 1, half = lane & 1; const f32x4 o0 = *(const LAS f32x4*)(LO + row * 16 + half * 8), o1 = *(const LAS f32x4*)(LO + row * 16 + half * 8 + 4);
        *(u32x4*)(Og + (size_t)(tcur + row) * 16 + half * 8) = (u32x4){pk_bf16(o0[0], o0[1]), pk_bf16(o0[2], o0[3]), pk_bf16(o1[0], o1[1]), pk_bf16(o1[2], o1[3])}; }
}
__device__ __forceinline__ void scan_ret_chunk(KP p, LAS unsigned char* Lb, int idx, int l, int wv) {
    const int lane = tid_launder(wv) & 63, fr = lane & 15, kq = lane >> 4;
    const int dir = idx & 1, h = (idx >> 1) & 3, b = idx >> 3;
    const bf16_t* P = (const bf16_t*)(p->ws + WS_P);
    const bf16_t* Qg = P + 3 * PANEL_EL + (size_t)b * TT * 256 + h * 64; const bf16_t* Kg = Qg + PANEL_EL; const bf16_t* Vg = Qg + 2 * PANEL_EL;
    bf16_t* Og = obuf(p->ws, 2 + dir) + (size_t)((b * 4 + h) * 4) * TT * 16;
    const float lg2 = log2f(sigmoidf_(p->in[I_RETD][(l * 2 + dir) * 4 + h]));
    const float g16 = exp2f(16.f * lg2);
    LAS bf16_t* QL = (LAS bf16_t*)Lb; LAS bf16_t* KL = QL + 16 * 72; LAS bf16_t* KT = KL + 16 * 72; LAS bf16_t* VT = KT + 64 * 32; LAS bf16_t* GL = VT + 64 * 32;
    for (int i = lane; i < (64 * 32 * 2 + 16 * 32) / 2; i += 64) ((LAS unsigned*)KT)[i] = 0u;
    f32x4 S[4][4];
#pragma unroll
    for (int a = 0; a < 4; ++a)
#pragma unroll
        for (int c = 0; c < 4; ++c) S[a][c] = (f32x4){0.f, 0.f, 0.f, 0.f};
    u32x4 rq[2], rk[2], rv[2];
    int tb = blk_tok0(dir, 0);
#define RC_LOAD(T0) do { _Pragma("unroll") for (int i = 0; i < 2; ++i) { const int q = lane + 64 * i, r = q >> 3, c8 = (q & 7) * 8; const size_t ro = (size_t)((T0) + (dir ? 15 - r : r)) * 256 + c8; \
        rq[i] = *(const u32x4*)(Qg + ro); rk[i] = *(const u32x4*)(Kg + ro); rv[i] = *(const u32x4*)(Vg + ro); } } while (0)
    RC_LOAD(tb);
    float rowsc[4];
#pragma unroll
    for (int i = 0; i < 4; ++i) rowsc[i] = exp2f(lg2 * (float)(4 * kq + i - 15));
    for (int blk = 0; blk < 144; ++blk) {
#pragma unroll
        for (int i = 0; i < 2; ++i) { const int q = lane + 64 * i, r = q >> 3, c8 = (q & 7) * 8;
            *(LAS u32x4*)(QL + r * 72 + c8) = rq[i]; *(LAS u32x4*)(KL + r * 72 + c8) = rk[i];
            const float vs = exp2f(lg2 * (float)(15 - r));
#pragma unroll
            for (int e = 0; e < 4; ++e) { KT[(c8 + 2 * e) * 32 + r] = (bf16_t)(rk[i][e] & 0xffffu); KT[(c8 + 2 * e + 1) * 32 + r] = (bf16_t)(rk[i][e] >> 16);
                const unsigned pv = pk_bf16(bflo(rv[i][e]) * vs, bfhi(rv[i][e]) * vs);
                VT[(c8 + 2 * e) * 32 + r] = (bf16_t)(pv & 0xffffu); VT[(c8 + 2 * e + 1) * 32 + r] = (bf16_t)(pv >> 16); } }
        const int tcur = tb;
        if (blk + 1 < 144) { tb = blk_tok0(dir, blk + 1); RC_LOAD(tb); }
        WAVE_LDS_SYNC();
        f32x4 G = (f32x4){0.f, 0.f, 0.f, 0.f};
#pragma unroll
        for (int kk = 0; kk < 2; ++kk) { const bf16x8 a = *(const LAS bf16x8*)(QL + fr * 72 + 32 * kk + 8 * kq), bb = *(const LAS bf16x8*)(KL + fr * 72 + 32 * kk + 8 * kq);
            G = __builtin_amdgcn_mfma_f32_16x16x32_bf16(a, bb, G, 0, 0, 0); }
#pragma unroll
        for (int i = 0; i < 4; ++i) { const int r = 4 * kq + i; GL[r * 32 + fr] = (bf16_t)(pk_bf16(fr <= r ? G[i] : 0.f, 0.f) & 0xffffu); }
#pragma unroll
        for (int a = 0; a < 4; ++a)
#pragma unroll
            for (int c = 0; c < 4; ++c) S[a][c] = S[a][c] * g16;
        WAVE_LDS_SYNC();
        const bf16x8 ag = *(const LAS bf16x8*)(GL + fr * 32 + 8 * kq);
        bf16x8 aq[2];
#pragma unroll
        for (int kk = 0; kk < 2; ++kk) { const u32x2 lo = *(const LAS u32x2*)(QL + fr * 72 + 32 * kk + 4 * kq), hi = *(const LAS u32x2*)(QL + fr * 72 + 32 * kk + 16 + 4 * kq);
            aq[kk] = __builtin_bit_cast(bf16x8, (u32x4){lo[0], lo[1], hi[0], hi[1]}); }
        bf16x8 bv[4], ak[4];
#pragma unroll
        for (int c = 0; c < 4; ++c) { bv[c] = *(const LAS bf16x8*)(VT + (16 * c + fr) * 32 + 8 * kq); ak[c] = *(const LAS bf16x8*)(KT + (16 * c + fr) * 32 + 8 * kq); }
        f32x4 acc[4];
#pragma unroll
        for (int c = 0; c < 4; ++c) { acc[c] = __builtin_amdgcn_mfma_f32_16x16x32_bf16(ag, bv[c], (f32x4){0.f, 0.f, 0.f, 0.f}, 0, 0, 0);
#pragma unroll
            for (int kk = 0; kk < 2; ++kk) { const f32x4 s0 = S[2 * kk][c], s1 = S[2 * kk + 1][c];
                const bf16x8 bs = __builtin_bit_cast(bf16x8, (u32x4){pk_bf16(s0[0], s0[1]), pk_bf16(s0[2], s0[3]), pk_bf16(s1[0], s1[1]), pk_bf16(s1[2], s1[3])});
                acc[c] = __builtin_amdgcn_mfma_f32_16x16x32_bf16(aq[kk], bs, acc[c], 0, 0, 0); } }
#pragma unroll
        for (int a = 0; a < 4; ++a)
#pragma unroll
            for (int c = 0; c < 4; ++c) S[a][c] = __builtin_amdgcn_mfma_f32_16x16x32_bf16(ak[a], bv[c], S[a][c], 0, 0, 0);
#pragma unroll
        for (int c = 0; c < 4; ++c)
#pragma unroll
            for (int i = 0; i < 4; ++i) { const int r = 4 * kq + i; Og[((size_t)c * TT + (size_t)(tcur + (dir ? 15 - r : r))) * 16 + fr] = (bf16_t)(pk_bf16(acc[c][i] * rowsc[i], 0.f) & 0xffffu); }
        WAVE_LDS_SYNC();
    }
#undef RC_LOAD
}
__device__ __forceinline__ void scan_gla_chunk(KP p, LAS unsigned char* Lb, int idx, int wv) {
    const int lane = tid_launder(wv) & 63, fr = lane & 15, kq = lane >> 4;
    const int dir = idx & 1, h = (idx >> 1) & 3, b = idx >> 3;
    const bf16_t* P = (const bf16_t*)(p->ws + WS_P);
    const bf16_t* Qg = P + (size_t)b * TT * 256 + h * 32; const bf16_t* Kg = Qg + 128; const bf16_t* Vg = P + PANEL_EL + (size_t)b * TT * 256 + h * 64;
    const float* Ag = (const float*)(p->ws + WS_GDEC) + (size_t)b * TT * 256 + dir * 128 + h * 32;
    bf16_t* Og = obuf(p->ws, dir) + (size_t)((b * 4 + h) * 4) * TT * 16;
    LAS bf16_t* QL = (LAS bf16_t*)Lb; LAS bf16_t* KL = QL + 16 * 40; LAS bf16_t* KT = KL + 16 * 40; LAS bf16_t* VT = KT + 32 * 32; LAS bf16_t* GL = VT + 64 * 32; LAS float* EB = (LAS float*)(GL + 16 * 32);
    for (int i = lane; i < (32 * 32 + 64 * 32 + 16 * 32) / 2; i += 64) ((LAS unsigned*)KT)[i] = 0u;
    f32x4 S[2][4];
#pragma unroll
    for (int a = 0; a < 2; ++a)
#pragma unroll
        for (int c = 0; c < 4; ++c) S[a][c] = (f32x4){0.f, 0.f, 0.f, 0.f};
    const int sg = lane >> 4, dp = lane & 15;
    unsigned rq[4], rk[4]; f32x2 ra[4]; u32x4 rv[2];
    int tb = blk_tok0(dir, 0);
#define GC_LOAD(T0) do { _Pragma("unroll") for (int i = 0; i < 4; ++i) { const int r = 4 * sg + i; const size_t ro = (size_t)((T0) + (dir ? 15 - r : r)) * 256 + 2 * dp; \
            rq[i] = *(const unsigned*)(Qg + ro); rk[i] = *(const unsigned*)(Kg + ro); ra[i] = *(const f32x2*)(Ag + ro); } \
        _Pragma("unroll") for (int i = 0; i < 2; ++i) { const int q = lane + 64 * i, r = q >> 3, c8 = (q & 7) * 8; rv[i] = *(const u32x4*)(Vg + (size_t)((T0) + (dir ? 15 - r : r)) * 256 + c8); } } while (0)
    GC_LOAD(tb);
    for (int blk = 0; blk < 144; ++blk) {
        f32x2 bc[4]; bc[0] = ra[0]; bc[1] = bc[0] + ra[1]; bc[2] = bc[1] + ra[2]; bc[3] = bc[2] + ra[3];
        f32x2 inc = bc[3];
        { const float u0 = __shfl_up(inc[0], 16, 64), u1 = __shfl_up(inc[1], 16, 64); if (sg >= 1) { inc[0] += u0; inc[1] += u1; } }
        { const float u0 = __shfl_up(inc[0], 32, 64), u1 = __shfl_up(inc[1], 32, 64); if (sg >= 2) { inc[0] += u0; inc[1] += u1; } }
        const f32x2 excl = inc - bc[3];
        if (sg == 3) { EB[2 * dp] = __expf(inc[0]); EB[2 * dp + 1] = __expf(inc[1]); }
#pragma unroll
        for (int i = 0; i < 4; ++i) { const int r = 4 * sg + i; const f32x2 bb = bc[i] + excl;
            const float e0 = __expf(bb[0]), e1 = __expf(bb[1]), n0 = __expf(-bb[0]), n1 = __expf(-bb[1]);
            const unsigned qv = pk_bf16(bflo(rq[i]) * e0, bfhi(rq[i]) * e1), kv = pk_bf16(bflo(rk[i]) * n0, bfhi(rk[i]) * n1);
            *(LAS unsigned*)(QL + r * 40 + 2 * dp) = qv; *(LAS unsigned*)(KL + r * 40 + 2 * dp) = kv;
            KT[(2 * dp) * 32 + r] = (bf16_t)(kv & 0xffffu); KT[(2 * dp + 1) * 32 + r] = (bf16_t)(kv >> 16); }
#pragma unroll
        for (int i = 0; i < 2; ++i) { const int q = lane + 64 * i, r = q >> 3, c8 = (q & 7) * 8;
#pragma unroll
            for (int e = 0; e < 4; ++e) { VT[(c8 + 2 * e) * 32 + r] = (bf16_t)(rv[i][e] & 0xffffu); VT[(c8 + 2 * e + 1) * 32 + r] = (bf16_t)(rv[i][e] >> 16); } }
        const int tcur = tb;
        if (blk + 1 < 144) { tb = blk_tok0(dir, blk + 1); GC_LOAD(tb); }
        WAVE_LDS_SYNC();
        { const bf16x8 a = *(const LAS bf16x8*)(QL + fr * 40 + 8 * kq), bb = *(const LAS bf16x8*)(KL + fr * 40 + 8 * kq);
            const f32x4 G = __builtin_amdgcn_mfma_f32_16x16x32_bf16(a, bb, (f32x4){0.f, 0.f, 0.f, 0.f}, 0, 0, 0);
#pragma unroll
            for (int i = 0; i < 4; ++i) { const int r = 4 * kq + i; GL[r * 32 + fr] = (bf16_t)(pk_bf16(fr <= r ? G[i] : 0.f, 0.f) & 0xffffu); } }
        WAVE_LDS_SYNC();
        const bf16x8 ag = *(const LAS bf16x8*)(GL + fr * 32 + 8 * kq);
        const u32x2 qlo = *(const LAS u32x2*)(QL + fr * 40 + 4 * kq), qhi = *(const LAS u32x2*)(QL + fr * 40 + 16 + 4 * kq);
        const bf16x8 aq = __builtin_bit_cast(bf16x8, (u32x4){qlo[0], qlo[1], qhi[0], qhi[1]});
        bf16x8 bv[4], ak[2];
#pragma unroll
        for (int c = 0; c < 4; ++c) bv[c] = *(const LAS bf16x8*)(VT + (16 * c + fr) * 32 + 8 * kq);
#pragma unroll
        for (int a = 0; a < 2; ++a) ak[a] = *(const LAS bf16x8*)(KT + (16 * a + fr) * 32 + 8 * kq);
        const f32x4 eb0 = *(const LAS f32x4*)(EB + 4 * kq), eb1 = *(const LAS f32x4*)(EB + 16 + 4 * kq);
#pragma unroll
        for (int c = 0; c < 4; ++c) { f32x4 acc = __builtin_amdgcn_mfma_f32_16x16x32_bf16(ag, bv[c], (f32x4){0.f, 0.f, 0.f, 0.f}, 0, 0, 0);
            const f32x4 s0 = S[0][c], s1 = S[1][c];
            const bf16x8 bs = __builtin_bit_cast(bf16x8, (u32x4){pk_bf16(s0[0], s0[1]), pk_bf16(s0[2], s0[3]), pk_bf16(s1[0], s1[1]), pk_bf16(s1[2], s1[3])});
            acc = __builtin_amdgcn_mfma_f32_16x16x32_bf16(aq, bs, acc, 0, 0, 0);
            S[0][c] = __builtin_amdgcn_mfma_f32_16x16x32_bf16(ak[0], bv[c], S[0][c], 0, 0, 0) * eb0;
            S[1][c] = __builtin_amdgcn_mfma_f32_16x16x32_bf16(ak[1], bv[c], S[1][c], 0, 0, 0) * eb1;
#pragma unroll
            for (int i = 0; i < 4; ++i) { const int r = 4 * kq + i; Og[((size_t)c * TT + (size_t)(tcur + (dir ? 15 - r : r))) * 16 + fr] = (bf16_t)(pk_bf16(acc[i], 0.f) & 0xffffu); } }
        WAVE_LDS_SYNC();
    }
#undef GC_LOAD
}
__device__ __forceinline__ float oct_sum(float v) {
    v += __builtin_bit_cast(float, __builtin_amdgcn_update_dpp(0, __builtin_bit_cast(int, v), 0xB1, 0xF, 0xF, true));
    v += __builtin_bit_cast(float, __builtin_amdgcn_update_dpp(0, __builtin_bit_cast(int, v), 0x4E, 0xF, 0xF, true));
    v += __builtin_bit_cast(float, __builtin_amdgcn_update_dpp(0, __builtin_bit_cast(int, v), 0x141, 0xF, 0xF, true));
    return v;
}
__device__ __forceinline__ void scan_dn(KP p, LAS float* L, int idx, int wv, int noload) {
    const int lane = tid_launder(wv) & 63, vl = lane >> 3, dg = lane & 7;
    const int cq = idx & 7, dir = (idx >> 3) & 1, h = (idx >> 4) & 3, b = idx >> 6;
    const bf16_t* Qg = (const bf16_t*)(p->ws + WS_ABUF) + (size_t)b * TT * 256 + h * 64; const bf16_t* Kg = Qg + PANEL_EL; const bf16_t* Vg = Qg + 2 * PANEL_EL + cq * 8;
    const float* ABg = (const float*)(p->ws + WS_DNAB) + (size_t)b * TT * 16 + dir * 4 + h;
    bf16_t* Og = obuf(p->ws, 4 + dir) + (size_t)((b * 4 + h) * 8 + cq) * TT * 8;
    LAS float* LQ = L; LAS float* LK = L + 1024; LAS float* LV = L + 2048; LAS float* LAB = L + 2176; LAS float* LOP = L + 2208;
    f32x2 S[4];
#pragma unroll
    for (int i = 0; i < 4; ++i) S[i] = (f32x2){0.f, 0.f};
    const int lrow = lane >> 2, lseg = lane & 3;
    struct DnSet { u32x4 q0, q1, k0, k1, v; float a, b; };
    DnSet R0, R1;
#define DN_LOAD(R, BLK) do { if ((BLK) < 144 && !(noload && (BLK) >= 2)) { const int T0_ = blk_tok0(dir, (BLK)); const size_t ro = (size_t)(T0_ + lrow) * 256 + lseg * 16; R.q0 = *(const u32x4*)(Qg + ro); R.q1 = *(const u32x4*)(Qg + ro + 8); R.k0 = *(const u32x4*)(Kg + ro); R.k1 = *(const u32x4*)(Kg + ro + 8); \
        R.v = *(const u32x4*)(Vg + (size_t)(T0_ + (lane & 15)) * 256); R.a = ABg[(size_t)(T0_ + (lane & 15)) * 16]; R.b = ABg[(size_t)(T0_ + (lane & 15)) * 16 + 8]; } } while (0)
#define DN_RD(LS) do { nk0 = *(const LAS f32x4*)(LK + (LS) * 64 + dg * 8); nk1 = *(const LAS f32x4*)(LK + (LS) * 64 + dg * 8 + 4); nq0 = *(const LAS f32x4*)(LQ + (LS) * 64 + dg * 8); nq1 = *(const LAS f32x4*)(LQ + (LS) * 64 + dg * 8 + 4); \
            nv = LV[(LS) * 8 + vl]; na = LAB[(LS) * 2]; nb = LAB[(LS) * 2 + 1]; } while (0)
#define DN_BLOCK(R, BLK) do { \
        cvt8(R.q0, LQ + lrow * 64 + lseg * 16); cvt8(R.q1, LQ + lrow * 64 + lseg * 16 + 8); cvt8(R.k0, LK + lrow * 64 + lseg * 16); cvt8(R.k1, LK + lrow * 64 + lseg * 16 + 8); \
        if (lane < 16) { cvt8(R.v, LV + lane * 8); LAB[lane * 2] = R.a; LAB[lane * 2 + 1] = R.b; } \
        const int tcur = blk_tok0(dir, (BLK)); \
        DN_LOAD(R, (BLK) + 2); \
        WAVE_LDS_SYNC(); \
        f32x4 nk0, nk1, nq0, nq1; float nv, na, nb; \
        DN_RD(dir ? 15 : 0); \
        _Pragma("unroll") for (int s = 0; s < 16; ++s) { \
            const f32x2 ka = {nk0[0], nk0[1]}, kb = {nk0[2], nk0[3]}, kc = {nk1[0], nk1[1]}, kd = {nk1[2], nk1[3]}; \
            const f32x2 qa = {nq0[0], nq0[1]}, qb = {nq0[2], nq0[3]}, qc = {nq1[0], nq1[1]}, qd = {nq1[2], nq1[3]}; const float v = nv, a = na, bt = nb; \
            const int ls = dir ? 15 - s : s; \
            if (s < 15) { DN_RD(dir ? 14 - s : s + 1); } \
            const f32x2 r2 = (ka * S[0] + kb * S[1]) + (kc * S[2] + kd * S[3]);        \
            const float r = oct_sum(r2[0] + r2[1]); \
            const float c = bt * (v - a * r); \
            const f32x2 c2 = {c, c}, a2 = {a, a}; \
            S[0] = a2 * S[0] + ka * c2; S[1] = a2 * S[1] + kb * c2; S[2] = a2 * S[2] + kc * c2; S[3] = a2 * S[3] + kd * c2; \
            const f32x2 o2 = (qa * S[0] + qb * S[1]) + (qc * S[2] + qd * S[3]); \
            LOP[ls * 64 + lane] = o2[0] + o2[1]; \
            asm volatile("" ::: "memory"); } \
        WAVE_LDS_SYNC(); \
        { const int ts = lane >> 2, c0 = (lane & 3) * 2;                         \
            const f32x4 p0 = *(const LAS f32x4*)(LOP + ts * 64 + c0 * 8), p1 = *(const LAS f32x4*)(LOP + ts * 64 + c0 * 8 + 4), p2 = *(const LAS f32x4*)(LOP + ts * 64 + c0 * 8 + 8), p3 = *(const LAS f32x4*)(LOP + ts * 64 + c0 * 8 + 12); \
            const float oa = (p0[0] + p0[1]) + (p0[2] + p0[3]) + (p1[0] + p1[1]) + (p1[2] + p1[3]), ob = (p2[0] + p2[1]) + (p2[2] + p2[3]) + (p3[0] + p3[1]) + (p3[2] + p3[3]); \
            *(unsigned*)(Og + (size_t)(tcur + ts) * 8 + c0) = pk_bf16(oa, ob); } \
        WAVE_LDS_SYNC(); } while (0)
    DN_LOAD(R0, 0); DN_LOAD(R1, 1);
    for (int blk = 0; blk < 144; blk += 2) { DN_BLOCK(R0, blk); DN_BLOCK(R1, blk + 1); }
#undef DN_BLOCK
#undef DN_RD
#undef DN_LOAD
}
__device__ __forceinline__ bf16x8 packz(const f32x4 v) { return __builtin_bit_cast(bf16x8, (u32x4){pk_bf16(v[0], v[1]), pk_bf16(v[2], v[3]), 0u, 0u}); }
__device__ __forceinline__ bf16x8 ldaz(const LAS bf16_t* img, int fr, int kq) { const u32x2 lo = *(const LAS u32x2*)(img + fr * 32 + 4 * kq); return __builtin_bit_cast(bf16x8, (u32x4){lo[0], lo[1], 0u, 0u}); }
__device__ __forceinline__ void stz(LAS bf16_t* img, const f32x4 v, int fr, int kq) {
#pragma unroll
    for (int i = 0; i < 4; ++i) img[(4 * kq + i) * 32 + fr] = (bf16_t)(pk_bf16(v[i], 0.f) & 0xffffu);
}
__device__ __forceinline__ float row_scan16(float v) {
    v += __builtin_bit_cast(float, __builtin_amdgcn_update_dpp(0, __builtin_bit_cast(int, v), 0x111, 0xF, 0xF, true));
    v += __builtin_bit_cast(float, __builtin_amdgcn_update_dpp(0, __builtin_bit_cast(int, v), 0x112, 0xF, 0xF, true));
    v += __builtin_bit_cast(float, __builtin_amdgcn_update_dpp(0, __builtin_bit_cast(int, v), 0x114, 0xF, 0xF, true));
    v += __builtin_bit_cast(float, __builtin_amdgcn_update_dpp(0, __builtin_bit_cast(int, v), 0x118, 0xF, 0xF, true));
    return v;
}
constexpr int DN_SLOT = 13568, DN_NSLOT = 3;
__device__ __forceinline__ void lds_wait_ge(volatile LAS int* f, int need) { for (int it = 0; it < (1 << 22); ++it) { if (*f >= need) break; __builtin_amdgcn_s_sleep(1); } }
__device__ __forceinline__ void scan_dn_producer(KP p, LAS unsigned char* ring, LAS unsigned char* scratch, volatile LAS int* flags, int idx, int wv) {
    const int lane = tid_launder(wv) & 63, fr = lane & 15, kq = lane >> 4;
    const int dir = idx & 1, h = (idx >> 1) & 3, b = idx >> 3;
    const bf16_t* Qg = (const bf16_t*)(p->ws + WS_ABUF) + (size_t)b * TT * 256 + h * 64; const bf16_t* Kg = Qg + PANEL_EL; const bf16_t* Vg = Qg + 2 * PANEL_EL;
    const float* ABg = (const float*)(p->ws + WS_DNAB) + (size_t)b * TT * 16 + dir * 4 + h;
    LAS bf16_t* L0 = (LAS bf16_t*)scratch; LAS bf16_t* L1 = L0 + 16 * 32; LAS bf16_t* L2 = L1 + 16 * 32;
    for (int i = lane; i < (3 * 16 * 32) / 2; i += 64) ((LAS unsigned*)L0)[i] = 0u;
    for (int sl = 0; sl < DN_NSLOT; ++sl) { LAS unsigned* z = (LAS unsigned*)(ring + sl * DN_SLOT + 3 * 16 * 72 * 2); for (int i = lane; i < (64 * 32 + 2 * 16 * 32) / 2; i += 64) z[i] = 0u; }
    u32x4 rq[2], rk[2], rv[2]; float rla, rbe;
    int tb = blk_tok0(dir, 0);
#define DC_LOAD(T0) do { _Pragma("unroll") for (int i = 0; i < 2; ++i) { const int q = lane + 64 * i, r = q >> 3, c8 = (q & 7) * 8; const size_t ro = (size_t)((T0) + (dir ? 15 - r : r)) * 256 + c8; \
            rq[i] = *(const u32x4*)(Qg + ro); rk[i] = *(const u32x4*)(Kg + ro); rv[i] = *(const u32x4*)(Vg + ro); } \
        { const size_t ao = (size_t)((T0) + (dir ? 15 - fr : fr)) * 16; rla = ABg[ao]; rbe = ABg[ao + 8]; } } while (0)
    DC_LOAD(tb);
    for (int blk = 0; blk < 144; ++blk) {
        LAS unsigned char* sl = ring + (blk % DN_NSLOT) * DN_SLOT;
        LAS bf16_t* QL = (LAS bf16_t*)sl; LAS bf16_t* KL = QL + 16 * 72; LAS bf16_t* VL = KL + 16 * 72; LAS bf16_t* KT = VL + 16 * 72; LAS bf16_t* TL = KT + 64 * 32; LAS bf16_t* PL = TL + 16 * 32; LAS float* GS = (LAS float*)(PL + 16 * 32);
        if (blk >= DN_NSLOT) lds_wait_ge(flags + 1, blk - DN_NSLOT + 1);
        const float gsc = row_scan16(rla), bec = rbe;
        const float g15 = __builtin_bit_cast(float, __builtin_amdgcn_readlane(__builtin_bit_cast(int, gsc), 15));
        if (lane < 16) { GS[lane] = gsc; GS[16 + lane] = bec; GS[32 + lane] = g15; }
#pragma unroll
        for (int i = 0; i < 2; ++i) { const int q = lane + 64 * i, r = q >> 3, c8 = (q & 7) * 8;
            *(LAS u32x4*)(QL + r * 72 + c8) = rq[i]; *(LAS u32x4*)(KL + r * 72 + c8) = rk[i]; *(LAS u32x4*)(VL + r * 72 + c8) = rv[i]; }
        WAVE_LDS_SYNC();
        const f32x4 gr = *(const LAS f32x4*)(GS + 4 * kq), br = *(const LAS f32x4*)(GS + 16 + 4 * kq);
#pragma unroll
        for (int i = 0; i < 2; ++i) { const int q = lane + 64 * i, r = q >> 3, c8 = (q & 7) * 8; const float ks = __expf(g15 - GS[r]);
#pragma unroll
            for (int e = 0; e < 4; ++e) { const unsigned kv = pk_bf16(bflo(rk[i][e]) * ks, bfhi(rk[i][e]) * ks); KT[(c8 + 2 * e) * 32 + r] = (bf16_t)(kv & 0xffffu); KT[(c8 + 2 * e + 1) * 32 + r] = (bf16_t)(kv >> 16); } }
        if (blk + 1 < 144) { tb = blk_tok0(dir, blk + 1); DC_LOAD(tb); }
        f32x4 KK = (f32x4){0.f, 0.f, 0.f, 0.f}, QK = (f32x4){0.f, 0.f, 0.f, 0.f};
#pragma unroll
        for (int kk = 0; kk < 2; ++kk) { const bf16x8 ak = *(const LAS bf16x8*)(KL + fr * 72 + 32 * kk + 8 * kq), aq = *(const LAS bf16x8*)(QL + fr * 72 + 32 * kk + 8 * kq);
            KK = __builtin_amdgcn_mfma_f32_16x16x32_bf16(ak, ak, KK, 0, 0, 0); QK = __builtin_amdgcn_mfma_f32_16x16x32_bf16(aq, ak, QK, 0, 0, 0); }
        f32x4 Lm, Pm;
#pragma unroll
        for (int i = 0; i < 4; ++i) { const int r = 4 * kq + i; const float e = __expf(fminf(gr[i] - gsc, 0.f)); Lm[i] = fr < r ? br[i] * e * KK[i] : 0.f; Pm[i] = fr <= r ? e * QK[i] : 0.f; }
        stz(L0, Lm, fr, kq); stz(PL, Pm, fr, kq);
        WAVE_LDS_SYNC();
        const bf16x8 aL = ldaz(L0, fr, kq);
        const f32x4 Lsq = __builtin_amdgcn_mfma_f32_16x16x32_bf16(aL, packz(Lm), (f32x4){0.f, 0.f, 0.f, 0.f}, 0, 0, 0);
        stz(L1, Lsq, fr, kq);
        WAVE_LDS_SYNC();
        const bf16x8 aL2 = ldaz(L1, fr, kq);
        const f32x4 Lq = __builtin_amdgcn_mfma_f32_16x16x32_bf16(aL2, packz(Lsq), (f32x4){0.f, 0.f, 0.f, 0.f}, 0, 0, 0);
        stz(L2, Lq, fr, kq);
        WAVE_LDS_SYNC();
        const bf16x8 aL4 = ldaz(L2, fr, kq);
        f32x4 Y = __builtin_amdgcn_mfma_f32_16x16x32_bf16(aL4, packz(Lq), (f32x4){0.f, 0.f, 0.f, 0.f}, 0, 0, 0);
#pragma unroll
        for (int i = 0; i < 4; ++i) Y[i] += (fr == 4 * kq + i) ? 1.f : 0.f;
        Y = __builtin_amdgcn_mfma_f32_16x16x32_bf16(aL4, packz(Y), Y, 0, 0, 0);
        Y = __builtin_amdgcn_mfma_f32_16x16x32_bf16(aL2, packz(Y), Y, 0, 0, 0);
        { const f32x4 nY = -Y; Y = __builtin_amdgcn_mfma_f32_16x16x32_bf16(aL, packz(nY), Y, 0, 0, 0); }
        stz(TL, Y, fr, kq);
        WAVE_LDS_SYNC();
        if (lane == 0) flags[0] = blk + 1;
    }
#undef DC_LOAD
}
__device__ __forceinline__ void scan_dn_consumer(KP p, LAS unsigned char* ring, volatile LAS int* flags, int idx, int wv) {
    const int lane = tid_launder(wv) & 63, fr = lane & 15, kq = lane >> 4;
    const int dir = idx & 1, h = (idx >> 1) & 3, b = idx >> 3;
    bf16_t* Og = obuf(p->ws, 4 + dir) + (size_t)((b * 4 + h) * 4) * TT * 16;
    f32x4 S[4][4];
#pragma unroll
    for (int a = 0; a < 4; ++a)
#pragma unroll
        for (int c = 0; c < 4; ++c) S[a][c] = (f32x4){0.f, 0.f, 0.f, 0.f};
    for (int blk = 0; blk < 144; ++blk) {
        LAS unsigned char* sl = ring + (blk % DN_NSLOT) * DN_SLOT;
        LAS bf16_t* QL = (LAS bf16_t*)sl; LAS bf16_t* KL = QL + 16 * 72; LAS bf16_t* VL = KL + 16 * 72; LAS bf16_t* KT = VL + 16 * 72; LAS bf16_t* TL = KT + 64 * 32; LAS bf16_t* PL = TL + 16 * 32; LAS float* GS = (LAS float*)(PL + 16 * 32);
        lds_wait_ge(flags, blk + 1);
        const f32x4 gr = *(const LAS f32x4*)(GS + 4 * kq), br = *(const LAS f32x4*)(GS + 16 + 4 * kq); const float g15 = GS[32];
        float vv[4][4];
#pragma unroll
        for (int c = 0; c < 4; ++c)
#pragma unroll
            for (int i = 0; i < 4; ++i) vv[c][i] = bf2f(VL[(4 * kq + i) * 72 + 16 * c + fr]);
        const bf16x8 aT = ldaz(TL, fr, kq), aP = ldaz(PL, fr, kq);
        bf16x8 akp[2], aqp[2], aKT[4];
#pragma unroll
        for (int kk = 0; kk < 2; ++kk) { const u32x2 klo = *(const LAS u32x2*)(KL + fr * 72 + 32 * kk + 4 * kq), khi = *(const LAS u32x2*)(KL + fr * 72 + 32 * kk + 16 + 4 * kq);
            const u32x2 qlo = *(const LAS u32x2*)(QL + fr * 72 + 32 * kk + 4 * kq), qhi = *(const LAS u32x2*)(QL + fr * 72 + 32 * kk + 16 + 4 * kq);
            akp[kk] = __builtin_bit_cast(bf16x8, (u32x4){klo[0], klo[1], khi[0], khi[1]}); aqp[kk] = __builtin_bit_cast(bf16x8, (u32x4){qlo[0], qlo[1], qhi[0], qhi[1]}); }
#pragma unroll
        for (int a = 0; a < 4; ++a) aKT[a] = ldaz(KT + (16 * a) * 32, fr, kq);
        WAVE_LDS_SYNC();
        if (lane == 0) flags[1] = blk + 1;
        f32x4 Gr;
#pragma unroll
        for (int i = 0; i < 4; ++i) Gr[i] = __expf(gr[i]);
        const float G15 = __expf(g15);
        const int tcur = blk_tok0(dir, blk);
#pragma unroll
        for (int c = 0; c < 4; ++c) {
            f32x4 KS = (f32x4){0.f, 0.f, 0.f, 0.f}, QS = (f32x4){0.f, 0.f, 0.f, 0.f};
#pragma unroll
            for (int kk = 0; kk < 2; ++kk) { const f32x4 s0 = S[2 * kk][c], s1 = S[2 * kk + 1][c];
                const bf16x8 bs = __builtin_bit_cast(bf16x8, (u32x4){pk_bf16(s0[0], s0[1]), pk_bf16(s0[2], s0[3]), pk_bf16(s1[0], s1[1]), pk_bf16(s1[2], s1[3])});
                KS = __builtin_amdgcn_mfma_f32_16x16x32_bf16(akp[kk], bs, KS, 0, 0, 0); QS = __builtin_amdgcn_mfma_f32_16x16x32_bf16(aqp[kk], bs, QS, 0, 0, 0); }
            f32x4 R;
#pragma unroll
            for (int i = 0; i < 4; ++i) R[i] = br[i] * (vv[c][i] - Gr[i] * KS[i]);
            const f32x4 U = __builtin_amdgcn_mfma_f32_16x16x32_bf16(aT, packz(R), (f32x4){0.f, 0.f, 0.f, 0.f}, 0, 0, 0);
            const bf16x8 bu = packz(U);
            const f32x4 O = __builtin_amdgcn_mfma_f32_16x16x32_bf16(aP, bu, Gr * QS, 0, 0, 0);
#pragma unroll
            for (int a = 0; a < 4; ++a) S[a][c] = __builtin_amdgcn_mfma_f32_16x16x32_bf16(aKT[a], bu, S[a][c] * G15, 0, 0, 0);
#pragma unroll
            for (int i = 0; i < 4; ++i) { const int r = 4 * kq + i; Og[((size_t)c * TT + (size_t)(tcur + (dir ? 15 - r : r))) * 16 + fr] = (bf16_t)(pk_bf16(O[i], 0.f) & 0xffffu); }
        }
    }
}
__device__ __forceinline__ void scan_s5(KP p, LAS unsigned char* Lb, int idx, int l, int wv) {
    const int lane = tid_launder(wv) & 63, fr = lane & 15, kq = lane >> 4;
    const int dir = idx & 1, g = (idx >> 1) & 15, b = idx >> 5;
    const bf16_t* Ug = (const bf16_t*)(p->ws + WS_P) + 7 * PANEL_EL + (size_t)b * TT * 256 + g * 16;
    bf16_t* Og = obuf(p->ws, 6 + dir) + (size_t)(b * 16 + g) * TT * 16;
    LAS bf16_t* UL = (LAS bf16_t*)Lb; LAS float* BL = (LAS float*)(Lb + 1024); LAS unsigned* HB = (LAS unsigned*)(Lb + 1024 + 8192);
    for (int i = lane; i < 256; i += 64) ((LAS unsigned*)UL)[i] = 0u;
    const float dt = expf(p->in[I_S5DT][(l * 2 + dir) * 16 + g]);
    const float* LRE = p->in[I_S5LRE] + ((l * 2 + dir) * 16 + g) * 64; const float* LIM = p->in[I_S5LIM] + ((l * 2 + dir) * 16 + g) * 64;
    float lbr, lbi;
    { const float lre = LRE[lane], lim = LIM[lane]; float sn, cs; sincosf(lim * dt, &sn, &cs); const float mag = expf(lre * dt); lbr = mag * cs; lbi = mag * sn; }
    bf16x8 Bf[8];
#pragma unroll
    for (int pt = 0; pt < 4; ++pt) { const int ps = fr + 16 * pt;
        const float lre = LRE[ps], lim = LIM[ps]; float sn, cs; sincosf(lim * dt, &sn, &cs); const float mag = expf(lre * dt);
        const float nr = mag * cs - 1.f, ni = mag * sn, den = 1.f / (lre * lre + lim * lim);
        const float bsr = (nr * lre + ni * lim) * den, bsi = (ni * lre - nr * lim) * den;
        u32x4 wre = (u32x4){0u, 0u, 0u, 0u}, wim = (u32x4){0u, 0u, 0u, 0u};
        if (kq < 2) { const float* bre = p->in[I_S5BRE] + (size_t)((l * 16 + g) * 64 + ps) * 16 + 8 * kq; const float* bim = p->in[I_S5BIM] + (size_t)((l * 16 + g) * 64 + ps) * 16 + 8 * kq;
#pragma unroll
            for (int e = 0; e < 4; ++e) { const float r0 = bre[2 * e], r1 = bre[2 * e + 1], i0 = bim[2 * e], i1 = bim[2 * e + 1];
                wre[e] = pk_bf16(bsr * r0 - bsi * i0, bsr * r1 - bsi * i1); wim[e] = pk_bf16(bsr * i0 + bsi * r0, bsr * i1 + bsi * r1); } }
        Bf[pt] = __builtin_bit_cast(bf16x8, wre); Bf[4 + pt] = __builtin_bit_cast(bf16x8, wim); }
    bf16x8 Cf[4];
    { const float* cre = p->in[I_S5CRE] + (size_t)((l * 16 + g) * 16 + fr) * 64; const float* cim = p->in[I_S5CIM] + (size_t)((l * 16 + g) * 16 + fr) * 64;
#pragma unroll
        for (int kk = 0; kk < 4; ++kk) { const int p0 = 16 * kk + 4 * kq; const f32x4 r = *(const f32x4*)(cre + p0), im = *(const f32x4*)(cim + p0);
            const u32x4 w = (u32x4){pk_bf16(r[0], -im[0]), pk_bf16(r[1], -im[1]), pk_bf16(r[2], -im[2]), pk_bf16(r[3], -im[3])}; Cf[kk] = __builtin_bit_cast(bf16x8, w); } }
    float hre = 0.f, him = 0.f;
    u32x4 U0, U1, U2;
#define S5_LOAD(R, BLK) do { if ((BLK) < 144) R = *(const u32x4*)(Ug + (size_t)(blk_tok0(dir, (BLK)) + ((lane >> 1) & 15)) * 256 + (lane & 1) * 8); } while (0)
#define S5_BLOCK(R, BLK) do { \
        if (lane < 32) *(LAS u32x4*)(UL + (lane >> 1) * 32 + (lane & 1) * 8) = R; \
        const int tcur = blk_tok0(dir, (BLK)); \
        S5_LOAD(R, (BLK) + 3); \
        WAVE_LDS_SYNC(); \
        { const bf16x8 au = *(const LAS bf16x8*)(UL + fr * 32 + 8 * kq); \
            _Pragma("unroll") for (int nt = 0; nt < 8; ++nt) { const f32x4 d = __builtin_amdgcn_mfma_f32_16x16x32_bf16(au, Bf[nt], (f32x4){0.f, 0.f, 0.f, 0.f}, 0, 0, 0); \
                _Pragma("unroll") for (int i = 0; i < 4; ++i) BL[(4 * kq + i) * 128 + 16 * nt + fr] = d[i]; } } \
        WAVE_LDS_SYNC(); \
        float bur[16], bui[16]; \
        _Pragma("unroll") for (int s = 0; s < 16; ++s) { bur[s] = BL[s * 128 + lane]; bui[s] = BL[s * 128 + 64 + lane]; } \
        _Pragma("unroll") for (int s = 0; s < 16; ++s) { \
            const int ls = dir ? 15 - s : s; \
            const float bre = dir ? bur[15 - s] : bur[s], bim = dir ? bui[15 - s] : bui[s]; \
            const float nre = lbr * hre - lbi * him + bre, nim = lbr * him + lbi * hre + bim; \
            hre = nre; him = nim; \
            HB[ls * 68 + lane] = pk_bf16(nre, nim); } \
        WAVE_LDS_SYNC(); \
        f32x4 acc = (f32x4){0.f, 0.f, 0.f, 0.f}; \
        _Pragma("unroll") for (int kk = 0; kk < 4; ++kk) { const bf16x8 a = *(const LAS bf16x8*)(HB + fr * 68 + 16 * kk + 4 * kq); acc = __builtin_amdgcn_mfma_f32_16x16x32_bf16(a, Cf[kk], acc, 0, 0, 0); } \
        _Pragma("unroll") for (int i = 0; i < 4; ++i) Og[(size_t)(tcur + 4 * kq + i) * 16 + fr] = (bf16_t)(pk_bf16(acc[i], 0.f) & 0xffffu); \
        WAVE_LDS_SYNC(); } while (0)
    S5_LOAD(U0, 0); S5_LOAD(U1, 1); S5_LOAD(U2, 2);
    for (int blk = 0; blk < 144; blk += 3) { S5_BLOCK(U0, blk); S5_BLOCK(U1, blk + 1); S5_BLOCK(U2, blk + 2); }
#undef S5_BLOCK
#undef S5_LOAD
}
__device__ __forceinline__ void phase_scan(KP p, LAS unsigned char* lds, int l, int tm, int wv) {
    const int tid = tid_launder(wv), wave = __builtin_amdgcn_readfirstlane(tid >> 6);
    LAS unsigned char* Lb = lds + wave * LDS_WAVE;
    LAS unsigned char* ring = lds + 4 * LDS_WAVE; LAS unsigned char* scratch = ring + DN_NSLOT * DN_SLOT; volatile LAS int* flags = (volatile LAS int*)(scratch + 3072);
    static_assert(4 * LDS_WAVE + DN_NSLOT * DN_SLOT + 3072 + 64 <= LDS_BAR_OFF, "scan LDS map");
    for (int vb = bid_launder(); vb < NVB; vb += gridDim.x) {
        if (tid == 0) { flags[0] = 0; flags[1] = 0; }
        __syncthreads();
        if (vb < 128) {
            if (wave == 0) { if (tm & 2) scan_s5(p, Lb, vb, l, wv); }
            else if (wave == 1) { if (tm & 4) scan_ret_chunk(p, Lb, vb, l, wv); }
            else if (wave == 2) { if (tm & 1) scan_dn_consumer(p, ring, flags, vb, wv); }
            else if (wave == 3) { if (tm & 1) scan_dn_producer(p, ring, scratch, flags, vb, wv); }
        } else {
            if (wave < 3) { if (tm & 2) scan_s5(p, Lb, 128 + (vb - 128) * 3 + wave, l, wv); }
            else if (wave == 3) { if (tm & 8) scan_gla_chunk(p, Lb, vb - 128, wv); }
        }
        __syncthreads();
    }
}

__device__ __forceinline__ float gelu_tanh(float y) { const float x = 0.7978845608028654f * (y + 0.044715f * y * y * y); const float th = 1.f - 2.f / (__expf(2.f * x) + 1.f); return 0.5f * y * (1.f + th); }
__device__ __forceinline__ void phase_mixpost(KP p, LAS unsigned char* lds, int l, int wv) {
    const int tid = tid_launder(wv), lane = tid & 63, wave = tid >> 6;
    const bf16_t* P = (const bf16_t*)(p->ws + WS_P); bf16_t* MIX = (bf16_t*)(p->ws + WS_ABUF);
    LAS float* YF = (LAS float*)lds; LAS bf16_t* YB = (LAS bf16_t*)(lds + 16384);
    bf16x8 bfr[2][8];
    { const float* gw = p->in[I_GLUW] + (size_t)l * 256 * 256;
#pragma unroll
        for (int nt = 0; nt < 2; ++nt)
#pragma unroll
            for (int kk = 0; kk < 8; ++kk) { const int n = wave * 32 + nt * 16 + (lane & 15), k0 = 32 * kk + 8 * (lane >> 4); u32x4 w;
#pragma unroll
                for (int j = 0; j < 4; ++j) w[j] = pk_bf16(gw[(size_t)(k0 + 2 * j) * 256 + n], gw[(size_t)(k0 + 2 * j + 1) * 256 + n]);
                bfr[nt][kk] = __builtin_bit_cast(bf16x8, w); } }
    const float* s5d = p->in[I_S5D] + l * 256; const float* glub = p->in[I_GLUB] + l * 256;
    for (int vb = bid_launder(); vb < NVB; vb += gridDim.x) {
        for (int tile = 0; tile < 9; ++tile) {
            const int m0 = vb * 144 + tile * 16;
            const int l32 = lane & 31, tb0 = (vb & 15) * 144 + tile * 16;
            const int tkb = tid >> 5, c8 = (tid & 31) * 8;
            const size_t offb = (size_t)(m0 + tkb) * 256 + c8;
            const size_t yoff = ((size_t)((vb >> 4) * 16 + (c8 >> 4)) * TT + (size_t)(tb0 + tkb)) * 16 + (c8 & 15);
            const u32x4 yf = *(const u32x4*)(obuf(p->ws, 6) + yoff), yb = *(const u32x4*)(obuf(p->ws, 7) + yoff), uu = *(const u32x4*)(P + (size_t)7 * PANEL_EL + offb);
#pragma unroll 1
            for (int pg = 0; pg < 2; ++pg) {
                unsigned rfv[6], rbv[6], rgv[6];
#pragma unroll
                for (int q = 0; q < 6; ++q) { const int ps = pg * 6 + q;
                    const int c = ps * 16 + wave * 2 + (lane >> 5), tk = c / 12, hh = c - tk * 12, mixer = hh >> 2, head = hh & 3;
                    const size_t off = (size_t)(m0 + tk) * 256 + head * 64 + 2 * l32;
                    const size_t ooff = ((size_t)(((vb >> 4) * 4 + head) * 4 + (l32 >> 3)) * TT + (size_t)(tb0 + tk)) * 16 + ((2 * l32) & 15);
                    const int ob = mixer == 0 ? 0 : (mixer == 1 ? 2 : 4), gp = mixer == 0 ? 2 : (mixer == 1 ? 6 : 11);
                    const size_t doff = ((size_t)(((vb >> 4) * 4 + head) * 8 + (l32 >> 2)) * TT + (size_t)(tb0 + tk)) * 8 + ((2 * l32) & 7);
                    const size_t xoff = ooff;
                    rfv[q] = *(const unsigned*)(obuf(p->ws, ob) + xoff); rbv[q] = *(const unsigned*)(obuf(p->ws, ob + 1) + xoff); rgv[q] = *(const unsigned*)(P + (size_t)gp * PANEL_EL + off); }
#pragma unroll
                for (int q = 0; q < 6; ++q) { const int ps = pg * 6 + q;
                    const int c = ps * 16 + wave * 2 + (lane >> 5), tk = c / 12, hh = c - tk * 12, mixer = hh >> 2, head = hh & 3;
                    float o0 = bflo(rfv[q]) + bflo(rbv[q]), o1 = bfhi(rfv[q]) + bfhi(rbv[q]);
                    if (mixer == 1) { const float mean = half_sum32(o0 + o1) * (1.f / 64.f); o0 -= mean; o1 -= mean; }
                    const float var = half_sum32(o0 * o0 + o1 * o1) * (1.f / 64.f);
                    const float rn = rsqrtf(var + EPS);
                    o0 = o0 * rn * siluf_(bflo(rgv[q])); o1 = o1 * rn * siluf_(bfhi(rgv[q]));
                    *(unsigned*)(MIX + (size_t)(m0 + tk) * 1024 + (mixer == 2 ? 768 : mixer * 256) + head * 64 + 2 * l32) = pk_bf16(o0, o1); }
            }
            { const int tk = tkb;
                const f32x4 d0 = *(const f32x4*)(s5d + c8), d1 = *(const f32x4*)(s5d + c8 + 4);
                float y[8];
#pragma unroll
                for (int q = 0; q < 4; ++q) { y[2 * q] = bflo(yf[q]) + bflo(yb[q]) + (q < 2 ? d0[2 * q] : d1[2 * q - 4]) * bflo(uu[q]); y[2 * q + 1] = bfhi(yf[q]) + bfhi(yb[q]) + (q < 2 ? d0[2 * q + 1] : d1[2 * q - 3]) * bfhi(uu[q]); }
#pragma unroll
                for (int q = 0; q < 8; ++q) y[q] = gelu_tanh(y[q]);
                *(LAS f32x4*)(YF + tk * 256 + c8) = (f32x4){y[0], y[1], y[2], y[3]}; *(LAS f32x4*)(YF + tk * 256 + c8 + 4) = (f32x4){y[4], y[5], y[6], y[7]};
                *(LAS u32x4*)(YB + tk * 264 + c8) = (u32x4){pk_bf16(y[0], y[1]), pk_bf16(y[2], y[3]), pk_bf16(y[4], y[5]), pk_bf16(y[6], y[7])}; }
            __syncthreads();
#pragma unroll
            for (int nt = 0; nt < 2; ++nt) { f32x4 acc = (f32x4){0.f, 0.f, 0.f, 0.f};
#pragma unroll
                for (int kk = 0; kk < 8; ++kk) { const bf16x8 a = *(const LAS bf16x8*)(YB + (lane & 15) * 264 + 32 * kk + 8 * (lane >> 4)); acc = __builtin_amdgcn_mfma_f32_16x16x32_bf16(a, bfr[nt][kk], acc, 0, 0, 0); }
                const int n = wave * 32 + nt * 16 + (lane & 15); const float gb = glub[n];
#pragma unroll
                for (int i = 0; i < 4; ++i) { const int tk = 4 * (lane >> 4) + i; const float yv = YF[tk * 256 + n];
                    MIX[(size_t)(m0 + tk) * 1024 + 512 + n] = (bf16_t)(pk_bf16(yv * sigmoidf_(acc[i] + gb), 0.f) & 0xffffu); } }
            __syncthreads();
        }
    }
}

__device__ __forceinline__ void phase_final(KP p, int wv) {
    const int tid = tid_launder(wv), lane = tid & 63, gw = bid_launder() * 8 + (tid >> 6), nw = gridDim.x * 8;
    const float* g = p->in[I_FNG];
    const bool poison = xb_ld((unsigned*)(p->ws + WS_CTL) + XB_TMO) != 0u;
    for (int r = gw; r < NB * SEQ; r += nw) {
        float* xr = p->out + (size_t)r * D;
        f32x4 xv[4]; float ss = 0.f;
#pragma unroll
        for (int j = 0; j < 4; ++j) { xv[j] = *(const f32x4*)(xr + 4 * lane + 256 * j); ss += xv[j][0] * xv[j][0] + xv[j][1] * xv[j][1] + xv[j][2] * xv[j][2] + xv[j][3] * xv[j][3]; }
        ss = wave_sum(ss);
        const float rstd = rsqrtf(ss * (1.f / 1024.f) + EPS);
#pragma unroll
        for (int j = 0; j < 4; ++j) { const f32x4 gv = *(const f32x4*)(g + 4 * lane + 256 * j); *(f32x4*)(xr + 4 * lane + 256 * j) = poison ? (f32x4){NAN, NAN, NAN, NAN} : xv[j] * rstd * gv; }
    }
}

__global__ void __launch_bounds__(512, 2) fwd_kernel(Params parg) {
    KP p = (KP)__builtin_amdgcn_kernarg_segment_ptr();
    extern __shared__ __attribute__((aligned(16))) unsigned char lds_raw[];
    LAS unsigned char* lds = (LAS unsigned char*)lds_raw;
    const int wv = __builtin_amdgcn_readfirstlane((int)threadIdx.x >> 6);
    if (tid_launder(wv) == 0) *(LAS u32x4*)(lds + LDS_BAR_OFF) = (u32x4){0u, 0u, 0u, 0u};
    __syncthreads();
    const unsigned bar_x = xcd_barrier_post((unsigned*)(p->ws + WS_CTL), (volatile LAS unsigned*)(lds + LDS_BAR_OFF), tid_launder(wv)).x;
#define NEXT_PHASE() do { p = kp_launder(p); XcdBarrier bb_; { unsigned* bp_ = (unsigned*)(p->ws + WS_CTL); asm volatile("" : "+s"(bp_)); unsigned bx_ = bar_x; asm volatile("" : "+s"(bx_)); \
        unsigned lo_ = LDS_BAR_OFF; asm volatile("" : "+s"(lo_)); bb_.bar = bp_; bb_.x = bx_; bb_.st = (volatile LAS unsigned*)(lds + lo_); } xcd_barrier(bb_, tid_launder(wv)); p = kp_launder(p); } while (0)
#define REP(bit) for (int rep_ = ((REPEAT_MASK) & (bit)) ? 1 : 0; rep_ >= 0; --rep_)
    REP(1) { phase_prologue(p, lds, wv); NEXT_PHASE(); }
    for (int l = 0; l < 2; ++l) {
        const int last = l == 1;
        REP(2) { phase_prep<false>(p, lds, l, l == 0 ? p->in[I_X] : p->out, l == 0 ? p->in[I_CTX] : (const float*)(p->ws + WS_Z), 0, wv);
            if (l == 1 && rep_ == 0) { __syncthreads(); convert_moe(p, lds, 1, wv); }
            NEXT_PHASE(); }
        REP(4) { Dsc1 S{(const bf16_t*)(p->ws + WS_ABUF), (const bf16_t*)(p->ws + WS_WIN) + (size_t)l * NWIN * 1024, (bf16_t*)(p->ws + WS_P), (int)gridDim.x, bid_launder()}; pg8::gemm_phase(lds, S, wv); NEXT_PHASE(); }
        REP(8) { phase_mixprep(p, l, rep_, wv); NEXT_PHASE(); }
        REP(16) { phase_scan(p, lds, l, rep_ ? SCAN_PROBE : 15, wv); NEXT_PHASE(); }
        REP(32) { phase_mixpost(p, lds, l, wv); NEXT_PHASE(); }
        REP(64) { Dsc2 S{(const bf16_t*)(p->ws + WS_ABUF), (const bf16_t*)(p->ws + WS_WOUT) + (size_t)l * 1024 * 1024, l == 0 ? p->in[I_X] : p->out, l == 0 ? p->in[I_CTX] : (const float*)(p->ws + WS_Z),
                          p->out, (float*)(p->ws + WS_Z), (const float*)(p->ws + WS_MOD) + (size_t)l * 17 * 6144, (int)gridDim.x, bid_launder(), last, rep_}; pg8::gemm_phase(lds, S, wv); NEXT_PHASE(); }
        REP(128) { phase_prep<true>(p, lds, l, p->out, (const float*)(p->ws + WS_Z), last, wv); NEXT_PHASE(); }
        REP(256) { phase_moe_offsets(p, lds, last, wv); NEXT_PHASE(); }
        REP(512) { const int ntl = __builtin_amdgcn_readfirstlane(((const int*)(p->ws + WS_TILE))[0]);
            Dsc3 S{(const bf16_t*)(p->ws + WS_ABUF), (const bf16_t*)(p->ws + WS_WGU), (bf16_t*)(p->ws + WS_P), (const int*)(p->ws + WS_LIST), (const float*)(p->ws + WS_SLOTW), (const int*)(p->ws + WS_TILE), (int)gridDim.x, bid_launder(), ntl}; pg8::gemm_phase(lds, S, wv); NEXT_PHASE(); }
        REP(1024) { const int ntl = __builtin_amdgcn_readfirstlane(((const int*)(p->ws + WS_TILE))[0]);
            Dsc4 S{(const bf16_t*)(p->ws + WS_P), (const bf16_t*)(p->ws + WS_WDN), p->out, (float*)(p->ws + WS_Z), (const float*)(p->ws + WS_MOD) + (size_t)l * 17 * 6144, (const int*)(p->ws + WS_LIST), (const int*)(p->ws + WS_TILE), (int)gridDim.x, bid_launder(), ntl, rep_}; pg8::gemm_phase(lds, S, wv); NEXT_PHASE(); }
    }
#undef REP
    if (PHASE_MASK & 2048) phase_final(p, wv);
#undef NEXT_PHASE
}

extern "C" void kernel_launch(void* const* d_in, const int* in_sizes, int n_in, void* d_out, int out_size, void* d_ws, size_t ws_size, hipStream_t stream) {
    static int grid = 0;
    if (grid == 0) {
        if (n_in != 31 || out_size != NB * SEQ * D || ws_size < WS_END) { fprintf(stderr, "kernel_launch: unexpected problem shape (n_in %d, out %d, ws %zu)\n", n_in, out_size, ws_size); grid = -1; return; }
        int dev = 0, cus = 0, per_cu = 0;
        if (hipGetDevice(&dev) != hipSuccess || hipDeviceGetAttribute(&cus, hipDeviceAttributeMultiprocessorCount, dev) != hipSuccess) { grid = -1; return; }
        if (hipFuncSetAttribute((const void*)fwd_kernel, hipFuncAttributeMaxDynamicSharedMemorySize, LDS_BYTES) != hipSuccess) { fprintf(stderr, "kernel_launch: hipFuncSetAttribute failed\n"); grid = -1; return; }
        if (hipOccupancyMaxActiveBlocksPerMultiprocessor(&per_cu, (const void*)fwd_kernel, 512, LDS_BYTES) != hipSuccess || per_cu < 1) fprintf(stderr, "kernel_launch: occupancy query reports %d\n", per_cu);
        (void)hipGetLastError();
        grid = cus > 256 ? 256 : cus;
    }
    if (grid < 0) return;
    (void)hipMemsetAsync((char*)d_ws + WS_CTL, 0, 65536, stream);
    Params p{};
    for (int i = 0; i < 31; ++i) p.in[i] = (const float*)d_in[i];
    p.out = (float*)d_out; p.ws = (unsigned char*)d_ws;
    hipLaunchKernelGGL(fwd_kernel, dim3(grid), dim3(512), LDS_BYTES, stream, p);
}
```

```cpp
#include <hip/hip_runtime.h>
#include <cstdio>
#include <cstdint>

#define LAS __attribute__((address_space(3)))
typedef unsigned short bf16_t;
typedef short bf16x8 __attribute__((ext_vector_type(8)));
typedef float f32x4 __attribute__((ext_vector_type(4)));
typedef float f32x2 __attribute__((ext_vector_type(2)));
typedef unsigned u32x4 __attribute__((ext_vector_type(4)));
typedef unsigned u32x2 __attribute__((ext_vector_type(2)));

constexpr int D = 1024, NB = 16, SEQ = 2048, LC = 256, TT = 2304, NTOK = NB * TT;
constexpr int DIN = 3120, NWIN = 3328, NPANEL = 13, NVB = 256;
constexpr float EPS = 1e-6f;
constexpr size_t PANEL_EL = (size_t)NTOK * 256;
constexpr int MAXTILES = 168, MAXSLOT = MAXTILES * 256;

constexpr size_t WS_CTL = 0;
constexpr size_t WS_MOD = 65536;
constexpr size_t WS_Z = WS_MOD + 1048576;
constexpr size_t WS_WIN = WS_Z + (size_t)NB * LC * D * 4;
constexpr size_t WS_WOUT = WS_WIN + (size_t)2 * NWIN * D * 2;
constexpr size_t WS_WGU = WS_WOUT + (size_t)2 * D * D * 2;
constexpr size_t WS_WDN = WS_WGU + (size_t)16 * 1024 * 1024 * 2;
constexpr size_t WS_P = WS_WDN + (size_t)16 * 1024 * 512 * 2;
constexpr size_t WS_ABUF = WS_P + NPANEL * PANEL_EL * 2;
constexpr size_t WS_GDEC = WS_ABUF + (size_t)NTOK * D * 2;
constexpr size_t WS_DNAB = WS_GDEC + (size_t)NTOK * 256 * 4;
constexpr size_t WS_O = WS_DNAB + (size_t)NTOK * 16 * 4;
constexpr size_t WS_ROUTE = WS_O + 4 * PANEL_EL * 2;
constexpr size_t WS_HIST = WS_ROUTE + (size_t)NTOK * 16;
constexpr size_t WS_LIST = WS_HIST + 256 * 32 * 4;
constexpr size_t WS_SLOTW = WS_LIST + 196608;
constexpr size_t WS_TILE = WS_SLOTW + 393216;
constexpr size_t WS_SMALL = WS_TILE + 4096;
constexpr size_t WS_RB8 = WS_SMALL + (size_t)NTOK * 64 * 2;
constexpr size_t WS_END = WS_RB8 + 65536;
static_assert(WS_END <= (size_t)512 * 1024 * 1024, "workspace");
static_assert((size_t)MAXSLOT * 4 <= 196608 && (size_t)MAXSLOT * 8 <= 393216 && (size_t)MAXSLOT * D * 2 <= NPANEL * PANEL_EL * 2, "moe buffers");

constexpr int LDS_WAVE = 18432;
constexpr int LDS_BAR_OFF = 8 * LDS_WAVE;
constexpr int LDS_BYTES = LDS_BAR_OFF + 256;

#ifndef SCAN_PROBE
#define SCAN_PROBE 15
#endif
#ifndef EXTRA_BARRIERS
#define EXTRA_BARRIERS 0
#endif
#ifndef MIXPOST_PROBE
#define MIXPOST_PROBE 3
#endif
#ifndef REPEAT_MASK
#define REPEAT_MASK 0
#endif
#ifndef PHASE_MASK
#define PHASE_MASK 0xFFFF
#endif
struct Params { const float* in[31]; float* out; unsigned char* ws; };
typedef const Params __attribute__((address_space(4)))* KP;
__device__ __forceinline__ KP kp_launder(KP p) { asm volatile("" : "+s"(p)); return p; }
__device__ __forceinline__ int bid_launder() { int b = blockIdx.x; asm volatile("" : "+s"(b)); return b; }
__device__ __forceinline__ int tid_launder(int wv) { unsigned m = ~0u; asm volatile("" : "+s"(wv), "+s"(m)); int t = wv * 64 + (int)__builtin_amdgcn_mbcnt_hi(m, __builtin_amdgcn_mbcnt_lo(m, 0u)); asm volatile("" : "+v"(t)); return t; }
enum { I_X = 0, I_C, I_CTX, I_CCTX, I_WADA, I_BADA, I_NORMG, I_WIN, I_WOUT, I_GKW, I_GKB, I_RETD, I_S5LRE, I_S5LIM, I_S5DT, I_S5BRE, I_S5BIM, I_S5CRE, I_S5CIM,
       I_S5D, I_GLUW, I_GLUB, I_CONVW, I_ALOG, I_DTB, I_RW, I_RB, I_WG, I_WU, I_WD, I_FNG };

__device__ __forceinline__ float bf2f(unsigned v) { return __uint_as_float(v << 16); }
__device__ __forceinline__ float bflo(unsigned v) { return __uint_as_float(v << 16); }
__device__ __forceinline__ float bfhi(unsigned v) { return __uint_as_float(v & 0xffff0000u); }
typedef __bf16 bf16v2 __attribute__((ext_vector_type(2)));
__device__ __forceinline__ unsigned pk_bf16(float lo, float hi) { const f32x2 v = {lo, hi}; return __builtin_bit_cast(unsigned, __builtin_convertvector(v, bf16v2)); }
__device__ __forceinline__ float sigmoidf_(float x) { return 1.f / (1.f + __expf(-x)); }
__device__ __forceinline__ float siluf_(float x) { return x / (1.f + __expf(-x)); }
__device__ __forceinline__ float softplusf_(float x) { return fmaxf(x, 0.f) + log1pf(__expf(-fabsf(x))); }
__device__ __forceinline__ float wave_sum(float v) {
#pragma unroll
    for (int o = 32; o >= 1; o >>= 1) v += __shfl_xor(v, o, 64);
    return v;
}
__device__ __forceinline__ float half_sum32(float v) {
#pragma unroll
    for (int o = 16; o >= 1; o >>= 1) v += __shfl_xor(v, o, 64);
    return v;
}
__device__ __forceinline__ float quad_sum(float v) {
    v += __builtin_bit_cast(float, __builtin_amdgcn_update_dpp(0, __builtin_bit_cast(int, v), 0xB1, 0xF, 0xF, true));
    v += __builtin_bit_cast(float, __builtin_amdgcn_update_dpp(0, __builtin_bit_cast(int, v), 0x4E, 0xF, 0xF, true));
    return v;
}
#define WAVE_LDS_SYNC() asm volatile("s_waitcnt lgkmcnt(0)" ::: "memory")
#define LDS_BARRIER() asm volatile("s_waitcnt lgkmcnt(0)\n\ts_barrier" ::: "memory")
__device__ __forceinline__ const float* res_row_c(const float* lat, const float* ctx, int m) { const int b = m / TT, t = m - b * TT; return t < LC ? ctx + (size_t)(b * LC + t) * D : lat + (size_t)(b * SEQ + t - LC) * D; }
__device__ __forceinline__ float* res_row(float* lat, float* ctx, int m) { const int b = m / TT, t = m - b * TT; return t < LC ? ctx + (size_t)(b * LC + t) * D : lat + (size_t)(b * SEQ + t - LC) * D; }

#define XB_TMO      128
#define XB_XCNT(j)  (256  + 64 * (j))
#define XB_XSUB(j)  (1280 + 64 * (j))
#define XB_XGEN(j)  (2304 + 64 * (j))
#define XB_TOP      3328
#define XB_TOPGEN   3392
#define XCD_BAR_WORDS 3456
#define XB_SPIN_CAP (1u << 18)

__device__ __forceinline__ unsigned xb_ld(unsigned* p)              { return __hip_atomic_load(p, __ATOMIC_RELAXED, __HIP_MEMORY_SCOPE_AGENT); }
__device__ __forceinline__ unsigned xb_add(unsigned* p, unsigned v) { return __hip_atomic_fetch_add(p, v, __ATOMIC_RELAXED, __HIP_MEMORY_SCOPE_AGENT); }
__device__ __forceinline__ unsigned xb_xcc_id() { return (unsigned)__builtin_amdgcn_s_getreg((3 << 11) | 20) & 0xFu; }
#define XB_SPIN(cond, bar) do { unsigned _sp = 0; while (cond) { __builtin_amdgcn_s_sleep(1); \
    if ((++_sp & 255u) == 0u) { if (xb_ld(&(bar)[XB_TMO])) break; if (_sp > XB_SPIN_CAP) { atomicAdd(&(bar)[XB_TMO], 1u); break; } } } } while (0)

struct XcdBarrier { unsigned* bar; unsigned x; volatile LAS unsigned* st; };

__device__ __forceinline__ XcdBarrier xcd_barrier_post(unsigned* bar, volatile LAS unsigned* st, int tid) {
    XcdBarrier b; b.bar = bar; b.x = xb_xcc_id(); b.st = st;
    if (tid == 0) (void)xb_add(&bar[XB_XCNT(b.x)], 1u);
    return b;
}
__device__ __forceinline__ void xcd_barrier_complete(unsigned* bar, unsigned x, unsigned& nloc, unsigned& nx) {
    const unsigned G = gridDim.x * gridDim.y * gridDim.z;
    unsigned sum, cnt, mine, sp = 0u;
    for (;;) {
        sum = 0u; cnt = 0u; mine = 0u;
#pragma unroll
        for (unsigned j = 0; j < 16; ++j) { const unsigned c = xb_ld(&bar[XB_XCNT(j)]); sum += c; cnt += (c > 0u) ? 1u : 0u; mine = (j == x) ? c : mine; }
        if (sum == G) break;
        __builtin_amdgcn_s_sleep(1);
        if ((++sp & 255u) == 0u) { if (xb_ld(&bar[XB_TMO])) break; if (sp > XB_SPIN_CAP) { atomicAdd(&bar[XB_TMO], 1u); break; } }
    }
    nloc = mine > 0u ? mine : 1u; nx = cnt > 0u ? cnt : 1u;
}
__device__ __forceinline__ void xcd_barrier(const XcdBarrier& b, int tid) {
    asm volatile("s_waitcnt vmcnt(0)" ::: "memory");
    __syncthreads();
    if (tid == 0) {
        unsigned* bar = b.bar;
        __builtin_amdgcn_s_waitcnt(0);
        unsigned nloc = b.st[0], nx = b.st[1];
        if (nloc == 0u) { xcd_barrier_complete(bar, b.x, nloc, nx); b.st[0] = nloc; b.st[1] = nx; }
        const unsigned old = xb_add(&bar[XB_XSUB(b.x)], 1u);
        const unsigned gen = old / nloc;
        if (old + 1u == (gen + 1u) * nloc) {
            __builtin_amdgcn_fence(__ATOMIC_RELEASE, "agent");
            asm volatile("s_waitcnt vmcnt(0)" ::: "memory");
            const unsigned og = xb_add(&bar[XB_TOP], 1u);
            const unsigned tg = og / nx;
            if (og + 1u == (tg + 1u) * nx) xb_add(&bar[XB_TOPGEN], 1u);
            else XB_SPIN(xb_ld(&bar[XB_TOPGEN]) == tg, bar);
            __builtin_amdgcn_fence(__ATOMIC_ACQUIRE, "agent");
            xb_add(&bar[XB_XGEN(b.x)], 1u);
            asm volatile("s_waitcnt vmcnt(0)" ::: "memory");
        } else {
            XB_SPIN(xb_ld(&bar[XB_XGEN(b.x)]) == gen, bar);
            __builtin_amdgcn_fence(__ATOMIC_ACQUIRE, "agent");
            asm volatile("s_waitcnt vmcnt(0)" ::: "memory");
        }
    }
    __syncthreads();
}

namespace pg8 {
constexpr int BM = 256, BK = 64, HALF = 128, HTB = HALF * BK * 2, STAGE_BYTES = 8 * HTB, NXCD = 8, WGM = 8;
__device__ __forceinline__ int lds_byte(int r, int c) { const int st = (r >> 4) * 2 + (c >> 5), rr = r & 15, cc = c & 31, ob = rr * 64 + cc * 2; return st * 1024 + (ob ^ (((ob >> 9) & 1) << 5)); }
__device__ __forceinline__ void stage_rc(int b, int& R, int& C) { const int st = b / 1024, sb = b % 1024, swz = sb ^ (((sb >> 9) & 1) << 5); R = (st >> 1) * 16 + swz / 64; C = (st & 1) * 32 + (swz % 64) / 2; }
__device__ __forceinline__ int perm32(int rho) { const int n = rho >> 4, i = rho & 15; return 8 * (i >> 2) + 4 * n + (i & 3); }

__device__ __forceinline__ bool static_order(int i, int G, int c, int nM, int nN, int& pm, int& pn) {
    const int nwg = nM * nN; const long L = (long)i * G + c; if (L >= nwg) return false;
    int wgid = (int)L; { const int q = nwg / NXCD, r = nwg % NXCD, xcd = wgid % NXCD, off = wgid / NXCD; wgid = (xcd < r ? xcd * (q + 1) : r * (q + 1) + (xcd - r) * q) + off; }
    const int nig = WGM * nN, gid = wgid / nig, fm = gid * WGM, gsz = (nM - fm) < WGM ? (nM - fm) : WGM;
    pm = fm + ((wgid % nig) % gsz); pn = (wgid % nig) / gsz; return true;
}

template <class DSC>
__device__ __forceinline__ void gemm_phase(LAS unsigned char* lds, const DSC& S, int wv) {
    const int tid = tid_launder(wv), wid = __builtin_amdgcn_readfirstlane(tid >> 6), lane = tid & 63, wr = wid >> 2, wc = wid & 3, fr = lane & 15, fq = lane >> 4;
    constexpr int K = DSC::K, nt = K / BK, LDB = DSC::LDB;
    int sR[2], sC[2]; unsigned voffB[2];
#pragma unroll
    for (int i = 0; i < 2; ++i) { int R, C; stage_rc(tid * 16 + i * 8192, R, C); sR[i] = R; sC[i] = C; const int Rb = DSC::PERM ? ((R & ~31) + perm32(R & 31)) : R; voffB[i] = (unsigned)(Rb * LDB + C) * 2u; }
    constexpr size_t kstep = (size_t)(BK * 2);
    constexpr size_t hstepB = (size_t)HALF * LDB * 2;
    const unsigned ldsw = (unsigned)wid * 1024u;
    const int aoff = lds_byte(wr * 64 + fr, fq * 8), boff = lds_byte(wc * 32 + fr, fq * 8);
#define PG8_SA(b, h) (((b) * 2 + (h)) * HTB)
#define PG8_SB(b, h) ((4 + (b) * 2 + (h)) * HTB)
#define PG8_STAGE(bufoff, gbase, voff) do { _Pragma("unroll") for (int _i = 0; _i < 2; ++_i) \
        __builtin_amdgcn_global_load_lds((const unsigned*)((const char*)(gbase) + (voff)[_i]), (LAS unsigned*)(lds + (bufoff) + ldsw + _i * 8192), 16, 0, 0); } while (0)
#define PG8_LDA(dst, b, h) do { _Pragma("unroll") for (int m = 0; m < 4; ++m) _Pragma("unroll") for (int k = 0; k < 2; ++k) dst[m][k] = *(const LAS bf16x8*)(lds + PG8_SA(b, h) + aoff + m * 2048 + k * 1024); } while (0)
#define PG8_LDB(dst, b, h) do { _Pragma("unroll") for (int n = 0; n < 2; ++n) _Pragma("unroll") for (int k = 0; k < 2; ++k) dst[n][k] = *(const LAS bf16x8*)(lds + PG8_SB(b, h) + boff + n * 2048 + k * 1024); } while (0)
#define PG8_MMA(ai, bj, At, Bt) do { __builtin_amdgcn_s_setprio(1); _Pragma("unroll") for (int m = 0; m < 4; ++m) _Pragma("unroll") for (int n = 0; n < 2; ++n) _Pragma("unroll") for (int k = 0; k < 2; ++k) \
        acc[ai][bj][m][n] = __builtin_amdgcn_mfma_f32_16x16x32_bf16(Bt[n][k], At[m][k], acc[ai][bj][m][n], 0, 0, 0); __builtin_amdgcn_s_setprio(0); } while (0)
#define PG8_WAIT_V(n) asm volatile("s_waitcnt vmcnt(" #n ")" ::: "memory")
#define PG8_WAIT_L(n) asm volatile("s_waitcnt lgkmcnt(" #n ")" ::: "memory")
#define PG8_BAR __builtin_amdgcn_s_barrier()
#define PG8_SCHED __builtin_amdgcn_sched_barrier(0)
    typename DSC::Unit cur, nxt; int ui = 0;
    if (!S.next(0, cur)) return;
    f32x4 acc[2][2][4][2];
#pragma unroll
    for (int a = 0; a < 2; ++a)
#pragma unroll
        for (int b = 0; b < 2; ++b)
#pragma unroll
            for (int m = 0; m < 4; ++m)
#pragma unroll
                for (int n = 0; n < 2; ++n) acc[a][b][m][n] = (f32x4){0.f, 0.f, 0.f, 0.f};
    bf16x8 At[4][2], B0[2][2], B1[2][2];
    constexpr size_t hstepA = (size_t)HALF * 1024 * 2;
    unsigned va[2][2], vn[2][2];
#define PG8_STAGE_A(bufoff, h, gb, V) do { if constexpr (DSC::GATHER) { PG8_STAGE(bufoff, gb, V[h]); } else { PG8_STAGE(bufoff, (gb) + (h) * hstepA, V[0]); } } while (0)
    const char* cA = S.a_base(cur); S.a_off(cur, sR, sC, va);
    const char* cBl = S.b_lo(cur); const char* cBh = S.b_hi(cur);
    PG8_STAGE(PG8_SB(0, 0), cBl, voffB); PG8_STAGE_A(PG8_SA(0, 0), 0, cA, va); PG8_STAGE(PG8_SB(0, 1), cBl + hstepB, voffB); PG8_STAGE_A(PG8_SA(0, 1), 1, cA, va);
    if (wr == 1) PG8_BAR;
    PG8_WAIT_V(4); PG8_BAR;
    PG8_STAGE(PG8_SB(1, 0), cBl + kstep, voffB); PG8_STAGE_A(PG8_SA(1, 0), 0, cA + kstep, va); PG8_STAGE(PG8_SB(1, 1), cBl + hstepB + kstep, voffB);
    PG8_WAIT_V(6); PG8_BAR;
    for (;;) {
        const bool has_next = S.next(ui + 1, nxt);
        const char* nA; const char* nBl; const char* nBh;
        if (has_next) { nA = S.a_base(nxt); nBl = S.b_lo(nxt); nBh = S.b_hi(nxt); if constexpr (DSC::GATHER) S.a_off(nxt, sR, sC, vn); }
        else { nA = cA; nBl = cBl; nBh = cBh;
            if constexpr (DSC::GATHER) {
#pragma unroll
                for (int h = 0; h < 2; ++h)
#pragma unroll
                    for (int i = 0; i < 2; ++i) vn[h][i] = va[h][i]; } }
        for (int t = 0; t < nt; t += 2) {
            const bool last = (t == nt - 2);
            const char* a1 = cA + (size_t)(t + 1) * kstep;
            const char* a2 = last ? nA : cA + (size_t)(t + 2) * kstep;
            const char* b2 = last ? nBl : ((t + 2) < nt / 2 ? cBl : cBh) + (size_t)(t + 2) * kstep;
            const char* a3 = a2 + kstep; const char* b3 = b2 + kstep;
            unsigned vs[2][2];
#pragma unroll
            for (int h = 0; h < 2; ++h)
#pragma unroll
                for (int i = 0; i < 2; ++i) vs[h][i] = (DSC::GATHER && last) ? vn[h][i] : va[h][i];
            PG8_LDB(B0, 0, 0); PG8_SCHED; PG8_LDA(At, 0, 0); PG8_STAGE_A(PG8_SA(1, 1), 1, a1, va);
            PG8_WAIT_L(8); PG8_BAR; PG8_WAIT_L(0); PG8_MMA(0, 0, At, B0); PG8_BAR; PG8_SCHED;
            PG8_LDB(B1, 0, 1); PG8_STAGE(PG8_SB(0, 0), b2, voffB);
            PG8_BAR; PG8_WAIT_L(0); PG8_MMA(0, 1, At, B1); PG8_BAR;
            PG8_LDA(At, 0, 1); PG8_STAGE_A(PG8_SA(0, 0), 0, a2, vs);
            PG8_BAR; PG8_WAIT_L(0); PG8_MMA(1, 0, At, B0); PG8_BAR; PG8_SCHED;
            PG8_STAGE(PG8_SB(0, 1), b2 + hstepB, voffB);
            PG8_WAIT_V(6); PG8_BAR; PG8_MMA(1, 1, At, B1); PG8_BAR;
            PG8_LDB(B0, 1, 0); PG8_SCHED; PG8_LDA(At, 1, 0); PG8_STAGE_A(PG8_SA(0, 1), 1, a2, vs);
            PG8_WAIT_L(8); PG8_BAR; PG8_WAIT_L(0); PG8_MMA(0, 0, At, B0); PG8_BAR; PG8_SCHED;
            PG8_LDB(B1, 1, 1); PG8_STAGE(PG8_SB(1, 0), b3, voffB);
            PG8_BAR; PG8_WAIT_L(0); PG8_MMA(0, 1, At, B1); PG8_BAR;
            PG8_LDA(At, 1, 1); PG8_STAGE_A(PG8_SA(1, 0), 0, a3, vs);
            PG8_BAR; PG8_WAIT_L(0); PG8_MMA(1, 0, At, B0); PG8_BAR; PG8_SCHED;
            PG8_STAGE(PG8_SB(1, 1), b3 + hstepB, voffB);
            PG8_WAIT_V(6); PG8_BAR; PG8_MMA(1, 1, At, B1); PG8_BAR;
        }
        S.epi(acc, cur, wr, wc, fr, fq);
        if (!has_next) break;
#pragma unroll
        for (int a = 0; a < 2; ++a)
#pragma unroll
            for (int b = 0; b < 2; ++b)
#pragma unroll
                for (int m = 0; m < 4; ++m)
#pragma unroll
                    for (int n = 0; n < 2; ++n) acc[a][b][m][n] = (f32x4){0.f, 0.f, 0.f, 0.f};
        cur = nxt; cA = nA; cBl = nBl; cBh = nBh; ++ui;
        if constexpr (DSC::GATHER) {
#pragma unroll
            for (int h = 0; h < 2; ++h)
#pragma unroll
                for (int i = 0; i < 2; ++i) va[h][i] = vn[h][i]; }
    }
    PG8_WAIT_V(0);
    if (wr == 0) PG8_BAR;
    PG8_BAR;
#undef PG8_SA
#undef PG8_SB
#undef PG8_STAGE
#undef PG8_STAGE_A
#undef PG8_LDA
#undef PG8_LDB
#undef PG8_MMA
#undef PG8_WAIT_V
#undef PG8_WAIT_L
#undef PG8_BAR
#undef PG8_SCHED
}
}

__device__ __forceinline__ void std_a_off(const int (&sR)[2], const int (&sC)[2], unsigned (&v)[2][2]) {
#pragma unroll
    for (int h = 0; h < 2; ++h)
#pragma unroll
        for (int i = 0; i < 2; ++i) v[h][i] = (unsigned)((sR[i] + 128 * h) * 1024 + sC[i]) * 2u;
}
struct Dsc1 {
    static constexpr int K = 1024, LDB = 1024; static constexpr bool PERM = true, GATHER = false;
    struct Unit { int pm, pn; };
    const bf16_t* A; const bf16_t* Bt; bf16_t* P; int G, c;
    __device__ __forceinline__ bool next(int i, Unit& u) const { return pg8::static_order(i, G, c, NTOK / 256, 12, u.pm, u.pn); }
    __device__ __forceinline__ const char* a_base(const Unit& u) const { return (const char*)A + (size_t)u.pm * 256 * 1024 * 2; }
    __device__ __forceinline__ void a_off(const Unit&, const int (&sR)[2], const int (&sC)[2], unsigned (&v)[2][2]) const { std_a_off(sR, sC, v); }
    __device__ __forceinline__ const char* b_lo(const Unit& u) const { return (const char*)Bt + (size_t)u.pn * 256 * 1024 * 2; }
    __device__ __forceinline__ const char* b_hi(const Unit& u) const { return b_lo(u); }
    __device__ __forceinline__ void epi(const f32x4 (&acc)[2][2][4][2], const Unit& u, int wr, int wc, int fr, int fq) const {
        bf16_t* base = P + (size_t)u.pn * PANEL_EL + (size_t)(u.pm * 256 + wr * 64 + fr) * 256 + wc * 32 + 8 * fq;
#pragma unroll
        for (int ai = 0; ai < 2; ++ai)
#pragma unroll
            for (int m = 0; m < 4; ++m) { bf16_t* rowp = base + (size_t)(ai * 128 + m * 16) * 256;
#pragma unroll
                for (int bj = 0; bj < 2; ++bj) { const f32x4 v0 = acc[ai][bj][m][0], v1 = acc[ai][bj][m][1];
                    *(u32x4*)(rowp + bj * 128) = (u32x4){pk_bf16(v0[0], v0[1]), pk_bf16(v0[2], v0[3]), pk_bf16(v1[0], v1[1]), pk_bf16(v1[2], v1[3])}; } }
    }
};
struct Dsc2 {
    static constexpr int K = 1024, LDB = 1024; static constexpr bool PERM = false, GATHER = false;
    struct Unit { int pm, pn; };
    const bf16_t* A; const bf16_t* Bt; const float* lat_in; const float* ctx_in; float* lat_out; float* ctx_out; const float* mod; int G, c, last, dry;
    __device__ __forceinline__ bool next(int i, Unit& u) const {
        int pm, pn; if (!pg8::static_order(i, G, c, last ? 128 : 144, 4, pm, pn)) return false;
        u.pm = last ? (pm >> 3) * 9 + 1 + (pm & 7) : pm; u.pn = pn; return true; }
    __device__ __forceinline__ const char* a_base(const Unit& u) const { return (const char*)A + (size_t)u.pm * 256 * 1024 * 2; }
    __device__ __forceinline__ void a_off(const Unit&, const int (&sR)[2], const int (&sC)[2], unsigned (&v)[2][2]) const { std_a_off(sR, sC, v); }
    __device__ __forceinline__ const char* b_lo(const Unit& u) const { return (const char*)Bt + (size_t)u.pn * 256 * 1024 * 2; }
    __device__ __forceinline__ const char* b_hi(const Unit& u) const { return b_lo(u); }
    __device__ __forceinline__ void epi(const f32x4 (&acc)[2][2][4][2], const Unit& u, int wr, int wc, int fr, int fq) const {
        const int b = u.pm / 9, pp = u.pm - b * 9;
        const size_t ro = pp == 0 ? (size_t)b * LC * D : ((size_t)b * SEQ + (size_t)(pp - 1) * 256) * D;
        const float* inb = (pp == 0 ? ctx_in : lat_in) + ro; float* outb = (pp == 0 ? ctx_out : lat_out) + ro;
        const int col0 = u.pn * 256 + wc * 32 + 4 * fq, row0 = wr * 64 + fr;
        const float* gate = mod + (size_t)(pp == 0 ? 16 : b) * 6144 + 2 * 1024 + col0;
        f32x4 gv[2][2];
#pragma unroll
        for (int bj = 0; bj < 2; ++bj)
#pragma unroll
            for (int n = 0; n < 2; ++n) gv[bj][n] = *(const f32x4*)(gate + bj * 128 + n * 16);
#pragma unroll
        for (int ai = 0; ai < 2; ++ai)
#pragma unroll
            for (int m = 0; m < 4; ++m) { const size_t o = (size_t)(row0 + ai * 128 + m * 16) * D + col0;
#pragma unroll
                for (int bj = 0; bj < 2; ++bj)
#pragma unroll
                    for (int n = 0; n < 2; ++n) { const f32x4 x = *(const f32x4*)(inb + o + bj * 128 + n * 16);
                        if (!dry) *(f32x4*)(outb + o + bj * 128 + n * 16) = x + gv[bj][n] * acc[ai][bj][m][n]; else asm volatile("" :: "v"(x + gv[bj][n] * acc[ai][bj][m][n])); } }
    }
};
__device__ __forceinline__ void bucket_experts(int bk, int& elo, int& ehi) {
    const int gr = bk / 6, pr = bk - gr * 6;
    const int i = pr < 3 ? 0 : (pr < 5 ? 1 : 2), j = pr < 3 ? pr + 1 : (pr < 5 ? pr - 1 : 3);
    elo = gr * 4 + i; ehi = gr * 4 + j;
}
struct Dsc3 {
    static constexpr int K = 1024, LDB = 1024; static constexpr bool PERM = true, GATHER = true;
    struct Unit { int ti, pn, elo, ehi; };
    const bf16_t* A; const bf16_t* Wgu; bf16_t* ACT; const int* list; const float* slotw; const int* tile; int G, c, nt_;
    __device__ __forceinline__ bool next(int i, Unit& u) const {
        if (!pg8::static_order(i, G, c, nt_, 8, u.ti, u.pn)) return false;
        const int bk = __builtin_amdgcn_readfirstlane(tile[8 + u.ti]); bucket_experts(bk, u.elo, u.ehi); return true; }
    __device__ __forceinline__ const char* a_base(const Unit&) const { return (const char*)A; }
    __device__ __forceinline__ void a_off(const Unit& u, const int (&sR)[2], const int (&sC)[2], unsigned (&v)[2][2]) const {
#pragma unroll
        for (int h = 0; h < 2; ++h)
#pragma unroll
            for (int i = 0; i < 2; ++i) { int tok = list[u.ti * 256 + sR[i] + 128 * h]; tok = tok < 0 ? 0 : tok; v[h][i] = (unsigned)(tok * 1024 + sC[i]) * 2u; }
    }
    __device__ __forceinline__ const char* b_lo(const Unit& u) const { const int e = u.pn < 4 ? u.elo : u.ehi; return (const char*)Wgu + ((size_t)e * 1024 + (size_t)(u.pn & 3) * 256) * 1024 * 2; }
    __device__ __forceinline__ const char* b_hi(const Unit& u) const { return b_lo(u); }
    __device__ __forceinline__ void epi(const f32x4 (&acc)[2][2][4][2], const Unit& u, int wr, int wc, int fr, int fq) const {
        const int slot0 = u.ti * 256 + wr * 64 + fr, wsel = u.pn < 4 ? 0 : 1;
        bf16_t* base = ACT + (size_t)slot0 * 1024 + (u.pn < 4 ? 0 : 512) + (u.pn & 3) * 128 + wc * 32 + 8 * fq;
#pragma unroll
        for (int ai = 0; ai < 2; ++ai)
#pragma unroll
            for (int m = 0; m < 4; ++m) { const int dr = ai * 128 + m * 16; const float w = slotw[(size_t)(slot0 + dr) * 2 + wsel];
                const f32x4 g0 = acc[ai][0][m][0], g1 = acc[ai][0][m][1], u0 = acc[ai][1][m][0], u1 = acc[ai][1][m][1];
                float r[8];
#pragma unroll
                for (int q = 0; q < 4; ++q) { r[q] = w * siluf_(g0[q]) * u0[q]; r[4 + q] = w * siluf_(g1[q]) * u1[q]; }
                *(u32x4*)(base + (size_t)dr * 1024) = (u32x4){pk_bf16(r[0], r[1]), pk_bf16(r[2], r[3]), pk_bf16(r[4], r[5]), pk_bf16(r[6], r[7])}; }
    }
};
struct Dsc4 {
    static constexpr int K = 1024, LDB = 512; static constexpr bool PERM = false, GATHER = false;
    struct Unit { int ti, pn, elo, ehi; };
    const bf16_t* A; const bf16_t* Wdn; float* lat; float* ctx; const float* mod; const int* list; const int* tile; int G, c, nt_, dry;
    __device__ __forceinline__ bool next(int i, Unit& u) const {
        if (!pg8::static_order(i, G, c, nt_, 4, u.ti, u.pn)) return false;
        const int bk = __builtin_amdgcn_readfirstlane(tile[8 + u.ti]); bucket_experts(bk, u.elo, u.ehi); return true; }
    __device__ __forceinline__ const char* a_base(const Unit& u) const { return (const char*)A + (size_t)u.ti * 256 * 1024 * 2; }
    __device__ __forceinline__ void a_off(const Unit&, const int (&sR)[2], const int (&sC)[2], unsigned (&v)[2][2]) const { std_a_off(sR, sC, v); }
    __device__ __forceinline__ const char* b_lo(const Unit& u) const { return (const char*)Wdn + ((size_t)u.elo * 1024 + (size_t)u.pn * 256) * 512 * 2; }
    __device__ __forceinline__ const char* b_hi(const Unit& u) const { return (const char*)Wdn + ((size_t)u.ehi * 1024 + (size_t)u.pn * 256) * 512 * 2 - (size_t)(K / 128) * 128; }
    __device__ __forceinline__ void epi(const f32x4 (&acc)[2][2][4][2], const Unit& u, int wr, int wc, int fr, int fq) const {
        const int slot0 = u.ti * 256 + wr * 64 + fr, col0 = u.pn * 256 + wc * 32 + 4 * fq;
#pragma unroll
        for (int ai = 0; ai < 2; ++ai)
#pragma unroll
            for (int m = 0; m < 4; ++m) { const int tok = list[slot0 + ai * 128 + m * 16];
                if (tok >= 0) { const int b = tok / TT, t = tok - b * TT;
                    float* rp = (t < LC ? ctx + (size_t)(b * LC + t) * D : lat + (size_t)(b * SEQ + t - LC) * D) + col0;
                    const float* gate = mod + (size_t)(t < LC ? 16 : b) * 6144 + 5 * 1024 + col0;
#pragma unroll
                    for (int bj = 0; bj < 2; ++bj)
#pragma unroll
                        for (int n = 0; n < 2; ++n) { const f32x4 gv = *(const f32x4*)(gate + bj * 128 + n * 16); const f32x4 x = *(const f32x4*)(rp + bj * 128 + n * 16);
                            if (!dry) *(f32x4*)(rp + bj * 128 + n * 16) = x + gv * acc[ai][bj][m][n]; else asm volatile("" :: "v"(x + gv * acc[ai][bj][m][n])); } } }
    }
};

__device__ __forceinline__ void tr_tile(LAS float* tl, const float* src, int ld, int scol, float scale, bf16_t* dst, int lddst, int wv) {
    const int tid = tid_launder(wv), n = tid & 63, kq = tid >> 6;
#pragma unroll
    for (int i = 0; i < 8; ++i) { const int k = kq + 8 * i; tl[k * 65 + n] = scol >= 0 ? src[(size_t)k * ld + scol] * scale : 0.f; }
    __syncthreads();
    const int nn = tid >> 3, k8 = (tid & 7) * 8;
    u32x4 w;
#pragma unroll
    for (int j = 0; j < 4; ++j) w[j] = pk_bf16(tl[(k8 + 2 * j) * 65 + nn], tl[(k8 + 2 * j + 1) * 65 + nn]);
    *(u32x4*)(dst + (size_t)nn * lddst + k8) = w;
    __syncthreads();
}
__device__ __forceinline__ void convert_moe(KP p, LAS unsigned char* lds, int l, int wv) {
    LAS float* tl = (LAS float*)lds;
    bf16_t* WGU = (bf16_t*)(p->ws + WS_WGU); bf16_t* WDN = (bf16_t*)(p->ws + WS_WDN);
    const int n = tid_launder(wv) & 63;
    for (int idx = bid_launder(); idx < 4096 + 2048; idx += gridDim.x) {
        if (idx < 4096) { const int e = idx >> 8, rt = (idx >> 4) & 15, kt = idx & 15, q = rt >> 2, sub = rt & 3;
            const float* src = p->in[sub < 2 ? I_WG : I_WU] + ((size_t)(l * 16 + e) * 1024 + kt * 64) * 512;
            tr_tile(tl, src, 512, q * 128 + (sub & 1) * 64 + n, 1.f, WGU + ((size_t)e * 1024 + rt * 64) * 1024 + kt * 64, 1024, wv);
        } else { const int j = idx - 4096, e = j >> 7, ntile = (j >> 3) & 15, kt = j & 7;
            const float* src = p->in[I_WD] + ((size_t)(l * 16 + e) * 512 + kt * 64) * 1024;
            tr_tile(tl, src, 1024, ntile * 64 + n, 1.f, WDN + ((size_t)e * 1024 + ntile * 64) * 512 + kt * 64, 512, wv); }
    }
}
__device__ __forceinline__ void tr_tile_wave(LAS float* tl, const float* src, int ld, int scol, float scale, bf16_t* dst, int lddst, int lane) {
#pragma unroll 4
    for (int k = 0; k < 64; ++k) tl[k * 65 + lane] = scol >= 0 ? src[(size_t)k * ld + scol] * scale : 0.f;
    WAVE_LDS_SYNC();
#pragma unroll 2
    for (int k8 = 0; k8 < 64; k8 += 8) { u32x4 w;
#pragma unroll
        for (int j = 0; j < 4; ++j) w[j] = pk_bf16(tl[(k8 + 2 * j) * 65 + lane], tl[(k8 + 2 * j + 1) * 65 + lane]);
        *(u32x4*)(dst + (size_t)lane * lddst + k8) = w; }
    WAVE_LDS_SYNC();
}
__device__ __forceinline__ void convert_moe_wave(KP p, LAS unsigned char* Lb, int l, int cvi, int ncv, int wv) {
    const int lane = tid_launder(wv) & 63;
    LAS float* tl = (LAS float*)Lb;
    bf16_t* WGU = (bf16_t*)(p->ws + WS_WGU); bf16_t* WDN = (bf16_t*)(p->ws + WS_WDN);
    for (int idx = cvi; idx < 4096 + 2048 + (l == 0 ? 832 + 256 : 0); idx += ncv) {
        if (idx >= 4096 + 2048) {
            bf16_t* WIN = (bf16_t*)(p->ws + WS_WIN); bf16_t* WOUT = (bf16_t*)(p->ws + WS_WOUT); const int r = idx - 6144;
            if (r < 832) { const int ntile = r >> 4, kt = r & 15, np = ntile * 64 + lane;
                int scol; if (np < 768) scol = np; else if (np < 3072) scol = np + 32; else { const int j = np - 3072; scol = j < 32 ? 768 + j : (j < 48 ? 3104 + (j - 32) : -1); }
                const float scale = np < 128 ? 0.17677669529663687f : ((np >= 768 && np < 1024) ? 0.125f : 1.f);
                tr_tile_wave(tl, p->in[I_WIN] + ((size_t)1024 + kt * 64) * DIN, DIN, scol, scale, WIN + ((size_t)NWIN + ntile * 64) * 1024 + kt * 64, 1024, lane);
            } else { const int j = r - 832, ntile = j >> 4, kt = j & 15;
                tr_tile_wave(tl, p->in[I_WOUT] + ((size_t)1024 + kt * 64) * 1024, 1024, ntile * 64 + lane, 1.f, WOUT + ((size_t)1024 + ntile * 64) * 1024 + kt * 64, 1024, lane); }
        } else if (idx < 4096) { const int e = idx >> 8, rt = (idx >> 4) & 15, kt = idx & 15, q = rt >> 2, sub = rt & 3;
            const float* src = p->in[sub < 2 ? I_WG : I_WU] + ((size_t)(l * 16 + e) * 1024 + kt * 64) * 512;
            tr_tile_wave(tl, src, 512, q * 128 + (sub & 1) * 64 + lane, 1.f, WGU + ((size_t)e * 1024 + rt * 64) * 1024 + kt * 64, 1024, lane);
        } else { const int j = idx - 4096, e = j >> 7, ntile = (j >> 3) & 15, kt = j & 7;
            const float* src = p->in[I_WD] + ((size_t)(l * 16 + e) * 512 + kt * 64) * 1024;
            tr_tile_wave(tl, src, 1024, ntile * 64 + lane, 1.f, WDN + ((size_t)e * 1024 + ntile * 64) * 512 + kt * 64, 512, lane); }
    }
}
__device__ __forceinline__ void phase_prologue(KP p, LAS unsigned char* lds, int wv) {
    const int tid = tid_launder(wv), lane = tid & 63, wave = tid >> 6;
    {
        LAS float* SC = (LAS float*)lds; LAS float* RED = (LAS float*)(lds + 17 * 1024 * 4);
        for (int i = tid; i < 17 * 1024; i += 512) { const int r = i >> 10, k = i & 1023; const float v = r < 16 ? p->in[I_C][r * 1024 + k] : p->in[I_CCTX][k]; SC[i] = siluf_(v); }
        __syncthreads();
        float* MOD = (float*)(p->ws + WS_MOD);
        for (int unit = bid_launder(); unit < 192; unit += gridDim.x) {
            const int l = unit / 96, cg = unit - l * 96;
            const float* W = p->in[I_WADA] + (size_t)l * 1024 * 6144 + cg * 64 + lane;
            float acc[17];
#pragma unroll
            for (int r = 0; r < 17; ++r) acc[r] = 0.f;
            for (int k = wave * 128; k < wave * 128 + 128; k += 4) {
                const float w0 = W[(size_t)k * 6144], w1 = W[(size_t)(k + 1) * 6144], w2 = W[(size_t)(k + 2) * 6144], w3 = W[(size_t)(k + 3) * 6144];
#pragma unroll
                for (int r = 0; r < 17; ++r) { const f32x4 s = *(const LAS f32x4*)(SC + r * 1024 + k); acc[r] += s[0] * w0 + s[1] * w1 + s[2] * w2 + s[3] * w3; }
            }
#pragma unroll
            for (int r = 0; r < 17; ++r) RED[(wave * 17 + r) * 64 + lane] = acc[r];
            __syncthreads();
            for (int i = tid; i < 17 * 64; i += 512) { const int r = i >> 6, cc = i & 63; float s = 0.f;
#pragma unroll
                for (int w = 0; w < 8; ++w) s += RED[(w * 17 + r) * 64 + cc];
                MOD[(size_t)(l * 17 + r) * 6144 + cg * 64 + cc] = s + p->in[I_BADA][l * 6144 + cg * 64 + cc]; }
            __syncthreads();
        }
        __syncthreads();
    }
    {
        LAS float* tl = (LAS float*)lds;
        bf16_t* WIN = (bf16_t*)(p->ws + WS_WIN); bf16_t* WOUT = (bf16_t*)(p->ws + WS_WOUT);
        const int n = tid & 63;
        for (int idx0 = bid_launder(); idx0 < 832 + 256; idx0 += gridDim.x) {
            const int idx = idx0 < 832 ? idx0 : 1664 + (idx0 - 832);
            if (idx < 1664) { const int l = idx / 832, r = idx - l * 832, ntile = r >> 4, kt = r & 15, np = ntile * 64 + n;
                int scol; if (np < 768) scol = np; else if (np < 3072) scol = np + 32; else { const int j = np - 3072; scol = j < 32 ? 768 + j : (j < 48 ? 3104 + (j - 32) : -1); }
                const float scale = np < 128 ? 0.17677669529663687f : ((np >= 768 && np < 1024) ? 0.125f : 1.f);
                tr_tile(tl, p->in[I_WIN] + ((size_t)l * 1024 + kt * 64) * DIN, DIN, scol, scale, WIN + ((size_t)l * NWIN + ntile * 64) * 1024 + kt * 64, 1024, wv);
            } else { const int j = idx - 1664, l = j >> 8, ntile = (j >> 4) & 15, kt = j & 15;
                tr_tile(tl, p->in[I_WOUT] + ((size_t)l * 1024 + kt * 64) * 1024, 1024, ntile * 64 + n, 1.f, WOUT + ((size_t)l * 1024 + ntile * 64) * 1024 + kt * 64, 1024, wv); }
        }
    }
}

__device__ __forceinline__ void route16(const float (&lg)[16], const float* rb, int& bucket, float& wlo, float& whi) {
    float bestgs = -INFINITY, bs1 = 0.f, bs2 = 0.f; int bestg = 0, bi1 = 0, bi2 = 1;
#pragma unroll
    for (int g = 0; g < 4; ++g) {
        float sc[4], sl[4];
#pragma unroll
        for (int j = 0; j < 4; ++j) { sc[j] = sigmoidf_(lg[4 * g + j]); sl[j] = sc[j] + rb[4 * g + j]; }
        int i1 = 0; float v1 = sl[0], s1 = sc[0];
#pragma unroll
        for (int j = 1; j < 4; ++j) if (sl[j] > v1) { v1 = sl[j]; s1 = sc[j]; i1 = j; }
        int i2 = 0; float v2 = -INFINITY, s2 = 0.f;
#pragma unroll
        for (int j = 0; j < 4; ++j) if (j != i1 && sl[j] > v2) { v2 = sl[j]; s2 = sc[j]; i2 = j; }
        const float gs = v1 + v2;
        if (gs > bestgs) { bestgs = gs; bestg = g; bi1 = i1; bi2 = i2; bs1 = s1; bs2 = s2; }
    }
    const int lo = bi1 < bi2 ? bi1 : bi2, hi = bi1 < bi2 ? bi2 : bi1;
    const float slo = bi1 < bi2 ? bs1 : bs2, shi = bi1 < bi2 ? bs2 : bs1;
    const int pr = lo == 0 ? hi - 1 : (lo == 1 ? hi + 1 : 5);
    bucket = bestg * 6 + pr; const float inv = 1.f / (bs1 + bs2); wlo = slo * inv; whi = shi * inv;
}
template <bool ROUTER>
__device__ __forceinline__ void phase_prep(KP p, LAS unsigned char* lds, int l, const float* lat, const float* ctx, int latent_only, int wv) {
    const int tid = tid_launder(wv), lane = tid & 63, wave = tid >> 6, fr = lane & 15, kq = lane >> 4;
    const float* MOD = (const float*)(p->ws + WS_MOD) + (size_t)l * 17 * 6144;
    const float* g = p->in[I_NORMG] + (l * 2 + (ROUTER ? 1 : 0)) * 1024;
    bf16_t* H = (bf16_t*)(p->ws + WS_ABUF);
    constexpr int NT = ROUTER ? 1 : 3, AST = 1032;
    LAS bf16_t* AH = (LAS bf16_t*)lds; LAS bf16_t* AL = AH + 16 * AST; LAS float* PART = (LAS float*)(lds + 2 * 16 * AST * 2); LAS float* LG = PART + 8 * NT * 256; LAS int* hist = (LAS int*)(LG + 256);
    bf16x8 Bh[NT][4], Bl[4];
    if (ROUTER) {
#pragma unroll
        for (int kk = 0; kk < 4; ++kk) { const int k0 = 128 * wave + 32 * kk + 8 * kq; u32x4 wh, wl;
#pragma unroll
            for (int e = 0; e < 4; ++e) { const float w0 = p->in[I_RW][(size_t)(k0 + 2 * e) * 16 + fr], w1 = p->in[I_RW][(size_t)(k0 + 2 * e + 1) * 16 + fr];
                const unsigned hh = pk_bf16(w0, w1); wh[e] = hh; wl[e] = pk_bf16(w0 - bflo(hh), w1 - bfhi(hh)); }
            Bh[0][kk] = __builtin_bit_cast(bf16x8, wh); Bl[kk] = __builtin_bit_cast(bf16x8, wl); }
    } else {
        const bf16_t* WS_ = (const bf16_t*)(p->ws + WS_WIN) + ((size_t)l * NWIN + 3072) * 1024;
#pragma unroll
        for (int nt = 0; nt < NT; ++nt)
#pragma unroll
            for (int kk = 0; kk < 4; ++kk) { Bh[nt][kk] = *(const bf16x8*)(WS_ + (size_t)(16 * nt + fr) * 1024 + 128 * wave + 32 * kk + 8 * kq); }
#pragma unroll
        for (int kk = 0; kk < 4; ++kk) Bl[kk] = Bh[0][kk];
    }
    const int n_per = latent_only ? 128 : 144, ngrp = n_per / 16;
    for (int vb = bid_launder(); vb < NVB; vb += gridDim.x) {
        if (ROUTER) { if (tid < 32) hist[tid] = 0; }
        const int mbase = latent_only ? (vb >> 4) * TT + LC + (vb & 15) * 128 : vb * 144;
        f32x4 xn[2][4];
#pragma unroll
        for (int r = 0; r < 2; ++r) { const float* xr0 = res_row_c(lat, ctx, mbase + 2 * wave + r);
#pragma unroll
            for (int j = 0; j < 4; ++j) xn[r][j] = *(const f32x4*)(xr0 + 4 * lane + 256 * j); }
        for (int grp = 0; grp < ngrp; ++grp) {
            f32x4 xv[2][4];
#pragma unroll
            for (int r = 0; r < 2; ++r)
#pragma unroll
                for (int j = 0; j < 4; ++j) xv[r][j] = xn[r][j];
            if (grp + 1 < ngrp) {
#pragma unroll
                for (int r = 0; r < 2; ++r) { const float* xrn = res_row_c(lat, ctx, mbase + 16 * (grp + 1) + 2 * wave + r);
#pragma unroll
                    for (int j = 0; j < 4; ++j) xn[r][j] = *(const f32x4*)(xrn + 4 * lane + 256 * j); } }
#pragma unroll
            for (int r = 0; r < 2; ++r) {
                const int m = mbase + 16 * grp + 2 * wave + r, b = m / TT, t = m - b * TT, rb = t < LC ? 16 : b;
                float ss = 0.f;
#pragma unroll
                for (int j = 0; j < 4; ++j) ss += xv[r][j][0] * xv[r][j][0] + xv[r][j][1] * xv[r][j][1] + xv[r][j][2] * xv[r][j][2] + xv[r][j][3] * xv[r][j][3];
                ss = wave_sum(ss);
                const float rstd = rsqrtf(ss * (1.f / 1024.f) + EPS);
                const float* sh = MOD + (size_t)rb * 6144 + (ROUTER ? 3 : 0) * 1024; const float* sc = sh + 1024;
#pragma unroll
                for (int j = 0; j < 4; ++j) { const int idx = 4 * lane + 256 * j;
                    const f32x4 gv = *(const f32x4*)(g + idx), shv = *(const f32x4*)(sh + idx), scv = *(const f32x4*)(sc + idx);
                    const f32x4 hv = xv[r][j] * rstd * gv * (1.f + scv) + shv;
                    const unsigned h0 = pk_bf16(hv[0], hv[1]), h1 = pk_bf16(hv[2], hv[3]);
                    *(u32x2*)(H + (size_t)m * 1024 + idx) = (u32x2){h0, h1};
                    *(LAS u32x2*)(AH + (2 * wave + r) * AST + idx) = (u32x2){h0, h1};
                    if (ROUTER) *(LAS u32x2*)(AL + (2 * wave + r) * AST + idx) = (u32x2){pk_bf16(hv[0] - bflo(h0), hv[1] - bfhi(h0)), pk_bf16(hv[2] - bflo(h1), hv[3] - bfhi(h1))}; }
            }
            LDS_BARRIER();
            { f32x4 acc[NT];
#pragma unroll
                for (int nt = 0; nt < NT; ++nt) acc[nt] = (f32x4){0.f, 0.f, 0.f, 0.f};
#pragma unroll
                for (int kk = 0; kk < 4; ++kk) { const bf16x8 ah = *(const LAS bf16x8*)(AH + fr * AST + 128 * wave + 32 * kk + 8 * kq);
#pragma unroll
                    for (int nt = 0; nt < NT; ++nt) acc[nt] = __builtin_amdgcn_mfma_f32_16x16x32_bf16(ah, Bh[nt][kk], acc[nt], 0, 0, 0);
                    if (ROUTER) { const bf16x8 al = *(const LAS bf16x8*)(AL + fr * AST + 128 * wave + 32 * kk + 8 * kq);
                        acc[0] = __builtin_amdgcn_mfma_f32_16x16x32_bf16(ah, Bl[kk], acc[0], 0, 0, 0); acc[0] = __builtin_amdgcn_mfma_f32_16x16x32_bf16(al, Bh[0][kk], acc[0], 0, 0, 0); } }
#pragma unroll
                for (int nt = 0; nt < NT; ++nt)
#pragma unroll
                    for (int i = 0; i < 4; ++i) PART[(wave * NT + nt) * 256 + (4 * kq + i) * 16 + fr] = acc[nt][i]; }
            LDS_BARRIER();
            for (int e2 = tid; e2 < NT * 256; e2 += 512) { const int nt = e2 >> 8, e = e2 & 255; float sacc = 0.f;
#pragma unroll
                for (int w = 0; w < 8; ++w) sacc += PART[(w * NT + nt) * 256 + e];
                if (ROUTER) LG[e] = sacc;
                else ((bf16_t*)(p->ws + WS_SMALL))[(size_t)(mbase + 16 * grp + (e >> 4)) * 64 + 16 * nt + (e & 15)] = (bf16_t)(pk_bf16(sacc, 0.f) & 0xffffu); }
            if (ROUTER) {
                LDS_BARRIER();
                if (tid < 16) { float lg[16];
#pragma unroll
                    for (int q = 0; q < 4; ++q) { const f32x4 v = *(const LAS f32x4*)(LG + tid * 16 + 4 * q); lg[4 * q] = v[0]; lg[4 * q + 1] = v[1]; lg[4 * q + 2] = v[2]; lg[4 * q + 3] = v[3]; }
                    int bucket; float wlo, whi; route16(lg, p->in[I_RB], bucket, wlo, whi);
                    *(f32x4*)(p->ws + WS_ROUTE + (size_t)(mbase + 16 * grp + tid) * 16) = (f32x4){__int_as_float(bucket), wlo, whi, 0.f};
                    ((unsigned char*)(p->ws + WS_RB8))[mbase + 16 * grp + tid] = (unsigned char)bucket;
                    __hip_atomic_fetch_add(hist + bucket, 1, __ATOMIC_RELAXED, __HIP_MEMORY_SCOPE_WORKGROUP); }
            }
        }
        if (ROUTER) { __syncthreads(); if (tid < 32) ((int*)(p->ws + WS_HIST))[vb * 32 + tid] = tid < 24 ? hist[tid] : 0; }
        __syncthreads();
    }
}

__device__ __forceinline__ void phase_moe_offsets(KP p, LAS unsigned char* lds, int latent_only, int wv) {
    const int tid = tid_launder(wv), lane = tid & 63, wave = tid >> 6;
    LAS int* PT = (LAS int*)lds; LAS int* tot = PT + 384; LAS int* tbase = tot + 32; LAS int* wsum = tbase + 32;
    const int* HIST = (const int*)(p->ws + WS_HIST); int* LIST = (int*)(p->ws + WS_LIST); f32x2* SLOTW = (f32x2*)(p->ws + WS_SLOTW); int* TILE = (int*)(p->ws + WS_TILE);
    for (int j = bid_launder(); j < 24; j += gridDim.x) {
        if (tid < 384) { const int jj = tid % 24, pi = tid / 24; int sacc = 0; for (int w = pi * 16; w < pi * 16 + 16; ++w) sacc += HIST[w * 32 + jj]; PT[pi * 24 + jj] = sacc; }
        __syncthreads();
        if (tid < 24) { int sacc = 0; for (int i = 0; i < 16; ++i) sacc += PT[i * 24 + tid]; tot[tid] = sacc; }
        __syncthreads();
        if (tid == 0) { int run = 0; for (int q = 0; q < 24; ++q) { tbase[q] = run; run += (tot[q] + 255) >> 8; } tbase[24] = run; }
        __syncthreads();
        const int base = tbase[j] * 256, cnt = tot[j], ntile = (cnt + 255) >> 8;
        if (j == 0) { if (tid == 0) TILE[0] = tbase[24]; if (tid < 24) { const int nq = (tot[tid] + 255) >> 8; for (int i = 0; i < nq; ++i) TILE[8 + tbase[tid] + i] = tid; } }
        const unsigned* rb = (const unsigned*)(p->ws + WS_RB8) + tid * 18;
        int mycnt = 0;
#pragma unroll 1
        for (int g3 = 0; g3 < 3; ++g3) { unsigned bw[6];
#pragma unroll
            for (int q = 0; q < 6; ++q) bw[q] = rb[g3 * 6 + q];
#pragma unroll
            for (int q = 0; q < 6; ++q)
#pragma unroll
                for (int e = 0; e < 4; ++e) { const int m = tid * 72 + g3 * 24 + 4 * q + e; const int t = m % TT; const int bk = (int)((bw[q] >> (8 * e)) & 0xffu);
                    mycnt += ((!latent_only || t >= LC) && bk == j) ? 1 : 0; } }
        int incl = mycnt;
#pragma unroll
        for (int o = 1; o < 64; o <<= 1) { const int v = __shfl_up(incl, o, 64); if (lane >= o) incl += v; }
        if (lane == 63) wsum[wave] = incl;
        __syncthreads();
        int woff = 0;
#pragma unroll
        for (int w = 0; w < 8; ++w) woff += (w < wave) ? wsum[w] : 0;
        int pos = base + woff + incl - mycnt;
#pragma unroll 1
        for (int g3 = 0; g3 < 3; ++g3) { unsigned bw[6];
#pragma unroll
            for (int q = 0; q < 6; ++q) bw[q] = rb[g3 * 6 + q];
#pragma unroll 1
            for (int q = 0; q < 6; ++q)
#pragma unroll 1
                for (int e = 0; e < 4; ++e) { const int m = tid * 72 + g3 * 24 + 4 * q + e; const int t = m % TT; const unsigned w4 = q == 0 ? bw[0] : (q == 1 ? bw[1] : (q == 2 ? bw[2] : (q == 3 ? bw[3] : (q == 4 ? bw[4] : bw[5])))); const int bk = (int)((w4 >> (8 * e)) & 0xffu);
                    if ((!latent_only || t >= LC) && bk == j) { const f32x4 r = *(const f32x4*)(p->ws + WS_ROUTE + (size_t)m * 16); LIST[pos] = m; SLOTW[pos] = (f32x2){r[1], r[2]}; ++pos; } } }
        for (int sidx = base + cnt + tid; sidx < base + ntile * 256; sidx += 512) { LIST[sidx] = -1; SLOTW[sidx] = (f32x2){0.f, 0.f}; }
        __syncthreads();
    }
}

__device__ __forceinline__ bf16_t* obuf(unsigned char* ws, int k) {
    const int panel = k == 4 ? 8 : (k == 5 ? 9 : (k == 6 ? 10 : 12));
    return k < 4 ? (bf16_t*)(ws + WS_O) + (size_t)k * PANEL_EL : (bf16_t*)(ws + WS_P) + (size_t)panel * PANEL_EL;
}
__device__ __forceinline__ void phase_mixprep(KP p, int l, int skip_rope, int wv) {
    const int tid = tid_launder(wv);
    bf16_t* P = (bf16_t*)(p->ws + WS_P); bf16_t* DNP = (bf16_t*)(p->ws + WS_ABUF);
    float* GDEC = (float*)(p->ws + WS_GDEC); float* DNAB = (float*)(p->ws + WS_DNAB);
    float cw[5][2] = {{0.f, 0.f}, {0.f, 0.f}, {0.f, 0.f}, {0.f, 0.f}, {0.f, 0.f}};
    const int sec = tid >> 7, cp = (tid & 127) * 2;
    if (tid < 384) {
#pragma unroll
        for (int j = 0; j < 5; ++j) { cw[j][0] = p->in[I_CONVW][(l * 5 + j) * 768 + sec * 256 + cp]; cw[j][1] = p->in[I_CONVW][(l * 5 + j) * 768 + sec * 256 + cp + 1]; }
    }
    float nalog = 0.f, dtb = 0.f;
    if (tid >= 384 && tid < 392) { nalog = -__expf(p->in[I_ALOG][l * 8 + tid - 384]); dtb = p->in[I_DTB][l * 8 + tid - 384]; }
    float gw[16], gb = 0.f, invf = 0.f; int userow = 0;
#pragma unroll
    for (int r = 0; r < 16; ++r) gw[r] = 0.f;
    const int t2 = tid & 255;
    if (tid >= 256) { const int dir = t2 >> 7, c = t2 & 127;
#pragma unroll
        for (int r = 0; r < 16; ++r) gw[r] = p->in[I_GKW][((l * 2 + dir) * 16 + r) * 128 + c];
        gb = p->in[I_GKB][(l * 2 + dir) * 128 + c];
    } else { const int i = t2 & 31; invf = exp2f(-(float)(i & 15) * (13.287712379549449f / 16.f)); userow = i < 16; }
    for (int vb = bid_launder(); vb < NVB; vb += gridDim.x) {
        const int b = vb >> 4, t0 = (vb & 15) * 144;
        unsigned nA[8]; float nda[4], ndb[4]; u32x4 nz0[4], nz1[4]; unsigned nC[4];
#define MP_LOADS(C0) do { const int t_ = t0 + (C0), m_ = b * TT + t_, lo_ = t_ < LC ? 0 : LC, hi_ = t_ < LC ? LC : TT; \
            if (tid < 384) { const bf16_t* src = P + (size_t)(8 + sec) * PANEL_EL + cp; \
                _Pragma("unroll") for (int j = 0; j < 8; ++j) { const int tt = t_ - 2 + j; nA[j] = (tt >= lo_ && tt < hi_) ? *(const unsigned*)(src + (size_t)(b * TT + tt) * 256) : 0u; } } \
            else if (tid < 392) { const int j = tid - 384; const bf16_t* s12 = (const bf16_t*)(p->ws + WS_SMALL) + (size_t)m_ * 64; \
                _Pragma("unroll") for (int q = 0; q < 4; ++q) { nda[q] = bf2f(s12[q * 64 + 32 + j]); ndb[q] = bf2f(s12[q * 64 + 40 + j]); } } \
            if (tid >= 256) { const bf16_t* zp = (const bf16_t*)(p->ws + WS_SMALL) + (size_t)m_ * 64 + (t2 >> 7) * 16; \
                _Pragma("unroll") for (int q = 0; q < 4; ++q) { nz0[q] = *(const u32x4*)(zp + q * 64); nz1[q] = *(const u32x4*)(zp + q * 64 + 8); } } \
            else if (t_ >= LC && !skip_rope) { const bf16_t* ap = P + (size_t)(3 + (t2 >> 7)) * PANEL_EL + (size_t)m_ * 256 + 2 * (t2 & 127); \
                _Pragma("unroll") for (int q = 0; q < 4; ++q) nC[q] = *(const unsigned*)(ap + q * 256); } } while (0)
        MP_LOADS(0);
        for (int c0 = 0; c0 < 144; c0 += 4) {
            const int t = t0 + c0, m = b * TT + t;
            unsigned raw[8]; float da[4], db[4]; u32x4 z0[4], z1[4]; unsigned rc[4];
#pragma unroll
            for (int j = 0; j < 8; ++j) raw[j] = nA[j];
#pragma unroll
            for (int q = 0; q < 4; ++q) { da[q] = nda[q]; db[q] = ndb[q]; z0[q] = nz0[q]; z1[q] = nz1[q]; rc[q] = nC[q]; }
            if (c0 + 4 < 144) MP_LOADS(c0 + 4);
            if (tid < 384) {
                unsigned outv[4];
#pragma unroll
                for (int q = 0; q < 4; ++q) { float a0 = 0.f, a1 = 0.f;
#pragma unroll
                    for (int j = 0; j < 5; ++j) { a0 += cw[j][0] * bflo(raw[q + j]); a1 += cw[j][1] * bfhi(raw[q + j]); }
                    a0 = siluf_(a0); a1 = siluf_(a1);
                    if (sec < 2) { const float ss = half_sum32(a0 * a0 + a1 * a1); const float rn = rsqrtf(ss + EPS) * (sec == 0 ? 0.125f : 1.f); a0 *= rn; a1 *= rn; }
                    outv[q] = pk_bf16(a0, a1); }
#pragma unroll
                for (int q = 0; q < 4; ++q) *(unsigned*)(DNP + (size_t)sec * PANEL_EL + (size_t)(m + q) * 256 + cp) = outv[q];
            } else if (tid < 392) {
                const int j = tid - 384;
#pragma unroll
                for (int q = 0; q < 4; ++q) { DNAB[(size_t)(m + q) * 16 + j] = nalog * softplusf_(da[q] + dtb);     DNAB[(size_t)(m + q) * 16 + 8 + j] = sigmoidf_(db[q]); }
            }
            if (tid >= 256) {
#pragma unroll
                for (int q = 0; q < 4; ++q) { float logit = gb;
#pragma unroll
                    for (int e = 0; e < 4; ++e) { logit += bflo(z0[q][e]) * gw[2 * e] + bfhi(z0[q][e]) * gw[2 * e + 1] + bflo(z1[q][e]) * gw[8 + 2 * e] + bfhi(z1[q][e]) * gw[8 + 2 * e + 1]; }
                    const float ls = fminf(logit, 0.f) - __logf(1.f + __expf(-fabsf(logit)));
                    GDEC[(size_t)(m + q) * 256 + t2] = ls * 0.0625f; }
            } else if (t >= LC && !skip_rope) {
                bf16_t* ap = P + (size_t)(3 + (t2 >> 7)) * PANEL_EL + (size_t)m * 256 + 2 * (t2 & 127);
#pragma unroll
                for (int q = 0; q < 4; ++q) { const int pos = t + q - LC; const float t1 = bflo(rc[q]), tq = bfhi(rc[q]);
                    const float ang = (float)(userow ? (pos >> 6) : (pos & 63)) * invf; const float sn = __sinf(ang), cs = __cosf(ang);
                    rc[q] = pk_bf16(t1 * cs - tq * sn, t1 * sn + tq * cs); }
#pragma unroll
                for (int q = 0; q < 4; ++q) *(unsigned*)(ap + q * 256) = rc[q];
            }
        }
#undef MP_LOADS
    }
}

__device__ __forceinline__ int blk_tok0(int dir, int blk) { return dir == 0 ? 16 * blk : (blk < 16 ? LC - 16 * (blk + 1) : TT - 16 * (blk - 15)); }
__device__ __forceinline__ void cvt8(const u32x4 r, LAS float* d) {
    *(LAS f32x4*)d = (f32x4){bflo(r[0]), bfhi(r[0]), bflo(r[1]), bfhi(r[1])}; *(LAS f32x4*)(d + 4) = (f32x4){bflo(r[2]), bfhi(r[2]), bflo(r[3]), bfhi(r[3])};
}
__device__ __forceinline__ void store_out16(const LAS float* LO, bf16_t* Og, int tcur, int lane) {
    if (lane < 32) { const int row = lane >> 1, half = lane & 1; const f32x4 o0 = *(const LAS f32x4*)(LO + row * 16 + half * 8), o1 = *(const LAS f32x4*)(LO + row * 16 + half * 8 + 4);
        *(u32x4*)(Og + (size_t)(tcur + row) * 16 + half * 8) = (u32x4){pk_bf16(o0[0], o0[1]), pk_bf16(o0[2], o0[3]), pk_bf16(o1[0], o1[1]), pk_bf16(o1[2], o1[3])}; }
}
template <int DIR>
__device__ __forceinline__ void scan_ret_chunk(KP p, LAS unsigned char* Lb, int idx, int l, int wv) {
    const int lane = tid_launder(wv) & 63, fr = lane & 15, kq = lane >> 4;
    constexpr int dir = DIR; const int h = (idx >> 1) & 3, b = idx >> 3;
    const bf16_t* P = (const bf16_t*)(p->ws + WS_P);
    const bf16_t* Qg = P + 3 * PANEL_EL + (size_t)b * TT * 256 + h * 64; const bf16_t* Kg = Qg + PANEL_EL; const bf16_t* Vg = Qg + 2 * PANEL_EL;
    bf16_t* Og = obuf(p->ws, 2 + dir) + (size_t)((b * 4 + h) * 4) * TT * 16;
    const float lg2 = log2f(sigmoidf_(p->in[I_RETD][(l * 2 + dir) * 4 + h]));
    const float g16 = exp2f(16.f * lg2);
    LAS bf16_t* QL = (LAS bf16_t*)Lb; LAS bf16_t* KL = QL + 16 * 72; LAS bf16_t* KT = KL + 16 * 72; LAS bf16_t* VT = KT + 64 * 32; LAS bf16_t* GL = VT + 64 * 32;
    for (int i = lane; i < (64 * 32 * 2 + 16 * 32) / 2; i += 64) ((LAS unsigned*)KT)[i] = 0u;
    f32x4 S[4][4];
#pragma unroll
    for (int a = 0; a < 4; ++a)
#pragma unroll
        for (int c = 0; c < 4; ++c) S[a][c] = (f32x4){0.f, 0.f, 0.f, 0.f};
    u32x4 rq[2], rk[2], rv[2];
    int tb = blk_tok0(dir, 0);
#define RC_LOAD(T0) do { _Pragma("unroll") for (int i = 0; i < 2; ++i) { const int q = lane + 64 * i, r = q >> 3, c8 = (q & 7) * 8; const size_t ro = (size_t)((T0) + (dir ? 15 - r : r)) * 256 + c8; \
        rq[i] = *(const u32x4*)(Qg + ro); rk[i] = *(const u32x4*)(Kg + ro); rv[i] = *(const u32x4*)(Vg + ro); } } while (0)
    RC_LOAD(tb);
    float rowsc[4];
#pragma unroll
    for (int i = 0; i < 4; ++i) rowsc[i] = exp2f(lg2 * (float)(4 * kq + i - 15));
    for (int blk = 0; blk < 144; ++blk) {
#pragma unroll
        for (int i = 0; i < 2; ++i) { const int q = lane + 64 * i, r = q >> 3, c8 = (q & 7) * 8;
            *(LAS u32x4*)(QL + r * 72 + c8) = rq[i]; *(LAS u32x4*)(KL + r * 72 + c8) = rk[i];
            const float vs = exp2f(lg2 * (float)(15 - r));
#pragma unroll
            for (int e = 0; e < 4; ++e) { KT[(c8 + 2 * e) * 32 + r] = (bf16_t)(rk[i][e] & 0xffffu); KT[(c8 + 2 * e + 1) * 32 + r] = (bf16_t)(rk[i][e] >> 16);
                const unsigned pv = pk_bf16(bflo(rv[i][e]) * vs, bfhi(rv[i][e]) * vs);
                VT[(c8 + 2 * e) * 32 + r] = (bf16_t)(pv & 0xffffu); VT[(c8 + 2 * e + 1) * 32 + r] = (bf16_t)(pv >> 16); } }
        const int tcur = tb;
        if (blk + 1 < 144) { tb = blk_tok0(dir, blk + 1); RC_LOAD(tb); }
        WAVE_LDS_SYNC();
        f32x4 G = (f32x4){0.f, 0.f, 0.f, 0.f};
#pragma unroll
        for (int kk = 0; kk < 2; ++kk) { const bf16x8 a = *(const LAS bf16x8*)(QL + fr * 72 + 32 * kk + 8 * kq), bb = *(const LAS bf16x8*)(KL + fr * 72 + 32 * kk + 8 * kq);
            G = __builtin_amdgcn_mfma_f32_16x16x32_bf16(a, bb, G, 0, 0, 0); }
#pragma unroll
        for (int i = 0; i < 4; ++i) { const int r = 4 * kq + i; GL[r * 32 + fr] = (bf16_t)(pk_bf16(fr <= r ? G[i] : 0.f, 0.f) & 0xffffu); }
#pragma unroll
        for (int a = 0; a < 4; ++a)
#pragma unroll
            for (int c = 0; c < 4; ++c) S[a][c] = S[a][c] * g16;
        WAVE_LDS_SYNC();
        const bf16x8 ag = *(const LAS bf16x8*)(GL + fr * 32 + 8 * kq);
        bf16x8 aq[2];
#pragma unroll
        for (int kk = 0; kk < 2; ++kk) { const u32x2 lo = *(const LAS u32x2*)(QL + fr * 72 + 32 * kk + 4 * kq), hi = *(const LAS u32x2*)(QL + fr * 72 + 32 * kk + 16 + 4 * kq);
            aq[kk] = __builtin_bit_cast(bf16x8, (u32x4){lo[0], lo[1], hi[0], hi[1]}); }
        bf16x8 bv[4], ak[4];
#pragma unroll
        for (int c = 0; c < 4; ++c) { bv[c] = *(const LAS bf16x8*)(VT + (16 * c + fr) * 32 + 8 * kq); ak[c] = *(const LAS bf16x8*)(KT + (16 * c + fr) * 32 + 8 * kq); }
        f32x4 acc[4];
#pragma unroll
        for (int c = 0; c < 4; ++c) { acc[c] = __builtin_amdgcn_mfma_f32_16x16x32_bf16(ag, bv[c], (f32x4){0.f, 0.f, 0.f, 0.f}, 0, 0, 0);
#pragma unroll
            for (int kk = 0; kk < 2; ++kk) { const f32x4 s0 = S[2 * kk][c], s1 = S[2 * kk + 1][c];
                const bf16x8 bs = __builtin_bit_cast(bf16x8, (u32x4){pk_bf16(s0[0], s0[1]), pk_bf16(s0[2], s0[3]), pk_bf16(s1[0], s1[1]), pk_bf16(s1[2], s1[3])});
                acc[c] = __builtin_amdgcn_mfma_f32_16x16x32_bf16(aq[kk], bs, acc[c], 0, 0, 0); } }
#pragma unroll
        for (int a = 0; a < 4; ++a)
#pragma unroll
            for (int c = 0; c < 4; ++c) S[a][c] = __builtin_amdgcn_mfma_f32_16x16x32_bf16(ak[a], bv[c], S[a][c], 0, 0, 0);
#pragma unroll
        for (int c = 0; c < 4; ++c)
#pragma unroll
            for (int i = 0; i < 4; ++i) { const int r = 4 * kq + i; Og[((size_t)c * TT + (size_t)(tcur + (dir ? 15 - r : r))) * 16 + fr] = (bf16_t)(pk_bf16(acc[c][i] * rowsc[i], 0.f) & 0xffffu); }
        WAVE_LDS_SYNC();
    }
#undef RC_LOAD
}
template <int DIR>
__device__ __forceinline__ void scan_gla_chunk(KP p, LAS unsigned char* Lb, int idx, int wv) {
    const int lane = tid_launder(wv) & 63, fr = lane & 15, kq = lane >> 4;
    constexpr int dir = DIR; const int h = (idx >> 1) & 3, b = idx >> 3;
    const bf16_t* P = (const bf16_t*)(p->ws + WS_P);
    const bf16_t* Qg = P + (size_t)b * TT * 256 + h * 32; const bf16_t* Kg = Qg + 128; const bf16_t* Vg = P + PANEL_EL + (size_t)b * TT * 256 + h * 64;
    const float* Ag = (const float*)(p->ws + WS_GDEC) + (size_t)b * TT * 256 + dir * 128 + h * 32;
    bf16_t* Og = obuf(p->ws, dir) + (size_t)((b * 4 + h) * 4) * TT * 16;
    LAS bf16_t* QL = (LAS bf16_t*)Lb; LAS bf16_t* KL = QL + 16 * 40; LAS bf16_t* KT = KL + 16 * 40; LAS bf16_t* VT = KT + 32 * 32; LAS bf16_t* GL = VT + 64 * 32; LAS float* EB = (LAS float*)(GL + 16 * 32);
    for (int i = lane; i < (32 * 32 + 64 * 32 + 16 * 32) / 2; i += 64) ((LAS unsigned*)KT)[i] = 0u;
    f32x4 S[2][4];
#pragma unroll
    for (int a = 0; a < 2; ++a)
#pragma unroll
        for (int c = 0; c < 4; ++c) S[a][c] = (f32x4){0.f, 0.f, 0.f, 0.f};
    const int sg = lane >> 4, dp = lane & 15;
    unsigned rq[4], rk[4]; f32x2 ra[4]; u32x4 rv[2];
    int tb = blk_tok0(dir, 0);
#define GC_LOAD(T0) do { _Pragma("unroll") for (int i = 0; i < 4; ++i) { const int r = 4 * sg + i; const size_t ro = (size_t)((T0) + (dir ? 15 - r : r)) * 256 + 2 * dp; \
            rq[i] = *(const unsigned*)(Qg + ro); rk[i] = *(const unsigned*)(Kg + ro); ra[i] = *(const f32x2*)(Ag + ro); } \
        _Pragma("unroll") for (int i = 0; i < 2; ++i) { const int q = lane + 64 * i, r = q >> 3, c8 = (q & 7) * 8; rv[i] = *(const u32x4*)(Vg + (size_t)((T0) + (dir ? 15 - r : r)) * 256 + c8); } } while (0)
    GC_LOAD(tb);
    for (int blk = 0; blk < 144; ++blk) {
        f32x2 bc[4]; bc[0] = ra[0]; bc[1] = bc[0] + ra[1]; bc[2] = bc[1] + ra[2]; bc[3] = bc[2] + ra[3];
        f32x2 inc = bc[3];
        { const float u0 = __shfl_up(inc[0], 16, 64), u1 = __shfl_up(inc[1], 16, 64); if (sg >= 1) { inc[0] += u0; inc[1] += u1; } }
        { const float u0 = __shfl_up(inc[0], 32, 64), u1 = __shfl_up(inc[1], 32, 64); if (sg >= 2) { inc[0] += u0; inc[1] += u1; } }
        const f32x2 excl = inc - bc[3];
        if (sg == 3) { EB[2 * dp] = __expf(inc[0]); EB[2 * dp + 1] = __expf(inc[1]); }
#pragma unroll
        for (int i = 0; i < 4; ++i) { const int r = 4 * sg + i; const f32x2 bb = bc[i] + excl;
            const float e0 = __expf(bb[0]), e1 = __expf(bb[1]), n0 = __expf(-bb[0]), n1 = __expf(-bb[1]);
            const unsigned qv = pk_bf16(bflo(rq[i]) * e0, bfhi(rq[i]) * e1), kv = pk_bf16(bflo(rk[i]) * n0, bfhi(rk[i]) * n1);
            *(LAS unsigned*)(QL + r * 40 + 2 * dp) = qv; *(LAS unsigned*)(KL + r * 40 + 2 * dp) = kv;
            KT[(2 * dp) * 32 + r] = (bf16_t)(kv & 0xffffu); KT[(2 * dp + 1) * 32 + r] = (bf16_t)(kv >> 16); }
#pragma unroll
        for (int i = 0; i < 2; ++i) { const int q = lane + 64 * i, r = q >> 3, c8 = (q & 7) * 8;
#pragma unroll
            for (int e = 0; e < 4; ++e) { VT[(c8 + 2 * e) * 32 + r] = (bf16_t)(rv[i][e] & 0xffffu); VT[(c8 + 2 * e + 1) * 32 + r] = (bf16_t)(rv[i][e] >> 16); } }
        const int tcur = tb;
        if (blk + 1 < 144) { tb = blk_tok0(dir, blk + 1); GC_LOAD(tb); }
        WAVE_LDS_SYNC();
        { const bf16x8 a = *(const LAS bf16x8*)(QL + fr * 40 + 8 * kq), bb = *(const LAS bf16x8*)(KL + fr * 40 + 8 * kq);
            const f32x4 G = __builtin_amdgcn_mfma_f32_16x16x32_bf16(a, bb, (f32x4){0.f, 0.f, 0.f, 0.f}, 0, 0, 0);
#pragma unroll
            for (int i = 0; i < 4; ++i) { const int r = 4 * kq + i; GL[r * 32 + fr] = (bf16_t)(pk_bf16(fr <= r ? G[i] : 0.f, 0.f) & 0xffffu); } }
        WAVE_LDS_SYNC();
        const bf16x8 ag = *(const LAS bf16x8*)(GL + fr * 32 + 8 * kq);
        const u32x2 qlo = *(const LAS u32x2*)(QL + fr * 40 + 4 * kq), qhi = *(const LAS u32x2*)(QL + fr * 40 + 16 + 4 * kq);
        const bf16x8 aq = __builtin_bit_cast(bf16x8, (u32x4){qlo[0], qlo[1], qhi[0], qhi[1]});
        bf16x8 bv[4], ak[2];
#pragma unroll
        for (int c = 0; c < 4; ++c) bv[c] = *(const LAS bf16x8*)(VT + (16 * c + fr) * 32 + 8 * kq);
#pragma unroll
        for (int a = 0; a < 2; ++a) ak[a] = *(const LAS bf16x8*)(KT + (16 * a + fr) * 32 + 8 * kq);
        const f32x4 eb0 = *(const LAS f32x4*)(EB + 4 * kq), eb1 = *(const LAS f32x4*)(EB + 16 + 4 * kq);
#pragma unroll
        for (int c = 0; c < 4; ++c) { f32x4 acc = __builtin_amdgcn_mfma_f32_16x16x32_bf16(ag, bv[c], (f32x4){0.f, 0.f, 0.f, 0.f}, 0, 0, 0);
            const f32x4 s0 = S[0][c], s1 = S[1][c];
            const bf16x8 bs = __builtin_bit_cast(bf16x8, (u32x4){pk_bf16(s0[0], s0[1]), pk_bf16(s0[2], s0[3]), pk_bf16(s1[0], s1[1]), pk_bf16(s1[2], s1[3])});
            acc = __builtin_amdgcn_mfma_f32_16x16x32_bf16(aq, bs, acc, 0, 0, 0);
            S[0][c] = __builtin_amdgcn_mfma_f32_16x16x32_bf16(ak[0], bv[c], S[0][c], 0, 0, 0) * eb0;
            S[1][c] = __builtin_amdgcn_mfma_f32_16x16x32_bf16(ak[1], bv[c], S[1][c], 0, 0, 0) * eb1;
#pragma unroll
            for (int i = 0; i < 4; ++i) { const int r = 4 * kq + i; Og[((size_t)c * TT + (size_t)(tcur + (dir ? 15 - r : r))) * 16 + fr] = (bf16_t)(pk_bf16(acc[i], 0.f) & 0xffffu); } }
        WAVE_LDS_SYNC();
    }
#undef GC_LOAD
}
__device__ __forceinline__ float oct_sum(float v) {
    v += __builtin_bit_cast(float, __builtin_amdgcn_update_dpp(0, __builtin_bit_cast(int, v), 0xB1, 0xF, 0xF, true));
    v += __builtin_bit_cast(float, __builtin_amdgcn_update_dpp(0, __builtin_bit_cast(int, v), 0x4E, 0xF, 0xF, true));
    v += __builtin_bit_cast(float, __builtin_amdgcn_update_dpp(0, __builtin_bit_cast(int, v), 0x141, 0xF, 0xF, true));
    return v;
}
__device__ __forceinline__ void scan_dn(KP p, LAS float* L, int idx, int wv, int noload) {
    const int lane = tid_launder(wv) & 63, vl = lane >> 3, dg = lane & 7;
    const int cq = idx & 7, dir = (idx >> 3) & 1, h = (idx >> 4) & 3, b = idx >> 6;
    const bf16_t* Qg = (const bf16_t*)(p->ws + WS_ABUF) + (size_t)b * TT * 256 + h * 64; const bf16_t* Kg = Qg + PANEL_EL; const bf16_t* Vg = Qg + 2 * PANEL_EL + cq * 8;
    const float* ABg = (const float*)(p->ws + WS_DNAB) + (size_t)b * TT * 16 + dir * 4 + h;
    bf16_t* Og = obuf(p->ws, 4 + dir) + (size_t)((b * 4 + h) * 8 + cq) * TT * 8;
    LAS float* LQ = L; LAS float* LK = L + 1024; LAS float* LV = L + 2048; LAS float* LAB = L + 2176; LAS float* LOP = L + 2208;
    f32x2 S[4];
#pragma unroll
    for (int i = 0; i < 4; ++i) S[i] = (f32x2){0.f, 0.f};
    const int lrow = lane >> 2, lseg = lane & 3;
    struct DnSet { u32x4 q0, q1, k0, k1, v; float a, b; };
    DnSet R0, R1;
#define DN_LOAD(R, BLK) do { if ((BLK) < 144 && !(noload && (BLK) >= 2)) { const int T0_ = blk_tok0(dir, (BLK)); const size_t ro = (size_t)(T0_ + lrow) * 256 + lseg * 16; R.q0 = *(const u32x4*)(Qg + ro); R.q1 = *(const u32x4*)(Qg + ro + 8); R.k0 = *(const u32x4*)(Kg + ro); R.k1 = *(const u32x4*)(Kg + ro + 8); \
        R.v = *(const u32x4*)(Vg + (size_t)(T0_ + (lane & 15)) * 256); R.a = ABg[(size_t)(T0_ + (lane & 15)) * 16]; R.b = ABg[(size_t)(T0_ + (lane & 15)) * 16 + 8]; } } while (0)
#define DN_RD(LS) do { nk0 = *(const LAS f32x4*)(LK + (LS) * 64 + dg * 8); nk1 = *(const LAS f32x4*)(LK + (LS) * 64 + dg * 8 + 4); nq0 = *(const LAS f32x4*)(LQ + (LS) * 64 + dg * 8); nq1 = *(const LAS f32x4*)(LQ + (LS) * 64 + dg * 8 + 4); \
            nv = LV[(LS) * 8 + vl]; na = LAB[(LS) * 2]; nb = LAB[(LS) * 2 + 1]; } while (0)
#define DN_BLOCK(R, BLK) do { \
        cvt8(R.q0, LQ + lrow * 64 + lseg * 16); cvt8(R.q1, LQ + lrow * 64 + lseg * 16 + 8); cvt8(R.k0, LK + lrow * 64 + lseg * 16); cvt8(R.k1, LK + lrow * 64 + lseg * 16 + 8); \
        if (lane < 16) { cvt8(R.v, LV + lane * 8); LAB[lane * 2] = R.a; LAB[lane * 2 + 1] = R.b; } \
        const int tcur = blk_tok0(dir, (BLK)); \
        DN_LOAD(R, (BLK) + 2); \
        WAVE_LDS_SYNC(); \
        f32x4 nk0, nk1, nq0, nq1; float nv, na, nb; \
        DN_RD(dir ? 15 : 0); \
        _Pragma("unroll") for (int s = 0; s < 16; ++s) { \
            const f32x2 ka = {nk0[0], nk0[1]}, kb = {nk0[2], nk0[3]}, kc = {nk1[0], nk1[1]}, kd = {nk1[2], nk1[3]}; \
            const f32x2 qa = {nq0[0], nq0[1]}, qb = {nq0[2], nq0[3]}, qc = {nq1[0], nq1[1]}, qd = {nq1[2], nq1[3]}; const float v = nv, a = na, bt = nb; \
            const int ls = dir ? 15 - s : s; \
            if (s < 15) { DN_RD(dir ? 14 - s : s + 1); } \
            const f32x2 r2 = (ka * S[0] + kb * S[1]) + (kc * S[2] + kd * S[3]);        \
            const float r = oct_sum(r2[0] + r2[1]); \
            const float c = bt * (v - a * r); \
            const f32x2 c2 = {c, c}, a2 = {a, a}; \
            S[0] = a2 * S[0] + ka * c2; S[1] = a2 * S[1] + kb * c2; S[2] = a2 * S[2] + kc * c2; S[3] = a2 * S[3] + kd * c2; \
            const f32x2 o2 = (qa * S[0] + qb * S[1]) + (qc * S[2] + qd * S[3]); \
            LOP[ls * 64 + lane] = o2[0] + o2[1]; \
            asm volatile("" ::: "memory"); } \
        WAVE_LDS_SYNC(); \
        { const int ts = lane >> 2, c0 = (lane & 3) * 2;                         \
            const f32x4 p0 = *(const LAS f32x4*)(LOP + ts * 64 + c0 * 8), p1 = *(const LAS f32x4*)(LOP + ts * 64 + c0 * 8 + 4), p2 = *(const LAS f32x4*)(LOP + ts * 64 + c0 * 8 + 8), p3 = *(const LAS f32x4*)(LOP + ts * 64 + c0 * 8 + 12); \
            const float oa = (p0[0] + p0[1]) + (p0[2] + p0[3]) + (p1[0] + p1[1]) + (p1[2] + p1[3]), ob = (p2[0] + p2[1]) + (p2[2] + p2[3]) + (p3[0] + p3[1]) + (p3[2] + p3[3]); \
            *(unsigned*)(Og + (size_t)(tcur + ts) * 8 + c0) = pk_bf16(oa, ob); } \
        WAVE_LDS_SYNC(); } while (0)
    DN_LOAD(R0, 0); DN_LOAD(R1, 1);
    for (int blk = 0; blk < 144; blk += 2) { DN_BLOCK(R0, blk); DN_BLOCK(R1, blk + 1); }
#undef DN_BLOCK
#undef DN_RD
#undef DN_LOAD
}
__device__ __forceinline__ bf16x8 packz(const f32x4 v) { return __builtin_bit_cast(bf16x8, (u32x4){pk_bf16(v[0], v[1]), pk_bf16(v[2], v[3]), 0u, 0u}); }
__device__ __forceinline__ bf16x8 ldaz(const LAS bf16_t* img, int fr, int kq) { const u32x2 lo = *(const LAS u32x2*)(img + fr * 32 + 4 * kq); return __builtin_bit_cast(bf16x8, (u32x4){lo[0], lo[1], 0u, 0u}); }
__device__ __forceinline__ void stz(LAS bf16_t* img, const f32x4 v, int fr, int kq) {
#pragma unroll
    for (int i = 0; i < 4; ++i) img[(4 * kq + i) * 32 + fr] = (bf16_t)(pk_bf16(v[i], 0.f) & 0xffffu);
}
__device__ __forceinline__ float row_scan16(float v) {
    v += __builtin_bit_cast(float, __builtin_amdgcn_update_dpp(0, __builtin_bit_cast(int, v), 0x111, 0xF, 0xF, true));
    v += __builtin_bit_cast(float, __builtin_amdgcn_update_dpp(0, __builtin_bit_cast(int, v), 0x112, 0xF, 0xF, true));
    v += __builtin_bit_cast(float, __builtin_amdgcn_update_dpp(0, __builtin_bit_cast(int, v), 0x114, 0xF, 0xF, true));
    v += __builtin_bit_cast(float, __builtin_amdgcn_update_dpp(0, __builtin_bit_cast(int, v), 0x118, 0xF, 0xF, true));
    return v;
}
constexpr int DN_SLOT = 13568, DN_NSLOT = 3;
__device__ __forceinline__ void lds_wait_ge(volatile LAS int* f, int need) { for (int it = 0; it < (1 << 22); ++it) { if (*f >= need) break; __builtin_amdgcn_s_sleep(1); } }
template <int DIR>
__device__ __forceinline__ void scan_dn_producer(KP p, LAS unsigned char* ring, LAS unsigned char* scratch, volatile LAS int* flags, int idx, int wv) {
    const int lane = tid_launder(wv) & 63, fr = lane & 15, kq = lane >> 4;
    constexpr int dir = DIR; const int h = (idx >> 1) & 3, b = idx >> 3;
    const bf16_t* Qg = (const bf16_t*)(p->ws + WS_ABUF) + (size_t)b * TT * 256 + h * 64; const bf16_t* Kg = Qg + PANEL_EL; const bf16_t* Vg = Qg + 2 * PANEL_EL;
    const float* ABg = (const float*)(p->ws + WS_DNAB) + (size_t)b * TT * 16 + dir * 4 + h;
    LAS bf16_t* L0 = (LAS bf16_t*)scratch; LAS bf16_t* L1 = L0 + 16 * 32; LAS bf16_t* L2 = L1 + 16 * 32;
    for (int i = lane; i < (3 * 16 * 32) / 2; i += 64) ((LAS unsigned*)L0)[i] = 0u;
    for (int sl = 0; sl < DN_NSLOT; ++sl) { LAS unsigned* z = (LAS unsigned*)(ring + sl * DN_SLOT + 3 * 16 * 72 * 2); for (int i = lane; i < (64 * 32 + 2 * 16 * 32) / 2; i += 64) z[i] = 0u; }
    u32x4 rq[2], rk[2], rv[2]; float rla, rbe;
    int tb = blk_tok0(dir, 0);
#define DC_LOAD(T0) do { _Pragma("unroll") for (int i = 0; i < 2; ++i) { const int q = lane + 64 * i, r = q >> 3, c8 = (q & 7) * 8; const size_t ro = (size_t)((T0) + (dir ? 15 - r : r)) * 256 + c8; \
            rq[i] = *(const u32x4*)(Qg + ro); rk[i] = *(const u32x4*)(Kg + ro); rv[i] = *(const u32x4*)(Vg + ro); } \
        { const size_t ao = (size_t)((T0) + (dir ? 15 - fr : fr)) * 16; rla = ABg[ao]; rbe = ABg[ao + 8]; } } while (0)
    DC_LOAD(tb);
    for (int blk = 0; blk < 144; ++blk) {
        LAS unsigned char* sl = ring + (blk % DN_NSLOT) * DN_SLOT;
        LAS bf16_t* QL = (LAS bf16_t*)sl; LAS bf16_t* KL = QL + 16 * 72; LAS bf16_t* VL = KL + 16 * 72; LAS bf16_t* KT = VL + 16 * 72; LAS bf16_t* TL = KT + 64 * 32; LAS bf16_t* PL = TL + 16 * 32; LAS float* GS = (LAS float*)(PL + 16 * 32);
        if (blk >= DN_NSLOT) lds_wait_ge(flags + 1, blk - DN_NSLOT + 1);
        const float gsc = row_scan16(rla), bec = rbe;
        const float g15 = __builtin_bit_cast(float, __builtin_amdgcn_readlane(__builtin_bit_cast(int, gsc), 15));
        if (lane < 16) { GS[lane] = gsc; GS[16 + lane] = bec; GS[32 + lane] = g15; }
#pragma unroll
        for (int i = 0; i < 2; ++i) { const int q = lane + 64 * i, r = q >> 3, c8 = (q & 7) * 8;
            *(LAS u32x4*)(QL + r * 72 + c8) = rq[i]; *(LAS u32x4*)(KL + r * 72 + c8) = rk[i]; *(LAS u32x4*)(VL + r * 72 + c8) = rv[i]; }
        WAVE_LDS_SYNC();
        const f32x4 gr = *(const LAS f32x4*)(GS + 4 * kq), br = *(const LAS f32x4*)(GS + 16 + 4 * kq);
#pragma unroll
        for (int i = 0; i < 2; ++i) { const int q = lane + 64 * i, r = q >> 3, c8 = (q & 7) * 8; const float ks = __expf(g15 - GS[r]);
#pragma unroll
            for (int e = 0; e < 4; ++e) { const unsigned kv = pk_bf16(bflo(rk[i][e]) * ks, bfhi(rk[i][e]) * ks); KT[(c8 + 2 * e) * 32 + r] = (bf16_t)(kv & 0xffffu); KT[(c8 + 2 * e + 1) * 32 + r] = (bf16_t)(kv >> 16); } }
        if (blk + 1 < 144) { tb = blk_tok0(dir, blk + 1); DC_LOAD(tb); }
        f32x4 KK = (f32x4){0.f, 0.f, 0.f, 0.f}, QK = (f32x4){0.f, 0.f, 0.f, 0.f};
#pragma unroll
        for (int kk = 0; kk < 2; ++kk) { const bf16x8 ak = *(const LAS bf16x8*)(KL + fr * 72 + 32 * kk + 8 * kq), aq = *(const LAS bf16x8*)(QL + fr * 72 + 32 * kk + 8 * kq);
            KK = __builtin_amdgcn_mfma_f32_16x16x32_bf16(ak, ak, KK, 0, 0, 0); QK = __builtin_amdgcn_mfma_f32_16x16x32_bf16(aq, ak, QK, 0, 0, 0); }
        f32x4 Lm, Pm;
#pragma unroll
        for (int i = 0; i < 4; ++i) { const int r = 4 * kq + i; const float e = __expf(fminf(gr[i] - gsc, 0.f)); Lm[i] = fr < r ? br[i] * e * KK[i] : 0.f; Pm[i] = fr <= r ? e * QK[i] : 0.f; }
        stz(L0, Lm, fr, kq); stz(PL, Pm, fr, kq);
        WAVE_LDS_SYNC();
        const bf16x8 aL = ldaz(L0, fr, kq);
        const f32x4 Lsq = __builtin_amdgcn_mfma_f32_16x16x32_bf16(aL, packz(Lm), (f32x4){0.f, 0.f, 0.f, 0.f}, 0, 0, 0);
        stz(L1, Lsq, fr, kq);
        WAVE_LDS_SYNC();
        const bf16x8 aL2 = ldaz(L1, fr, kq);
        const f32x4 Lq = __builtin_amdgcn_mfma_f32_16x16x32_bf16(aL2, packz(Lsq), (f32x4){0.f, 0.f, 0.f, 0.f}, 0, 0, 0);
        stz(L2, Lq, fr, kq);
        WAVE_LDS_SYNC();
        const bf16x8 aL4 = ldaz(L2, fr, kq);
        f32x4 Y = __builtin_amdgcn_mfma_f32_16x16x32_bf16(aL4, packz(Lq), (f32x4){0.f, 0.f, 0.f, 0.f}, 0, 0, 0);
#pragma unroll
        for (int i = 0; i < 4; ++i) Y[i] += (fr == 4 * kq + i) ? 1.f : 0.f;
        Y = __builtin_amdgcn_mfma_f32_16x16x32_bf16(aL4, packz(Y), Y, 0, 0, 0);
        Y = __builtin_amdgcn_mfma_f32_16x16x32_bf16(aL2, packz(Y), Y, 0, 0, 0);
        { const f32x4 nY = -Y; Y = __builtin_amdgcn_mfma_f32_16x16x32_bf16(aL, packz(nY), Y, 0, 0, 0); }
        stz(TL, Y, fr, kq);
        WAVE_LDS_SYNC();
        if (lane == 0) flags[0] = blk + 1;
    }
#undef DC_LOAD
}
template <int DIR>
__device__ __forceinline__ void scan_dn_consumer(KP p, LAS unsigned char* ring, volatile LAS int* flags, int idx, int wv) {
    const int lane = tid_launder(wv) & 63, fr = lane & 15, kq = lane >> 4;
    constexpr int dir = DIR; const int h = (idx >> 1) & 3, b = idx >> 3;
    bf16_t* Og = obuf(p->ws, 4 + dir) + (size_t)((b * 4 + h) * 4) * TT * 16;
    f32x4 S[4][4];
#pragma unroll
    for (int a = 0; a < 4; ++a)
#pragma unroll
        for (int c = 0; c < 4; ++c) S[a][c] = (f32x4){0.f, 0.f, 0.f, 0.f};
    for (int blk = 0; blk < 144; ++blk) {
        LAS unsigned char* sl = ring + (blk % DN_NSLOT) * DN_SLOT;
        LAS bf16_t* QL = (LAS bf16_t*)sl; LAS bf16_t* KL = QL + 16 * 72; LAS bf16_t* VL = KL + 16 * 72; LAS bf16_t* KT = VL + 16 * 72; LAS bf16_t* TL = KT + 64 * 32; LAS bf16_t* PL = TL + 16 * 32; LAS float* GS = (LAS float*)(PL + 16 * 32);
        lds_wait_ge(flags, blk + 1);
        const f32x4 gr = *(const LAS f32x4*)(GS + 4 * kq), br = *(const LAS f32x4*)(GS + 16 + 4 * kq); const float g15 = GS[32];
        float vv[4][4];
#pragma unroll
        for (int c = 0; c < 4; ++c)
#pragma unroll
            for (int i = 0; i < 4; ++i) vv[c][i] = bf2f(VL[(4 * kq + i) * 72 + 16 * c + fr]);
        const bf16x8 aT = ldaz(TL, fr, kq), aP = ldaz(PL, fr, kq);
        bf16x8 akp[2], aqp[2], aKT[4];
#pragma unroll
        for (int kk = 0; kk < 2; ++kk) { const u32x2 klo = *(const LAS u32x2*)(KL + fr * 72 + 32 * kk + 4 * kq), khi = *(const LAS u32x2*)(KL + fr * 72 + 32 * kk + 16 + 4 * kq);
            const u32x2 qlo = *(const LAS u32x2*)(QL + fr * 72 + 32 * kk + 4 * kq), qhi = *(const LAS u32x2*)(QL + fr * 72 + 32 * kk + 16 + 4 * kq);
            akp[kk] = __builtin_bit_cast(bf16x8, (u32x4){klo[0], klo[1], khi[0], khi[1]}); aqp[kk] = __builtin_bit_cast(bf16x8, (u32x4){qlo[0], qlo[1], qhi[0], qhi[1]}); }
#pragma unroll
        for (int a = 0; a < 4; ++a) aKT[a] = ldaz(KT + (16 * a) * 32, fr, kq);
        WAVE_LDS_SYNC();
        if (lane == 0) flags[1] = blk + 1;
        f32x4 Gr;
#pragma unroll
        for (int i = 0; i < 4; ++i) Gr[i] = __expf(gr[i]);
        const float G15 = __expf(g15);
        const int tcur = blk_tok0(dir, blk);
#pragma unroll
        for (int c = 0; c < 4; ++c) {
            f32x4 KS = (f32x4){0.f, 0.f, 0.f, 0.f}, QS = (f32x4){0.f, 0.f, 0.f, 0.f};
#pragma unroll
            for (int kk = 0; kk < 2; ++kk) { const f32x4 s0 = S[2 * kk][c], s1 = S[2 * kk + 1][c];
                const bf16x8 bs = __builtin_bit_cast(bf16x8, (u32x4){pk_bf16(s0[0], s0[1]), pk_bf16(s0[2], s0[3]), pk_bf16(s1[0], s1[1]), pk_bf16(s1[2], s1[3])});
                KS = __builtin_amdgcn_mfma_f32_16x16x32_bf16(akp[kk], bs, KS, 0, 0, 0); QS = __builtin_amdgcn_mfma_f32_16x16x32_bf16(aqp[kk], bs, QS, 0, 0, 0); }
            f32x4 R;
#pragma unroll
            for (int i = 0; i < 4; ++i) R[i] = br[i] * (vv[c][i] - Gr[i] * KS[i]);
            const f32x4 U = __builtin_amdgcn_mfma_f32_16x16x32_bf16(aT, packz(R), (f32x4){0.f, 0.f, 0.f, 0.f}, 0, 0, 0);
            const bf16x8 bu = packz(U);
            const f32x4 O = __builtin_amdgcn_mfma_f32_16x16x32_bf16(aP, bu, Gr * QS, 0, 0, 0);
#pragma unroll
            for (int a = 0; a < 4; ++a) S[a][c] = __builtin_amdgcn_mfma_f32_16x16x32_bf16(aKT[a], bu, S[a][c] * G15, 0, 0, 0);
#pragma unroll
            for (int i = 0; i < 4; ++i) { const int r = 4 * kq + i; Og[((size_t)c * TT + (size_t)(tcur + (dir ? 15 - r : r))) * 16 + fr] = (bf16_t)(pk_bf16(O[i], 0.f) & 0xffffu); }
        }
    }
}
template <int DIR>
__device__ __forceinline__ void scan_s5(KP p, LAS unsigned char* Lb, int idx, int l, int wv) {
    const int lane = tid_launder(wv) & 63, fr = lane & 15, kq = lane >> 4;
    constexpr int dir = DIR; const int g = (idx >> 1) & 15, b = idx >> 5;
    const bf16_t* Ug = (const bf16_t*)(p->ws + WS_P) + 7 * PANEL_EL + (size_t)b * TT * 256 + g * 16;
    bf16_t* Og = obuf(p->ws, 6 + dir) + (size_t)(b * 16 + g) * TT * 16;
    LAS bf16_t* UL = (LAS bf16_t*)Lb; LAS float* BL = (LAS float*)(Lb + 1024); LAS unsigned* HB = (LAS unsigned*)(Lb + 1024 + 8192);
    for (int i = lane; i < 256; i += 64) ((LAS unsigned*)UL)[i] = 0u;
    const float dt = expf(p->in[I_S5DT][(l * 2 + dir) * 16 + g]);
    const float* LRE = p->in[I_S5LRE] + ((l * 2 + dir) * 16 + g) * 64; const float* LIM = p->in[I_S5LIM] + ((l * 2 + dir) * 16 + g) * 64;
    float lbr, lbi;
    { const float lre = LRE[lane], lim = LIM[lane]; float sn, cs; sincosf(lim * dt, &sn, &cs); const float mag = expf(lre * dt); lbr = mag * cs; lbi = mag * sn; }
    bf16x8 Bf[8];
#pragma unroll
    for (int pt = 0; pt < 4; ++pt) { const int ps = fr + 16 * pt;
        const float lre = LRE[ps], lim = LIM[ps]; float sn, cs; sincosf(lim * dt, &sn, &cs); const float mag = expf(lre * dt);
        const float nr = mag * cs - 1.f, ni = mag * sn, den = 1.f / (lre * lre + lim * lim);
        const float bsr = (nr * lre + ni * lim) * den, bsi = (ni * lre - nr * lim) * den;
        u32x4 wre = (u32x4){0u, 0u, 0u, 0u}, wim = (u32x4){0u, 0u, 0u, 0u};
        if (kq < 2) { const float* bre = p->in[I_S5BRE] + (size_t)((l * 16 + g) * 64 + ps) * 16 + 8 * kq; const float* bim = p->in[I_S5BIM] + (size_t)((l * 16 + g) * 64 + ps) * 16 + 8 * kq;
#pragma unroll
            for (int e = 0; e < 4; ++e) { const float r0 = bre[2 * e], r1 = bre[2 * e + 1], i0 = bim[2 * e], i1 = bim[2 * e + 1];
                wre[e] = pk_bf16(bsr * r0 - bsi * i0, bsr * r1 - bsi * i1); wim[e] = pk_bf16(bsr * i0 + bsi * r0, bsr * i1 + bsi * r1); } }
        Bf[pt] = __builtin_bit_cast(bf16x8, wre); Bf[4 + pt] = __builtin_bit_cast(bf16x8, wim); }
    bf16x8 Cf[4];
    { const float* cre = p->in[I_S5CRE] + (size_t)((l * 16 + g) * 16 + fr) * 64; const float* cim = p->in[I_S5CIM] + (size_t)((l * 16 + g) * 16 + fr) * 64;
#pragma unroll
        for (int kk = 0; kk < 4; ++kk) { const int p0 = 16 * kk + 4 * kq; const f32x4 r = *(const f32x4*)(cre + p0), im = *(const f32x4*)(cim + p0);
            const u32x4 w = (u32x4){pk_bf16(r[0], -im[0]), pk_bf16(r[1], -im[1]), pk_bf16(r[2], -im[2]), pk_bf16(r[3], -im[3])}; Cf[kk] = __builtin_bit_cast(bf16x8, w); } }
    float hre = 0.f, him = 0.f;
    u32x4 U0, U1, U2;
#define S5_LOAD(R, BLK) do { if ((BLK) < 144) R = *(const u32x4*)(Ug + (size_t)(blk_tok0(dir, (BLK)) + ((lane >> 1) & 15)) * 256 + (lane & 1) * 8); } while (0)
#define S5_BLOCK(R, BLK) do { \
        if (lane < 32) *(LAS u32x4*)(UL + (lane >> 1) * 32 + (lane & 1) * 8) = R; \
        const int tcur = blk_tok0(dir, (BLK)); \
        S5_LOAD(R, (BLK) + 3); \
        WAVE_LDS_SYNC(); \
        { const bf16x8 au = *(const LAS bf16x8*)(UL + fr * 32 + 8 * kq); \
            _Pragma("unroll") for (int nt = 0; nt < 8; ++nt) { const f32x4 d = __builtin_amdgcn_mfma_f32_16x16x32_bf16(au, Bf[nt], (f32x4){0.f, 0.f, 0.f, 0.f}, 0, 0, 0); \
                _Pragma("unroll") for (int i = 0; i < 4; ++i) BL[(4 * kq + i) * 128 + 16 * nt + fr] = d[i]; } } \
        WAVE_LDS_SYNC(); \
        float bur[16], bui[16]; \
        _Pragma("unroll") for (int s = 0; s < 16; ++s) { bur[s] = BL[s * 128 + lane]; bui[s] = BL[s * 128 + 64 + lane]; } \
        _Pragma("unroll") for (int s = 0; s < 16; ++s) { \
            const int ls = dir ? 15 - s : s; \
            const float bre = dir ? bur[15 - s] : bur[s], bim = dir ? bui[15 - s] : bui[s]; \
            const float nre = lbr * hre - lbi * him + bre, nim = lbr * him + lbi * hre + bim; \
            hre = nre; him = nim; \
            HB[ls * 68 + lane] = pk_bf16(nre, nim); } \
        WAVE_LDS_SYNC(); \
        f32x4 acc = (f32x4){0.f, 0.f, 0.f, 0.f}; \
        _Pragma("unroll") for (int kk = 0; kk < 4; ++kk) { const bf16x8 a = *(const LAS bf16x8*)(HB + fr * 68 + 16 * kk + 4 * kq); acc = __builtin_amdgcn_mfma_f32_16x16x32_bf16(a, Cf[kk], acc, 0, 0, 0); } \
        _Pragma("unroll") for (int i = 0; i < 4; ++i) Og[(size_t)(tcur + 4 * kq + i) * 16 + fr] = (bf16_t)(pk_bf16(acc[i], 0.f) & 0xffffu); \
        WAVE_LDS_SYNC(); } while (0)
    S5_LOAD(U0, 0); S5_LOAD(U1, 1); S5_LOAD(U2, 2);
    for (int blk = 0; blk < 144; blk += 3) { S5_BLOCK(U0, blk); S5_BLOCK(U1, blk + 1); S5_BLOCK(U2, blk + 2); }
#undef S5_BLOCK
#undef S5_LOAD
}
__device__ __forceinline__ void phase_scan(KP p, LAS unsigned char* lds, int l, int tm, int wv) {
    const int tid = tid_launder(wv), wave = __builtin_amdgcn_readfirstlane(tid >> 6);
    LAS unsigned char* Lb = lds + wave * LDS_WAVE;
    LAS unsigned char* ring = lds + 4 * LDS_WAVE; LAS unsigned char* scratch = ring + DN_NSLOT * DN_SLOT; volatile LAS int* flags = (volatile LAS int*)(scratch + 3072);
    static_assert(4 * LDS_WAVE + DN_NSLOT * DN_SLOT + 3072 + 64 <= LDS_BAR_OFF, "scan LDS map");
    for (int vb = bid_launder(); vb < NVB; vb += gridDim.x) {
        if (tid == 0) { flags[0] = 0; flags[1] = 0; }
        __syncthreads();
        if (vb < 128) {
            if (wave == 0) { if (tm & 2) { if ((vb) & 1) scan_s5<1>(p, Lb, vb, l, wv); else scan_s5<0>(p, Lb, vb, l, wv); } }
            else if (wave == 1) { if (tm & 4) { if ((vb) & 1) scan_ret_chunk<1>(p, Lb, vb, l, wv); else scan_ret_chunk<0>(p, Lb, vb, l, wv); } }
            else if (wave == 2) { if (tm & 1) { if ((vb) & 1) scan_dn_consumer<1>(p, ring, flags, vb, wv); else scan_dn_consumer<0>(p, ring, flags, vb, wv); } }
            else if (wave == 3) { if (tm & 1) { if ((vb) & 1) scan_dn_producer<1>(p, ring, scratch, flags, vb, wv); else scan_dn_producer<0>(p, ring, scratch, flags, vb, wv); } }
            else if (wave == 7) convert_moe_wave(p, Lb, l, vb, 640, wv);
        } else {
            if (wave < 3) { if (tm & 2) { if ((128 + (vb - 128) * 3 + wave) & 1) scan_s5<1>(p, Lb, 128 + (vb - 128) * 3 + wave, l, wv); else scan_s5<0>(p, Lb, 128 + (vb - 128) * 3 + wave, l, wv); } }
            else if (wave == 3) { if (tm & 8) { if ((vb - 128) & 1) scan_gla_chunk<1>(p, Lb, vb - 128, wv); else scan_gla_chunk<0>(p, Lb, vb - 128, wv); } }
            else convert_moe_wave(p, Lb, l, 128 + (vb - 128) * 4 + (wave - 4), 640, wv);
        }
        __syncthreads();
    }
}

__device__ __forceinline__ float gelu_tanh(float y) { const float x = 0.7978845608028654f * (y + 0.044715f * y * y * y); const float th = 1.f - 2.f / (__expf(2.f * x) + 1.f); return 0.5f * y * (1.f + th); }
__device__ __forceinline__ void phase_mixpost(KP p, LAS unsigned char* lds, int l, int wv, int mode) {
    const int tid = tid_launder(wv), lane = tid & 63, wave = tid >> 6;
    const bf16_t* P = (const bf16_t*)(p->ws + WS_P); bf16_t* MIX = (bf16_t*)(p->ws + WS_ABUF);
    LAS float* YF = (LAS float*)lds; LAS bf16_t* YB = (LAS bf16_t*)(lds + 16384);
    bf16x8 bfr[2][8];
    { const float* gw = p->in[I_GLUW] + (size_t)l * 256 * 256;
#pragma unroll
        for (int nt = 0; nt < 2; ++nt)
#pragma unroll
            for (int kk = 0; kk < 8; ++kk) { const int n = wave * 32 + nt * 16 + (lane & 15), k0 = 32 * kk + 8 * (lane >> 4); u32x4 w;
#pragma unroll
                for (int j = 0; j < 4; ++j) w[j] = pk_bf16(gw[(size_t)(k0 + 2 * j) * 256 + n], gw[(size_t)(k0 + 2 * j + 1) * 256 + n]);
                bfr[nt][kk] = __builtin_bit_cast(bf16x8, w); } }
    const float* s5d = p->in[I_S5D] + l * 256; const float* glub = p->in[I_GLUB] + l * 256;
    for (int vb = bid_launder(); vb < NVB; vb += gridDim.x) {
        const int l32 = lane & 31, tkb = tid >> 5, c8 = (tid & 31) * 8, tkh = wave * 2 + (lane >> 5);
        unsigned nrf[12], nrb[12], nrg[12]; u32x4 nyf, nyb, nuu;
#define MX_LOADS(TILE) do { const int m0_ = vb * 144 + (TILE) * 16, tb0_ = (vb & 15) * 144 + (TILE) * 16; \
            const size_t offt = (size_t)(m0_ + tkh) * 256 + 2 * l32;                                                \
            const size_t ooft = ((size_t)((vb >> 4) * 16 + (l32 >> 3)) * TT + (size_t)(tb0_ + tkh)) * 16 + ((2 * l32) & 15);     \
            _Pragma("unroll") for (int ps = 0; ps < 12; ++ps) { const int mixer = ps >> 2, head = ps & 3; \
                const int ob = mixer == 0 ? 0 : (mixer == 1 ? 2 : 4), gp = mixer == 0 ? 2 : (mixer == 1 ? 6 : 11); \
                nrf[ps] = *(const unsigned*)(obuf(p->ws, ob) + ooft + (size_t)head * 4 * TT * 16); nrb[ps] = *(const unsigned*)(obuf(p->ws, ob + 1) + ooft + (size_t)head * 4 * TT * 16); \
                nrg[ps] = *(const unsigned*)(P + (size_t)gp * PANEL_EL + offt + head * 64); } \
            { const size_t offb = (size_t)(m0_ + tkb) * 256 + c8; const size_t yoff = ((size_t)((vb >> 4) * 16 + (c8 >> 4)) * TT + (size_t)(tb0_ + tkb)) * 16 + (c8 & 15); \
                nyf = *(const u32x4*)(obuf(p->ws, 6) + yoff); nyb = *(const u32x4*)(obuf(p->ws, 7) + yoff); nuu = *(const u32x4*)(P + (size_t)7 * PANEL_EL + offb); } } while (0)
        MX_LOADS(0);
        for (int tile = 0; tile < 9; ++tile) {
            const int m0 = vb * 144 + tile * 16;
            unsigned rfv[12], rbv[12], rgv[12];
#pragma unroll
            for (int ps = 0; ps < 12; ++ps) { rfv[ps] = nrf[ps]; rbv[ps] = nrb[ps]; rgv[ps] = nrg[ps]; }
            const u32x4 yf = nyf, yb = nyb, uu = nuu;
            if (tile + 1 < 9) MX_LOADS(tile + 1);
            if (mode & 1)
#pragma unroll
            for (int ps = 0; ps < 12; ++ps) {
                const int tk = tkh, mixer = ps >> 2, head = ps & 3;
                float o0 = bflo(rfv[ps]) + bflo(rbv[ps]), o1 = bfhi(rfv[ps]) + bfhi(rbv[ps]);
                if (mixer == 1) { const float mean = half_sum32(o0 + o1) * (1.f / 64.f); o0 -= mean; o1 -= mean; }
                const float var = half_sum32(o0 * o0 + o1 * o1) * (1.f / 64.f);
                const float rn = rsqrtf(var + EPS);
                o0 = o0 * rn * siluf_(bflo(rgv[ps])); o1 = o1 * rn * siluf_(bfhi(rgv[ps]));
                *(unsigned*)(MIX + (size_t)(m0 + tk) * 1024 + (mixer == 2 ? 768 : mixer * 256) + head * 64 + 2 * l32) = pk_bf16(o0, o1);
            }
            if (mode & 2) { const int tk = tkb;
                const f32x4 d0 = *(const f32x4*)(s5d + c8), d1 = *(const f32x4*)(s5d + c8 + 4);
                float y[8];
#pragma unroll
                for (int q = 0; q < 4; ++q) { y[2 * q] = bflo(yf[q]) + bflo(yb[q]) + (q < 2 ? d0[2 * q] : d1[2 * q - 4]) * bflo(uu[q]); y[2 * q + 1] = bfhi(yf[q]) + bfhi(yb[q]) + (q < 2 ? d0[2 * q + 1] : d1[2 * q - 3]) * bfhi(uu[q]); }
#pragma unroll
                for (int q = 0; q < 8; ++q) y[q] = gelu_tanh(y[q]);
                *(LAS f32x4*)(YF + tk * 256 + c8) = (f32x4){y[0], y[1], y[2], y[3]}; *(LAS f32x4*)(YF + tk * 256 + c8 + 4) = (f32x4){y[4], y[5], y[6], y[7]};
                *(LAS u32x4*)(YB + tk * 264 + c8) = (u32x4){pk_bf16(y[0], y[1]), pk_bf16(y[2], y[3]), pk_bf16(y[4], y[5]), pk_bf16(y[6], y[7])}; }
            LDS_BARRIER();
            if (mode & 2)
#pragma unroll
            for (int nt = 0; nt < 2; ++nt) { f32x4 acc = (f32x4){0.f, 0.f, 0.f, 0.f};
#pragma unroll
                for (int kk = 0; kk < 8; ++kk) { const bf16x8 a = *(const LAS bf16x8*)(YB + (lane & 15) * 264 + 32 * kk + 8 * (lane >> 4)); acc = __builtin_amdgcn_mfma_f32_16x16x32_bf16(a, bfr[nt][kk], acc, 0, 0, 0); }
                const int n = wave * 32 + nt * 16 + (lane & 15); const float gb = glub[n];
#pragma unroll
                for (int i = 0; i < 4; ++i) { const int tk = 4 * (lane >> 4) + i; const float yv = YF[tk * 256 + n];
                    MIX[(size_t)(m0 + tk) * 1024 + 512 + n] = (bf16_t)(pk_bf16(yv * sigmoidf_(acc[i] + gb), 0.f) & 0xffffu); } }
            LDS_BARRIER();
        }
#undef MX_LOADS
    }
}

__device__ __forceinline__ void phase_final(KP p, int wv) {
    const int tid = tid_launder(wv), lane = tid & 63, gw = bid_launder() * 8 + (tid >> 6), nw = gridDim.x * 8;
    const float* g = p->in[I_FNG];
    const bool poison = xb_ld((unsigned*)(p->ws + WS_CTL) + XB_TMO) != 0u;
    f32x4 xn[4];
    if (gw < NB * SEQ) {
#pragma unroll
        for (int j = 0; j < 4; ++j) xn[j] = *(const f32x4*)(p->out + (size_t)gw * D + 4 * lane + 256 * j); }
    for (int r = gw; r < NB * SEQ; r += nw) {
        float* xr = p->out + (size_t)r * D;
        f32x4 xv[4]; float ss = 0.f;
#pragma unroll
        for (int j = 0; j < 4; ++j) { xv[j] = xn[j]; ss += xv[j][0] * xv[j][0] + xv[j][1] * xv[j][1] + xv[j][2] * xv[j][2] + xv[j][3] * xv[j][3]; }
        if (r + nw < NB * SEQ) {
#pragma unroll
            for (int j = 0; j < 4; ++j) xn[j] = *(const f32x4*)(p->out + (size_t)(r + nw) * D + 4 * lane + 256 * j); }
        ss = wave_sum(ss);
        const float rstd = rsqrtf(ss * (1.f / 1024.f) + EPS);
#pragma unroll
        for (int j = 0; j < 4; ++j) { const f32x4 gv = *(const f32x4*)(g + 4 * lane + 256 * j); *(f32x4*)(xr + 4 * lane + 256 * j) = poison ? (f32x4){NAN, NAN, NAN, NAN} : xv[j] * rstd * gv; }
    }
}

__global__ void __launch_bounds__(512, 2) fwd_kernel(Params parg) {
    KP p = (KP)__builtin_amdgcn_kernarg_segment_ptr();
    extern __shared__ __attribute__((aligned(16))) unsigned char lds_raw[];
    LAS unsigned char* lds = (LAS unsigned char*)lds_raw;
    const int wv = __builtin_amdgcn_readfirstlane((int)threadIdx.x >> 6);
    if (tid_launder(wv) == 0) *(LAS u32x4*)(lds + LDS_BAR_OFF) = (u32x4){0u, 0u, 0u, 0u};
    __syncthreads();
    const unsigned bar_x = xcd_barrier_post((unsigned*)(p->ws + WS_CTL), (volatile LAS unsigned*)(lds + LDS_BAR_OFF), tid_launder(wv)).x;
#define NEXT_PHASE() do { p = kp_launder(p); XcdBarrier bb_; { unsigned* bp_ = (unsigned*)(p->ws + WS_CTL); asm volatile("" : "+s"(bp_)); unsigned bx_ = bar_x; asm volatile("" : "+s"(bx_)); \
        unsigned lo_ = LDS_BAR_OFF; asm volatile("" : "+s"(lo_)); bb_.bar = bp_; bb_.x = bx_; bb_.st = (volatile LAS unsigned*)(lds + lo_); } xcd_barrier(bb_, tid_launder(wv)); p = kp_launder(p); } while (0)
#define REP(bit) for (int rep_ = ((REPEAT_MASK) & (bit)) ? 1 : 0; rep_ >= 0; --rep_)
    REP(1) { phase_prologue(p, lds, wv); NEXT_PHASE(); }
    for (int xb_ = 0; xb_ < EXTRA_BARRIERS; ++xb_) NEXT_PHASE();
    for (int l = 0; l < 2; ++l) {
        const int last = l == 1;
        REP(2) { phase_prep<false>(p, lds, l, l == 0 ? p->in[I_X] : p->out, l == 0 ? p->in[I_CTX] : (const float*)(p->ws + WS_Z), 0, wv);
            NEXT_PHASE(); }
        REP(4) { Dsc1 S{(const bf16_t*)(p->ws + WS_ABUF), (const bf16_t*)(p->ws + WS_WIN) + (size_t)l * NWIN * 1024, (bf16_t*)(p->ws + WS_P), (int)gridDim.x, bid_launder()}; pg8::gemm_phase(lds, S, wv); NEXT_PHASE(); }
        REP(8) { phase_mixprep(p, l, rep_, wv); NEXT_PHASE(); }
        REP(16) { phase_scan(p, lds, l, rep_ ? SCAN_PROBE : 15, wv); NEXT_PHASE(); }
        REP(32) { phase_mixpost(p, lds, l, wv, rep_ ? MIXPOST_PROBE : 3); NEXT_PHASE(); }
        REP(64) { Dsc2 S{(const bf16_t*)(p->ws + WS_ABUF), (const bf16_t*)(p->ws + WS_WOUT) + (size_t)l * 1024 * 1024, l == 0 ? p->in[I_X] : p->out, l == 0 ? p->in[I_CTX] : (const float*)(p->ws + WS_Z),
                          p->out, (float*)(p->ws + WS_Z), (const float*)(p->ws + WS_MOD) + (size_t)l * 17 * 6144, (int)gridDim.x, bid_launder(), last, rep_}; pg8::gemm_phase(lds, S, wv); NEXT_PHASE(); }
        REP(128) { phase_prep<true>(p, lds, l, p->out, (const float*)(p->ws + WS_Z), last, wv); NEXT_PHASE(); }
        REP(256) { phase_moe_offsets(p, lds, last, wv); NEXT_PHASE(); }
        REP(512) { const int ntl = __builtin_amdgcn_readfirstlane(((const int*)(p->ws + WS_TILE))[0]);
            Dsc3 S{(const bf16_t*)(p->ws + WS_ABUF), (const bf16_t*)(p->ws + WS_WGU), (bf16_t*)(p->ws + WS_P), (const int*)(p->ws + WS_LIST), (const float*)(p->ws + WS_SLOTW), (const int*)(p->ws + WS_TILE), (int)gridDim.x, bid_launder(), ntl}; pg8::gemm_phase(lds, S, wv); NEXT_PHASE(); }
        REP(1024) { const int ntl = __builtin_amdgcn_readfirstlane(((const int*)(p->ws + WS_TILE))[0]);
            Dsc4 S{(const bf16_t*)(p->ws + WS_P), (const bf16_t*)(p->ws + WS_WDN), p->out, (float*)(p->ws + WS_Z), (const float*)(p->ws + WS_MOD) + (size_t)l * 17 * 6144, (const int*)(p->ws + WS_LIST), (const int*)(p->ws + WS_TILE), (int)gridDim.x, bid_launder(), ntl, rep_}; pg8::gemm_phase(lds, S, wv); NEXT_PHASE(); }
    }
#undef REP
    if (PHASE_MASK & 2048) phase_final(p, wv);
#undef NEXT_PHASE
}

extern "C" void kernel_launch(void* const* d_in, const int* in_sizes, int n_in, void* d_out, int out_size, void* d_ws, size_t ws_size, hipStream_t stream) {
    static int grid = 0;
    if (grid == 0) {
        if (n_in != 31 || out_size != NB * SEQ * D || ws_size < WS_END) { fprintf(stderr, "kernel_launch: unexpected problem shape (n_in %d, out %d, ws %zu)\n", n_in, out_size, ws_size); grid = -1; return; }
        int dev = 0, cus = 0, per_cu = 0;
        if (hipGetDevice(&dev) != hipSuccess || hipDeviceGetAttribute(&cus, hipDeviceAttributeMultiprocessorCount, dev) != hipSuccess) { grid = -1; return; }
        if (hipFuncSetAttribute((const void*)fwd_kernel, hipFuncAttributeMaxDynamicSharedMemorySize, LDS_BYTES) != hipSuccess) { fprintf(stderr, "kernel_launch: hipFuncSetAttribute failed\n"); grid = -1; return; }
        if (hipOccupancyMaxActiveBlocksPerMultiprocessor(&per_cu, (const void*)fwd_kernel, 512, LDS_BYTES) != hipSuccess || per_cu < 1) fprintf(stderr, "kernel_launch: occupancy query reports %d\n", per_cu);
        (void)hipGetLastError();
        grid = cus > 256 ? 256 : cus;
    }
    if (grid < 0) return;
    (void)hipMemsetAsync((char*)d_ws + WS_CTL, 0, 65536, stream);
    Params p{};
    for (int i = 0; i < 31; ++i) p.in[i] = (const float*)d_in[i];
    p.out = (float*)d_out; p.ws = (unsigned char*)d_ws;
    hipLaunchKernelGGL(fwd_kernel, dim3(grid), dim3(512), LDS_BYTES, stream, p);
}
```

```cpp
#include <hip/hip_runtime.h>
#include <cstdio>
#include <cstdint>

#define LAS __attribute__((address_space(3)))
typedef unsigned short bf16_t;
typedef short bf16x8 __attribute__((ext_vector_type(8)));
typedef float f32x4 __attribute__((ext_vector_type(4)));
typedef float f32x2 __attribute__((ext_vector_type(2)));
typedef unsigned u32x4 __attribute__((ext_vector_type(4)));
typedef unsigned u32x2 __attribute__((ext_vector_type(2)));

constexpr int D = 1024, NB = 16, SEQ = 2048, LC = 256, TT = 2304, NTOK = NB * TT;
constexpr int DIN = 3120, NWIN = 3328, NPANEL = 13, NVB = 256;
constexpr float EPS = 1e-6f;
constexpr size_t PANEL_EL = (size_t)NTOK * 256;
constexpr int MAXTILES = 168, MAXSLOT = MAXTILES * 256;

constexpr size_t WS_CTL = 0;
constexpr size_t WS_MOD = 65536;
constexpr size_t WS_Z = WS_MOD + 1048576;
constexpr size_t WS_WIN = WS_Z + (size_t)NB * LC * D * 4;
constexpr size_t WS_WOUT = WS_WIN + (size_t)2 * NWIN * D * 2;
constexpr size_t WS_WGU = WS_WOUT + (size_t)2 * D * D * 2;
constexpr size_t WS_WDN = WS_WGU + (size_t)16 * 1024 * 1024 * 2;
constexpr size_t WS_P = WS_WDN + (size_t)16 * 1024 * 512 * 2;
constexpr size_t WS_ABUF = WS_P + NPANEL * PANEL_EL * 2;
constexpr size_t WS_GDEC = WS_ABUF + (size_t)NTOK * D * 2;
constexpr size_t WS_DNAB = WS_GDEC + (size_t)NTOK * 256 * 4;
constexpr size_t WS_O = WS_DNAB + (size_t)NTOK * 16 * 4;
constexpr size_t WS_ROUTE = WS_O + 4 * PANEL_EL * 2;
constexpr size_t WS_HIST = WS_ROUTE + (size_t)NTOK * 16;
constexpr size_t WS_LIST = WS_HIST + 256 * 32 * 4;
constexpr size_t WS_SLOTW = WS_LIST + 196608;
constexpr size_t WS_TILE = WS_SLOTW + 393216;
constexpr size_t WS_SMALL = WS_TILE + 4096;
constexpr size_t WS_RB8 = WS_SMALL + (size_t)NTOK * 64 * 2;
constexpr size_t WS_END = WS_RB8 + 65536;
static_assert(WS_END <= (size_t)512 * 1024 * 1024, "workspace");
static_assert((size_t)MAXSLOT * 4 <= 196608 && (size_t)MAXSLOT * 8 <= 393216 && (size_t)MAXSLOT * D * 2 <= NPANEL * PANEL_EL * 2, "moe buffers");

constexpr int LDS_WAVE = 18432;
constexpr int LDS_BAR_OFF = 8 * LDS_WAVE;
constexpr int LDS_BYTES = LDS_BAR_OFF + 256;

#ifndef SCAN_PROBE
#define SCAN_PROBE 15
#endif
#ifndef EXTRA_BARRIERS
#define EXTRA_BARRIERS 0
#endif
#ifndef MIXPOST_PROBE
#define MIXPOST_PROBE 3
#endif
#ifndef REPEAT_MASK
#define REPEAT_MASK 0
#endif
#ifndef PHASE_MASK
#define PHASE_MASK 0xFFFF
#endif
struct Params { const float* in[31]; float* out; unsigned char* ws; };
typedef const Params __attribute__((address_space(4)))* KP;
__device__ __forceinline__ KP kp_launder(KP p) { asm volatile("" : "+s"(p)); return p; }
__device__ __forceinline__ int bid_launder() { int b = blockIdx.x; asm volatile("" : "+s"(b)); return b; }
__device__ __forceinline__ int tid_launder(int wv) { unsigned m = ~0u; asm volatile("" : "+s"(wv), "+s"(m)); int t = wv * 64 + (int)__builtin_amdgcn_mbcnt_hi(m, __builtin_amdgcn_mbcnt_lo(m, 0u)); asm volatile("" : "+v"(t)); return t; }
enum { I_X = 0, I_C, I_CTX, I_CCTX, I_WADA, I_BADA, I_NORMG, I_WIN, I_WOUT, I_GKW, I_GKB, I_RETD, I_S5LRE, I_S5LIM, I_S5DT, I_S5BRE, I_S5BIM, I_S5CRE, I_S5CIM,
       I_S5D, I_GLUW, I_GLUB, I_CONVW, I_ALOG, I_DTB, I_RW, I_RB, I_WG, I_WU, I_WD, I_FNG };

__device__ __forceinline__ float bf2f(unsigned v) { return __uint_as_float(v << 16); }
__device__ __forceinline__ float bflo(unsigned v) { return __uint_as_float(v << 16); }
__device__ __forceinline__ float bfhi(unsigned v) { return __uint_as_float(v & 0xffff0000u); }
typedef __bf16 bf16v2 __attribute__((ext_vector_type(2)));
__device__ __forceinline__ unsigned pk_bf16(float lo, float hi) { const f32x2 v = {lo, hi}; return __builtin_bit_cast(unsigned, __builtin_convertvector(v, bf16v2)); }
__device__ __forceinline__ float sigmoidf_(float x) { return 1.f / (1.f + __expf(-x)); }
__device__ __forceinline__ float siluf_(float x) { return x / (1.f + __expf(-x)); }
__device__ __forceinline__ float softplusf_(float x) { return fmaxf(x, 0.f) + log1pf(__expf(-fabsf(x))); }
__device__ __forceinline__ float wave_sum(float v) {
#pragma unroll
    for (int o = 32; o >= 1; o >>= 1) v += __shfl_xor(v, o, 64);
    return v;
}
__device__ __forceinline__ float half_sum32(float v) {
#pragma unroll
    for (int o = 16; o >= 1; o >>= 1) v += __shfl_xor(v, o, 64);
    return v;
}
__device__ __forceinline__ float quad_sum(float v) {
    v += __builtin_bit_cast(float, __builtin_amdgcn_update_dpp(0, __builtin_bit_cast(int, v), 0xB1, 0xF, 0xF, true));
    v += __builtin_bit_cast(float, __builtin_amdgcn_update_dpp(0, __builtin_bit_cast(int, v), 0x4E, 0xF, 0xF, true));
    return v;
}
#define WAVE_LDS_SYNC() asm volatile("s_waitcnt lgkmcnt(0)" ::: "memory")
#define LDS_BARRIER() asm volatile("s_waitcnt lgkmcnt(0)\n\ts_barrier" ::: "memory")
__device__ __forceinline__ const float* res_row_c(const float* lat, const float* ctx, int m) { const int b = m / TT, t = m - b * TT; return t < LC ? ctx + (size_t)(b * LC + t) * D : lat + (size_t)(b * SEQ + t - LC) * D; }
__device__ __forceinline__ float* res_row(float* lat, float* ctx, int m) { const int b = m / TT, t = m - b * TT; return t < LC ? ctx + (size_t)(b * LC + t) * D : lat + (size_t)(b * SEQ + t - LC) * D; }

#define XB_TMO      128
#define XB_XCNT(j)  (256  + 64 * (j))
#define XB_XSUB(j)  (1280 + 64 * (j))
#define XB_XGEN(j)  (2304 + 64 * (j))
#define XB_TOP      3328
#define XB_TOPGEN   3392
#define XCD_BAR_WORDS 3456
#define XB_SPIN_CAP (1u << 18)

__device__ __forceinline__ unsigned xb_ld(unsigned* p)              { return __hip_atomic_load(p, __ATOMIC_RELAXED, __HIP_MEMORY_SCOPE_AGENT); }
__device__ __forceinline__ unsigned xb_add(unsigned* p, unsigned v) { return __hip_atomic_fetch_add(p, v, __ATOMIC_RELAXED, __HIP_MEMORY_SCOPE_AGENT); }
__device__ __forceinline__ unsigned xb_xcc_id() { return (unsigned)__builtin_amdgcn_s_getreg((3 << 11) | 20) & 0xFu; }
#define XB_SPIN(cond, bar) do { unsigned _sp = 0; while (cond) { __builtin_amdgcn_s_sleep(1); \
    if ((++_sp & 255u) == 0u) { if (xb_ld(&(bar)[XB_TMO])) break; if (_sp > XB_SPIN_CAP) { atomicAdd(&(bar)[XB_TMO], 1u); break; } } } } while (0)

struct XcdBarrier { unsigned* bar; unsigned x; volatile LAS unsigned* st; };

__device__ __forceinline__ XcdBarrier xcd_barrier_post(unsigned* bar, volatile LAS unsigned* st, int tid) {
    XcdBarrier b; b.bar = bar; b.x = xb_xcc_id(); b.st = st;
    if (tid == 0) (void)xb_add(&bar[XB_XCNT(b.x)], 1u);
    return b;
}
__device__ __forceinline__ void xcd_barrier_complete(unsigned* bar, unsigned x, unsigned& nloc, unsigned& nx) {
    const unsigned G = gridDim.x * gridDim.y * gridDim.z;
    unsigned sum, cnt, mine, sp = 0u;
    for (;;) {
        sum = 0u; cnt = 0u; mine = 0u;
#pragma unroll
        for (unsigned j = 0; j < 16; ++j) { const unsigned c = xb_ld(&bar[XB_XCNT(j)]); sum += c; cnt += (c > 0u) ? 1u : 0u; mine = (j == x) ? c : mine; }
        if (sum == G) break;
        __builtin_amdgcn_s_sleep(1);
        if ((++sp & 255u) == 0u) { if (xb_ld(&bar[XB_TMO])) break; if (sp > XB_SPIN_CAP) { atomicAdd(&bar[XB_TMO], 1u); break; } }
    }
    nloc = mine > 0u ? mine : 1u; nx = cnt > 0u ? cnt : 1u;
}
__device__ __forceinline__ void xcd_barrier(const XcdBarrier& b, int tid) {
    asm volatile("s_waitcnt vmcnt(0)" ::: "memory");
    __syncthreads();
    if (tid == 0) {
        unsigned* bar = b.bar;
        __builtin_amdgcn_s_waitcnt(0);
        unsigned nloc = b.st[0], nx = b.st[1];
        if (nloc == 0u) { xcd_barrier_complete(bar, b.x, nloc, nx); b.st[0] = nloc; b.st[1] = nx; }
        const unsigned old = xb_add(&bar[XB_XSUB(b.x)], 1u);
        const unsigned gen = old / nloc;
        if (old + 1u == (gen + 1u) * nloc) {
            __builtin_amdgcn_fence(__ATOMIC_RELEASE, "agent");
            asm volatile("s_waitcnt vmcnt(0)" ::: "memory");
            const unsigned og = xb_add(&bar[XB_TOP], 1u);
            const unsigned tg = og / nx;
            if (og + 1u == (tg + 1u) * nx) xb_add(&bar[XB_TOPGEN], 1u);
            else XB_SPIN(xb_ld(&bar[XB_TOPGEN]) == tg, bar);
            __builtin_amdgcn_fence(__ATOMIC_ACQUIRE, "agent");
            xb_add(&bar[XB_XGEN(b.x)], 1u);
            asm volatile("s_waitcnt vmcnt(0)" ::: "memory");
        } else {
            XB_SPIN(xb_ld(&bar[XB_XGEN(b.x)]) == gen, bar);
            __builtin_amdgcn_fence(__ATOMIC_ACQUIRE, "agent");
            asm volatile("s_waitcnt vmcnt(0)" ::: "memory");
        }
    }
    __syncthreads();
}

namespace pg8 {
constexpr int BM = 256, BK = 64, HALF = 128, HTB = HALF * BK * 2, STAGE_BYTES = 8 * HTB, NXCD = 8, WGM = 8;
__device__ __forceinline__ int lds_byte(int r, int c) { const int st = (r >> 4) * 2 + (c >> 5), rr = r & 15, cc = c & 31, ob = rr * 64 + cc * 2; return st * 1024 + (ob ^ (((ob >> 9) & 1) << 5)); }
__device__ __forceinline__ void stage_rc(int b, int& R, int& C) { const int st = b / 1024, sb = b % 1024, swz = sb ^ (((sb >> 9) & 1) << 5); R = (st >> 1) * 16 + swz / 64; C = (st & 1) * 32 + (swz % 64) / 2; }
__device__ __forceinline__ int perm32(int rho) { const int n = rho >> 4, i = rho & 15; return 8 * (i >> 2) + 4 * n + (i & 3); }

__device__ __forceinline__ bool static_order(int i, int G, int c, int nM, int nN, int& pm, int& pn) {
    const int nwg = nM * nN; const long L = (long)i * G + c; if (L >= nwg) return false;
    int wgid = (int)L; { const int q = nwg / NXCD, r = nwg % NXCD, xcd = wgid % NXCD, off = wgid / NXCD; wgid = (xcd < r ? xcd * (q + 1) : r * (q + 1) + (xcd - r) * q) + off; }
    const int nig = WGM * nN, gid = wgid / nig, fm = gid * WGM, gsz = (nM - fm) < WGM ? (nM - fm) : WGM;
    pm = fm + ((wgid % nig) % gsz); pn = (wgid % nig) / gsz; return true;
}

template <class DSC>
__device__ __forceinline__ void gemm_phase(LAS unsigned char* lds, const DSC& S, int wv) {
    const int tid = tid_launder(wv), wid = __builtin_amdgcn_readfirstlane(tid >> 6), lane = tid & 63, wr = wid >> 2, wc = wid & 3, fr = lane & 15, fq = lane >> 4;
    constexpr int K = DSC::K, nt = K / BK, LDB = DSC::LDB;
    int sR[2], sC[2]; unsigned voffB[2];
#pragma unroll
    for (int i = 0; i < 2; ++i) { int R, C; stage_rc(tid * 16 + i * 8192, R, C); sR[i] = R; sC[i] = C; const int Rb = DSC::PERM ? ((R & ~31) + perm32(R & 31)) : R; voffB[i] = (unsigned)(Rb * LDB + C) * 2u; }
    constexpr size_t kstep = (size_t)(BK * 2);
    constexpr size_t hstepB = (size_t)HALF * LDB * 2;
    const unsigned ldsw = (unsigned)wid * 1024u;
    const int aoff = lds_byte(wr * 64 + fr, fq * 8), boff = lds_byte(wc * 32 + fr, fq * 8);
#define PG8_SA(b, h) (((b) * 2 + (h)) * HTB)
#define PG8_SB(b, h) ((4 + (b) * 2 + (h)) * HTB)
#define PG8_STAGE(bufoff, gbase, voff) do { _Pragma("unroll") for (int _i = 0; _i < 2; ++_i) \
        __builtin_amdgcn_global_load_lds((const unsigned*)((const char*)(gbase) + (voff)[_i]), (LAS unsigned*)(lds + (bufoff) + ldsw + _i * 8192), 16, 0, 0); } while (0)
#define PG8_LDA(dst, b, h) do { _Pragma("unroll") for (int m = 0; m < 4; ++m) _Pragma("unroll") for (int k = 0; k < 2; ++k) dst[m][k] = *(const LAS bf16x8*)(lds + PG8_SA(b, h) + aoff + m * 2048 + k * 1024); } while (0)
#define PG8_LDB(dst, b, h) do { _Pragma("unroll") for (int n = 0; n < 2; ++n) _Pragma("unroll") for (int k = 0; k < 2; ++k) dst[n][k] = *(const LAS bf16x8*)(lds + PG8_SB(b, h) + boff + n * 2048 + k * 1024); } while (0)
#define PG8_MMA(ai, bj, At, Bt) do { __builtin_amdgcn_s_setprio(1); _Pragma("unroll") for (int m = 0; m < 4; ++m) _Pragma("unroll") for (int n = 0; n < 2; ++n) _Pragma("unroll") for (int k = 0; k < 2; ++k) \
        acc[ai][bj][m][n] = __builtin_amdgcn_mfma_f32_16x16x32_bf16(Bt[n][k], At[m][k], acc[ai][bj][m][n], 0, 0, 0); __builtin_amdgcn_s_setprio(0); } while (0)
#define PG8_WAIT_V(n) asm volatile("s_waitcnt vmcnt(" #n ")" ::: "memory")
#define PG8_WAIT_L(n) asm volatile("s_waitcnt lgkmcnt(" #n ")" ::: "memory")
#define PG8_BAR __builtin_amdgcn_s_barrier()
#define PG8_SCHED __builtin_amdgcn_sched_barrier(0)
    typename DSC::Unit cur, nxt; int ui = 0;
    S.begin(lds, tid);
    if (!S.next(0, cur)) return;
    f32x4 acc[2][2][4][2];
#pragma unroll
    for (int a = 0; a < 2; ++a)
#pragma unroll
        for (int b = 0; b < 2; ++b)
#pragma unroll
            for (int m = 0; m < 4; ++m)
#pragma unroll
                for (int n = 0; n < 2; ++n) acc[a][b][m][n] = (f32x4){0.f, 0.f, 0.f, 0.f};
    bf16x8 At[4][2], B0[2][2], B1[2][2];
    constexpr size_t hstepA = (size_t)HALF * 1024 * 2;
    unsigned va[2][2], vn[2][2];
#define PG8_STAGE_A(bufoff, h, gb, V) do { if constexpr (DSC::GATHER) { PG8_STAGE(bufoff, gb, V[h]); } else { PG8_STAGE(bufoff, (gb) + (h) * hstepA, V[0]); } } while (0)
    const char* cA = S.a_base(cur); S.a_off(cur, sR, sC, va);
    const char* cBl = S.b_lo(cur); const char* cBh = S.b_hi(cur);
    PG8_STAGE(PG8_SB(0, 0), cBl, voffB); PG8_STAGE_A(PG8_SA(0, 0), 0, cA, va); PG8_STAGE(PG8_SB(0, 1), cBl + hstepB, voffB); PG8_STAGE_A(PG8_SA(0, 1), 1, cA, va);
    if (wr == 1) PG8_BAR;
    PG8_WAIT_V(4); PG8_BAR;
    PG8_STAGE(PG8_SB(1, 0), cBl + kstep, voffB); PG8_STAGE_A(PG8_SA(1, 0), 0, cA + kstep, va); PG8_STAGE(PG8_SB(1, 1), cBl + hstepB + kstep, voffB);
    PG8_WAIT_V(6); PG8_BAR;
    for (;;) {
        const bool has_next = S.next(ui + 1, nxt);
        const char* nA; const char* nBl; const char* nBh;
        if (has_next) { nA = S.a_base(nxt); nBl = S.b_lo(nxt); nBh = S.b_hi(nxt); }
        else { nA = cA; nBl = cBl; nBh = cBh; }
        if constexpr (DSC::GATHER) {
#pragma unroll
            for (int h = 0; h < 2; ++h)
#pragma unroll
                for (int i = 0; i < 2; ++i) vn[h][i] = va[h][i]; }
        for (int t = 0; t < nt; t += 2) {
            const bool last = (t == nt - 2);
            if constexpr (DSC::GATHER) { if (t == nt - 4 && has_next) S.a_off(nxt, sR, sC, vn); }
            const char* a1 = cA + (size_t)(t + 1) * kstep;
            const char* a2 = last ? nA : cA + (size_t)(t + 2) * kstep;
            const char* b2 = last ? nBl : ((t + 2) < nt / 2 ? cBl : cBh) + (size_t)(t + 2) * kstep;
            const char* a3 = a2 + kstep; const char* b3 = b2 + kstep;
            unsigned vs[2][2];
#pragma unroll
            for (int h = 0; h < 2; ++h)
#pragma unroll
                for (int i = 0; i < 2; ++i) vs[h][i] = (DSC::GATHER && last) ? vn[h][i] : va[h][i];
            PG8_LDB(B0, 0, 0); PG8_SCHED; PG8_LDA(At, 0, 0); PG8_STAGE_A(PG8_SA(1, 1), 1, a1, va);
            PG8_WAIT_L(8); PG8_BAR; PG8_WAIT_L(0); PG8_MMA(0, 0, At, B0); PG8_BAR; PG8_SCHED;
            PG8_LDB(B1, 0, 1); PG8_STAGE(PG8_SB(0, 0), b2, voffB);
            PG8_BAR; PG8_WAIT_L(0); PG8_MMA(0, 1, At, B1); PG8_BAR;
            PG8_LDA(At, 0, 1); PG8_STAGE_A(PG8_SA(0, 0), 0, a2, vs);
            PG8_BAR; PG8_WAIT_L(0); PG8_MMA(1, 0, At, B0); PG8_BAR; PG8_SCHED;
            PG8_STAGE(PG8_SB(0, 1), b2 + hstepB, voffB);
            PG8_WAIT_V(6); PG8_BAR; PG8_MMA(1, 1, At, B1); PG8_BAR;
            PG8_LDB(B0, 1, 0); PG8_SCHED; PG8_LDA(At, 1, 0); PG8_STAGE_A(PG8_SA(0, 1), 1, a2, vs);
            PG8_WAIT_L(8); PG8_BAR; PG8_WAIT_L(0); PG8_MMA(0, 0, At, B0); PG8_BAR; PG8_SCHED;
            PG8_LDB(B1, 1, 1); PG8_STAGE(PG8_SB(1, 0), b3, voffB);
            PG8_BAR; PG8_WAIT_L(0); PG8_MMA(0, 1, At, B1); PG8_BAR;
            PG8_LDA(At, 1, 1); PG8_STAGE_A(PG8_SA(1, 0), 0, a3, vs);
            PG8_BAR; PG8_WAIT_L(0); PG8_MMA(1, 0, At, B0); PG8_BAR; PG8_SCHED;
            PG8_STAGE(PG8_SB(1, 1), b3 + hstepB, voffB);
            PG8_WAIT_V(6); PG8_BAR; PG8_MMA(1, 1, At, B1); PG8_BAR;
        }
        S.epi(acc, cur, wr, wc, fr, fq);
        if (!has_next) break;
#pragma unroll
        for (int a = 0; a < 2; ++a)
#pragma unroll
            for (int b = 0; b < 2; ++b)
#pragma unroll
                for (int m = 0; m < 4; ++m)
#pragma unroll
                    for (int n = 0; n < 2; ++n) acc[a][b][m][n] = (f32x4){0.f, 0.f, 0.f, 0.f};
        cur = nxt; cA = nA; cBl = nBl; cBh = nBh; ++ui;
        if constexpr (DSC::GATHER) {
#pragma unroll
            for (int h = 0; h < 2; ++h)
#pragma unroll
                for (int i = 0; i < 2; ++i) va[h][i] = vn[h][i]; }
    }
    PG8_WAIT_V(0);
    if (wr == 0) PG8_BAR;
    PG8_BAR;
#undef PG8_SA
#undef PG8_SB
#undef PG8_STAGE
#undef PG8_STAGE_A
#undef PG8_LDA
#undef PG8_LDB
#undef PG8_MMA
#undef PG8_WAIT_V
#undef PG8_WAIT_L
#undef PG8_BAR
#undef PG8_SCHED
}
}

__device__ __forceinline__ void std_a_off(const int (&sR)[2], const int (&sC)[2], unsigned (&v)[2][2]) {
#pragma unroll
    for (int h = 0; h < 2; ++h)
#pragma unroll
        for (int i = 0; i < 2; ++i) v[h][i] = (unsigned)((sR[i] + 128 * h) * 1024 + sC[i]) * 2u;
}
struct Dsc1 {
    static constexpr int K = 1024, LDB = 1024; static constexpr bool PERM = true, GATHER = false;
    struct Unit { int pm, pn; };
    const bf16_t* A; const bf16_t* Bt; bf16_t* P; int G, c;
    __device__ __forceinline__ void begin(LAS unsigned char*, int) const {}
    __device__ __forceinline__ bool next(int i, Unit& u) const { return pg8::static_order(i, G, c, NTOK / 256, 12, u.pm, u.pn); }
    __device__ __forceinline__ const char* a_base(const Unit& u) const { return (const char*)A + (size_t)u.pm * 256 * 1024 * 2; }
    __device__ __forceinline__ void a_off(const Unit&, const int (&sR)[2], const int (&sC)[2], unsigned (&v)[2][2]) const { std_a_off(sR, sC, v); }
    __device__ __forceinline__ const char* b_lo(const Unit& u) const { return (const char*)Bt + (size_t)u.pn * 256 * 1024 * 2; }
    __device__ __forceinline__ const char* b_hi(const Unit& u) const { return b_lo(u); }
    __device__ __forceinline__ void epi(const f32x4 (&acc)[2][2][4][2], const Unit& u, int wr, int wc, int fr, int fq) const {
        bf16_t* base = P + (size_t)u.pn * PANEL_EL + (size_t)(u.pm * 256 + wr * 64 + fr) * 256 + wc * 32 + 8 * fq;
        const bool rope = (u.pn == 3 || u.pn == 4) && (u.pm % 9) != 0;
        float invf[2][4]; bool byrow[2][4];
#pragma unroll
        for (int bj = 0; bj < 2; ++bj)
#pragma unroll
            for (int j = 0; j < 4; ++j) { const int col = bj * 128 + wc * 32 + 8 * fq + 2 * j, i = (col & 63) >> 1; invf[bj][j] = exp2f(-(float)(i & 15) * (13.287712379549449f / 16.f)); byrow[bj][j] = i < 16; }
#pragma unroll
        for (int ai = 0; ai < 2; ++ai)
#pragma unroll
            for (int m = 0; m < 4; ++m) { bf16_t* rowp = base + (size_t)(ai * 128 + m * 16) * 256;
                const int pos = ((u.pm % 9) - 1) * 256 + wr * 64 + fr + ai * 128 + m * 16;
#pragma unroll
                for (int bj = 0; bj < 2; ++bj) { f32x4 v0 = acc[ai][bj][m][0], v1 = acc[ai][bj][m][1];
                    if (rope) { float x[8] = {v0[0], v0[1], v0[2], v0[3], v1[0], v1[1], v1[2], v1[3]};
#pragma unroll
                        for (int j = 0; j < 4; ++j) { const float ang = (float)(byrow[bj][j] ? (pos >> 6) : (pos & 63)) * invf[bj][j]; const float sn = __sinf(ang), cs = __cosf(ang);
                            const float t1 = x[2 * j], t2 = x[2 * j + 1]; x[2 * j] = t1 * cs - t2 * sn; x[2 * j + 1] = t1 * sn + t2 * cs; }
                        v0 = (f32x4){x[0], x[1], x[2], x[3]}; v1 = (f32x4){x[4], x[5], x[6], x[7]}; }
                    *(u32x4*)(rowp + bj * 128) = (u32x4){pk_bf16(v0[0], v0[1]), pk_bf16(v0[2], v0[3]), pk_bf16(v1[0], v1[1]), pk_bf16(v1[2], v1[3])}; } }
    }
};
struct Dsc2 {
    static constexpr int K = 1024, LDB = 1024; static constexpr bool PERM = false, GATHER = false;
    struct Unit { int pm, pn; };
    const bf16_t* A; const bf16_t* Bt; const float* lat_in; const float* ctx_in; float* lat_out; float* ctx_out; const float* mod; int G, c, last, dry;
    __device__ __forceinline__ void begin(LAS unsigned char*, int) const {}
    __device__ __forceinline__ bool next(int i, Unit& u) const {
        int pm, pn; if (!pg8::static_order(i, G, c, last ? 128 : 144, 4, pm, pn)) return false;
        u.pm = last ? (pm >> 3) * 9 + 1 + (pm & 7) : pm; u.pn = pn; return true; }
    __device__ __forceinline__ const char* a_base(const Unit& u) const { return (const char*)A + (size_t)u.pm * 256 * 1024 * 2; }
    __device__ __forceinline__ void a_off(const Unit&, const int (&sR)[2], const int (&sC)[2], unsigned (&v)[2][2]) const { std_a_off(sR, sC, v); }
    __device__ __forceinline__ const char* b_lo(const Unit& u) const { return (const char*)Bt + (size_t)u.pn * 256 * 1024 * 2; }
    __device__ __forceinline__ const char* b_hi(const Unit& u) const { return b_lo(u); }
    __device__ __forceinline__ void epi(const f32x4 (&acc)[2][2][4][2], const Unit& u, int wr, int wc, int fr, int fq) const {
        const int b = u.pm / 9, pp = u.pm - b * 9;
        const size_t ro = pp == 0 ? (size_t)b * LC * D : ((size_t)b * SEQ + (size_t)(pp - 1) * 256) * D;
        const float* inb = (pp == 0 ? ctx_in : lat_in) + ro; float* outb = (pp == 0 ? ctx_out : lat_out) + ro;
        const int col0 = u.pn * 256 + wc * 32 + 4 * fq, row0 = wr * 64 + fr;
        const float* gate = mod + (size_t)(pp == 0 ? 16 : b) * 6144 + 2 * 1024 + col0;
        f32x4 gv[2][2];
#pragma unroll
        for (int bj = 0; bj < 2; ++bj)
#pragma unroll
            for (int n = 0; n < 2; ++n) gv[bj][n] = *(const f32x4*)(gate + bj * 128 + n * 16);
#pragma unroll
        for (int ai = 0; ai < 2; ++ai)
#pragma unroll
            for (int m = 0; m < 4; ++m) { const size_t o = (size_t)(row0 + ai * 128 + m * 16) * D + col0;
#pragma unroll
                for (int bj = 0; bj < 2; ++bj)
#pragma unroll
                    for (int n = 0; n < 2; ++n) { const f32x4 x = *(const f32x4*)(inb + o + bj * 128 + n * 16);
                        if (!dry) *(f32x4*)(outb + o + bj * 128 + n * 16) = x + gv[bj][n] * acc[ai][bj][m][n]; else asm volatile("" :: "v"(x + gv[bj][n] * acc[ai][bj][m][n])); } }
    }
};
__device__ __forceinline__ void bucket_experts(int bk, int& elo, int& ehi) {
    const int gr = bk / 6, pr = bk - gr * 6;
    const int i = pr < 3 ? 0 : (pr < 5 ? 1 : 2), j = pr < 3 ? pr + 1 : (pr < 5 ? pr - 1 : 3);
    elo = gr * 4 + i; ehi = gr * 4 + j;
}
struct Dsc3 {
    static constexpr int K = 1024, LDB = 1024; static constexpr bool PERM = true, GATHER = true;
    struct Unit { int ti, pn, elo, ehi; };
    const bf16_t* A; const bf16_t* Wgu; bf16_t* ACT; const int* list; const float* slotw; const int* tile; int G, c, nt_; mutable LAS int* tbl;
    __device__ __forceinline__ void begin(LAS unsigned char* lds, int tid) const { LAS int* tb = (LAS int*)(lds + pg8::STAGE_BYTES); if (tid < MAXTILES) tb[tid] = tid < nt_ ? tile[8 + tid] : 0; __syncthreads(); tbl = tb; }
    __device__ __forceinline__ bool next(int i, Unit& u) const {
        if (!pg8::static_order(i, G, c, nt_, 8, u.ti, u.pn)) return false;
        const int bk = __builtin_amdgcn_readfirstlane(tbl[u.ti]); bucket_experts(bk, u.elo, u.ehi); return true; }
    __device__ __forceinline__ const char* a_base(const Unit&) const { return (const char*)A; }
    __device__ __forceinline__ void a_off(const Unit& u, const int (&sR)[2], const int (&sC)[2], unsigned (&v)[2][2]) const {
#pragma unroll
        for (int h = 0; h < 2; ++h)
#pragma unroll
            for (int i = 0; i < 2; ++i) { int tok = list[u.ti * 256 + sR[i] + 128 * h]; tok = tok < 0 ? 0 : tok; v[h][i] = (unsigned)(tok * 1024 + sC[i]) * 2u; }
    }
    __device__ __forceinline__ const char* b_lo(const Unit& u) const { const int e = u.pn < 4 ? u.elo : u.ehi; return (const char*)Wgu + ((size_t)e * 1024 + (size_t)(u.pn & 3) * 256) * 1024 * 2; }
    __device__ __forceinline__ const char* b_hi(const Unit& u) const { return b_lo(u); }
    __device__ __forceinline__ void epi(const f32x4 (&acc)[2][2][4][2], const Unit& u, int wr, int wc, int fr, int fq) const {
        const int slot0 = u.ti * 256 + wr * 64 + fr, wsel = u.pn < 4 ? 0 : 1;
        bf16_t* base = ACT + (size_t)slot0 * 1024 + (u.pn < 4 ? 0 : 512) + (u.pn & 3) * 128 + wc * 32 + 8 * fq;
#pragma unroll
        for (int ai = 0; ai < 2; ++ai)
#pragma unroll
            for (int m = 0; m < 4; ++m) { const int dr = ai * 128 + m * 16; const float w = slotw[(size_t)(slot0 + dr) * 2 + wsel];
                const f32x4 g0 = acc[ai][0][m][0], g1 = acc[ai][0][m][1], u0 = acc[ai][1][m][0], u1 = acc[ai][1][m][1];
                float r[8];
#pragma unroll
                for (int q = 0; q < 4; ++q) { r[q] = w * siluf_(g0[q]) * u0[q]; r[4 + q] = w * siluf_(g1[q]) * u1[q]; }
                *(u32x4*)(base + (size_t)dr * 1024) = (u32x4){pk_bf16(r[0], r[1]), pk_bf16(r[2], r[3]), pk_bf16(r[4], r[5]), pk_bf16(r[6], r[7])}; }
    }
};
struct Dsc4 {
    static constexpr int K = 1024, LDB = 512; static constexpr bool PERM = false, GATHER = false;
    struct Unit { int ti, pn, elo, ehi; };
    const bf16_t* A; const bf16_t* Wdn; float* lat; float* ctx; const float* mod; const int* list; const int* tile; int G, c, nt_, dry; mutable LAS int* tbl;
    __device__ __forceinline__ void begin(LAS unsigned char* lds, int tid) const { LAS int* tb = (LAS int*)(lds + pg8::STAGE_BYTES); if (tid < MAXTILES) tb[tid] = tid < nt_ ? tile[8 + tid] : 0; __syncthreads(); tbl = tb; }
    __device__ __forceinline__ bool next(int i, Unit& u) const {
        if (!pg8::static_order(i, G, c, nt_, 4, u.ti, u.pn)) return false;
        const int bk = __builtin_amdgcn_readfirstlane(tbl[u.ti]); bucket_experts(bk, u.elo, u.ehi); return true; }
    __device__ __forceinline__ const char* a_base(const Unit& u) const { return (const char*)A + (size_t)u.ti * 256 * 1024 * 2; }
    __device__ __forceinline__ void a_off(const Unit&, const int (&sR)[2], const int (&sC)[2], unsigned (&v)[2][2]) const { std_a_off(sR, sC, v); }
    __device__ __forceinline__ const char* b_lo(const Unit& u) const { return (const char*)Wdn + ((size_t)u.elo * 1024 + (size_t)u.pn * 256) * 512 * 2; }
    __device__ __forceinline__ const char* b_hi(const Unit& u) const { return (const char*)Wdn + ((size_t)u.ehi * 1024 + (size_t)u.pn * 256) * 512 * 2 - (size_t)(K / 128) * 128; }
    __device__ __forceinline__ void epi(const f32x4 (&acc)[2][2][4][2], const Unit& u, int wr, int wc, int fr, int fq) const {
        const int slot0 = u.ti * 256 + wr * 64 + fr, col0 = u.pn * 256 + wc * 32 + 4 * fq;
#pragma unroll
        for (int ai = 0; ai < 2; ++ai)
#pragma unroll
            for (int m = 0; m < 4; ++m) { const int tok = list[slot0 + ai * 128 + m * 16];
                if (tok >= 0) { const int b = tok / TT, t = tok - b * TT;
                    float* rp = (t < LC ? ctx + (size_t)(b * LC + t) * D : lat + (size_t)(b * SEQ + t - LC) * D) + col0;
                    const float* gate = mod + (size_t)(t < LC ? 16 : b) * 6144 + 5 * 1024 + col0;
#pragma unroll
                    for (int bj = 0; bj < 2; ++bj)
#pragma unroll
                        for (int n = 0; n < 2; ++n) { const f32x4 gv = *(const f32x4*)(gate + bj * 128 + n * 16); const f32x4 x = *(const f32x4*)(rp + bj * 128 + n * 16);
                            if (!dry) *(f32x4*)(rp + bj * 128 + n * 16) = x + gv * acc[ai][bj][m][n]; else asm volatile("" :: "v"(x + gv * acc[ai][bj][m][n])); } } }
    }
};

__device__ __forceinline__ void tr_tile(LAS float* tl, const float* src, int ld, int scol, float scale, bf16_t* dst, int lddst, int wv) {
    const int tid = tid_launder(wv), n = tid & 63, kq = tid >> 6;
#pragma unroll
    for (int i = 0; i < 8; ++i) { const int k = kq + 8 * i; tl[k * 65 + n] = scol >= 0 ? src[(size_t)k * ld + scol] * scale : 0.f; }
    __syncthreads();
    const int nn = tid >> 3, k8 = (tid & 7) * 8;
    u32x4 w;
#pragma unroll
    for (int j = 0; j < 4; ++j) w[j] = pk_bf16(tl[(k8 + 2 * j) * 65 + nn], tl[(k8 + 2 * j + 1) * 65 + nn]);
    *(u32x4*)(dst + (size_t)nn * lddst + k8) = w;
    __syncthreads();
}
__device__ __forceinline__ void convert_moe(KP p, LAS unsigned char* lds, int l, int wv) {
    LAS float* tl = (LAS float*)lds;
    bf16_t* WGU = (bf16_t*)(p->ws + WS_WGU); bf16_t* WDN = (bf16_t*)(p->ws + WS_WDN);
    const int n = tid_launder(wv) & 63;
    for (int idx = bid_launder(); idx < 4096 + 2048; idx += gridDim.x) {
        if (idx < 4096) { const int e = idx >> 8, rt = (idx >> 4) & 15, kt = idx & 15, q = rt >> 2, sub = rt & 3;
            const float* src = p->in[sub < 2 ? I_WG : I_WU] + ((size_t)(l * 16 + e) * 1024 + kt * 64) * 512;
            tr_tile(tl, src, 512, q * 128 + (sub & 1) * 64 + n, 1.f, WGU + ((size_t)e * 1024 + rt * 64) * 1024 + kt * 64, 1024, wv);
        } else { const int j = idx - 4096, e = j >> 7, ntile = (j >> 3) & 15, kt = j & 7;
            const float* src = p->in[I_WD] + ((size_t)(l * 16 + e) * 512 + kt * 64) * 1024;
            tr_tile(tl, src, 1024, ntile * 64 + n, 1.f, WDN + ((size_t)e * 1024 + ntile * 64) * 512 + kt * 64, 512, wv); }
    }
}
__device__ __forceinline__ void tr_tile_wave(LAS float* tl, const float* src, int ld, int scol4, float scale, bf16_t* dst, int lddst, int lane) {
    const int kq = lane >> 4, c4 = (lane & 15) * 4;
    f32x4 v[16];
#pragma unroll
    for (int i = 0; i < 16; ++i) v[i] = scol4 >= 0 ? *(const f32x4*)(src + (size_t)(kq + 4 * i) * ld + scol4) : (f32x4){0.f, 0.f, 0.f, 0.f};
#pragma unroll
    for (int i = 0; i < 16; ++i) { LAS float* t = tl + (kq + 4 * i) * 65 + c4; t[0] = v[i][0] * scale; t[1] = v[i][1] * scale; t[2] = v[i][2] * scale; t[3] = v[i][3] * scale; }
    WAVE_LDS_SYNC();
#pragma unroll 2
    for (int k8 = 0; k8 < 64; k8 += 8) { u32x4 w;
#pragma unroll
        for (int j = 0; j < 4; ++j) w[j] = pk_bf16(tl[(k8 + 2 * j) * 65 + lane], tl[(k8 + 2 * j + 1) * 65 + lane]);
        *(u32x4*)(dst + (size_t)lane * lddst + k8) = w; }
    WAVE_LDS_SYNC();
}
__device__ __forceinline__ void convert_moe_wave(KP p, LAS unsigned char* Lb, int l, int cvi, int ncv, int wv) {
    const int lane = tid_launder(wv) & 63;
    LAS float* tl = (LAS float*)Lb;
    bf16_t* WGU = (bf16_t*)(p->ws + WS_WGU); bf16_t* WDN = (bf16_t*)(p->ws + WS_WDN);
    for (int idx = cvi; idx < 4096 + 2048 + (l == 0 ? 832 + 256 : 0); idx += ncv) {
        if (idx >= 4096 + 2048) {
            bf16_t* WIN = (bf16_t*)(p->ws + WS_WIN); bf16_t* WOUT = (bf16_t*)(p->ws + WS_WOUT); const int r = idx - 6144;
            if (r < 832) { const int ntile = r >> 4, kt = r & 15, np = ntile * 64 + (lane & 15) * 4;
                int scol; if (np < 768) scol = np; else if (np < 3072) scol = np + 32; else { const int j = np - 3072; scol = j < 32 ? 768 + j : (j < 48 ? 3104 + (j - 32) : -1); }
                const float scale = np < 128 ? 0.17677669529663687f : ((np >= 768 && np < 1024) ? 0.125f : 1.f);
                tr_tile_wave(tl, p->in[I_WIN] + ((size_t)1024 + kt * 64) * DIN, DIN, scol, scale, WIN + ((size_t)NWIN + ntile * 64) * 1024 + kt * 64, 1024, lane);
            } else { const int j = r - 832, ntile = j >> 4, kt = j & 15;
                tr_tile_wave(tl, p->in[I_WOUT] + ((size_t)1024 + kt * 64) * 1024, 1024, ntile * 64 + (lane & 15) * 4, 1.f, WOUT + ((size_t)1024 + ntile * 64) * 1024 + kt * 64, 1024, lane); }
        } else if (idx < 4096) { const int e = idx >> 8, rt = (idx >> 4) & 15, kt = idx & 15, q = rt >> 2, sub = rt & 3;
            const float* src = p->in[sub < 2 ? I_WG : I_WU] + ((size_t)(l * 16 + e) * 1024 + kt * 64) * 512;
            tr_tile_wave(tl, src, 512, q * 128 + (sub & 1) * 64 + (lane & 15) * 4, 1.f, WGU + ((size_t)e * 1024 + rt * 64) * 1024 + kt * 64, 1024, lane);
        } else { const int j = idx - 4096, e = j >> 7, ntile = (j >> 3) & 15, kt = j & 7;
            const float* src = p->in[I_WD] + ((size_t)(l * 16 + e) * 512 + kt * 64) * 1024;
            tr_tile_wave(tl, src, 1024, ntile * 64 + (lane & 15) * 4, 1.f, WDN + ((size_t)e * 1024 + ntile * 64) * 512 + kt * 64, 512, lane); }
    }
}
__device__ __forceinline__ void phase_prologue(KP p, LAS unsigned char* lds, int wv) {
    const int tid = tid_launder(wv), lane = tid & 63, wave = tid >> 6;
    {
        LAS float* SC = (LAS float*)lds; LAS float* RED = (LAS float*)(lds + 17 * 1024 * 4);
        { float cv[34];
#pragma unroll
            for (int q = 0; q < 34; ++q) { const int i = tid + 512 * q, r = i >> 10, k = i & 1023; cv[q] = r < 16 ? p->in[I_C][r * 1024 + k] : p->in[I_CCTX][k]; }
#pragma unroll
            for (int q = 0; q < 34; ++q) SC[tid + 512 * q] = siluf_(cv[q]); }
        __syncthreads();
        float* MOD = (float*)(p->ws + WS_MOD);
        for (int unit = bid_launder(); unit < 192; unit += gridDim.x) {
            const int l = unit / 96, cg = unit - l * 96;
            const float* W = p->in[I_WADA] + (size_t)l * 1024 * 6144 + cg * 64 + lane;
            float acc[17];
#pragma unroll
            for (int r = 0; r < 17; ++r) acc[r] = 0.f;
            for (int k0 = wave * 128; k0 < wave * 128 + 128; k0 += 16) {
                float wk[16];
#pragma unroll
                for (int q = 0; q < 16; ++q) wk[q] = W[(size_t)(k0 + q) * 6144];
#pragma unroll
                for (int q4 = 0; q4 < 4; ++q4) {
#pragma unroll
                    for (int r = 0; r < 17; ++r) { const f32x4 s = *(const LAS f32x4*)(SC + r * 1024 + k0 + 4 * q4); acc[r] += s[0] * wk[4 * q4] + s[1] * wk[4 * q4 + 1] + s[2] * wk[4 * q4 + 2] + s[3] * wk[4 * q4 + 3]; }
                    asm volatile("" ::: "memory"); }
            }
#pragma unroll
            for (int r = 0; r < 17; ++r) RED[(wave * 17 + r) * 64 + lane] = acc[r];
            __syncthreads();
            for (int i = tid; i < 17 * 64; i += 512) { const int r = i >> 6, cc = i & 63; float s = 0.f;
#pragma unroll
                for (int w = 0; w < 8; ++w) s += RED[(w * 17 + r) * 64 + cc];
                MOD[(size_t)(l * 17 + r) * 6144 + cg * 64 + cc] = s + p->in[I_BADA][l * 6144 + cg * 64 + cc]; }
            __syncthreads();
        }
        __syncthreads();
    }
    {
        LAS float* tl = (LAS float*)lds;
        bf16_t* WIN = (bf16_t*)(p->ws + WS_WIN); bf16_t* WOUT = (bf16_t*)(p->ws + WS_WOUT);
        const int n = tid & 63;
        for (int idx0 = bid_launder(); idx0 < 832 + 256; idx0 += gridDim.x) {
            const int idx = idx0 < 832 ? idx0 : 1664 + (idx0 - 832);
            if (idx < 1664) { const int l = idx / 832, r = idx - l * 832, ntile = r >> 4, kt = r & 15, np = ntile * 64 + n;
                int scol; if (np < 768) scol = np; else if (np < 3072) scol = np + 32; else { const int j = np - 3072; scol = j < 32 ? 768 + j : (j < 48 ? 3104 + (j - 32) : -1); }
                const float scale = np < 128 ? 0.17677669529663687f : ((np >= 768 && np < 1024) ? 0.125f : 1.f);
                tr_tile(tl, p->in[I_WIN] + ((size_t)l * 1024 + kt * 64) * DIN, DIN, scol, scale, WIN + ((size_t)l * NWIN + ntile * 64) * 1024 + kt * 64, 1024, wv);
            } else { const int j = idx - 1664, l = j >> 8, ntile = (j >> 4) & 15, kt = j & 15;
                tr_tile(tl, p->in[I_WOUT] + ((size_t)l * 1024 + kt * 64) * 1024, 1024, ntile * 64 + n, 1.f, WOUT + ((size_t)l * 1024 + ntile * 64) * 1024 + kt * 64, 1024, wv); }
        }
    }
}

__device__ __forceinline__ void route16(const float (&lg)[16], const float* rb, int& bucket, float& wlo, float& whi) {
    float bestgs = -INFINITY, bs1 = 0.f, bs2 = 0.f; int bestg = 0, bi1 = 0, bi2 = 1;
#pragma unroll
    for (int g = 0; g < 4; ++g) {
        float sc[4], sl[4];
#pragma unroll
        for (int j = 0; j < 4; ++j) { sc[j] = sigmoidf_(lg[4 * g + j]); sl[j] = sc[j] + rb[4 * g + j]; }
        int i1 = 0; float v1 = sl[0], s1 = sc[0];
#pragma unroll
        for (int j = 1; j < 4; ++j) if (sl[j] > v1) { v1 = sl[j]; s1 = sc[j]; i1 = j; }
        int i2 = 0; float v2 = -INFINITY, s2 = 0.f;
#pragma unroll
        for (int j = 0; j < 4; ++j) if (j != i1 && sl[j] > v2) { v2 = sl[j]; s2 = sc[j]; i2 = j; }
        const float gs = v1 + v2;
        if (gs > bestgs) { bestgs = gs; bestg = g; bi1 = i1; bi2 = i2; bs1 = s1; bs2 = s2; }
    }
    const int lo = bi1 < bi2 ? bi1 : bi2, hi = bi1 < bi2 ? bi2 : bi1;
    const float slo = bi1 < bi2 ? bs1 : bs2, shi = bi1 < bi2 ? bs2 : bs1;
    const int pr = lo == 0 ? hi - 1 : (lo == 1 ? hi + 1 : 5);
    bucket = bestg * 6 + pr; const float inv = 1.f / (bs1 + bs2); wlo = slo * inv; whi = shi * inv;
}
template <bool ROUTER>
__device__ __forceinline__ void phase_prep(KP p, LAS unsigned char* lds, int l, const float* lat, const float* ctx, int latent_only, int wv) {
    const int tid = tid_launder(wv), lane = tid & 63, wave = tid >> 6, fr = lane & 15, kq = lane >> 4;
    const float* MOD = (const float*)(p->ws + WS_MOD) + (size_t)l * 17 * 6144;
    const float* g = p->in[I_NORMG] + (l * 2 + (ROUTER ? 1 : 0)) * 1024;
    bf16_t* H = (bf16_t*)(p->ws + WS_ABUF);
    constexpr int NT = ROUTER ? 1 : 3, AST = 1032;
    LAS bf16_t* AH = (LAS bf16_t*)lds; LAS bf16_t* AL = AH + 16 * AST; LAS float* PART = (LAS float*)(lds + 2 * 16 * AST * 2); LAS float* LG = PART + 8 * NT * 256; LAS int* hist = (LAS int*)(LG + 256);
    bf16x8 Bh[NT][4], Bl[4];
    if (ROUTER) {
#pragma unroll
        for (int kk = 0; kk < 4; ++kk) { const int k0 = 128 * wave + 32 * kk + 8 * kq; u32x4 wh, wl;
#pragma unroll
            for (int e = 0; e < 4; ++e) { const float w0 = p->in[I_RW][(size_t)(k0 + 2 * e) * 16 + fr], w1 = p->in[I_RW][(size_t)(k0 + 2 * e + 1) * 16 + fr];
                const unsigned hh = pk_bf16(w0, w1); wh[e] = hh; wl[e] = pk_bf16(w0 - bflo(hh), w1 - bfhi(hh)); }
            Bh[0][kk] = __builtin_bit_cast(bf16x8, wh); Bl[kk] = __builtin_bit_cast(bf16x8, wl); }
    } else {
        const bf16_t* WS_ = (const bf16_t*)(p->ws + WS_WIN) + ((size_t)l * NWIN + 3072) * 1024;
#pragma unroll
        for (int nt = 0; nt < NT; ++nt)
#pragma unroll
            for (int kk = 0; kk < 4; ++kk) { Bh[nt][kk] = *(const bf16x8*)(WS_ + (size_t)(16 * nt + fr) * 1024 + 128 * wave + 32 * kk + 8 * kq); }
#pragma unroll
        for (int kk = 0; kk < 4; ++kk) Bl[kk] = Bh[0][kk];
    }
    const int n_per = latent_only ? 128 : 144, ngrp = n_per / 16;
    for (int vb = bid_launder(); vb < NVB; vb += gridDim.x) {
        if (ROUTER) { if (tid < 32) hist[tid] = 0; }
        const int mbase = latent_only ? (vb >> 4) * TT + LC + (vb & 15) * 128 : vb * 144;
        f32x4 xn[2][4];
#pragma unroll
        for (int r = 0; r < 2; ++r) { const float* xr0 = res_row_c(lat, ctx, mbase + 2 * wave + r);
#pragma unroll
            for (int j = 0; j < 4; ++j) xn[r][j] = *(const f32x4*)(xr0 + 4 * lane + 256 * j); }
        for (int grp = 0; grp < ngrp; ++grp) {
            f32x4 xv[2][4];
#pragma unroll
            for (int r = 0; r < 2; ++r)
#pragma unroll
                for (int j = 0; j < 4; ++j) xv[r][j] = xn[r][j];
            if (grp + 1 < ngrp) {
#pragma unroll
                for (int r = 0; r < 2; ++r) { const float* xrn = res_row_c(lat, ctx, mbase + 16 * (grp + 1) + 2 * wave + r);
#pragma unroll
                    for (int j = 0; j < 4; ++j) xn[r][j] = *(const f32x4*)(xrn + 4 * lane + 256 * j); } }
#pragma unroll
            for (int r = 0; r < 2; ++r) {
                const int m = mbase + 16 * grp + 2 * wave + r, b = m / TT, t = m - b * TT, rb = t < LC ? 16 : b;
                float ss = 0.f;
#pragma unroll
                for (int j = 0; j < 4; ++j) ss += xv[r][j][0] * xv[r][j][0] + xv[r][j][1] * xv[r][j][1] + xv[r][j][2] * xv[r][j][2] + xv[r][j][3] * xv[r][j][3];
                ss = wave_sum(ss);
                const float rstd = rsqrtf(ss * (1.f / 1024.f) + EPS);
                const float* sh = MOD + (size_t)rb * 6144 + (ROUTER ? 3 : 0) * 1024; const float* sc = sh + 1024;
#pragma unroll
                for (int j = 0; j < 4; ++j) { const int idx = 4 * lane + 256 * j;
                    const f32x4 gv = *(const f32x4*)(g + idx), shv = *(const f32x4*)(sh + idx), scv = *(const f32x4*)(sc + idx);
                    const f32x4 hv = xv[r][j] * rstd * gv * (1.f + scv) + shv;
                    const unsigned h0 = pk_bf16(hv[0], hv[1]), h1 = pk_bf16(hv[2], hv[3]);
                    *(u32x2*)(H + (size_t)m * 1024 + idx) = (u32x2){h0, h1};
                    *(LAS u32x2*)(AH + (2 * wave + r) * AST + idx) = (u32x2){h0, h1};
                    if (ROUTER) *(LAS u32x2*)(AL + (2 * wave + r) * AST + idx) = (u32x2){pk_bf16(hv[0] - bflo(h0), hv[1] - bfhi(h0)), pk_bf16(hv[2] - bflo(h1), hv[3] - bfhi(h1))}; }
            }
            LDS_BARRIER();
            { f32x4 acc[NT];
#pragma unroll
                for (int nt = 0; nt < NT; ++nt) acc[nt] = (f32x4){0.f, 0.f, 0.f, 0.f};
#pragma unroll
                for (int kk = 0; kk < 4; ++kk) { const bf16x8 ah = *(const LAS bf16x8*)(AH + fr * AST + 128 * wave + 32 * kk + 8 * kq);
#pragma unroll
                    for (int nt = 0; nt < NT; ++nt) acc[nt] = __builtin_amdgcn_mfma_f32_16x16x32_bf16(ah, Bh[nt][kk], acc[nt], 0, 0, 0);
                    if (ROUTER) { const bf16x8 al = *(const LAS bf16x8*)(AL + fr * AST + 128 * wave + 32 * kk + 8 * kq);
                        acc[0] = __builtin_amdgcn_mfma_f32_16x16x32_bf16(ah, Bl[kk], acc[0], 0, 0, 0); acc[0] = __builtin_amdgcn_mfma_f32_16x16x32_bf16(al, Bh[0][kk], acc[0], 0, 0, 0); } }
#pragma unroll
                for (int nt = 0; nt < NT; ++nt)
#pragma unroll
                    for (int i = 0; i < 4; ++i) PART[(wave * NT + nt) * 256 + (4 * kq + i) * 16 + fr] = acc[nt][i]; }
            LDS_BARRIER();
            for (int e2 = tid; e2 < NT * 256; e2 += 512) { const int nt = e2 >> 8, e = e2 & 255; float sacc = 0.f;
#pragma unroll
                for (int w = 0; w < 8; ++w) sacc += PART[(w * NT + nt) * 256 + e];
                if (ROUTER) LG[e] = sacc;
                else ((bf16_t*)(p->ws + WS_SMALL))[(size_t)(mbase + 16 * grp + (e >> 4)) * 64 + 16 * nt + (e & 15)] = (bf16_t)(pk_bf16(sacc, 0.f) & 0xffffu); }
            if (ROUTER) {
                LDS_BARRIER();
                if (tid < 16) { float lg[16];
#pragma unroll
                    for (int q = 0; q < 4; ++q) { const f32x4 v = *(const LAS f32x4*)(LG + tid * 16 + 4 * q); lg[4 * q] = v[0]; lg[4 * q + 1] = v[1]; lg[4 * q + 2] = v[2]; lg[4 * q + 3] = v[3]; }
                    int bucket; float wlo, whi; route16(lg, p->in[I_RB], bucket, wlo, whi);
                    *(f32x4*)(p->ws + WS_ROUTE + (size_t)(mbase + 16 * grp + tid) * 16) = (f32x4){__int_as_float(bucket), wlo, whi, 0.f};
                    ((unsigned char*)(p->ws + WS_RB8))[mbase + 16 * grp + tid] = (unsigned char)bucket;
                    __hip_atomic_fetch_add(hist + bucket, 1, __ATOMIC_RELAXED, __HIP_MEMORY_SCOPE_WORKGROUP); }
            }
        }
        if (ROUTER) { __syncthreads(); if (tid < 32) ((int*)(p->ws + WS_HIST))[vb * 32 + tid] = tid < 24 ? hist[tid] : 0; }
        __syncthreads();
    }
}

__device__ __forceinline__ void phase_moe_offsets(KP p, LAS unsigned char* lds, int latent_only, int wv) {
    const int tid = tid_launder(wv), lane = tid & 63, wave = tid >> 6;
    LAS int* PT = (LAS int*)lds; LAS int* tot = PT + 384; LAS int* tbase = tot + 32; LAS int* wsum = tbase + 32;
    const int* HIST = (const int*)(p->ws + WS_HIST); int* LIST = (int*)(p->ws + WS_LIST); f32x2* SLOTW = (f32x2*)(p->ws + WS_SLOTW); int* TILE = (int*)(p->ws + WS_TILE);
    for (int j = bid_launder(); j < 24; j += gridDim.x) {
        if (tid < 384) { const int jj = tid % 24, pi = tid / 24; int sacc = 0; for (int w = pi * 16; w < pi * 16 + 16; ++w) sacc += HIST[w * 32 + jj]; PT[pi * 24 + jj] = sacc; }
        __syncthreads();
        if (tid < 24) { int sacc = 0; for (int i = 0; i < 16; ++i) sacc += PT[i * 24 + tid]; tot[tid] = sacc; }
        __syncthreads();
        if (tid == 0) { int run = 0; for (int q = 0; q < 24; ++q) { tbase[q] = run; run += (tot[q] + 255) >> 8; } tbase[24] = run; }
        __syncthreads();
        const int base = tbase[j] * 256, cnt = tot[j], ntile = (cnt + 255) >> 8;
        if (j == 0) { if (tid == 0) TILE[0] = tbase[24]; if (tid < 24) { const int nq = (tot[tid] + 255) >> 8; for (int i = 0; i < nq; ++i) TILE[8 + tbase[tid] + i] = tid; } }
        const unsigned* rb = (const unsigned*)(p->ws + WS_RB8) + tid * 18;
        const int t0m = (tid * 72) % TT;
        int mycnt = 0;
        { unsigned bwa[18];
#pragma unroll
            for (int q = 0; q < 18; ++q) bwa[q] = rb[q];
#pragma unroll
            for (int q = 0; q < 18; ++q)
#pragma unroll
                for (int e = 0; e < 4; ++e) { int tt = t0m + 4 * q + e; tt = tt >= TT ? tt - TT : tt; const int bk = (int)((bwa[q] >> (8 * e)) & 0xffu);
                    mycnt += ((!latent_only || tt >= LC) && bk == j) ? 1 : 0; } }
        int incl = mycnt;
#pragma unroll
        for (int o = 1; o < 64; o <<= 1) { const int v = __shfl_up(incl, o, 64); if (lane >= o) incl += v; }
        if (lane == 63) wsum[wave] = incl;
        __syncthreads();
        int woff = 0;
#pragma unroll
        for (int w = 0; w < 8; ++w) woff += (w < wave) ? wsum[w] : 0;
        int pos = base + woff + incl - mycnt;
        int mt[8]; int nm = 0;
#pragma unroll
        for (int q = 0; q < 8; ++q) mt[q] = 0;
#pragma unroll 1
        for (int g3 = 0; g3 < 3; ++g3) { unsigned bw[6];
#pragma unroll
            for (int q = 0; q < 6; ++q) bw[q] = rb[g3 * 6 + q];
#pragma unroll 1
            for (int q = 0; q < 6; ++q) { const unsigned w4 = q == 0 ? bw[0] : (q == 1 ? bw[1] : (q == 2 ? bw[2] : (q == 3 ? bw[3] : (q == 4 ? bw[4] : bw[5]))));
#pragma unroll 1
                for (int e = 0; e < 4; ++e) { const int m = tid * 72 + g3 * 24 + 4 * q + e; const int t = m % TT; const int bk = (int)((w4 >> (8 * e)) & 0xffu);
                    if ((!latent_only || t >= LC) && bk == j) {
                        if (nm < 8) { mt[0] = nm == 0 ? m : mt[0]; mt[1] = nm == 1 ? m : mt[1]; mt[2] = nm == 2 ? m : mt[2]; mt[3] = nm == 3 ? m : mt[3]; mt[4] = nm == 4 ? m : mt[4]; mt[5] = nm == 5 ? m : mt[5]; mt[6] = nm == 6 ? m : mt[6]; mt[7] = nm == 7 ? m : mt[7]; }
                        else { const f32x4 r = *(const f32x4*)(p->ws + WS_ROUTE + (size_t)m * 16); LIST[pos + nm] = m; SLOTW[pos + nm] = (f32x2){r[1], r[2]}; }
                        ++nm; } } } }
        { f32x4 rr[8];
#pragma unroll
            for (int q = 0; q < 8; ++q) rr[q] = *(const f32x4*)(p->ws + WS_ROUTE + (size_t)mt[q] * 16);
#pragma unroll
            for (int q = 0; q < 8; ++q) if (q < nm) { LIST[pos + q] = mt[q]; SLOTW[pos + q] = (f32x2){rr[q][1], rr[q][2]}; } }
        for (int sidx = base + cnt + tid; sidx < base + ntile * 256; sidx += 512) { LIST[sidx] = -1; SLOTW[sidx] = (f32x2){0.f, 0.f}; }
        __syncthreads();
    }
}

__device__ __forceinline__ bf16_t* obuf(unsigned char* ws, int k) {
    const int panel = k == 4 ? 8 : (k == 5 ? 9 : (k == 6 ? 10 : 12));
    return k < 4 ? (bf16_t*)(ws + WS_O) + (size_t)k * PANEL_EL : (bf16_t*)(ws + WS_P) + (size_t)panel * PANEL_EL;
}
__device__ __forceinline__ void phase_mixprep(KP p, int l, int skip_rope, int wv) {
    const int tid = tid_launder(wv);
    bf16_t* P = (bf16_t*)(p->ws + WS_P); bf16_t* DNP = (bf16_t*)(p->ws + WS_ABUF);
    float* GDEC = (float*)(p->ws + WS_GDEC); float* DNAB = (float*)(p->ws + WS_DNAB);
    float cw[5][2] = {{0.f, 0.f}, {0.f, 0.f}, {0.f, 0.f}, {0.f, 0.f}, {0.f, 0.f}};
    const int sec = tid >> 7, cp = (tid & 127) * 2;
    if (tid < 384) {
#pragma unroll
        for (int j = 0; j < 5; ++j) { cw[j][0] = p->in[I_CONVW][(l * 5 + j) * 768 + sec * 256 + cp]; cw[j][1] = p->in[I_CONVW][(l * 5 + j) * 768 + sec * 256 + cp + 1]; }
    }
    float nalog = 0.f, dtb = 0.f;
    if (tid >= 384 && tid < 392) { nalog = -__expf(p->in[I_ALOG][l * 8 + tid - 384]); dtb = p->in[I_DTB][l * 8 + tid - 384]; }
    float gw[16], gb = 0.f, invf = 0.f; int userow = 0;
#pragma unroll
    for (int r = 0; r < 16; ++r) gw[r] = 0.f;
    const int t2 = tid & 255;
    if (tid >= 256) { const int dir = t2 >> 7, c = t2 & 127;
#pragma unroll
        for (int r = 0; r < 16; ++r) gw[r] = p->in[I_GKW][((l * 2 + dir) * 16 + r) * 128 + c];
        gb = p->in[I_GKB][(l * 2 + dir) * 128 + c];
    } else { const int i = t2 & 31; invf = exp2f(-(float)(i & 15) * (13.287712379549449f / 16.f)); userow = i < 16; }
    for (int vb = bid_launder(); vb < NVB; vb += gridDim.x) {
        const int b = vb >> 4, t0 = (vb & 15) * 144;
        unsigned nA[8]; float nda[4], ndb[4]; u32x4 nz0[4], nz1[4]; unsigned nC[4];
#define MP_LOADS(C0) do { const int t_ = t0 + (C0), m_ = b * TT + t_, lo_ = t_ < LC ? 0 : LC, hi_ = t_ < LC ? LC : TT; \
            if (tid < 384) { const bf16_t* src = P + (size_t)(8 + sec) * PANEL_EL + cp; \
                _Pragma("unroll") for (int j = 0; j < 8; ++j) { const int tt = t_ - 2 + j; nA[j] = (tt >= lo_ && tt < hi_) ? *(const unsigned*)(src + (size_t)(b * TT + tt) * 256) : 0u; } } \
            else if (tid < 392) { const int j = tid - 384; const bf16_t* s12 = (const bf16_t*)(p->ws + WS_SMALL) + (size_t)m_ * 64; \
                _Pragma("unroll") for (int q = 0; q < 4; ++q) { nda[q] = bf2f(s12[q * 64 + 32 + j]); ndb[q] = bf2f(s12[q * 64 + 40 + j]); } } \
            if (tid >= 256) { const bf16_t* zp = (const bf16_t*)(p->ws + WS_SMALL) + (size_t)m_ * 64 + (t2 >> 7) * 16; \
                _Pragma("unroll") for (int q = 0; q < 4; ++q) { nz0[q] = *(const u32x4*)(zp + q * 64); nz1[q] = *(const u32x4*)(zp + q * 64 + 8); } } \
            else if (t_ >= LC && !skip_rope) { const bf16_t* ap = P + (size_t)(3 + (t2 >> 7)) * PANEL_EL + (size_t)m_ * 256 + 2 * (t2 & 127); \
                _Pragma("unroll") for (int q = 0; q < 4; ++q) nC[q] = *(const unsigned*)(ap + q * 256); } } while (0)
        MP_LOADS(0);
        for (int c0 = 0; c0 < 144; c0 += 4) {
            const int t = t0 + c0, m = b * TT + t;
            unsigned raw[8]; float da[4], db[4]; u32x4 z0[4], z1[4]; unsigned rc[4];
#pragma unroll
            for (int j = 0; j < 8; ++j) raw[j] = nA[j];
#pragma unroll
            for (int q = 0; q < 4; ++q) { da[q] = nda[q]; db[q] = ndb[q]; z0[q] = nz0[q]; z1[q] = nz1[q]; rc[q] = nC[q]; }
            if (c0 + 4 < 144) MP_LOADS(c0 + 4);
            if (tid < 384) {
                unsigned outv[4];
#pragma unroll
                for (int q = 0; q < 4; ++q) { float a0 = 0.f, a1 = 0.f;
#pragma unroll
                    for (int j = 0; j < 5; ++j) { a0 += cw[j][0] * bflo(raw[q + j]); a1 += cw[j][1] * bfhi(raw[q + j]); }
                    a0 = siluf_(a0); a1 = siluf_(a1);
                    if (sec < 2) { const float ss = half_sum32(a0 * a0 + a1 * a1); const float rn = rsqrtf(ss + EPS) * (sec == 0 ? 0.125f : 1.f); a0 *= rn; a1 *= rn; }
                    outv[q] = pk_bf16(a0, a1); }
#pragma unroll
                for (int q = 0; q < 4; ++q) *(unsigned*)(DNP + (size_t)sec * PANEL_EL + (size_t)(m + q) * 256 + cp) = outv[q];
            } else if (tid < 392) {
                const int j = tid - 384;
#pragma unroll
                for (int q = 0; q < 4; ++q) { DNAB[(size_t)(m + q) * 16 + j] = nalog * softplusf_(da[q] + dtb);     DNAB[(size_t)(m + q) * 16 + 8 + j] = sigmoidf_(db[q]); }
            }
            if (tid >= 256) {
#pragma unroll
                for (int q = 0; q < 4; ++q) { float logit = gb;
#pragma unroll
                    for (int e = 0; e < 4; ++e) { logit += bflo(z0[q][e]) * gw[2 * e] + bfhi(z0[q][e]) * gw[2 * e + 1] + bflo(z1[q][e]) * gw[8 + 2 * e] + bfhi(z1[q][e]) * gw[8 + 2 * e + 1]; }
                    const float ls = fminf(logit, 0.f) - __logf(1.f + __expf(-fabsf(logit)));
                    GDEC[(size_t)(m + q) * 256 + t2] = ls * 0.0625f; }
            } else if (t >= LC && !skip_rope) {
                bf16_t* ap = P + (size_t)(3 + (t2 >> 7)) * PANEL_EL + (size_t)m * 256 + 2 * (t2 & 127);
#pragma unroll
                for (int q = 0; q < 4; ++q) { const int pos = t + q - LC; const float t1 = bflo(rc[q]), tq = bfhi(rc[q]);
                    const float ang = (float)(userow ? (pos >> 6) : (pos & 63)) * invf; const float sn = __sinf(ang), cs = __cosf(ang);
                    rc[q] = pk_bf16(t1 * cs - tq * sn, t1 * sn + tq * cs); }
#pragma unroll
                for (int q = 0; q < 4; ++q) *(unsigned*)(ap + q * 256) = rc[q];
            }
        }
#undef MP_LOADS
    }
}

__device__ __forceinline__ int blk_tok0(int dir, int blk) { return dir == 0 ? 16 * blk : (blk < 16 ? LC - 16 * (blk + 1) : TT - 16 * (blk - 15)); }
__device__ __forceinline__ void cvt8(const u32x4 r, LAS float* d) {
    *(LAS f32x4*)d = (f32x4){bflo(r[0]), bfhi(r[0]), bflo(r[1]), bfhi(r[1])}; *(LAS f32x4*)(d + 4) = (f32x4){bflo(r[2]), bfhi(r[2]), bflo(r[3]), bfhi(r[3])};
}
__device__ __forceinline__ void store_out16(const LAS float* LO, bf16_t* Og, int tcur, int lane) {
    if (lane < 32) { const int row = lane >> 1, half = lane & 1; const f32x4 o0 = *(const LAS f32x4*)(LO + row * 16 + half * 8), o1 = *(const LAS f32x4*)(LO + row * 16 + half * 8 + 4);
        *(u32x4*)(Og + (size_t)(tcur + row) * 16 + half * 8) = (u32x4){pk_bf16(o0[0], o0[1]), pk_bf16(o0[2], o0[3]), pk_bf16(o1[0], o1[1]), pk_bf16(o1[2], o1[3])}; }
}
template <int DIR>
__device__ __forceinline__ void scan_ret_chunk(KP p, LAS unsigned char* Lb, int idx, int l, int wv) {
    const int lane = tid_launder(wv) & 63, fr = lane & 15, kq = lane >> 4;
    constexpr int dir = DIR; const int h = (idx >> 1) & 3, b = idx >> 3;
    const bf16_t* P = (const bf16_t*)(p->ws + WS_P);
    const bf16_t* Qg = P + 3 * PANEL_EL + (size_t)b * TT * 256 + h * 64; const bf16_t* Kg = Qg + PANEL_EL; const bf16_t* Vg = Qg + 2 * PANEL_EL;
    bf16_t* Og = obuf(p->ws, 2 + dir) + (size_t)((b * 4 + h) * 4) * TT * 16;
    const float lg2 = log2f(sigmoidf_(p->in[I_RETD][(l * 2 + dir) * 4 + h]));
    const float g16 = exp2f(16.f * lg2);
    LAS bf16_t* QL = (LAS bf16_t*)Lb; LAS bf16_t* KL = QL + 16 * 72; LAS bf16_t* KT = KL + 16 * 72; LAS bf16_t* VT = KT + 64 * 32; LAS bf16_t* GL = VT + 64 * 32;
    for (int i = lane; i < (64 * 32 * 2 + 16 * 32) / 2; i += 64) ((LAS unsigned*)KT)[i] = 0u;
    f32x4 S[4][4];
#pragma unroll
    for (int a = 0; a < 4; ++a)
#pragma unroll
        for (int c = 0; c < 4; ++c) S[a][c] = (f32x4){0.f, 0.f, 0.f, 0.f};
    u32x4 rq[2], rk[2], rv[2];
    int tb = blk_tok0(dir, 0);
#define RC_LOAD(T0) do { _Pragma("unroll") for (int i = 0; i < 2; ++i) { const int q = lane + 64 * i, r = q >> 3, c8 = (q & 7) * 8; const size_t ro = (size_t)((T0) + (dir ? 15 - r : r)) * 256 + c8; \
        rq[i] = *(const u32x4*)(Qg + ro); rk[i] = *(const u32x4*)(Kg + ro); rv[i] = *(const u32x4*)(Vg + ro); } } while (0)
    RC_LOAD(tb);
    float rowsc[4];
#pragma unroll
    for (int i = 0; i < 4; ++i) rowsc[i] = exp2f(lg2 * (float)(4 * kq + i - 15));
    for (int blk = 0; blk < 144; ++blk) {
#pragma unroll
        for (int i = 0; i < 2; ++i) { const int q = lane + 64 * i, r = q >> 3, c8 = (q & 7) * 8;
            *(LAS u32x4*)(QL + r * 72 + c8) = rq[i]; *(LAS u32x4*)(KL + r * 72 + c8) = rk[i];
            const float vs = exp2f(lg2 * (float)(15 - r));
#pragma unroll
            for (int e = 0; e < 4; ++e) { KT[(c8 + 2 * e) * 32 + r] = (bf16_t)(rk[i][e] & 0xffffu); KT[(c8 + 2 * e + 1) * 32 + r] = (bf16_t)(rk[i][e] >> 16);
                const unsigned pv = pk_bf16(bflo(rv[i][e]) * vs, bfhi(rv[i][e]) * vs);
                VT[(c8 + 2 * e) * 32 + r] = (bf16_t)(pv & 0xffffu); VT[(c8 + 2 * e + 1) * 32 + r] = (bf16_t)(pv >> 16); } }
        const int tcur = tb;
        if (blk + 1 < 144) { tb = blk_tok0(dir, blk + 1); RC_LOAD(tb); }
        WAVE_LDS_SYNC();
        f32x4 G = (f32x4){0.f, 0.f, 0.f, 0.f};
#pragma unroll
        for (int kk = 0; kk < 2; ++kk) { const bf16x8 a = *(const LAS bf16x8*)(QL + fr * 72 + 32 * kk + 8 * kq), bb = *(const LAS bf16x8*)(KL + fr * 72 + 32 * kk + 8 * kq);
            G = __builtin_amdgcn_mfma_f32_16x16x32_bf16(a, bb, G, 0, 0, 0); }
#pragma unroll
        for (int i = 0; i < 4; ++i) { const int r = 4 * kq + i; GL[r * 32 + fr] = (bf16_t)(pk_bf16(fr <= r ? G[i] : 0.f, 0.f) & 0xffffu); }
#pragma unroll
        for (int a = 0; a < 4; ++a)
#pragma unroll
            for (int c = 0; c < 4; ++c) S[a][c] = S[a][c] * g16;
        WAVE_LDS_SYNC();
        const bf16x8 ag = *(const LAS bf16x8*)(GL + fr * 32 + 8 * kq);
        bf16x8 aq[2];
#pragma unroll
        for (int kk = 0; kk < 2; ++kk) { const u32x2 lo = *(const LAS u32x2*)(QL + fr * 72 + 32 * kk + 4 * kq), hi = *(const LAS u32x2*)(QL + fr * 72 + 32 * kk + 16 + 4 * kq);
            aq[kk] = __builtin_bit_cast(bf16x8, (u32x4){lo[0], lo[1], hi[0], hi[1]}); }
        bf16x8 bv[4], ak[4];
#pragma unroll
        for (int c = 0; c < 4; ++c) { bv[c] = *(const LAS bf16x8*)(VT + (16 * c + fr) * 32 + 8 * kq); ak[c] = *(const LAS bf16x8*)(KT + (16 * c + fr) * 32 + 8 * kq); }
        f32x4 acc[4];
#pragma unroll
        for (int c = 0; c < 4; ++c) { acc[c] = __builtin_amdgcn_mfma_f32_16x16x32_bf16(ag, bv[c], (f32x4){0.f, 0.f, 0.f, 0.f}, 0, 0, 0);
#pragma unroll
            for (int kk = 0; kk < 2; ++kk) { const f32x4 s0 = S[2 * kk][c], s1 = S[2 * kk + 1][c];
                const bf16x8 bs = __builtin_bit_cast(bf16x8, (u32x4){pk_bf16(s0[0], s0[1]), pk_bf16(s0[2], s0[3]), pk_bf16(s1[0], s1[1]), pk_bf16(s1[2], s1[3])});
                acc[c] = __builtin_amdgcn_mfma_f32_16x16x32_bf16(aq[kk], bs, acc[c], 0, 0, 0); } }
#pragma unroll
        for (int a = 0; a < 4; ++a)
#pragma unroll
            for (int c = 0; c < 4; ++c) S[a][c] = __builtin_amdgcn_mfma_f32_16x16x32_bf16(ak[a], bv[c], S[a][c], 0, 0, 0);
#pragma unroll
        for (int c = 0; c < 4; ++c)
#pragma unroll
            for (int i = 0; i < 4; ++i) { const int r = 4 * kq + i; Og[((size_t)c * TT + (size_t)(tcur + (dir ? 15 - r : r))) * 16 + fr] = (bf16_t)(pk_bf16(acc[c][i] * rowsc[i], 0.f) & 0xffffu); }
        WAVE_LDS_SYNC();
    }
#undef RC_LOAD
}
template <int DIR>
__device__ __forceinline__ void scan_gla_chunk(KP p, LAS unsigned char* Lb, int idx, int wv) {
    const int lane = tid_launder(wv) & 63, fr = lane & 15, kq = lane >> 4;
    constexpr int dir = DIR; const int h = (idx >> 1) & 3, b = idx >> 3;
    const bf16_t* P = (const bf16_t*)(p->ws + WS_P);
    const bf16_t* Qg = P + (size_t)b * TT * 256 + h * 32; const bf16_t* Kg = Qg + 128; const bf16_t* Vg = P + PANEL_EL + (size_t)b * TT * 256 + h * 64;
    const float* Ag = (const float*)(p->ws + WS_GDEC) + (size_t)b * TT * 256 + dir * 128 + h * 32;
    bf16_t* Og = obuf(p->ws, dir) + (size_t)((b * 4 + h) * 4) * TT * 16;
    LAS bf16_t* QL = (LAS bf16_t*)Lb; LAS bf16_t* KL = QL + 16 * 40; LAS bf16_t* KT = KL + 16 * 40; LAS bf16_t* VT = KT + 32 * 32; LAS bf16_t* GL = VT + 64 * 32; LAS float* EB = (LAS float*)(GL + 16 * 32);
    for (int i = lane; i < (32 * 32 + 64 * 32 + 16 * 32) / 2; i += 64) ((LAS unsigned*)KT)[i] = 0u;
    f32x4 S[2][4];
#pragma unroll
    for (int a = 0; a < 2; ++a)
#pragma unroll
        for (int c = 0; c < 4; ++c) S[a][c] = (f32x4){0.f, 0.f, 0.f, 0.f};
    const int sg = lane >> 4, dp = lane & 15;
    unsigned rq[4], rk[4]; f32x2 ra[4]; u32x4 rv[2];
    int tb = blk_tok0(dir, 0);
#define GC_LOAD(T0) do { _Pragma("unroll") for (int i = 0; i < 4; ++i) { const int r = 4 * sg + i; const size_t ro = (size_t)((T0) + (dir ? 15 - r : r)) * 256 + 2 * dp; \
            rq[i] = *(const unsigned*)(Qg + ro); rk[i] = *(const unsigned*)(Kg + ro); ra[i] = *(const f32x2*)(Ag + ro); } \
        _Pragma("unroll") for (int i = 0; i < 2; ++i) { const int q = lane + 64 * i, r = q >> 3, c8 = (q & 7) * 8; rv[i] = *(const u32x4*)(Vg + (size_t)((T0) + (dir ? 15 - r : r)) * 256 + c8); } } while (0)
    GC_LOAD(tb);
    for (int blk = 0; blk < 144; ++blk) {
        f32x2 bc[4]; bc[0] = ra[0]; bc[1] = bc[0] + ra[1]; bc[2] = bc[1] + ra[2]; bc[3] = bc[2] + ra[3];
        f32x2 inc = bc[3];
        { const float u0 = __shfl_up(inc[0], 16, 64), u1 = __shfl_up(inc[1], 16, 64); if (sg >= 1) { inc[0] += u0; inc[1] += u1; } }
        { const float u0 = __shfl_up(inc[0], 32, 64), u1 = __shfl_up(inc[1], 32, 64); if (sg >= 2) { inc[0] += u0; inc[1] += u1; } }
        const f32x2 excl = inc - bc[3];
        if (sg == 3) { EB[2 * dp] = __expf(inc[0]); EB[2 * dp + 1] = __expf(inc[1]); }
#pragma unroll
        for (int i = 0; i < 4; ++i) { const int r = 4 * sg + i; const f32x2 bb = bc[i] + excl;
            const float e0 = __expf(bb[0]), e1 = __expf(bb[1]), n0 = __expf(-bb[0]), n1 = __expf(-bb[1]);
            const unsigned qv = pk_bf16(bflo(rq[i]) * e0, bfhi(rq[i]) * e1), kv = pk_bf16(bflo(rk[i]) * n0, bfhi(rk[i]) * n1);
            *(LAS unsigned*)(QL + r * 40 + 2 * dp) = qv; *(LAS unsigned*)(KL + r * 40 + 2 * dp) = kv;
            KT[(2 * dp) * 32 + r] = (bf16_t)(kv & 0xffffu); KT[(2 * dp + 1) * 32 + r] = (bf16_t)(kv >> 16); }
#pragma unroll
        for (int i = 0; i < 2; ++i) { const int q = lane + 64 * i, r = q >> 3, c8 = (q & 7) * 8;
#pragma unroll
            for (int e = 0; e < 4; ++e) { VT[(c8 + 2 * e) * 32 + r] = (bf16_t)(rv[i][e] & 0xffffu); VT[(c8 + 2 * e + 1) * 32 + r] = (bf16_t)(rv[i][e] >> 16); } }
        const int tcur = tb;
        if (blk + 1 < 144) { tb = blk_tok0(dir, blk + 1); GC_LOAD(tb); }
        WAVE_LDS_SYNC();
        { const bf16x8 a = *(const LAS bf16x8*)(QL + fr * 40 + 8 * kq), bb = *(const LAS bf16x8*)(KL + fr * 40 + 8 * kq);
            const f32x4 G = __builtin_amdgcn_mfma_f32_16x16x32_bf16(a, bb, (f32x4){0.f, 0.f, 0.f, 0.f}, 0, 0, 0);
#pragma unroll
            for (int i = 0; i < 4; ++i) { const int r = 4 * kq + i; GL[r * 32 + fr] = (bf16_t)(pk_bf16(fr <= r ? G[i] : 0.f, 0.f) & 0xffffu); } }
        WAVE_LDS_SYNC();
        const bf16x8 ag = *(const LAS bf16x8*)(GL + fr * 32 + 8 * kq);
        const u32x2 qlo = *(const LAS u32x2*)(QL + fr * 40 + 4 * kq), qhi = *(const LAS u32x2*)(QL + fr * 40 + 16 + 4 * kq);
        const bf16x8 aq = __builtin_bit_cast(bf16x8, (u32x4){qlo[0], qlo[1], qhi[0], qhi[1]});
        bf16x8 bv[4], ak[2];
#pragma unroll
        for (int c = 0; c < 4; ++c) bv[c] = *(const LAS bf16x8*)(VT + (16 * c + fr) * 32 + 8 * kq);
#pragma unroll
        for (int a = 0; a < 2; ++a) ak[a] = *(const LAS bf16x8*)(KT + (16 * a + fr) * 32 + 8 * kq);
        const f32x4 eb0 = *(const LAS f32x4*)(EB + 4 * kq), eb1 = *(const LAS f32x4*)(EB + 16 + 4 * kq);
#pragma unroll
        for (int c = 0; c < 4; ++c) { f32x4 acc = __builtin_amdgcn_mfma_f32_16x16x32_bf16(ag, bv[c], (f32x4){0.f, 0.f, 0.f, 0.f}, 0, 0, 0);
            const f32x4 s0 = S[0][c], s1 = S[1][c];
            const bf16x8 bs = __builtin_bit_cast(bf16x8, (u32x4){pk_bf16(s0[0], s0[1]), pk_bf16(s0[2], s0[3]), pk_bf16(s1[0], s1[1]), pk_bf16(s1[2], s1[3])});
            acc = __builtin_amdgcn_mfma_f32_16x16x32_bf16(aq, bs, acc, 0, 0, 0);
            S[0][c] = __builtin_amdgcn_mfma_f32_16x16x32_bf16(ak[0], bv[c], S[0][c], 0, 0, 0) * eb0;
            S[1][c] = __builtin_amdgcn_mfma_f32_16x16x32_bf16(ak[1], bv[c], S[1][c], 0, 0, 0) * eb1;
#pragma unroll
            for (int i = 0; i < 4; ++i) { const int r = 4 * kq + i; Og[((size_t)c * TT + (size_t)(tcur + (dir ? 15 - r : r))) * 16 + fr] = (bf16_t)(pk_bf16(acc[i], 0.f) & 0xffffu); } }
        WAVE_LDS_SYNC();
    }
#undef GC_LOAD
}
__device__ __forceinline__ float oct_sum(float v) {
    v += __builtin_bit_cast(float, __builtin_amdgcn_update_dpp(0, __builtin_bit_cast(int, v), 0xB1, 0xF, 0xF, true));
    v += __builtin_bit_cast(float, __builtin_amdgcn_update_dpp(0, __builtin_bit_cast(int, v), 0x4E, 0xF, 0xF, true));
    v += __builtin_bit_cast(float, __builtin_amdgcn_update_dpp(0, __builtin_bit_cast(int, v), 0x141, 0xF, 0xF, true));
    return v;
}
__device__ __forceinline__ void scan_dn(KP p, LAS float* L, int idx, int wv, int noload) {
    const int lane = tid_launder(wv) & 63, vl = lane >> 3, dg = lane & 7;
    const int cq = idx & 7, dir = (idx >> 3) & 1, h = (idx >> 4) & 3, b = idx >> 6;
    const bf16_t* Qg = (const bf16_t*)(p->ws + WS_ABUF) + (size_t)b * TT * 256 + h * 64; const bf16_t* Kg = Qg + PANEL_EL; const bf16_t* Vg = Qg + 2 * PANEL_EL + cq * 8;
    const float* ABg = (const float*)(p->ws + WS_DNAB) + (size_t)b * TT * 16 + dir * 4 + h;
    bf16_t* Og = obuf(p->ws, 4 + dir) + (size_t)((b * 4 + h) * 8 + cq) * TT * 8;
    LAS float* LQ = L; LAS float* LK = L + 1024; LAS float* LV = L + 2048; LAS float* LAB = L + 2176; LAS float* LOP = L + 2208;
    f32x2 S[4];
#pragma unroll
    for (int i = 0; i < 4; ++i) S[i] = (f32x2){0.f, 0.f};
    const int lrow = lane >> 2, lseg = lane & 3;
    struct DnSet { u32x4 q0, q1, k0, k1, v; float a, b; };
    DnSet R0, R1;
#define DN_LOAD(R, BLK) do { if ((BLK) < 144 && !(noload && (BLK) >= 2)) { const int T0_ = blk_tok0(dir, (BLK)); const size_t ro = (size_t)(T0_ + lrow) * 256 + lseg * 16; R.q0 = *(const u32x4*)(Qg + ro); R.q1 = *(const u32x4*)(Qg + ro + 8); R.k0 = *(const u32x4*)(Kg + ro); R.k1 = *(const u32x4*)(Kg + ro + 8); \
        R.v = *(const u32x4*)(Vg + (size_t)(T0_ + (lane & 15)) * 256); R.a = ABg[(size_t)(T0_ + (lane & 15)) * 16]; R.b = ABg[(size_t)(T0_ + (lane & 15)) * 16 + 8]; } } while (0)
#define DN_RD(LS) do { nk0 = *(const LAS f32x4*)(LK + (LS) * 64 + dg * 8); nk1 = *(const LAS f32x4*)(LK + (LS) * 64 + dg * 8 + 4); nq0 = *(const LAS f32x4*)(LQ + (LS) * 64 + dg * 8); nq1 = *(const LAS f32x4*)(LQ + (LS) * 64 + dg * 8 + 4); \
            nv = LV[(LS) * 8 + vl]; na = LAB[(LS) * 2]; nb = LAB[(LS) * 2 + 1]; } while (0)
#define DN_BLOCK(R, BLK) do { \
        cvt8(R.q0, LQ + lrow * 64 + lseg * 16); cvt8(R.q1, LQ + lrow * 64 + lseg * 16 + 8); cvt8(R.k0, LK + lrow * 64 + lseg * 16); cvt8(R.k1, LK + lrow * 64 + lseg * 16 + 8); \
        if (lane < 16) { cvt8(R.v, LV + lane * 8); LAB[lane * 2] = R.a; LAB[lane * 2 + 1] = R.b; } \
        const int tcur = blk_tok0(dir, (BLK)); \
        DN_LOAD(R, (BLK) + 2); \
        WAVE_LDS_SYNC(); \
        f32x4 nk0, nk1, nq0, nq1; float nv, na, nb; \
        DN_RD(dir ? 15 : 0); \
        _Pragma("unroll") for (int s = 0; s < 16; ++s) { \
            const f32x2 ka = {nk0[0], nk0[1]}, kb = {nk0[2], nk0[3]}, kc = {nk1[0], nk1[1]}, kd = {nk1[2], nk1[3]}; \
            const f32x2 qa = {nq0[0], nq0[1]}, qb = {nq0[2], nq0[3]}, qc = {nq1[0], nq1[1]}, qd = {nq1[2], nq1[3]}; const float v = nv, a = na, bt = nb; \
            const int ls = dir ? 15 - s : s; \
            if (s < 15) { DN_RD(dir ? 14 - s : s + 1); } \
            const f32x2 r2 = (ka * S[0] + kb * S[1]) + (kc * S[2] + kd * S[3]);        \
            const float r = oct_sum(r2[0] + r2[1]); \
            const float c = bt * (v - a * r); \
            const f32x2 c2 = {c, c}, a2 = {a, a}; \
            S[0] = a2 * S[0] + ka * c2; S[1] = a2 * S[1] + kb * c2; S[2] = a2 * S[2] + kc * c2; S[3] = a2 * S[3] + kd * c2; \
            const f32x2 o2 = (qa * S[0] + qb * S[1]) + (qc * S[2] + qd * S[3]); \
            LOP[ls * 64 + lane] = o2[0] + o2[1]; \
            asm volatile("" ::: "memory"); } \
        WAVE_LDS_SYNC(); \
        { const int ts = lane >> 2, c0 = (lane & 3) * 2;                         \
            const f32x4 p0 = *(const LAS f32x4*)(LOP + ts * 64 + c0 * 8), p1 = *(const LAS f32x4*)(LOP + ts * 64 + c0 * 8 + 4), p2 = *(const LAS f32x4*)(LOP + ts * 64 + c0 * 8 + 8), p3 = *(const LAS f32x4*)(LOP + ts * 64 + c0 * 8 + 12); \
            const float oa = (p0[0] + p0[1]) + (p0[2] + p0[3]) + (p1[0] + p1[1]) + (p1[2] + p1[3]), ob = (p2[0] + p2[1]) + (p2[2] + p2[3]) + (p3[0] + p3[1]) + (p3[2] + p3[3]); \
            *(unsigned*)(Og + (size_t)(tcur + ts) * 8 + c0) = pk_bf16(oa, ob); } \
        WAVE_LDS_SYNC(); } while (0)
    DN_LOAD(R0, 0); DN_LOAD(R1, 1);
    for (int blk = 0; blk < 144; blk += 2) { DN_BLOCK(R0, blk); DN_BLOCK(R1, blk + 1); }
#undef DN_BLOCK
#undef DN_RD
#undef DN_LOAD
}
__device__ __forceinline__ bf16x8 packz(const f32x4 v) { return __builtin_bit_cast(bf16x8, (u32x4){pk_bf16(v[0], v[1]), pk_bf16(v[2], v[3]), 0u, 0u}); }
__device__ __forceinline__ bf16x8 ldaz(const LAS bf16_t* img, int fr, int kq) { const u32x2 lo = *(const LAS u32x2*)(img + fr * 32 + 4 * kq); return __builtin_bit_cast(bf16x8, (u32x4){lo[0], lo[1], 0u, 0u}); }
__device__ __forceinline__ void stz(LAS bf16_t* img, const f32x4 v, int fr, int kq) {
#pragma unroll
    for (int i = 0; i < 4; ++i) img[(4 * kq + i) * 32 + fr] = (bf16_t)(pk_bf16(v[i], 0.f) & 0xffffu);
}
__device__ __forceinline__ float row_scan16(float v) {
    v += __builtin_bit_cast(float, __builtin_amdgcn_update_dpp(0, __builtin_bit_cast(int, v), 0x111, 0xF, 0xF, true));
    v += __builtin_bit_cast(float, __builtin_amdgcn_update_dpp(0, __builtin_bit_cast(int, v), 0x112, 0xF, 0xF, true));
    v += __builtin_bit_cast(float, __builtin_amdgcn_update_dpp(0, __builtin_bit_cast(int, v), 0x114, 0xF, 0xF, true));
    v += __builtin_bit_cast(float, __builtin_amdgcn_update_dpp(0, __builtin_bit_cast(int, v), 0x118, 0xF, 0xF, true));
    return v;
}
constexpr int DN_SLOT = 13568, DN_NSLOT = 3;
__device__ __forceinline__ void lds_wait_ge(volatile LAS int* f, int need) { for (int it = 0; it < (1 << 22); ++it) { if (*f >= need) break; __builtin_amdgcn_s_sleep(1); } }
template <int DIR>
__device__ __forceinline__ void scan_dn_producer(KP p, LAS unsigned char* ring, LAS unsigned char* scratch, volatile LAS int* flags, int idx, int wv) {
    const int lane = tid_launder(wv) & 63, fr = lane & 15, kq = lane >> 4;
    constexpr int dir = DIR; const int h = (idx >> 1) & 3, b = idx >> 3;
    const bf16_t* Qg = (const bf16_t*)(p->ws + WS_ABUF) + (size_t)b * TT * 256 + h * 64; const bf16_t* Kg = Qg + PANEL_EL; const bf16_t* Vg = Qg + 2 * PANEL_EL;
    const float* ABg = (const float*)(p->ws + WS_DNAB) + (size_t)b * TT * 16 + dir * 4 + h;
    LAS bf16_t* L0 = (LAS bf16_t*)scratch; LAS bf16_t* L1 = L0 + 16 * 32; LAS bf16_t* L2 = L1 + 16 * 32;
    for (int i = lane; i < (3 * 16 * 32) / 2; i += 64) ((LAS unsigned*)L0)[i] = 0u;
    for (int sl = 0; sl < DN_NSLOT; ++sl) { LAS unsigned* z = (LAS unsigned*)(ring + sl * DN_SLOT + 3 * 16 * 72 * 2); for (int i = lane; i < (64 * 32 + 2 * 16 * 32) / 2; i += 64) z[i] = 0u; }
    u32x4 rq[2], rk[2], rv[2]; float rla, rbe;
    int tb = blk_tok0(dir, 0);
#define DC_LOAD(T0) do { _Pragma("unroll") for (int i = 0; i < 2; ++i) { const int q = lane + 64 * i, r = q >> 3, c8 = (q & 7) * 8; const size_t ro = (size_t)((T0) + (dir ? 15 - r : r)) * 256 + c8; \
            rq[i] = *(const u32x4*)(Qg + ro); rk[i] = *(const u32x4*)(Kg + ro); rv[i] = *(const u32x4*)(Vg + ro); } \
        { const size_t ao = (size_t)((T0) + (dir ? 15 - fr : fr)) * 16; rla = ABg[ao]; rbe = ABg[ao + 8]; } } while (0)
    DC_LOAD(tb);
    for (int blk = 0; blk < 144; ++blk) {
        LAS unsigned char* sl = ring + (blk % DN_NSLOT) * DN_SLOT;
        LAS bf16_t* QL = (LAS bf16_t*)sl; LAS bf16_t* KL = QL + 16 * 72; LAS bf16_t* VL = KL + 16 * 72; LAS bf16_t* KT = VL + 16 * 72; LAS bf16_t* TL = KT + 64 * 32; LAS bf16_t* PL = TL + 16 * 32; LAS float* GS = (LAS float*)(PL + 16 * 32);
        if (blk >= DN_NSLOT) lds_wait_ge(flags + 1, blk - DN_NSLOT + 1);
        const float gsc = row_scan16(rla), bec = rbe;
        const float g15 = __builtin_bit_cast(float, __builtin_amdgcn_readlane(__builtin_bit_cast(int, gsc), 15));
        if (lane < 16) { GS[lane] = gsc; GS[16 + lane] = bec; GS[32 + lane] = g15; }
#pragma unroll
        for (int i = 0; i < 2; ++i) { const int q = lane + 64 * i, r = q >> 3, c8 = (q & 7) * 8;
            *(LAS u32x4*)(QL + r * 72 + c8) = rq[i]; *(LAS u32x4*)(KL + r * 72 + c8) = rk[i]; *(LAS u32x4*)(VL + r * 72 + c8) = rv[i]; }
        WAVE_LDS_SYNC();
        const f32x4 gr = *(const LAS f32x4*)(GS + 4 * kq), br = *(const LAS f32x4*)(GS + 16 + 4 * kq);
#pragma unroll
        for (int i = 0; i < 2; ++i) { const int q = lane + 64 * i, r = q >> 3, c8 = (q & 7) * 8; const float ks = __expf(g15 - GS[r]);
#pragma unroll
            for (int e = 0; e < 4; ++e) { const unsigned kv = pk_bf16(bflo(rk[i][e]) * ks, bfhi(rk[i][e]) * ks); KT[(c8 + 2 * e) * 32 + r] = (bf16_t)(kv & 0xffffu); KT[(c8 + 2 * e + 1) * 32 + r] = (bf16_t)(kv >> 16); } }
        if (blk + 1 < 144) { tb = blk_tok0(dir, blk + 1); DC_LOAD(tb); }
        f32x4 KK = (f32x4){0.f, 0.f, 0.f, 0.f}, QK = (f32x4){0.f, 0.f, 0.f, 0.f};
#pragma unroll
        for (int kk = 0; kk < 2; ++kk) { const bf16x8 ak = *(const LAS bf16x8*)(KL + fr * 72 + 32 * kk + 8 * kq), aq = *(const LAS bf16x8*)(QL + fr * 72 + 32 * kk + 8 * kq);
            KK = __builtin_amdgcn_mfma_f32_16x16x32_bf16(ak, ak, KK, 0, 0, 0); QK = __builtin_amdgcn_mfma_f32_16x16x32_bf16(aq, ak, QK, 0, 0, 0); }
        f32x4 Lm, Pm;
#pragma unroll
        for (int i = 0; i < 4; ++i) { const int r = 4 * kq + i; const float e = __expf(fminf(gr[i] - gsc, 0.f)); Lm[i] = fr < r ? br[i] * e * KK[i] : 0.f; Pm[i] = fr <= r ? e * QK[i] : 0.f; }
        stz(L0, Lm, fr, kq); stz(PL, Pm, fr, kq);
        WAVE_LDS_SYNC();
        const bf16x8 aL = ldaz(L0, fr, kq);
        const f32x4 Lsq = __builtin_amdgcn_mfma_f32_16x16x32_bf16(aL, packz(Lm), (f32x4){0.f, 0.f, 0.f, 0.f}, 0, 0, 0);
        stz(L1, Lsq, fr, kq);
        WAVE_LDS_SYNC();
        const bf16x8 aL2 = ldaz(L1, fr, kq);
        const f32x4 Lq = __builtin_amdgcn_mfma_f32_16x16x32_bf16(aL2, packz(Lsq), (f32x4){0.f, 0.f, 0.f, 0.f}, 0, 0, 0);
        stz(L2, Lq, fr, kq);
        WAVE_LDS_SYNC();
        const bf16x8 aL4 = ldaz(L2, fr, kq);
        f32x4 Y = __builtin_amdgcn_mfma_f32_16x16x32_bf16(aL4, packz(Lq), (f32x4){0.f, 0.f, 0.f, 0.f}, 0, 0, 0);
#pragma unroll
        for (int i = 0; i < 4; ++i) Y[i] += (fr == 4 * kq + i) ? 1.f : 0.f;
        Y = __builtin_amdgcn_mfma_f32_16x16x32_bf16(aL4, packz(Y), Y, 0, 0, 0);
        Y = __builtin_amdgcn_mfma_f32_16x16x32_bf16(aL2, packz(Y), Y, 0, 0, 0);
        { const f32x4 nY = -Y; Y = __builtin_amdgcn_mfma_f32_16x16x32_bf16(aL, packz(nY), Y, 0, 0, 0); }
        stz(TL, Y, fr, kq);
        WAVE_LDS_SYNC();
        if (lane == 0) flags[0] = blk + 1;
    }
#undef DC_LOAD
}
template <int DIR>
__device__ __forceinline__ void scan_dn_consumer(KP p, LAS unsigned char* ring, volatile LAS int* flags, int idx, int wv) {
    const int lane = tid_launder(wv) & 63, fr = lane & 15, kq = lane >> 4;
    constexpr int dir = DIR; const int h = (idx >> 1) & 3, b = idx >> 3;
    bf16_t* Og = obuf(p->ws, 4 + dir) + (size_t)((b * 4 + h) * 4) * TT * 16;
    f32x4 S[4][4];
#pragma unroll
    for (int a = 0; a < 4; ++a)
#pragma unroll
        for (int c = 0; c < 4; ++c) S[a][c] = (f32x4){0.f, 0.f, 0.f, 0.f};
    for (int blk = 0; blk < 144; ++blk) {
        LAS unsigned char* sl = ring + (blk % DN_NSLOT) * DN_SLOT;
        LAS bf16_t* QL = (LAS bf16_t*)sl; LAS bf16_t* KL = QL + 16 * 72; LAS bf16_t* VL = KL + 16 * 72; LAS bf16_t* KT = VL + 16 * 72; LAS bf16_t* TL = KT + 64 * 32; LAS bf16_t* PL = TL + 16 * 32; LAS float* GS = (LAS float*)(PL + 16 * 32);
        lds_wait_ge(flags, blk + 1);
        const f32x4 gr = *(const LAS f32x4*)(GS + 4 * kq), br = *(const LAS f32x4*)(GS + 16 + 4 * kq); const float g15 = GS[32];
        float vv[4][4];
#pragma unroll
        for (int c = 0; c < 4; ++c)
#pragma unroll
            for (int i = 0; i < 4; ++i) vv[c][i] = bf2f(VL[(4 * kq + i) * 72 + 16 * c + fr]);
        const bf16x8 aT = ldaz(TL, fr, kq), aP = ldaz(PL, fr, kq);
        bf16x8 akp[2], aqp[2], aKT[4];
#pragma unroll
        for (int kk = 0; kk < 2; ++kk) { const u32x2 klo = *(const LAS u32x2*)(KL + fr * 72 + 32 * kk + 4 * kq), khi = *(const LAS u32x2*)(KL + fr * 72 + 32 * kk + 16 + 4 * kq);
            const u32x2 qlo = *(const LAS u32x2*)(QL + fr * 72 + 32 * kk + 4 * kq), qhi = *(const LAS u32x2*)(QL + fr * 72 + 32 * kk + 16 + 4 * kq);
            akp[kk] = __builtin_bit_cast(bf16x8, (u32x4){klo[0], klo[1], khi[0], khi[1]}); aqp[kk] = __builtin_bit_cast(bf16x8, (u32x4){qlo[0], qlo[1], qhi[0], qhi[1]}); }
#pragma unroll
        for (int a = 0; a < 4; ++a) aKT[a] = ldaz(KT + (16 * a) * 32, fr, kq);
        WAVE_LDS_SYNC();
        if (lane == 0) flags[1] = blk + 1;
        f32x4 Gr;
#pragma unroll
        for (int i = 0; i < 4; ++i) Gr[i] = __expf(gr[i]);
        const float G15 = __expf(g15);
        const int tcur = blk_tok0(dir, blk);
#pragma unroll
        for (int c = 0; c < 4; ++c) {
            f32x4 KS = (f32x4){0.f, 0.f, 0.f, 0.f}, QS = (f32x4){0.f, 0.f, 0.f, 0.f};
#pragma unroll
            for (int kk = 0; kk < 2; ++kk) { const f32x4 s0 = S[2 * kk][c], s1 = S[2 * kk + 1][c];
                const bf16x8 bs = __builtin_bit_cast(bf16x8, (u32x4){pk_bf16(s0[0], s0[1]), pk_bf16(s0[2], s0[3]), pk_bf16(s1[0], s1[1]), pk_bf16(s1[2], s1[3])});
                KS = __builtin_amdgcn_mfma_f32_16x16x32_bf16(akp[kk], bs, KS, 0, 0, 0); QS = __builtin_amdgcn_mfma_f32_16x16x32_bf16(aqp[kk], bs, QS, 0, 0, 0); }
            f32x4 R;
#pragma unroll
            for (int i = 0; i < 4; ++i) R[i] = br[i] * (vv[c][i] - Gr[i] * KS[i]);
            const f32x4 U = __builtin_amdgcn_mfma_f32_16x16x32_bf16(aT, packz(R), (f32x4){0.f, 0.f, 0.f, 0.f}, 0, 0, 0);
            const bf16x8 bu = packz(U);
            const f32x4 O = __builtin_amdgcn_mfma_f32_16x16x32_bf16(aP, bu, Gr * QS, 0, 0, 0);
#pragma unroll
            for (int a = 0; a < 4; ++a) S[a][c] = __builtin_amdgcn_mfma_f32_16x16x32_bf16(aKT[a], bu, S[a][c] * G15, 0, 0, 0);
#pragma unroll
            for (int i = 0; i < 4; ++i) { const int r = 4 * kq + i; Og[((size_t)c * TT + (size_t)(tcur + (dir ? 15 - r : r))) * 16 + fr] = (bf16_t)(pk_bf16(O[i], 0.f) & 0xffffu); }
        }
    }
}
template <int DIR>
__device__ __forceinline__ void scan_s5(KP p, LAS unsigned char* Lb, int idx, int l, int wv) {
    const int lane = tid_launder(wv) & 63, fr = lane & 15, kq = lane >> 4;
    constexpr int dir = DIR; const int g = (idx >> 1) & 15, b = idx >> 5;
    const bf16_t* Ug = (const bf16_t*)(p->ws + WS_P) + 7 * PANEL_EL + (size_t)b * TT * 256 + g * 16;
    bf16_t* Og = obuf(p->ws, 6 + dir) + (size_t)(b * 16 + g) * TT * 16;
    LAS bf16_t* UL = (LAS bf16_t*)Lb; LAS float* BL = (LAS float*)(Lb + 1024); LAS unsigned* HB = (LAS unsigned*)(Lb + 1024 + 8192);
    for (int i = lane; i < 256; i += 64) ((LAS unsigned*)UL)[i] = 0u;
    const float dt = expf(p->in[I_S5DT][(l * 2 + dir) * 16 + g]);
    const float* LRE = p->in[I_S5LRE] + ((l * 2 + dir) * 16 + g) * 64; const float* LIM = p->in[I_S5LIM] + ((l * 2 + dir) * 16 + g) * 64;
    float lbr, lbi;
    { const float lre = LRE[lane], lim = LIM[lane]; float sn, cs; sincosf(lim * dt, &sn, &cs); const float mag = expf(lre * dt); lbr = mag * cs; lbi = mag * sn; }
    bf16x8 Bf[8];
#pragma unroll
    for (int pt = 0; pt < 4; ++pt) { const int ps = fr + 16 * pt;
        const float lre = LRE[ps], lim = LIM[ps]; float sn, cs; sincosf(lim * dt, &sn, &cs); const float mag = expf(lre * dt);
        const float nr = mag * cs - 1.f, ni = mag * sn, den = 1.f / (lre * lre + lim * lim);
        const float bsr = (nr * lre + ni * lim) * den, bsi = (ni * lre - nr * lim) * den;
        u32x4 wre = (u32x4){0u, 0u, 0u, 0u}, wim = (u32x4){0u, 0u, 0u, 0u};
        if (kq < 2) { const float* bre = p->in[I_S5BRE] + (size_t)((l * 16 + g) * 64 + ps) * 16 + 8 * kq; const float* bim = p->in[I_S5BIM] + (size_t)((l * 16 + g) * 64 + ps) * 16 + 8 * kq;
#pragma unroll
            for (int e = 0; e < 4; ++e) { const float r0 = bre[2 * e], r1 = bre[2 * e + 1], i0 = bim[2 * e], i1 = bim[2 * e + 1];
                wre[e] = pk_bf16(bsr * r0 - bsi * i0, bsr * r1 - bsi * i1); wim[e] = pk_bf16(bsr * i0 + bsi * r0, bsr * i1 + bsi * r1); } }
        Bf[pt] = __builtin_bit_cast(bf16x8, wre); Bf[4 + pt] = __builtin_bit_cast(bf16x8, wim); }
    bf16x8 Cf[4];
    { const float* cre = p->in[I_S5CRE] + (size_t)((l * 16 + g) * 16 + fr) * 64; const float* cim = p->in[I_S5CIM] + (size_t)((l * 16 + g) * 16 + fr) * 64;
#pragma unroll
        for (int kk = 0; kk < 4; ++kk) { const int p0 = 16 * kk + 4 * kq; const f32x4 r = *(const f32x4*)(cre + p0), im = *(const f32x4*)(cim + p0);
            const u32x4 w = (u32x4){pk_bf16(r[0], -im[0]), pk_bf16(r[1], -im[1]), pk_bf16(r[2], -im[2]), pk_bf16(r[3], -im[3])}; Cf[kk] = __builtin_bit_cast(bf16x8, w); } }
    float hre = 0.f, him = 0.f;
    u32x4 U0, U1, U2;
#define S5_LOAD(R, BLK) do { if ((BLK) < 144) R = *(const u32x4*)(Ug + (size_t)(blk_tok0(dir, (BLK)) + ((lane >> 1) & 15)) * 256 + (lane & 1) * 8); } while (0)
#define S5_BLOCK(R, BLK) do { \
        if (lane < 32) *(LAS u32x4*)(UL + (lane >> 1) * 32 + (lane & 1) * 8) = R; \
        const int tcur = blk_tok0(dir, (BLK)); \
        S5_LOAD(R, (BLK) + 3); \
        WAVE_LDS_SYNC(); \
        { const bf16x8 au = *(const LAS bf16x8*)(UL + fr * 32 + 8 * kq); \
            _Pragma("unroll") for (int nt = 0; nt < 8; ++nt) { const f32x4 d = __builtin_amdgcn_mfma_f32_16x16x32_bf16(au, Bf[nt], (f32x4){0.f, 0.f, 0.f, 0.f}, 0, 0, 0); \
                _Pragma("unroll") for (int i = 0; i < 4; ++i) BL[(4 * kq + i) * 128 + 16 * nt + fr] = d[i]; } } \
        WAVE_LDS_SYNC(); \
        float bur[16], bui[16]; \
        _Pragma("unroll") for (int s = 0; s < 16; ++s) { bur[s] = BL[s * 128 + lane]; bui[s] = BL[s * 128 + 64 + lane]; } \
        _Pragma("unroll") for (int s = 0; s < 16; ++s) { \
            const int ls = dir ? 15 - s : s; \
            const float bre = dir ? bur[15 - s] : bur[s], bim = dir ? bui[15 - s] : bui[s]; \
            const float nre = lbr * hre - lbi * him + bre, nim = lbr * him + lbi * hre + bim; \
            hre = nre; him = nim; \
            HB[ls * 68 + lane] = pk_bf16(nre, nim); } \
        WAVE_LDS_SYNC(); \
        f32x4 acc = (f32x4){0.f, 0.f, 0.f, 0.f}; \
        _Pragma("unroll") for (int kk = 0; kk < 4; ++kk) { const bf16x8 a = *(const LAS bf16x8*)(HB + fr * 68 + 16 * kk + 4 * kq); acc = __builtin_amdgcn_mfma_f32_16x16x32_bf16(a, Cf[kk], acc, 0, 0, 0); } \
        _Pragma("unroll") for (int i = 0; i < 4; ++i) Og[(size_t)(tcur + 4 * kq + i) * 16 + fr] = (bf16_t)(pk_bf16(acc[i], 0.f) & 0xffffu); \
        WAVE_LDS_SYNC(); } while (0)
    S5_LOAD(U0, 0); S5_LOAD(U1, 1); S5_LOAD(U2, 2);
    for (int blk = 0; blk < 144; blk += 3) { S5_BLOCK(U0, blk); S5_BLOCK(U1, blk + 1); S5_BLOCK(U2, blk + 2); }
#undef S5_BLOCK
#undef S5_LOAD
}
constexpr int S5_SLOT = 8192, NSLOT = 3;
template <int DIR>
__device__ __forceinline__ void scan_s5_producer(KP p, LAS unsigned char* ring, LAS unsigned char* scratch, volatile LAS int* flags, int idx, int l, int wv) {
    const int lane = tid_launder(wv) & 63, fr = lane & 15, kq = lane >> 4;
    constexpr int dir = DIR; const int g = (idx >> 1) & 15, b = idx >> 5;
    const bf16_t* Ug = (const bf16_t*)(p->ws + WS_P) + 7 * PANEL_EL + (size_t)b * TT * 256 + g * 16;
    LAS bf16_t* UL = (LAS bf16_t*)scratch;
    for (int i = lane; i < 256; i += 64) ((LAS unsigned*)UL)[i] = 0u;
    const float dt = expf(p->in[I_S5DT][(l * 2 + dir) * 16 + g]);
    const float* LRE = p->in[I_S5LRE] + ((l * 2 + dir) * 16 + g) * 64; const float* LIM = p->in[I_S5LIM] + ((l * 2 + dir) * 16 + g) * 64;
    bf16x8 Bf[8];
#pragma unroll
    for (int pt = 0; pt < 4; ++pt) { const int ps = fr + 16 * pt;
        const float lre = LRE[ps], lim = LIM[ps]; float sn, cs; sincosf(lim * dt, &sn, &cs); const float mag = expf(lre * dt);
        const float nr = mag * cs - 1.f, ni = mag * sn, den = 1.f / (lre * lre + lim * lim);
        const float bsr = (nr * lre + ni * lim) * den, bsi = (ni * lre - nr * lim) * den;
        u32x4 wre = (u32x4){0u, 0u, 0u, 0u}, wim = (u32x4){0u, 0u, 0u, 0u};
        if (kq < 2) { const float* bre = p->in[I_S5BRE] + (size_t)((l * 16 + g) * 64 + ps) * 16 + 8 * kq; const float* bim = p->in[I_S5BIM] + (size_t)((l * 16 + g) * 64 + ps) * 16 + 8 * kq;
#pragma unroll
            for (int e = 0; e < 4; ++e) { const float r0 = bre[2 * e], r1 = bre[2 * e + 1], i0 = bim[2 * e], i1 = bim[2 * e + 1];
                wre[e] = pk_bf16(bsr * r0 - bsi * i0, bsr * r1 - bsi * i1); wim[e] = pk_bf16(bsr * i0 + bsi * r0, bsr * i1 + bsi * r1); } }
        Bf[pt] = __builtin_bit_cast(bf16x8, wre); Bf[4 + pt] = __builtin_bit_cast(bf16x8, wim); }
    u32x4 U0, U1, U2;
#define S5_LOAD(R, BLK) do { if ((BLK) < 144) R = *(const u32x4*)(Ug + (size_t)(blk_tok0(dir, (BLK)) + ((lane >> 1) & 15)) * 256 + (lane & 1) * 8); } while (0)
#define S5_PBLOCK(R, BLK) do { \
        LAS float* BL = (LAS float*)(ring + ((BLK) % NSLOT) * S5_SLOT); \
        if ((BLK) >= NSLOT) lds_wait_ge(flags + 1, (BLK) - NSLOT + 1); \
        if (lane < 32) *(LAS u32x4*)(UL + (lane >> 1) * 32 + (lane & 1) * 8) = R; \
        S5_LOAD(R, (BLK) + 3); \
        WAVE_LDS_SYNC(); \
        { const bf16x8 au = *(const LAS bf16x8*)(UL + fr * 32 + 8 * kq); \
            _Pragma("unroll") for (int nt = 0; nt < 8; ++nt) { const f32x4 d = __builtin_amdgcn_mfma_f32_16x16x32_bf16(au, Bf[nt], (f32x4){0.f, 0.f, 0.f, 0.f}, 0, 0, 0); \
                _Pragma("unroll") for (int i = 0; i < 4; ++i) BL[(4 * kq + i) * 128 + 16 * nt + fr] = d[i]; } } \
        WAVE_LDS_SYNC(); \
        if (lane == 0) flags[0] = (BLK) + 1; } while (0)
    S5_LOAD(U0, 0); S5_LOAD(U1, 1); S5_LOAD(U2, 2);
    for (int blk = 0; blk < 144; blk += 3) { S5_PBLOCK(U0, blk); S5_PBLOCK(U1, blk + 1); S5_PBLOCK(U2, blk + 2); }
#undef S5_PBLOCK
#undef S5_LOAD
}
template <int DIR>
__device__ __forceinline__ void scan_s5_consumer(KP p, LAS unsigned char* ring, LAS unsigned char* priv, volatile LAS int* flags, int idx, int l, int wv) {
    const int lane = tid_launder(wv) & 63, fr = lane & 15, kq = lane >> 4;
    constexpr int dir = DIR; const int g = (idx >> 1) & 15, b = idx >> 5;
    bf16_t* Og = obuf(p->ws, 6 + dir) + (size_t)(b * 16 + g) * TT * 16;
    LAS unsigned* HB = (LAS unsigned*)priv;
    const float dt = expf(p->in[I_S5DT][(l * 2 + dir) * 16 + g]);
    float lbr, lbi;
    { const float lre = p->in[I_S5LRE][((l * 2 + dir) * 16 + g) * 64 + lane], lim = p->in[I_S5LIM][((l * 2 + dir) * 16 + g) * 64 + lane]; float sn, cs; sincosf(lim * dt, &sn, &cs); const float mag = expf(lre * dt); lbr = mag * cs; lbi = mag * sn; }
    bf16x8 Cf[4];
    { const float* cre = p->in[I_S5CRE] + (size_t)((l * 16 + g) * 16 + fr) * 64; const float* cim = p->in[I_S5CIM] + (size_t)((l * 16 + g) * 16 + fr) * 64;
#pragma unroll
        for (int kk = 0; kk < 4; ++kk) { const int p0 = 16 * kk + 4 * kq; const f32x4 r = *(const f32x4*)(cre + p0), im = *(const f32x4*)(cim + p0);
            const u32x4 w = (u32x4){pk_bf16(r[0], -im[0]), pk_bf16(r[1], -im[1]), pk_bf16(r[2], -im[2]), pk_bf16(r[3], -im[3])}; Cf[kk] = __builtin_bit_cast(bf16x8, w); } }
    float hre = 0.f, him = 0.f;
    for (int blk = 0; blk < 144; ++blk) {
        const LAS float* BL = (const LAS float*)(ring + (blk % NSLOT) * S5_SLOT);
        lds_wait_ge(flags, blk + 1);
        float bur[16], bui[16];
#pragma unroll
        for (int s = 0; s < 16; ++s) { bur[s] = BL[s * 128 + lane]; bui[s] = BL[s * 128 + 64 + lane]; }
        WAVE_LDS_SYNC();
        if (lane == 0) flags[1] = blk + 1;
        const int tcur = blk_tok0(dir, blk);
#pragma unroll
        for (int s = 0; s < 16; ++s) {
            const int ls = dir ? 15 - s : s;
            const float bre = dir ? bur[15 - s] : bur[s], bim = dir ? bui[15 - s] : bui[s];
            const float nre = lbr * hre - lbi * him + bre, nim = lbr * him + lbi * hre + bim;
            hre = nre; him = nim;
            HB[ls * 68 + lane] = pk_bf16(nre, nim);
        }
        WAVE_LDS_SYNC();
        f32x4 acc = (f32x4){0.f, 0.f, 0.f, 0.f};
#pragma unroll
        for (int kk = 0; kk < 4; ++kk) { const bf16x8 a = *(const LAS bf16x8*)(HB + fr * 68 + 16 * kk + 4 * kq); acc = __builtin_amdgcn_mfma_f32_16x16x32_bf16(a, Cf[kk], acc, 0, 0, 0); }
#pragma unroll
        for (int i = 0; i < 4; ++i) Og[(size_t)(tcur + 4 * kq + i) * 16 + fr] = (bf16_t)(pk_bf16(acc[i], 0.f) & 0xffffu);
        WAVE_LDS_SYNC();
    }
}
__device__ __forceinline__ void phase_scan(KP p, LAS unsigned char* lds, int l, int tm, int wv) {
    const int tid = tid_launder(wv), wave = __builtin_amdgcn_readfirstlane(tid >> 6);
    LAS unsigned char* Lb = lds + wave * LDS_WAVE;
    constexpr int S5_AREA = 2 * LDS_WAVE, S5_FL = NSLOT * S5_SLOT + 1024 + 4352;
    static_assert(S5_FL + 64 <= S5_AREA, "S5 LDS area");
    LAS unsigned char* ring = lds + 4 * LDS_WAVE; LAS unsigned char* scratch = ring + DN_NSLOT * DN_SLOT; volatile LAS int* flags = (volatile LAS int*)(scratch + 3072);
    static_assert(4 * LDS_WAVE + DN_NSLOT * DN_SLOT + 3072 + 64 <= 7 * LDS_WAVE, "scan LDS map");
    for (int vb = bid_launder(); vb < NVB; vb += gridDim.x) {
        if (tid == 0) { flags[0] = 0; flags[1] = 0; }
        if (tid < 3) { volatile LAS int* f5 = (volatile LAS int*)(lds + tid * S5_AREA + S5_FL); f5[0] = 0; f5[1] = 0; }
        __syncthreads();
        const int k5 = wave >> 1;
        LAS unsigned char* a5 = lds + k5 * S5_AREA; volatile LAS int* f5 = (volatile LAS int*)(a5 + S5_FL);
        if (vb < 128) {
            if (wave < 2) { if (tm & 2) { const int idx = vb;
                if (wave == 0) { if (idx & 1) scan_s5_producer<1>(p, a5, a5 + NSLOT * S5_SLOT, f5, idx, l, wv); else scan_s5_producer<0>(p, a5, a5 + NSLOT * S5_SLOT, f5, idx, l, wv); }
                else { if (idx & 1) scan_s5_consumer<1>(p, a5, a5 + NSLOT * S5_SLOT + 1024, f5, idx, l, wv); else scan_s5_consumer<0>(p, a5, a5 + NSLOT * S5_SLOT + 1024, f5, idx, l, wv); } } }
            else if (wave == 2) { if (tm & 4) { if ((vb) & 1) scan_ret_chunk<1>(p, Lb, vb, l, wv); else scan_ret_chunk<0>(p, Lb, vb, l, wv); } }
            else if (wave == 3) { if (tm & 1) { if ((vb) & 1) scan_dn_consumer<1>(p, ring, flags, vb, wv); else scan_dn_consumer<0>(p, ring, flags, vb, wv); } }
            else if (wave == 4) { if (tm & 1) { if ((vb) & 1) scan_dn_producer<1>(p, ring, scratch, flags, vb, wv); else scan_dn_producer<0>(p, ring, scratch, flags, vb, wv); } }
            else if (wave == 7) convert_moe_wave(p, Lb, l, vb, 256, wv);
        } else {
            if (wave < 6) { if (tm & 2) { const int idx = 128 + (vb - 128) * 3 + k5;
                if ((wave & 1) == 0) { if (idx & 1) scan_s5_producer<1>(p, a5, a5 + NSLOT * S5_SLOT, f5, idx, l, wv); else scan_s5_producer<0>(p, a5, a5 + NSLOT * S5_SLOT, f5, idx, l, wv); }
                else { if (idx & 1) scan_s5_consumer<1>(p, a5, a5 + NSLOT * S5_SLOT + 1024, f5, idx, l, wv); else scan_s5_consumer<0>(p, a5, a5 + NSLOT * S5_SLOT + 1024, f5, idx, l, wv); } } }
            else if (wave == 6) { if (tm & 8) { if ((vb - 128) & 1) scan_gla_chunk<1>(p, Lb, vb - 128, wv); else scan_gla_chunk<0>(p, Lb, vb - 128, wv); } }
            else convert_moe_wave(p, Lb, l, 128 + (vb - 128), 256, wv);
        }
        __syncthreads();
    }
}

__device__ __forceinline__ float gelu_tanh(float y) { const float x = 0.7978845608028654f * (y + 0.044715f * y * y * y); const float th = 1.f - 2.f / (__expf(2.f * x) + 1.f); return 0.5f * y * (1.f + th); }
__device__ __forceinline__ void phase_mixpost(KP p, LAS unsigned char* lds, int l, int wv, int mode) {
    const int tid = tid_launder(wv), lane = tid & 63, wave = tid >> 6;
    const bf16_t* P = (const bf16_t*)(p->ws + WS_P); bf16_t* MIX = (bf16_t*)(p->ws + WS_ABUF);
    LAS float* YF = (LAS float*)lds; LAS bf16_t* YB = (LAS bf16_t*)(lds + 16384);
    bf16x8 bfr[2][8];
    { const float* gw = p->in[I_GLUW] + (size_t)l * 256 * 256;
#pragma unroll
        for (int nt = 0; nt < 2; ++nt)
#pragma unroll
            for (int kk = 0; kk < 8; ++kk) { const int n = wave * 32 + nt * 16 + (lane & 15), k0 = 32 * kk + 8 * (lane >> 4); u32x4 w;
#pragma unroll
                for (int j = 0; j < 4; ++j) w[j] = pk_bf16(gw[(size_t)(k0 + 2 * j) * 256 + n], gw[(size_t)(k0 + 2 * j + 1) * 256 + n]);
                bfr[nt][kk] = __builtin_bit_cast(bf16x8, w); } }
    const float* s5d = p->in[I_S5D] + l * 256; const float* glub = p->in[I_GLUB] + l * 256;
    for (int vb = bid_launder(); vb < NVB; vb += gridDim.x) {
        const int l32 = lane & 31, tkb = tid >> 5, c8 = (tid & 31) * 8, tkh = wave * 2 + (lane >> 5);
        unsigned nrf[12], nrb[12], nrg[12]; u32x4 nyf, nyb, nuu;
#define MX_LOADS(TILE) do { const int m0_ = vb * 144 + (TILE) * 16, tb0_ = (vb & 15) * 144 + (TILE) * 16; \
            const size_t offt = (size_t)(m0_ + tkh) * 256 + 2 * l32;                                                \
            const size_t ooft = ((size_t)((vb >> 4) * 16 + (l32 >> 3)) * TT + (size_t)(tb0_ + tkh)) * 16 + ((2 * l32) & 15);     \
            _Pragma("unroll") for (int ps = 0; ps < 12; ++ps) { const int mixer = ps >> 2, head = ps & 3; \
                const int ob = mixer == 0 ? 0 : (mixer == 1 ? 2 : 4), gp = mixer == 0 ? 2 : (mixer == 1 ? 6 : 11); \
                nrf[ps] = *(const unsigned*)(obuf(p->ws, ob) + ooft + (size_t)head * 4 * TT * 16); nrb[ps] = *(const unsigned*)(obuf(p->ws, ob + 1) + ooft + (size_t)head * 4 * TT * 16); \
                nrg[ps] = *(const unsigned*)(P + (size_t)gp * PANEL_EL + offt + head * 64); } \
            { const size_t offb = (size_t)(m0_ + tkb) * 256 + c8; const size_t yoff = ((size_t)((vb >> 4) * 16 + (c8 >> 4)) * TT + (size_t)(tb0_ + tkb)) * 16 + (c8 & 15); \
                nyf = *(const u32x4*)(obuf(p->ws, 6) + yoff); nyb = *(const u32x4*)(obuf(p->ws, 7) + yoff); nuu = *(const u32x4*)(P + (size_t)7 * PANEL_EL + offb); } } while (0)
        MX_LOADS(0);
        for (int tile = 0; tile < 9; ++tile) {
            const int m0 = vb * 144 + tile * 16;
            unsigned rfv[12], rbv[12], rgv[12];
#pragma unroll
            for (int ps = 0; ps < 12; ++ps) { rfv[ps] = nrf[ps]; rbv[ps] = nrb[ps]; rgv[ps] = nrg[ps]; }
            const u32x4 yf = nyf, yb = nyb, uu = nuu;
            if (tile + 1 < 9) MX_LOADS(tile + 1);
            if (mode & 1)
#pragma unroll
            for (int ps = 0; ps < 12; ++ps) {
                const int tk = tkh, mixer = ps >> 2, head = ps & 3;
                float o0 = bflo(rfv[ps]) + bflo(rbv[ps]), o1 = bfhi(rfv[ps]) + bfhi(rbv[ps]);
                if (mixer == 1) { const float mean = half_sum32(o0 + o1) * (1.f / 64.f); o0 -= mean; o1 -= mean; }
                const float var = half_sum32(o0 * o0 + o1 * o1) * (1.f / 64.f);
                const float rn = rsqrtf(var + EPS);
                o0 = o0 * rn * siluf_(bflo(rgv[ps])); o1 = o1 * rn * siluf_(bfhi(rgv[ps]));
                *(unsigned*)(MIX + (size_t)(m0 + tk) * 1024 + (mixer == 2 ? 768 : mixer * 256) + head * 64 + 2 * l32) = pk_bf16(o0, o1);
            }
            if (mode & 2) { const int tk = tkb;
                const f32x4 d0 = *(const f32x4*)(s5d + c8), d1 = *(const f32x4*)(s5d + c8 + 4);
                float y[8];
#pragma unroll
                for (int q = 0; q < 4; ++q) { y[2 * q] = bflo(yf[q]) + bflo(yb[q]) + (q < 2 ? d0[2 * q] : d1[2 * q - 4]) * bflo(uu[q]); y[2 * q + 1] = bfhi(yf[q]) + bfhi(yb[q]) + (q < 2 ? d0[2 * q + 1] : d1[2 * q - 3]) * bfhi(uu[q]); }
#pragma unroll
                for (int q = 0; q < 8; ++q) y[q] = gelu_tanh(y[q]);
                *(LAS f32x4*)(YF + tk * 256 + c8) = (f32x4){y[0], y[1], y[2], y[3]}; *(LAS f32x4*)(YF + tk * 256 + c8 + 4) = (f32x4){y[4], y[5], y[6], y[7]};
                *(LAS u32x4*)(YB + tk * 264 + c8) = (u32x4){pk_bf16(y[0], y[1]), pk_bf16(y[2], y[3]), pk_bf16(y[4], y[5]), pk_bf16(y[6], y[7])}; }
            LDS_BARRIER();
            if (mode & 2)
#pragma unroll
            for (int nt = 0; nt < 2; ++nt) { f32x4 acc = (f32x4){0.f, 0.f, 0.f, 0.f};
#pragma unroll
                for (int kk = 0; kk < 8; ++kk) { const bf16x8 a = *(const LAS bf16x8*)(YB + (lane & 15) * 264 + 32 * kk + 8 * (lane >> 4)); acc = __builtin_amdgcn_mfma_f32_16x16x32_bf16(a, bfr[nt][kk], acc, 0, 0, 0); }
                const int n = wave * 32 + nt * 16 + (lane & 15); const float gb = glub[n];
#pragma unroll
                for (int i = 0; i < 4; ++i) { const int tk = 4 * (lane >> 4) + i; const float yv = YF[tk * 256 + n];
                    MIX[(size_t)(m0 + tk) * 1024 + 512 + n] = (bf16_t)(pk_bf16(yv * sigmoidf_(acc[i] + gb), 0.f) & 0xffffu); } }
            LDS_BARRIER();
        }
#undef MX_LOADS
    }
}

__device__ __forceinline__ void phase_final(KP p, int wv) {
    const int tid = tid_launder(wv), lane = tid & 63, gw = bid_launder() * 8 + (tid >> 6), nw = gridDim.x * 8;
    const float* g = p->in[I_FNG];
    const bool poison = xb_ld((unsigned*)(p->ws + WS_CTL) + XB_TMO) != 0u;
    f32x4 xn[4];
    if (gw < NB * SEQ) {
#pragma unroll
        for (int j = 0; j < 4; ++j) xn[j] = *(const f32x4*)(p->out + (size_t)gw * D + 4 * lane + 256 * j); }
    for (int r = gw; r < NB * SEQ; r += nw) {
        float* xr = p->out + (size_t)r * D;
        f32x4 xv[4]; float ss = 0.f;
#pragma unroll
        for (int j = 0; j < 4; ++j) { xv[j] = xn[j]; ss += xv[j][0] * xv[j][0] + xv[j][1] * xv[j][1] + xv[j][2] * xv[j][2] + xv[j][3] * xv[j][3]; }
        if (r + nw < NB * SEQ) {
#pragma unroll
            for (int j = 0; j < 4; ++j) xn[j] = *(const f32x4*)(p->out + (size_t)(r + nw) * D + 4 * lane + 256 * j); }
        ss = wave_sum(ss);
        const float rstd = rsqrtf(ss * (1.f / 1024.f) + EPS);
#pragma unroll
        for (int j = 0; j < 4; ++j) { const f32x4 gv = *(const f32x4*)(g + 4 * lane + 256 * j); *(f32x4*)(xr + 4 * lane + 256 * j) = poison ? (f32x4){NAN, NAN, NAN, NAN} : xv[j] * rstd * gv; }
    }
}

__global__ void __launch_bounds__(512, 2) fwd_kernel(Params parg) {
    KP p = (KP)__builtin_amdgcn_kernarg_segment_ptr();
    extern __shared__ __attribute__((aligned(16))) unsigned char lds_raw[];
    LAS unsigned char* lds = (LAS unsigned char*)lds_raw;
    const int wv = __builtin_amdgcn_readfirstlane((int)threadIdx.x >> 6);
    if (tid_launder(wv) == 0) *(LAS u32x4*)(lds + LDS_BAR_OFF) = (u32x4){0u, 0u, 0u, 0u};
    __syncthreads();
    const unsigned bar_x = xcd_barrier_post((unsigned*)(p->ws + WS_CTL), (volatile LAS unsigned*)(lds + LDS_BAR_OFF), tid_launder(wv)).x;
#define NEXT_PHASE() do { p = kp_launder(p); XcdBarrier bb_; { unsigned* bp_ = (unsigned*)(p->ws + WS_CTL); asm volatile("" : "+s"(bp_)); unsigned bx_ = bar_x; asm volatile("" : "+s"(bx_)); \
        unsigned lo_ = LDS_BAR_OFF; asm volatile("" : "+s"(lo_)); bb_.bar = bp_; bb_.x = bx_; bb_.st = (volatile LAS unsigned*)(lds + lo_); } xcd_barrier(bb_, tid_launder(wv)); p = kp_launder(p); } while (0)
#define REP(bit) for (int rep_ = ((REPEAT_MASK) & (bit)) ? 1 : 0; rep_ >= 0; --rep_)
    REP(1) { phase_prologue(p, lds, wv); NEXT_PHASE(); }
    for (int xb_ = 0; xb_ < EXTRA_BARRIERS; ++xb_) NEXT_PHASE();
    for (int l = 0; l < 2; ++l) {
        const int last = l == 1;
        REP(2) { phase_prep<false>(p, lds, l, l == 0 ? p->in[I_X] : p->out, l == 0 ? p->in[I_CTX] : (const float*)(p->ws + WS_Z), 0, wv);
            NEXT_PHASE(); }
        REP(4) { Dsc1 S{(const bf16_t*)(p->ws + WS_ABUF), (const bf16_t*)(p->ws + WS_WIN) + (size_t)l * NWIN * 1024, (bf16_t*)(p->ws + WS_P), (int)gridDim.x, bid_launder()}; pg8::gemm_phase(lds, S, wv); NEXT_PHASE(); }
        REP(8) { phase_mixprep(p, l, 1, wv); NEXT_PHASE(); }
        REP(16) { phase_scan(p, lds, l, rep_ ? SCAN_PROBE : 15, wv); NEXT_PHASE(); }
        REP(32) { phase_mixpost(p, lds, l, wv, rep_ ? MIXPOST_PROBE : 3); NEXT_PHASE(); }
        REP(64) { Dsc2 S{(const bf16_t*)(p->ws + WS_ABUF), (const bf16_t*)(p->ws + WS_WOUT) + (size_t)l * 1024 * 1024, l == 0 ? p->in[I_X] : p->out, l == 0 ? p->in[I_CTX] : (const float*)(p->ws + WS_Z),
                          p->out, (float*)(p->ws + WS_Z), (const float*)(p->ws + WS_MOD) + (size_t)l * 17 * 6144, (int)gridDim.x, bid_launder(), last, rep_}; pg8::gemm_phase(lds, S, wv); NEXT_PHASE(); }
        REP(128) { phase_prep<true>(p, lds, l, p->out, (const float*)(p->ws + WS_Z), last, wv); NEXT_PHASE(); }
        REP(256) { phase_moe_offsets(p, lds, last, wv); NEXT_PHASE(); }
        REP(512) { const int ntl = __builtin_amdgcn_readfirstlane(((const int*)(p->ws + WS_TILE))[0]);
            Dsc3 S{(const bf16_t*)(p->ws + WS_ABUF), (const bf16_t*)(p->ws + WS_WGU), (bf16_t*)(p->ws + WS_P), (const int*)(p->ws + WS_LIST), (const float*)(p->ws + WS_SLOTW), (const int*)(p->ws + WS_TILE), (int)gridDim.x, bid_launder(), ntl, nullptr}; pg8::gemm_phase(lds, S, wv); NEXT_PHASE(); }
        REP(1024) { const int ntl = __builtin_amdgcn_readfirstlane(((const int*)(p->ws + WS_TILE))[0]);
            Dsc4 S{(const bf16_t*)(p->ws + WS_P), (const bf16_t*)(p->ws + WS_WDN), p->out, (float*)(p->ws + WS_Z), (const float*)(p->ws + WS_MOD) + (size_t)l * 17 * 6144, (const int*)(p->ws + WS_LIST), (const int*)(p->ws + WS_TILE), (int)gridDim.x, bid_launder(), ntl, rep_, nullptr}; pg8::gemm_phase(lds, S, wv); NEXT_PHASE(); }
    }
#undef REP
    if (PHASE_MASK & 2048) phase_final(p, wv);
#undef NEXT_PHASE
}

extern "C" void kernel_launch(void* const* d_in, const int* in_sizes, int n_in, void* d_out, int out_size, void* d_ws, size_t ws_size, hipStream_t stream) {
    static int grid = 0;
    if (grid == 0) {
        if (n_in != 31 || out_size != NB * SEQ * D || ws_size < WS_END) { fprintf(stderr, "kernel_launch: unexpected problem shape (n_in %d, out %d, ws %zu)\n", n_in, out_size, ws_size); grid = -1; return; }
        int dev = 0, cus = 0, per_cu = 0;
        if (hipGetDevice(&dev) != hipSuccess || hipDeviceGetAttribute(&cus, hipDeviceAttributeMultiprocessorCount, dev) != hipSuccess) { grid = -1; return; }
        if (hipFuncSetAttribute((const void*)fwd_kernel, hipFuncAttributeMaxDynamicSharedMemorySize, LDS_BYTES) != hipSuccess) { fprintf(stderr, "kernel_launch: hipFuncSetAttribute failed\n"); grid = -1; return; }
        if (hipOccupancyMaxActiveBlocksPerMultiprocessor(&per_cu, (const void*)fwd_kernel, 512, LDS_BYTES) != hipSuccess || per_cu < 1) fprintf(stderr, "kernel_launch: occupancy query reports %d\n", per_cu);
        (void)hipGetLastError();
        grid = cus > 256 ? 256 : cus;
    }
    if (grid < 0) return;
    (void)hipMemsetAsync((char*)d_ws + WS_CTL, 0, 65536, stream);
    Params p{};
    for (int i = 0; i < 31; ++i) p.in[i] = (const float*)d_in[i];
    p.out = (float*)d_out; p.ws = (unsigned char*)d_ws;
    hipLaunchKernelGGL(fwd_kernel, dim3(grid), dim3(512), LDS_BYTES, stream, p);
}
```

```cpp
#include <hip/hip_runtime.h>
#include <cstdio>
#include <cstdint>

#define LAS __attribute__((address_space(3)))
typedef unsigned short bf16_t;
typedef short bf16x8 __attribute__((ext_vector_type(8)));
typedef float f32x4 __attribute__((ext_vector_type(4)));
typedef float f32x2 __attribute__((ext_vector_type(2)));
typedef unsigned u32x4 __attribute__((ext_vector_type(4)));
typedef unsigned u32x2 __attribute__((ext_vector_type(2)));

constexpr int D = 1024, NB = 16, SEQ = 2048, LC = 256, TT = 2304, NTOK = NB * TT;
constexpr int DIN = 3120, NWIN = 3328, NPANEL = 13, NVB = 256;
constexpr float EPS = 1e-6f;
constexpr size_t PANEL_EL = (size_t)NTOK * 256;
constexpr int MAXTILES = 168, MAXSLOT = MAXTILES * 256;

constexpr size_t WS_CTL = 0;
constexpr size_t WS_MOD = 65536;
constexpr size_t WS_Z = WS_MOD + 1048576;
constexpr size_t WS_WIN = WS_Z + (size_t)NB * LC * D * 4;
constexpr size_t WS_WOUT = WS_WIN + (size_t)2 * NWIN * D * 2;
constexpr size_t WS_WGU = WS_WOUT + (size_t)2 * D * D * 2;
constexpr size_t WS_WDN = WS_WGU + (size_t)16 * 1024 * 1024 * 2;
constexpr size_t WS_P = WS_WDN + (size_t)16 * 1024 * 512 * 2;
constexpr size_t WS_ABUF = WS_P + NPANEL * PANEL_EL * 2;
constexpr size_t WS_GDEC = WS_ABUF + (size_t)NTOK * D * 2;
constexpr size_t WS_DNAB = WS_GDEC + (size_t)NTOK * 256 * 4;
constexpr size_t WS_O = WS_DNAB + (size_t)NTOK * 16 * 4;
constexpr size_t WS_ROUTE = WS_O + 4 * PANEL_EL * 2;
constexpr size_t WS_HIST = WS_ROUTE + (size_t)NTOK * 16;
constexpr size_t WS_LIST = WS_HIST + 256 * 32 * 4;
constexpr size_t WS_SLOTW = WS_LIST + 196608;
constexpr size_t WS_TILE = WS_SLOTW + 393216;
constexpr size_t WS_SMALL = WS_TILE + 4096;
constexpr size_t WS_RB8 = WS_SMALL + (size_t)NTOK * 64 * 2;
constexpr size_t WS_END = WS_RB8 + 65536;
static_assert(WS_END <= (size_t)512 * 1024 * 1024, "workspace");
static_assert((size_t)MAXSLOT * 4 <= 196608 && (size_t)MAXSLOT * 8 <= 393216 && (size_t)MAXSLOT * D * 2 <= NPANEL * PANEL_EL * 2, "moe buffers");

constexpr int LDS_WAVE = 18432;
constexpr int LDS_BAR_OFF = 8 * LDS_WAVE;
constexpr int LDS_BYTES = LDS_BAR_OFF + 256;

#ifndef SCAN_PROBE
#define SCAN_PROBE 15
#endif
#ifndef EXTRA_BARRIERS
#define EXTRA_BARRIERS 0
#endif
#ifndef MIXPOST_PROBE
#define MIXPOST_PROBE 3
#endif
#ifndef REPEAT_MASK
#define REPEAT_MASK 0
#endif
#ifndef PHASE_MASK
#define PHASE_MASK 0xFFFF
#endif
struct Params { const float* in[31]; float* out; unsigned char* ws; };
typedef const Params __attribute__((address_space(4)))* KP;
__device__ __forceinline__ KP kp_launder(KP p) { asm volatile("" : "+s"(p)); return p; }
__device__ __forceinline__ int bid_launder() { int b = blockIdx.x; asm volatile("" : "+s"(b)); return b; }
__device__ __forceinline__ int tid_launder(int wv) { unsigned m = ~0u; asm volatile("" : "+s"(wv), "+s"(m)); int t = wv * 64 + (int)__builtin_amdgcn_mbcnt_hi(m, __builtin_amdgcn_mbcnt_lo(m, 0u)); asm volatile("" : "+v"(t)); return t; }
enum { I_X = 0, I_C, I_CTX, I_CCTX, I_WADA, I_BADA, I_NORMG, I_WIN, I_WOUT, I_GKW, I_GKB, I_RETD, I_S5LRE, I_S5LIM, I_S5DT, I_S5BRE, I_S5BIM, I_S5CRE, I_S5CIM,
       I_S5D, I_GLUW, I_GLUB, I_CONVW, I_ALOG, I_DTB, I_RW, I_RB, I_WG, I_WU, I_WD, I_FNG };

__device__ __forceinline__ float bf2f(unsigned v) { return __uint_as_float(v << 16); }
__device__ __forceinline__ float bflo(unsigned v) { return __uint_as_float(v << 16); }
__device__ __forceinline__ float bfhi(unsigned v) { return __uint_as_float(v & 0xffff0000u); }
typedef __bf16 bf16v2 __attribute__((ext_vector_type(2)));
__device__ __forceinline__ unsigned pk_bf16(float lo, float hi) { const f32x2 v = {lo, hi}; return __builtin_bit_cast(unsigned, __builtin_convertvector(v, bf16v2)); }
__device__ __forceinline__ float sigmoidf_(float x) { return 1.f / (1.f + __expf(-x)); }
__device__ __forceinline__ float siluf_(float x) { return x / (1.f + __expf(-x)); }
__device__ __forceinline__ float softplusf_(float x) { return fmaxf(x, 0.f) + log1pf(__expf(-fabsf(x))); }
__device__ __forceinline__ float dpp_row_sum16(float v) {
    v += __builtin_bit_cast(float, __builtin_amdgcn_update_dpp(0, __builtin_bit_cast(int, v), 0xB1, 0xF, 0xF, true));
    v += __builtin_bit_cast(float, __builtin_amdgcn_update_dpp(0, __builtin_bit_cast(int, v), 0x4E, 0xF, 0xF, true));
    v += __builtin_bit_cast(float, __builtin_amdgcn_update_dpp(0, __builtin_bit_cast(int, v), 0x141, 0xF, 0xF, true));
    v += __builtin_bit_cast(float, __builtin_amdgcn_update_dpp(0, __builtin_bit_cast(int, v), 0x140, 0xF, 0xF, true));
    return v;
}
__device__ __forceinline__ float wave_sum(float v) {
    v = dpp_row_sum16(v); v += __shfl_xor(v, 16, 64); v += __shfl_xor(v, 32, 64);
    return v;
}
__device__ __forceinline__ float half_sum32(float v) {
    v = dpp_row_sum16(v); v += __shfl_xor(v, 16, 64);
    return v;
}
__device__ __forceinline__ float quad_sum(float v) {
    v += __builtin_bit_cast(float, __builtin_amdgcn_update_dpp(0, __builtin_bit_cast(int, v), 0xB1, 0xF, 0xF, true));
    v += __builtin_bit_cast(float, __builtin_amdgcn_update_dpp(0, __builtin_bit_cast(int, v), 0x4E, 0xF, 0xF, true));
    return v;
}
#define WAVE_LDS_SYNC() asm volatile("s_waitcnt lgkmcnt(0)" ::: "memory")
#define LDS_BARRIER() asm volatile("s_waitcnt lgkmcnt(0)\n\ts_barrier" ::: "memory")
__device__ __forceinline__ const float* res_row_c(const float* lat, const float* ctx, int m) { const int b = m / TT, t = m - b * TT; return t < LC ? ctx + (size_t)(b * LC + t) * D : lat + (size_t)(b * SEQ + t - LC) * D; }
__device__ __forceinline__ float* res_row(float* lat, float* ctx, int m) { const int b = m / TT, t = m - b * TT; return t < LC ? ctx + (size_t)(b * LC + t) * D : lat + (size_t)(b * SEQ + t - LC) * D; }

#define XB_TMO      128
#define XB_XCNT(j)  (256  + 64 * (j))
#define XB_XSUB(j)  (1280 + 64 * (j))
#define XB_XGEN(j)  (2304 + 64 * (j))
#define XB_TOP      3328
#define XB_TOPGEN   3392
#define XCD_BAR_WORDS 3456
#define XB_SPIN_CAP (1u << 18)

__device__ __forceinline__ unsigned xb_ld(unsigned* p)              { return __hip_atomic_load(p, __ATOMIC_RELAXED, __HIP_MEMORY_SCOPE_AGENT); }
__device__ __forceinline__ unsigned xb_add(unsigned* p, unsigned v) { return __hip_atomic_fetch_add(p, v, __ATOMIC_RELAXED, __HIP_MEMORY_SCOPE_AGENT); }
__device__ __forceinline__ unsigned xb_xcc_id() { return (unsigned)__builtin_amdgcn_s_getreg((3 << 11) | 20) & 0xFu; }
#define XB_SPIN(cond, bar) do { unsigned _sp = 0; while (cond) { __builtin_amdgcn_s_sleep(1); \
    if ((++_sp & 255u) == 0u) { if (xb_ld(&(bar)[XB_TMO])) break; if (_sp > XB_SPIN_CAP) { atomicAdd(&(bar)[XB_TMO], 1u); break; } } } } while (0)

struct XcdBarrier { unsigned* bar; unsigned x; volatile LAS unsigned* st; };

__device__ __forceinline__ XcdBarrier xcd_barrier_post(unsigned* bar, volatile LAS unsigned* st, int tid) {
    XcdBarrier b; b.bar = bar; b.x = xb_xcc_id(); b.st = st;
    if (tid == 0) (void)xb_add(&bar[XB_XCNT(b.x)], 1u);
    return b;
}
__device__ __forceinline__ void xcd_barrier_complete(unsigned* bar, unsigned x, unsigned& nloc, unsigned& nx) {
    const unsigned G = gridDim.x * gridDim.y * gridDim.z;
    unsigned sum, cnt, mine, sp = 0u;
    for (;;) {
        sum = 0u; cnt = 0u; mine = 0u;
#pragma unroll
        for (unsigned j = 0; j < 16; ++j) { const unsigned c = xb_ld(&bar[XB_XCNT(j)]); sum += c; cnt += (c > 0u) ? 1u : 0u; mine = (j == x) ? c : mine; }
        if (sum == G) break;
        __builtin_amdgcn_s_sleep(1);
        if ((++sp & 255u) == 0u) { if (xb_ld(&bar[XB_TMO])) break; if (sp > XB_SPIN_CAP) { atomicAdd(&bar[XB_TMO], 1u); break; } }
    }
    nloc = mine > 0u ? mine : 1u; nx = cnt > 0u ? cnt : 1u;
}
__device__ __forceinline__ void xcd_barrier(const XcdBarrier& b, int tid) {
    asm volatile("s_waitcnt vmcnt(0)" ::: "memory");
    __syncthreads();
    if (tid == 0) {
        unsigned* bar = b.bar;
        __builtin_amdgcn_s_waitcnt(0);
        unsigned nloc = b.st[0], nx = b.st[1];
        if (nloc == 0u) { xcd_barrier_complete(bar, b.x, nloc, nx); b.st[0] = nloc; b.st[1] = nx; }
        const unsigned old = xb_add(&bar[XB_XSUB(b.x)], 1u);
        const unsigned gen = old / nloc;
        if (old + 1u == (gen + 1u) * nloc) {
            __builtin_amdgcn_fence(__ATOMIC_RELEASE, "agent");
            asm volatile("s_waitcnt vmcnt(0)" ::: "memory");
            const unsigned og = xb_add(&bar[XB_TOP], 1u);
            const unsigned tg = og / nx;
            if (og + 1u == (tg + 1u) * nx) xb_add(&bar[XB_TOPGEN], 1u);
            else XB_SPIN(xb_ld(&bar[XB_TOPGEN]) == tg, bar);
            __builtin_amdgcn_fence(__ATOMIC_ACQUIRE, "agent");
            xb_add(&bar[XB_XGEN(b.x)], 1u);
            asm volatile("s_waitcnt vmcnt(0)" ::: "memory");
        } else {
            XB_SPIN(xb_ld(&bar[XB_XGEN(b.x)]) == gen, bar);
            __builtin_amdgcn_fence(__ATOMIC_ACQUIRE, "agent");
            asm volatile("s_waitcnt vmcnt(0)" ::: "memory");
        }
    }
    __syncthreads();
}

namespace pg8 {
constexpr int BM = 256, BK = 64, HALF = 128, HTB = HALF * BK * 2, STAGE_BYTES = 8 * HTB, NXCD = 8, WGM = 8;
__device__ __forceinline__ int lds_byte(int r, int c) { const int st = (r >> 4) * 2 + (c >> 5), rr = r & 15, cc = c & 31, ob = rr * 64 + cc * 2; return st * 1024 + (ob ^ (((ob >> 9) & 1) << 5)); }
__device__ __forceinline__ void stage_rc(int b, int& R, int& C) { const int st = b / 1024, sb = b % 1024, swz = sb ^ (((sb >> 9) & 1) << 5); R = (st >> 1) * 16 + swz / 64; C = (st & 1) * 32 + (swz % 64) / 2; }
__device__ __forceinline__ int perm32(int rho) { const int n = rho >> 4, i = rho & 15; return 8 * (i >> 2) + 4 * n + (i & 3); }

__device__ __forceinline__ bool static_order(int i, int G, int c, int nM, int nN, int& pm, int& pn) {
    const int nwg = nM * nN; const long L = (long)i * G + c; if (L >= nwg) return false;
    int wgid = (int)L; { const int q = nwg / NXCD, r = nwg % NXCD, xcd = wgid % NXCD, off = wgid / NXCD; wgid = (xcd < r ? xcd * (q + 1) : r * (q + 1) + (xcd - r) * q) + off; }
    const int nig = WGM * nN, gid = wgid / nig, fm = gid * WGM, gsz = (nM - fm) < WGM ? (nM - fm) : WGM;
    pm = fm + ((wgid % nig) % gsz); pn = (wgid % nig) / gsz; return true;
}

template <class DSC>
__device__ __forceinline__ void gemm_phase(LAS unsigned char* lds, const DSC& S, int wv) {
    const int tid = tid_launder(wv), wid = __builtin_amdgcn_readfirstlane(tid >> 6), lane = tid & 63, wr = wid >> 2, wc = wid & 3, fr = lane & 15, fq = lane >> 4;
    constexpr int K = DSC::K, nt = K / BK, LDB = DSC::LDB;
    int sR[2], sC[2]; unsigned voffB[2];
#pragma unroll
    for (int i = 0; i < 2; ++i) { int R, C; stage_rc(tid * 16 + i * 8192, R, C); sR[i] = R; sC[i] = C; const int Rb = DSC::PERM ? ((R & ~31) + perm32(R & 31)) : R; voffB[i] = (unsigned)(Rb * LDB + C) * 2u; }
    constexpr size_t kstep = (size_t)(BK * 2);
    constexpr size_t hstepB = (size_t)HALF * LDB * 2;
    const unsigned ldsw = (unsigned)wid * 1024u;
    const int aoff = lds_byte(wr * 64 + fr, fq * 8), boff = lds_byte(wc * 32 + fr, fq * 8);
#define PG8_SA(b, h) (((b) * 2 + (h)) * HTB)
#define PG8_SB(b, h) ((4 + (b) * 2 + (h)) * HTB)
#define PG8_STAGE(bufoff, gbase, voff) do { _Pragma("unroll") for (int _i = 0; _i < 2; ++_i) \
        __builtin_amdgcn_global_load_lds((const unsigned*)((const char*)(gbase) + (voff)[_i]), (LAS unsigned*)(lds + (bufoff) + ldsw + _i * 8192), 16, 0, 0); } while (0)
#define PG8_LDA(dst, b, h) do { _Pragma("unroll") for (int m = 0; m < 4; ++m) _Pragma("unroll") for (int k = 0; k < 2; ++k) dst[m][k] = *(const LAS bf16x8*)(lds + PG8_SA(b, h) + aoff + m * 2048 + k * 1024); } while (0)
#define PG8_LDB(dst, b, h) do { _Pragma("unroll") for (int n = 0; n < 2; ++n) _Pragma("unroll") for (int k = 0; k < 2; ++k) dst[n][k] = *(const LAS bf16x8*)(lds + PG8_SB(b, h) + boff + n * 2048 + k * 1024); } while (0)
#define PG8_MMA(ai, bj, At, Bt) do { __builtin_amdgcn_s_setprio(1); _Pragma("unroll") for (int m = 0; m < 4; ++m) _Pragma("unroll") for (int n = 0; n < 2; ++n) _Pragma("unroll") for (int k = 0; k < 2; ++k) \
        acc[ai][bj][m][n] = __builtin_amdgcn_mfma_f32_16x16x32_bf16(Bt[n][k], At[m][k], acc[ai][bj][m][n], 0, 0, 0); __builtin_amdgcn_s_setprio(0); } while (0)
#define PG8_WAIT_V(n) asm volatile("s_waitcnt vmcnt(" #n ")" ::: "memory")
#define PG8_WAIT_L(n) asm volatile("s_waitcnt lgkmcnt(" #n ")" ::: "memory")
#define PG8_BAR __builtin_amdgcn_s_barrier()
#define PG8_SCHED __builtin_amdgcn_sched_barrier(0)
    typename DSC::Unit cur, nxt; int ui = 0;
    S.begin(lds, tid);
    if (!S.next(0, cur)) return;
    f32x4 acc[2][2][4][2];
#pragma unroll
    for (int a = 0; a < 2; ++a)
#pragma unroll
        for (int b = 0; b < 2; ++b)
#pragma unroll
            for (int m = 0; m < 4; ++m)
#pragma unroll
                for (int n = 0; n < 2; ++n) acc[a][b][m][n] = (f32x4){0.f, 0.f, 0.f, 0.f};
    bf16x8 At[4][2], B0[2][2], B1[2][2];
    constexpr size_t hstepA = (size_t)HALF * 1024 * 2;
    unsigned va[2][2], vn[2][2];
#define PG8_STAGE_A(bufoff, h, gb, V) do { if constexpr (DSC::GATHER) { PG8_STAGE(bufoff, gb, V[h]); } else { PG8_STAGE(bufoff, (gb) + (h) * hstepA, V[0]); } } while (0)
    const char* cA = S.a_base(cur); S.a_off(cur, sR, sC, va);
    const char* cBl = S.b_lo(cur); const char* cBh = S.b_hi(cur);
    PG8_STAGE(PG8_SB(0, 0), cBl, voffB); PG8_STAGE_A(PG8_SA(0, 0), 0, cA, va); PG8_STAGE(PG8_SB(0, 1), cBl + hstepB, voffB); PG8_STAGE_A(PG8_SA(0, 1), 1, cA, va);
    if (wr == 1) PG8_BAR;
    PG8_WAIT_V(4); PG8_BAR;
    PG8_STAGE(PG8_SB(1, 0), cBl + kstep, voffB); PG8_STAGE_A(PG8_SA(1, 0), 0, cA + kstep, va); PG8_STAGE(PG8_SB(1, 1), cBl + hstepB + kstep, voffB);
    PG8_WAIT_V(6); PG8_BAR;
    for (;;) {
        const bool has_next = S.next(ui + 1, nxt);
        const char* nA; const char* nBl; const char* nBh;
        if (has_next) { nA = S.a_base(nxt); nBl = S.b_lo(nxt); nBh = S.b_hi(nxt); }
        else { nA = cA; nBl = cBl; nBh = cBh; }
        if constexpr (DSC::GATHER) {
#pragma unroll
            for (int h = 0; h < 2; ++h)
#pragma unroll
                for (int i = 0; i < 2; ++i) vn[h][i] = va[h][i]; }
        for (int t = 0; t < nt; t += 2) {
            const bool last = (t == nt - 2);
            if constexpr (DSC::GATHER) { if (t == nt - 4 && has_next) S.a_off(nxt, sR, sC, vn); }
            const char* a1 = cA + (size_t)(t + 1) * kstep;
            const char* a2 = last ? nA : cA + (size_t)(t + 2) * kstep;
            const char* b2 = last ? nBl : ((t + 2) < nt / 2 ? cBl : cBh) + (size_t)(t + 2) * kstep;
            const char* a3 = a2 + kstep; const char* b3 = b2 + kstep;
            unsigned vs[2][2];
#pragma unroll
            for (int h = 0; h < 2; ++h)
#pragma unroll
                for (int i = 0; i < 2; ++i) vs[h][i] = (DSC::GATHER && last) ? vn[h][i] : va[h][i];
            PG8_LDB(B0, 0, 0); PG8_SCHED; PG8_LDA(At, 0, 0); PG8_STAGE_A(PG8_SA(1, 1), 1, a1, va);
            PG8_WAIT_L(8); PG8_BAR; PG8_WAIT_L(0); PG8_MMA(0, 0, At, B0); PG8_BAR; PG8_SCHED;
            PG8_LDB(B1, 0, 1); PG8_STAGE(PG8_SB(0, 0), b2, voffB);
            PG8_BAR; PG8_WAIT_L(0); PG8_MMA(0, 1, At, B1); PG8_BAR;
            PG8_LDA(At, 0, 1); PG8_STAGE_A(PG8_SA(0, 0), 0, a2, vs);
            PG8_BAR; PG8_WAIT_L(0); PG8_MMA(1, 0, At, B0); PG8_BAR; PG8_SCHED;
            PG8_STAGE(PG8_SB(0, 1), b2 + hstepB, voffB);
            PG8_WAIT_V(6); PG8_BAR; PG8_MMA(1, 1, At, B1); PG8_BAR;
            PG8_LDB(B0, 1, 0); PG8_SCHED; PG8_LDA(At, 1, 0); PG8_STAGE_A(PG8_SA(0, 1), 1, a2, vs);
            PG8_WAIT_L(8); PG8_BAR; PG8_WAIT_L(0); PG8_MMA(0, 0, At, B0); PG8_BAR; PG8_SCHED;
            PG8_LDB(B1, 1, 1); PG8_STAGE(PG8_SB(1, 0), b3, voffB);
            PG8_BAR; PG8_WAIT_L(0); PG8_MMA(0, 1, At, B1); PG8_BAR;
            PG8_LDA(At, 1, 1); PG8_STAGE_A(PG8_SA(1, 0), 0, a3, vs);
            PG8_BAR; PG8_WAIT_L(0); PG8_MMA(1, 0, At, B0); PG8_BAR; PG8_SCHED;
            PG8_STAGE(PG8_SB(1, 1), b3 + hstepB, voffB);
            PG8_WAIT_V(6); PG8_BAR; PG8_MMA(1, 1, At, B1); PG8_BAR;
        }
        S.epi(acc, cur, wr, wc, fr, fq);
        if (!has_next) break;
#pragma unroll
        for (int a = 0; a < 2; ++a)
#pragma unroll
            for (int b = 0; b < 2; ++b)
#pragma unroll
                for (int m = 0; m < 4; ++m)
#pragma unroll
                    for (int n = 0; n < 2; ++n) acc[a][b][m][n] = (f32x4){0.f, 0.f, 0.f, 0.f};
        cur = nxt; cA = nA; cBl = nBl; cBh = nBh; ++ui;
        if constexpr (DSC::GATHER) {
#pragma unroll
            for (int h = 0; h < 2; ++h)
#pragma unroll
                for (int i = 0; i < 2; ++i) va[h][i] = vn[h][i]; }
    }
    PG8_WAIT_V(0);
    if (wr == 0) PG8_BAR;
    PG8_BAR;
#undef PG8_SA
#undef PG8_SB
#undef PG8_STAGE
#undef PG8_STAGE_A
#undef PG8_LDA
#undef PG8_LDB
#undef PG8_MMA
#undef PG8_WAIT_V
#undef PG8_WAIT_L
#undef PG8_BAR
#undef PG8_SCHED
}
}

__device__ __forceinline__ void std_a_off(const int (&sR)[2], const int (&sC)[2], unsigned (&v)[2][2]) {
#pragma unroll
    for (int h = 0; h < 2; ++h)
#pragma unroll
        for (int i = 0; i < 2; ++i) v[h][i] = (unsigned)((sR[i] + 128 * h) * 1024 + sC[i]) * 2u;
}
struct Dsc1 {
    static constexpr int K = 1024, LDB = 1024; static constexpr bool PERM = true, GATHER = false;
    struct Unit { int pm, pn; };
    const bf16_t* A; const bf16_t* Bt; bf16_t* P; int G, c;
    __device__ __forceinline__ void begin(LAS unsigned char*, int) const {}
    __device__ __forceinline__ bool next(int i, Unit& u) const { return pg8::static_order(i, G, c, NTOK / 256, 12, u.pm, u.pn); }
    __device__ __forceinline__ const char* a_base(const Unit& u) const { return (const char*)A + (size_t)u.pm * 256 * 1024 * 2; }
    __device__ __forceinline__ void a_off(const Unit&, const int (&sR)[2], const int (&sC)[2], unsigned (&v)[2][2]) const { std_a_off(sR, sC, v); }
    __device__ __forceinline__ const char* b_lo(const Unit& u) const { return (const char*)Bt + (size_t)u.pn * 256 * 1024 * 2; }
    __device__ __forceinline__ const char* b_hi(const Unit& u) const { return b_lo(u); }
    __device__ __forceinline__ void epi(const f32x4 (&acc)[2][2][4][2], const Unit& u, int wr, int wc, int fr, int fq) const {
        bf16_t* base = P + (size_t)u.pn * PANEL_EL + (size_t)(u.pm * 256 + wr * 64 + fr) * 256 + wc * 32 + 8 * fq;
        const bool rope = (u.pn == 3 || u.pn == 4) && (u.pm % 9) != 0;
        float invf[2][4]; bool byrow[2][4];
#pragma unroll
        for (int bj = 0; bj < 2; ++bj)
#pragma unroll
            for (int j = 0; j < 4; ++j) { const int col = bj * 128 + wc * 32 + 8 * fq + 2 * j, i = (col & 63) >> 1; invf[bj][j] = exp2f(-(float)(i & 15) * (13.287712379549449f / 16.f)); byrow[bj][j] = i < 16; }
#pragma unroll
        for (int ai = 0; ai < 2; ++ai)
#pragma unroll
            for (int m = 0; m < 4; ++m) { bf16_t* rowp = base + (size_t)(ai * 128 + m * 16) * 256;
                const int pos = ((u.pm % 9) - 1) * 256 + wr * 64 + fr + ai * 128 + m * 16;
#pragma unroll
                for (int bj = 0; bj < 2; ++bj) { f32x4 v0 = acc[ai][bj][m][0], v1 = acc[ai][bj][m][1];
                    if (rope) { float x[8] = {v0[0], v0[1], v0[2], v0[3], v1[0], v1[1], v1[2], v1[3]};
#pragma unroll
                        for (int j = 0; j < 4; ++j) { const float ang = (float)(byrow[bj][j] ? (pos >> 6) : (pos & 63)) * invf[bj][j]; const float sn = __sinf(ang), cs = __cosf(ang);
                            const float t1 = x[2 * j], t2 = x[2 * j + 1]; x[2 * j] = t1 * cs - t2 * sn; x[2 * j + 1] = t1 * sn + t2 * cs; }
                        v0 = (f32x4){x[0], x[1], x[2], x[3]}; v1 = (f32x4){x[4], x[5], x[6], x[7]}; }
                    *(u32x4*)(rowp + bj * 128) = (u32x4){pk_bf16(v0[0], v0[1]), pk_bf16(v0[2], v0[3]), pk_bf16(v1[0], v1[1]), pk_bf16(v1[2], v1[3])}; } }
    }
};
struct Dsc2 {
    static constexpr int K = 1024, LDB = 1024; static constexpr bool PERM = false, GATHER = false;
    struct Unit { int pm, pn; };
    const bf16_t* A; const bf16_t* Bt; const float* lat_in; const float* ctx_in; float* lat_out; float* ctx_out; const float* mod; int G, c, last, dry;
    __device__ __forceinline__ void begin(LAS unsigned char*, int) const {}
    __device__ __forceinline__ bool next(int i, Unit& u) const {
        int pm, pn; if (!pg8::static_order(i, G, c, last ? 128 : 144, 4, pm, pn)) return false;
        u.pm = last ? (pm >> 3) * 9 + 1 + (pm & 7) : pm; u.pn = pn; return true; }
    __device__ __forceinline__ const char* a_base(const Unit& u) const { return (const char*)A + (size_t)u.pm * 256 * 1024 * 2; }
    __device__ __forceinline__ void a_off(const Unit&, const int (&sR)[2], const int (&sC)[2], unsigned (&v)[2][2]) const { std_a_off(sR, sC, v); }
    __device__ __forceinline__ const char* b_lo(const Unit& u) const { return (const char*)Bt + (size_t)u.pn * 256 * 1024 * 2; }
    __device__ __forceinline__ const char* b_hi(const Unit& u) const { return b_lo(u); }
    __device__ __forceinline__ void epi(const f32x4 (&acc)[2][2][4][2], const Unit& u, int wr, int wc, int fr, int fq) const {
        const int b = u.pm / 9, pp = u.pm - b * 9;
        const size_t ro = pp == 0 ? (size_t)b * LC * D : ((size_t)b * SEQ + (size_t)(pp - 1) * 256) * D;
        const float* inb = (pp == 0 ? ctx_in : lat_in) + ro; float* outb = (pp == 0 ? ctx_out : lat_out) + ro;
        const int col0 = u.pn * 256 + wc * 32 + 4 * fq, row0 = wr * 64 + fr;
        const float* gate = mod + (size_t)(pp == 0 ? 16 : b) * 6144 + 2 * 1024 + col0;
        f32x4 gv[2][2];
#pragma unroll
        for (int bj = 0; bj < 2; ++bj)
#pragma unroll
            for (int n = 0; n < 2; ++n) gv[bj][n] = *(const f32x4*)(gate + bj * 128 + n * 16);
#pragma unroll
        for (int ai = 0; ai < 2; ++ai)
#pragma unroll
            for (int m = 0; m < 4; ++m) { const size_t o = (size_t)(row0 + ai * 128 + m * 16) * D + col0;
#pragma unroll
                for (int bj = 0; bj < 2; ++bj)
#pragma unroll
                    for (int n = 0; n < 2; ++n) { const f32x4 x = *(const f32x4*)(inb + o + bj * 128 + n * 16);
                        if (!dry) *(f32x4*)(outb + o + bj * 128 + n * 16) = x + gv[bj][n] * acc[ai][bj][m][n]; else asm volatile("" :: "v"(x + gv[bj][n] * acc[ai][bj][m][n])); } }
    }
};
__device__ __forceinline__ void bucket_experts(int bk, int& elo, int& ehi) {
    const int gr = bk / 6, pr = bk - gr * 6;
    const int i = pr < 3 ? 0 : (pr < 5 ? 1 : 2), j = pr < 3 ? pr + 1 : (pr < 5 ? pr - 1 : 3);
    elo = gr * 4 + i; ehi = gr * 4 + j;
}
struct Dsc3 {
    static constexpr int K = 1024, LDB = 1024; static constexpr bool PERM = true, GATHER = true;
    struct Unit { int ti, pn, elo, ehi; };
    const bf16_t* A; const bf16_t* Wgu; bf16_t* ACT; const int* list; const float* slotw; const int* tile; int G, c, nt_; mutable LAS int* tbl;
    __device__ __forceinline__ void begin(LAS unsigned char* lds, int tid) const { LAS int* tb = (LAS int*)(lds + pg8::STAGE_BYTES); if (tid < MAXTILES) tb[tid] = tid < nt_ ? tile[8 + tid] : 0; __syncthreads(); tbl = tb; }
    __device__ __forceinline__ bool next(int i, Unit& u) const {
        if (!pg8::static_order(i, G, c, nt_, 8, u.ti, u.pn)) return false;
        const int bk = __builtin_amdgcn_readfirstlane(tbl[u.ti]); bucket_experts(bk, u.elo, u.ehi); return true; }
    __device__ __forceinline__ const char* a_base(const Unit&) const { return (const char*)A; }
    __device__ __forceinline__ void a_off(const Unit& u, const int (&sR)[2], const int (&sC)[2], unsigned (&v)[2][2]) const {
#pragma unroll
        for (int h = 0; h < 2; ++h)
#pragma unroll
            for (int i = 0; i < 2; ++i) { int tok = list[u.ti * 256 + sR[i] + 128 * h]; tok = tok < 0 ? 0 : tok; v[h][i] = (unsigned)(tok * 1024 + sC[i]) * 2u; }
    }
    __device__ __forceinline__ const char* b_lo(const Unit& u) const { const int e = u.pn < 4 ? u.elo : u.ehi; return (const char*)Wgu + ((size_t)e * 1024 + (size_t)(u.pn & 3) * 256) * 1024 * 2; }
    __device__ __forceinline__ const char* b_hi(const Unit& u) const { return b_lo(u); }
    __device__ __forceinline__ void epi(const f32x4 (&acc)[2][2][4][2], const Unit& u, int wr, int wc, int fr, int fq) const {
        const int slot0 = u.ti * 256 + wr * 64 + fr, wsel = u.pn < 4 ? 0 : 1;
        bf16_t* base = ACT + (size_t)slot0 * 1024 + (u.pn < 4 ? 0 : 512) + (u.pn & 3) * 128 + wc * 32 + 8 * fq;
#pragma unroll
        for (int ai = 0; ai < 2; ++ai)
#pragma unroll
            for (int m = 0; m < 4; ++m) { const int dr = ai * 128 + m * 16; const float w = slotw[(size_t)(slot0 + dr) * 2 + wsel];
                const f32x4 g0 = acc[ai][0][m][0], g1 = acc[ai][0][m][1], u0 = acc[ai][1][m][0], u1 = acc[ai][1][m][1];
                float r[8];
#pragma unroll
                for (int q = 0; q < 4; ++q) { r[q] = w * siluf_(g0[q]) * u0[q]; r[4 + q] = w * siluf_(g1[q]) * u1[q]; }
                *(u32x4*)(base + (size_t)dr * 1024) = (u32x4){pk_bf16(r[0], r[1]), pk_bf16(r[2], r[3]), pk_bf16(r[4], r[5]), pk_bf16(r[6], r[7])}; }
    }
};
struct Dsc4 {
    static constexpr int K = 1024, LDB = 512; static constexpr bool PERM = false, GATHER = false;
    struct Unit { int ti, pn, elo, ehi; };
    const bf16_t* A; const bf16_t* Wdn; float* lat; float* ctx; const float* mod; const int* list; const int* tile; int G, c, nt_, dry; mutable LAS int* tbl;
    __device__ __forceinline__ void begin(LAS unsigned char* lds, int tid) const { LAS int* tb = (LAS int*)(lds + pg8::STAGE_BYTES); if (tid < MAXTILES) tb[tid] = tid < nt_ ? tile[8 + tid] : 0; __syncthreads(); tbl = tb; }
    __device__ __forceinline__ bool next(int i, Unit& u) const {
        if (!pg8::static_order(i, G, c, nt_, 4, u.ti, u.pn)) return false;
        const int bk = __builtin_amdgcn_readfirstlane(tbl[u.ti]); bucket_experts(bk, u.elo, u.ehi); return true; }
    __device__ __forceinline__ const char* a_base(const Unit& u) const { return (const char*)A + (size_t)u.ti * 256 * 1024 * 2; }
    __device__ __forceinline__ void a_off(const Unit&, const int (&sR)[2], const int (&sC)[2], unsigned (&v)[2][2]) const { std_a_off(sR, sC, v); }
    __device__ __forceinline__ const char* b_lo(const Unit& u) const { return (const char*)Wdn + ((size_t)u.elo * 1024 + (size_t)u.pn * 256) * 512 * 2; }
    __device__ __forceinline__ const char* b_hi(const Unit& u) const { return (const char*)Wdn + ((size_t)u.ehi * 1024 + (size_t)u.pn * 256) * 512 * 2 - (size_t)(K / 128) * 128; }
    __device__ __forceinline__ void epi(const f32x4 (&acc)[2][2][4][2], const Unit& u, int wr, int wc, int fr, int fq) const {
        const int slot0 = u.ti * 256 + wr * 64 + fr, col0 = u.pn * 256 + wc * 32 + 4 * fq;
#pragma unroll
        for (int ai = 0; ai < 2; ++ai)
#pragma unroll
            for (int m = 0; m < 4; ++m) { const int tok = list[slot0 + ai * 128 + m * 16];
                if (tok >= 0) { const int b = tok / TT, t = tok - b * TT;
                    float* rp = (t < LC ? ctx + (size_t)(b * LC + t) * D : lat + (size_t)(b * SEQ + t - LC) * D) + col0;
                    const float* gate = mod + (size_t)(t < LC ? 16 : b) * 6144 + 5 * 1024 + col0;
#pragma unroll
                    for (int bj = 0; bj < 2; ++bj)
#pragma unroll
                        for (int n = 0; n < 2; ++n) { const f32x4 gv = *(const f32x4*)(gate + bj * 128 + n * 16); const f32x4 x = *(const f32x4*)(rp + bj * 128 + n * 16);
                            if (!dry) *(f32x4*)(rp + bj * 128 + n * 16) = x + gv * acc[ai][bj][m][n]; else asm volatile("" :: "v"(x + gv * acc[ai][bj][m][n])); } } }
    }
};

__device__ __forceinline__ void tr_tile(LAS float* tl, const float* src, int ld, int scol, float scale, bf16_t* dst, int lddst, int wv) {
    const int tid = tid_launder(wv), n = tid & 63, kq = tid >> 6;
#pragma unroll
    for (int i = 0; i < 8; ++i) { const int k = kq + 8 * i; tl[k * 65 + n] = scol >= 0 ? src[(size_t)k * ld + scol] * scale : 0.f; }
    __syncthreads();
    const int nn = tid >> 3, k8 = (tid & 7) * 8;
    u32x4 w;
#pragma unroll
    for (int j = 0; j < 4; ++j) w[j] = pk_bf16(tl[(k8 + 2 * j) * 65 + nn], tl[(k8 + 2 * j + 1) * 65 + nn]);
    *(u32x4*)(dst + (size_t)nn * lddst + k8) = w;
    __syncthreads();
}
__device__ __forceinline__ void convert_moe(KP p, LAS unsigned char* lds, int l, int wv) {
    LAS float* tl = (LAS float*)lds;
    bf16_t* WGU = (bf16_t*)(p->ws + WS_WGU); bf16_t* WDN = (bf16_t*)(p->ws + WS_WDN);
    const int n = tid_launder(wv) & 63;
    for (int idx = bid_launder(); idx < 4096 + 2048; idx += gridDim.x) {
        if (idx < 4096) { const int e = idx >> 8, rt = (idx >> 4) & 15, kt = idx & 15, q = rt >> 2, sub = rt & 3;
            const float* src = p->in[sub < 2 ? I_WG : I_WU] + ((size_t)(l * 16 + e) * 1024 + kt * 64) * 512;
            tr_tile(tl, src, 512, q * 128 + (sub & 1) * 64 + n, 1.f, WGU + ((size_t)e * 1024 + rt * 64) * 1024 + kt * 64, 1024, wv);
        } else { const int j = idx - 4096, e = j >> 7, ntile = (j >> 3) & 15, kt = j & 7;
            const float* src = p->in[I_WD] + ((size_t)(l * 16 + e) * 512 + kt * 64) * 1024;
            tr_tile(tl, src, 1024, ntile * 64 + n, 1.f, WDN + ((size_t)e * 1024 + ntile * 64) * 512 + kt * 64, 512, wv); }
    }
}
__device__ __forceinline__ void tr_tile_wave(LAS float* tl, const float* src, int ld, int scol4, float scale, bf16_t* dst, int lddst, int lane) {
    const int kq = lane >> 4, c4 = (lane & 15) * 4;
    f32x4 v[16];
#pragma unroll
    for (int i = 0; i < 16; ++i) v[i] = scol4 >= 0 ? *(const f32x4*)(src + (size_t)(kq + 4 * i) * ld + scol4) : (f32x4){0.f, 0.f, 0.f, 0.f};
#pragma unroll
    for (int i = 0; i < 16; ++i) { LAS float* t = tl + (kq + 4 * i) * 65 + c4; t[0] = v[i][0] * scale; t[1] = v[i][1] * scale; t[2] = v[i][2] * scale; t[3] = v[i][3] * scale; }
    WAVE_LDS_SYNC();
#pragma unroll 2
    for (int k8 = 0; k8 < 64; k8 += 8) { u32x4 w;
#pragma unroll
        for (int j = 0; j < 4; ++j) w[j] = pk_bf16(tl[(k8 + 2 * j) * 65 + lane], tl[(k8 + 2 * j + 1) * 65 + lane]);
        *(u32x4*)(dst + (size_t)lane * lddst + k8) = w; }
    WAVE_LDS_SYNC();
}
__device__ __forceinline__ void convert_moe_wave(KP p, LAS unsigned char* Lb, int l, int cvi, int ncv, int wv) {
    const int lane = tid_launder(wv) & 63;
    LAS float* tl = (LAS float*)Lb;
    bf16_t* WGU = (bf16_t*)(p->ws + WS_WGU); bf16_t* WDN = (bf16_t*)(p->ws + WS_WDN);
    for (int idx = cvi; idx < 4096 + 2048 + (l == 0 ? 832 + 256 : 0); idx += ncv) {
        if (idx >= 4096 + 2048) {
            bf16_t* WIN = (bf16_t*)(p->ws + WS_WIN); bf16_t* WOUT = (bf16_t*)(p->ws + WS_WOUT); const int r = idx - 6144;
            if (r < 832) { const int ntile = r >> 4, kt = r & 15, np = ntile * 64 + (lane & 15) * 4;
                int scol; if (np < 768) scol = np; else if (np < 3072) scol = np + 32; else { const int j = np - 3072; scol = j < 32 ? 768 + j : (j < 48 ? 3104 + (j - 32) : -1); }
                const float scale = np < 128 ? 0.17677669529663687f : ((np >= 768 && np < 1024) ? 0.125f : 1.f);
                tr_tile_wave(tl, p->in[I_WIN] + ((size_t)1024 + kt * 64) * DIN, DIN, scol, scale, WIN + ((size_t)NWIN + ntile * 64) * 1024 + kt * 64, 1024, lane);
            } else { const int j = r - 832, ntile = j >> 4, kt = j & 15;
                tr_tile_wave(tl, p->in[I_WOUT] + ((size_t)1024 + kt * 64) * 1024, 1024, ntile * 64 + (lane & 15) * 4, 1.f, WOUT + ((size_t)1024 + ntile * 64) * 1024 + kt * 64, 1024, lane); }
        } else if (idx < 4096) { const int e = idx >> 8, rt = (idx >> 4) & 15, kt = idx & 15, q = rt >> 2, sub = rt & 3;
            const float* src = p->in[sub < 2 ? I_WG : I_WU] + ((size_t)(l * 16 + e) * 1024 + kt * 64) * 512;
            tr_tile_wave(tl, src, 512, q * 128 + (sub & 1) * 64 + (lane & 15) * 4, 1.f, WGU + ((size_t)e * 1024 + rt * 64) * 1024 + kt * 64, 1024, lane);
        } else { const int j = idx - 4096, e = j >> 7, ntile = (j >> 3) & 15, kt = j & 7;
            const float* src = p->in[I_WD] + ((size_t)(l * 16 + e) * 512 + kt * 64) * 1024;
            tr_tile_wave(tl, src, 1024, ntile * 64 + (lane & 15) * 4, 1.f, WDN + ((size_t)e * 1024 + ntile * 64) * 512 + kt * 64, 512, lane); }
    }
}
__device__ __forceinline__ void phase_prologue(KP p, LAS unsigned char* lds, int wv) {
    const int tid = tid_launder(wv), lane = tid & 63, wave = tid >> 6;
    {
        LAS float* SC = (LAS float*)lds; LAS float* RED = (LAS float*)(lds + 17 * 1024 * 4);
        { float cv[34];
#pragma unroll
            for (int q = 0; q < 34; ++q) { const int i = tid + 512 * q, r = i >> 10, k = i & 1023; cv[q] = r < 16 ? p->in[I_C][r * 1024 + k] : p->in[I_CCTX][k]; }
#pragma unroll
            for (int q = 0; q < 34; ++q) SC[tid + 512 * q] = siluf_(cv[q]); }
        __syncthreads();
        float* MOD = (float*)(p->ws + WS_MOD);
        for (int unit = bid_launder(); unit < 192; unit += gridDim.x) {
            const int l = unit / 96, cg = unit - l * 96;
            const float* W = p->in[I_WADA] + (size_t)l * 1024 * 6144 + cg * 64 + lane;
            float acc[17];
#pragma unroll
            for (int r = 0; r < 17; ++r) acc[r] = 0.f;
            for (int k0 = wave * 128; k0 < wave * 128 + 128; k0 += 16) {
                float wk[16];
#pragma unroll
                for (int q = 0; q < 16; ++q) wk[q] = W[(size_t)(k0 + q) * 6144];
#pragma unroll
                for (int q4 = 0; q4 < 4; ++q4) {
#pragma unroll
                    for (int r = 0; r < 17; ++r) { const f32x4 s = *(const LAS f32x4*)(SC + r * 1024 + k0 + 4 * q4); acc[r] += s[0] * wk[4 * q4] + s[1] * wk[4 * q4 + 1] + s[2] * wk[4 * q4 + 2] + s[3] * wk[4 * q4 + 3]; }
                    asm volatile("" ::: "memory"); }
            }
#pragma unroll
            for (int r = 0; r < 17; ++r) RED[(wave * 17 + r) * 64 + lane] = acc[r];
            __syncthreads();
            for (int i = tid; i < 17 * 64; i += 512) { const int r = i >> 6, cc = i & 63; float s = 0.f;
#pragma unroll
                for (int w = 0; w < 8; ++w) s += RED[(w * 17 + r) * 64 + cc];
                MOD[(size_t)(l * 17 + r) * 6144 + cg * 64 + cc] = s + p->in[I_BADA][l * 6144 + cg * 64 + cc]; }
            __syncthreads();
        }
        __syncthreads();
    }
    {
        LAS float* tl = (LAS float*)lds;
        bf16_t* WIN = (bf16_t*)(p->ws + WS_WIN); bf16_t* WOUT = (bf16_t*)(p->ws + WS_WOUT);
        const int n = tid & 63;
        for (int idx0 = bid_launder(); idx0 < 832 + 256; idx0 += gridDim.x) {
            const int idx = idx0 < 832 ? idx0 : 1664 + (idx0 - 832);
            if (idx < 1664) { const int l = idx / 832, r = idx - l * 832, ntile = r >> 4, kt = r & 15, np = ntile * 64 + n;
                int scol; if (np < 768) scol = np; else if (np < 3072) scol = np + 32; else { const int j = np - 3072; scol = j < 32 ? 768 + j : (j < 48 ? 3104 + (j - 32) : -1); }
                const float scale = np < 128 ? 0.17677669529663687f : ((np >= 768 && np < 1024) ? 0.125f : 1.f);
                tr_tile(tl, p->in[I_WIN] + ((size_t)l * 1024 + kt * 64) * DIN, DIN, scol, scale, WIN + ((size_t)l * NWIN + ntile * 64) * 1024 + kt * 64, 1024, wv);
            } else { const int j = idx - 1664, l = j >> 8, ntile = (j >> 4) & 15, kt = j & 15;
                tr_tile(tl, p->in[I_WOUT] + ((size_t)l * 1024 + kt * 64) * 1024, 1024, ntile * 64 + n, 1.f, WOUT + ((size_t)l * 1024 + ntile * 64) * 1024 + kt * 64, 1024, wv); }
        }
    }
}

__device__ __forceinline__ void route16(const float (&lg)[16], const float* rb, int& bucket, float& wlo, float& whi) {
    float bestgs = -INFINITY, bs1 = 0.f, bs2 = 0.f; int bestg = 0, bi1 = 0, bi2 = 1;
#pragma unroll
    for (int g = 0; g < 4; ++g) {
        float sc[4], sl[4];
#pragma unroll
        for (int j = 0; j < 4; ++j) { sc[j] = sigmoidf_(lg[4 * g + j]); sl[j] = sc[j] + rb[4 * g + j]; }
        int i1 = 0; float v1 = sl[0], s1 = sc[0];
#pragma unroll
        for (int j = 1; j < 4; ++j) if (sl[j] > v1) { v1 = sl[j]; s1 = sc[j]; i1 = j; }
        int i2 = 0; float v2 = -INFINITY, s2 = 0.f;
#pragma unroll
        for (int j = 0; j < 4; ++j) if (j != i1 && sl[j] > v2) { v2 = sl[j]; s2 = sc[j]; i2 = j; }
        const float gs = v1 + v2;
        if (gs > bestgs) { bestgs = gs; bestg = g; bi1 = i1; bi2 = i2; bs1 = s1; bs2 = s2; }
    }
    const int lo = bi1 < bi2 ? bi1 : bi2, hi = bi1 < bi2 ? bi2 : bi1;
    const float slo = bi1 < bi2 ? bs1 : bs2, shi = bi1 < bi2 ? bs2 : bs1;
    const int pr = lo == 0 ? hi - 1 : (lo == 1 ? hi + 1 : 5);
    bucket = bestg * 6 + pr; const float inv = 1.f / (bs1 + bs2); wlo = slo * inv; whi = shi * inv;
}
template <bool ROUTER>
__device__ __forceinline__ void phase_prep(KP p, LAS unsigned char* lds, int l, const float* lat, const float* ctx, int latent_only, int wv) {
    const int tid = tid_launder(wv), lane = tid & 63, wave = tid >> 6, fr = lane & 15, kq = lane >> 4;
    const float* MOD = (const float*)(p->ws + WS_MOD) + (size_t)l * 17 * 6144;
    const float* g = p->in[I_NORMG] + (l * 2 + (ROUTER ? 1 : 0)) * 1024;
    bf16_t* H = (bf16_t*)(p->ws + WS_ABUF);
    constexpr int NT = ROUTER ? 1 : 3, AST = 1032;
    LAS bf16_t* AH = (LAS bf16_t*)lds; LAS bf16_t* AL = AH + 16 * AST; LAS float* PART = (LAS float*)(lds + 2 * 16 * AST * 2); LAS float* LG = PART + 8 * NT * 256; LAS int* hist = (LAS int*)(LG + 256);
    bf16x8 Bh[NT][4], Bl[4];
    if (ROUTER) {
#pragma unroll
        for (int kk = 0; kk < 4; ++kk) { const int k0 = 128 * wave + 32 * kk + 8 * kq; u32x4 wh, wl;
#pragma unroll
            for (int e = 0; e < 4; ++e) { const float w0 = p->in[I_RW][(size_t)(k0 + 2 * e) * 16 + fr], w1 = p->in[I_RW][(size_t)(k0 + 2 * e + 1) * 16 + fr];
                const unsigned hh = pk_bf16(w0, w1); wh[e] = hh; wl[e] = pk_bf16(w0 - bflo(hh), w1 - bfhi(hh)); }
            Bh[0][kk] = __builtin_bit_cast(bf16x8, wh); Bl[kk] = __builtin_bit_cast(bf16x8, wl); }
    } else {
        const bf16_t* WS_ = (const bf16_t*)(p->ws + WS_WIN) + ((size_t)l * NWIN + 3072) * 1024;
#pragma unroll
        for (int nt = 0; nt < NT; ++nt)
#pragma unroll
            for (int kk = 0; kk < 4; ++kk) { Bh[nt][kk] = *(const bf16x8*)(WS_ + (size_t)(16 * nt + fr) * 1024 + 128 * wave + 32 * kk + 8 * kq); }
#pragma unroll
        for (int kk = 0; kk < 4; ++kk) Bl[kk] = Bh[0][kk];
    }
    const int n_per = latent_only ? 128 : 144, ngrp = n_per / 16;
    for (int vb = bid_launder(); vb < NVB; vb += gridDim.x) {
        if (ROUTER) { if (tid < 32) hist[tid] = 0; }
        const int mbase = latent_only ? (vb >> 4) * TT + LC + (vb & 15) * 128 : vb * 144;
        f32x4 xn[2][4];
#pragma unroll
        for (int r = 0; r < 2; ++r) { const float* xr0 = res_row_c(lat, ctx, mbase + 2 * wave + r);
#pragma unroll
            for (int j = 0; j < 4; ++j) xn[r][j] = *(const f32x4*)(xr0 + 4 * lane + 256 * j); }
        for (int grp = 0; grp < ngrp; ++grp) {
            f32x4 xv[2][4];
#pragma unroll
            for (int r = 0; r < 2; ++r)
#pragma unroll
                for (int j = 0; j < 4; ++j) xv[r][j] = xn[r][j];
            if (grp + 1 < ngrp) {
#pragma unroll
                for (int r = 0; r < 2; ++r) { const float* xrn = res_row_c(lat, ctx, mbase + 16 * (grp + 1) + 2 * wave + r);
#pragma unroll
                    for (int j = 0; j < 4; ++j) xn[r][j] = *(const f32x4*)(xrn + 4 * lane + 256 * j); } }
#pragma unroll
            for (int r = 0; r < 2; ++r) {
                const int m = mbase + 16 * grp + 2 * wave + r, b = m / TT, t = m - b * TT, rb = t < LC ? 16 : b;
                float ss = 0.f;
#pragma unroll
                for (int j = 0; j < 4; ++j) ss += xv[r][j][0] * xv[r][j][0] + xv[r][j][1] * xv[r][j][1] + xv[r][j][2] * xv[r][j][2] + xv[r][j][3] * xv[r][j][3];
                ss = wave_sum(ss);
                const float rstd = rsqrtf(ss * (1.f / 1024.f) + EPS);
                const float* sh = MOD + (size_t)rb * 6144 + (ROUTER ? 3 : 0) * 1024; const float* sc = sh + 1024;
#pragma unroll
                for (int j = 0; j < 4; ++j) { const int idx = 4 * lane + 256 * j;
                    const f32x4 gv = *(const f32x4*)(g + idx), shv = *(const f32x4*)(sh + idx), scv = *(const f32x4*)(sc + idx);
                    const f32x4 hv = xv[r][j] * rstd * gv * (1.f + scv) + shv;
                    const unsigned h0 = pk_bf16(hv[0], hv[1]), h1 = pk_bf16(hv[2], hv[3]);
                    *(u32x2*)(H + (size_t)m * 1024 + idx) = (u32x2){h0, h1};
                    *(LAS u32x2*)(AH + (2 * wave + r) * AST + idx) = (u32x2){h0, h1};
                    if (ROUTER) *(LAS u32x2*)(AL + (2 * wave + r) * AST + idx) = (u32x2){pk_bf16(hv[0] - bflo(h0), hv[1] - bfhi(h0)), pk_bf16(hv[2] - bflo(h1), hv[3] - bfhi(h1))}; }
            }
            LDS_BARRIER();
            { f32x4 acc[NT];
#pragma unroll
                for (int nt = 0; nt < NT; ++nt) acc[nt] = (f32x4){0.f, 0.f, 0.f, 0.f};
#pragma unroll
                for (int kk = 0; kk < 4; ++kk) { const bf16x8 ah = *(const LAS bf16x8*)(AH + fr * AST + 128 * wave + 32 * kk + 8 * kq);
#pragma unroll
                    for (int nt = 0; nt < NT; ++nt) acc[nt] = __builtin_amdgcn_mfma_f32_16x16x32_bf16(ah, Bh[nt][kk], acc[nt], 0, 0, 0);
                    if (ROUTER) { const bf16x8 al = *(const LAS bf16x8*)(AL + fr * AST + 128 * wave + 32 * kk + 8 * kq);
                        acc[0] = __builtin_amdgcn_mfma_f32_16x16x32_bf16(ah, Bl[kk], acc[0], 0, 0, 0); acc[0] = __builtin_amdgcn_mfma_f32_16x16x32_bf16(al, Bh[0][kk], acc[0], 0, 0, 0); } }
#pragma unroll
                for (int nt = 0; nt < NT; ++nt)
#pragma unroll
                    for (int i = 0; i < 4; ++i) PART[(wave * NT + nt) * 256 + (4 * kq + i) * 16 + fr] = acc[nt][i]; }
            LDS_BARRIER();
            for (int e2 = tid; e2 < NT * 256; e2 += 512) { const int nt = e2 >> 8, e = e2 & 255; float sacc = 0.f;
#pragma unroll
                for (int w = 0; w < 8; ++w) sacc += PART[(w * NT + nt) * 256 + e];
                if (ROUTER) LG[e] = sacc;
                else ((bf16_t*)(p->ws + WS_SMALL))[(size_t)(mbase + 16 * grp + (e >> 4)) * 64 + 16 * nt + (e & 15)] = (bf16_t)(pk_bf16(sacc, 0.f) & 0xffffu); }
            if (ROUTER) {
                LDS_BARRIER();
                if (tid < 16) { float lg[16];
#pragma unroll
                    for (int q = 0; q < 4; ++q) { const f32x4 v = *(const LAS f32x4*)(LG + tid * 16 + 4 * q); lg[4 * q] = v[0]; lg[4 * q + 1] = v[1]; lg[4 * q + 2] = v[2]; lg[4 * q + 3] = v[3]; }
                    int bucket; float wlo, whi; route16(lg, p->in[I_RB], bucket, wlo, whi);
                    *(f32x4*)(p->ws + WS_ROUTE + (size_t)(mbase + 16 * grp + tid) * 16) = (f32x4){__int_as_float(bucket), wlo, whi, 0.f};
                    ((unsigned char*)(p->ws + WS_RB8))[mbase + 16 * grp + tid] = (unsigned char)bucket;
                    __hip_atomic_fetch_add(hist + bucket, 1, __ATOMIC_RELAXED, __HIP_MEMORY_SCOPE_WORKGROUP); }
            }
        }
        if (ROUTER) { __syncthreads(); if (tid < 32) ((int*)(p->ws + WS_HIST))[vb * 32 + tid] = tid < 24 ? hist[tid] : 0; }
        __syncthreads();
    }
}

__device__ __forceinline__ void phase_moe_offsets(KP p, LAS unsigned char* lds, int latent_only, int wv) {
    const int tid = tid_launder(wv), lane = tid & 63, wave = tid >> 6;
    LAS int* PT = (LAS int*)lds; LAS int* tot = PT + 384; LAS int* tbase = tot + 32; LAS int* wsum = tbase + 32;
    const int* HIST = (const int*)(p->ws + WS_HIST); int* LIST = (int*)(p->ws + WS_LIST); f32x2* SLOTW = (f32x2*)(p->ws + WS_SLOTW); int* TILE = (int*)(p->ws + WS_TILE);
    for (int j = bid_launder(); j < 24; j += gridDim.x) {
        if (tid < 384) { const int jj = tid % 24, pi = tid / 24; int sacc = 0; for (int w = pi * 16; w < pi * 16 + 16; ++w) sacc += HIST[w * 32 + jj]; PT[pi * 24 + jj] = sacc; }
        __syncthreads();
        if (tid < 24) { int sacc = 0; for (int i = 0; i < 16; ++i) sacc += PT[i * 24 + tid]; tot[tid] = sacc; }
        __syncthreads();
        if (tid == 0) { int run = 0; for (int q = 0; q < 24; ++q) { tbase[q] = run; run += (tot[q] + 255) >> 8; } tbase[24] = run; }
        __syncthreads();
        const int base = tbase[j] * 256, cnt = tot[j], ntile = (cnt + 255) >> 8;
        if (j == 0) { if (tid == 0) TILE[0] = tbase[24]; if (tid < 24) { const int nq = (tot[tid] + 255) >> 8; for (int i = 0; i < nq; ++i) TILE[8 + tbase[tid] + i] = tid; } }
        const unsigned* rb = (const unsigned*)(p->ws + WS_RB8) + tid * 18;
        const int t0m = (tid * 72) % TT;
        int mycnt = 0;
        { unsigned bwa[18];
#pragma unroll
            for (int q = 0; q < 18; ++q) bwa[q] = rb[q];
#pragma unroll
            for (int q = 0; q < 18; ++q)
#pragma unroll
                for (int e = 0; e < 4; ++e) { int tt = t0m + 4 * q + e; tt = tt >= TT ? tt - TT : tt; const int bk = (int)((bwa[q] >> (8 * e)) & 0xffu);
                    mycnt += ((!latent_only || tt >= LC) && bk == j) ? 1 : 0; } }
        int incl = mycnt;
#pragma unroll
        for (int o = 1; o < 64; o <<= 1) { const int v = __shfl_up(incl, o, 64); if (lane >= o) incl += v; }
        if (lane == 63) wsum[wave] = incl;
        __syncthreads();
        int woff = 0;
#pragma unroll
        for (int w = 0; w < 8; ++w) woff += (w < wave) ? wsum[w] : 0;
        int pos = base + woff + incl - mycnt;
        int mt[8]; int nm = 0;
#pragma unroll
        for (int q = 0; q < 8; ++q) mt[q] = 0;
#pragma unroll 1
        for (int g3 = 0; g3 < 3; ++g3) { unsigned bw[6];
#pragma unroll
            for (int q = 0; q < 6; ++q) bw[q] = rb[g3 * 6 + q];
#pragma unroll 1
            for (int q = 0; q < 6; ++q) { const unsigned w4 = q == 0 ? bw[0] : (q == 1 ? bw[1] : (q == 2 ? bw[2] : (q == 3 ? bw[3] : (q == 4 ? bw[4] : bw[5]))));
#pragma unroll 1
                for (int e = 0; e < 4; ++e) { const int m = tid * 72 + g3 * 24 + 4 * q + e; const int t = m % TT; const int bk = (int)((w4 >> (8 * e)) & 0xffu);
                    if ((!latent_only || t >= LC) && bk == j) {
                        if (nm < 8) { mt[0] = nm == 0 ? m : mt[0]; mt[1] = nm == 1 ? m : mt[1]; mt[2] = nm == 2 ? m : mt[2]; mt[3] = nm == 3 ? m : mt[3]; mt[4] = nm == 4 ? m : mt[4]; mt[5] = nm == 5 ? m : mt[5]; mt[6] = nm == 6 ? m : mt[6]; mt[7] = nm == 7 ? m : mt[7]; }
                        else { const f32x4 r = *(const f32x4*)(p->ws + WS_ROUTE + (size_t)m * 16); LIST[pos + nm] = m; SLOTW[pos + nm] = (f32x2){r[1], r[2]}; }
                        ++nm; } } } }
        { f32x4 rr[8];
#pragma unroll
            for (int q = 0; q < 8; ++q) rr[q] = *(const f32x4*)(p->ws + WS_ROUTE + (size_t)mt[q] * 16);
#pragma unroll
            for (int q = 0; q < 8; ++q) if (q < nm) { LIST[pos + q] = mt[q]; SLOTW[pos + q] = (f32x2){rr[q][1], rr[q][2]}; } }
        for (int sidx = base + cnt + tid; sidx < base + ntile * 256; sidx += 512) { LIST[sidx] = -1; SLOTW[sidx] = (f32x2){0.f, 0.f}; }
        __syncthreads();
    }
}

__device__ __forceinline__ bf16_t* obuf(unsigned char* ws, int k) {
    const int panel = k == 4 ? 8 : (k == 5 ? 9 : (k == 6 ? 10 : 12));
    return k < 4 ? (bf16_t*)(ws + WS_O) + (size_t)k * PANEL_EL : (bf16_t*)(ws + WS_P) + (size_t)panel * PANEL_EL;
}
__device__ __forceinline__ void phase_mixprep(KP p, LAS unsigned char* lds, int l, int wv) {
    const int tid = tid_launder(wv);
    bf16_t* P = (bf16_t*)(p->ws + WS_P); bf16_t* DNP = (bf16_t*)(p->ws + WS_ABUF);
    float* GDEC = (float*)(p->ws + WS_GDEC); float* DNAB = (float*)(p->ws + WS_DNAB);
    const bf16_t* SMALL = (const bf16_t*)(p->ws + WS_SMALL);
    LAS bf16_t* SM = (LAS bf16_t*)lds;
    float cw[5][2] = {{0.f, 0.f}, {0.f, 0.f}, {0.f, 0.f}, {0.f, 0.f}, {0.f, 0.f}};
    const int sec = tid >> 7, cp = (tid & 127) * 2;
    if (tid < 384) {
#pragma unroll
        for (int j = 0; j < 5; ++j) { cw[j][0] = p->in[I_CONVW][(l * 5 + j) * 768 + sec * 256 + cp]; cw[j][1] = p->in[I_CONVW][(l * 5 + j) * 768 + sec * 256 + cp + 1]; }
    }
    float nalog = 0.f, dtb = 0.f;
    if (tid >= 384 && tid < 392) { nalog = -__expf(p->in[I_ALOG][l * 8 + tid - 384]); dtb = p->in[I_DTB][l * 8 + tid - 384]; }
    float gw[16], gb = 0.f;
#pragma unroll
    for (int r = 0; r < 16; ++r) gw[r] = 0.f;
    const int t2 = tid & 255;
    if (tid >= 256) { const int dir = t2 >> 7, c = t2 & 127;
#pragma unroll
        for (int r = 0; r < 16; ++r) gw[r] = p->in[I_GKW][((l * 2 + dir) * 16 + r) * 128 + c];
        gb = p->in[I_GKB][(l * 2 + dir) * 128 + c]; }
    for (int vb = bid_launder(); vb < NVB; vb += gridDim.x) {
        const int b = vb >> 4, t0 = (vb & 15) * 144;
        unsigned nA[20]; u32x4 nS = (u32x4){0u, 0u, 0u, 0u};
#define MP_LOADS(C0) do { const int t_ = t0 + (C0), m_ = b * TT + t_, lo_ = t_ < LC ? 0 : LC, hi_ = t_ < LC ? LC : TT; \
            if (tid < 384) { const bf16_t* src = P + (size_t)(8 + sec) * PANEL_EL + cp; \
                _Pragma("unroll") for (int j = 0; j < 20; ++j) { const int tt = t_ - 2 + j; nA[j] = (tt >= lo_ && tt < hi_) ? *(const unsigned*)(src + (size_t)(b * TT + tt) * 256) : 0u; } } \
            if (tid < 128) nS = *(const u32x4*)(SMALL + (size_t)(m_ + (tid >> 3)) * 64 + (tid & 7) * 8); } while (0)
        MP_LOADS(0);
        for (int c0 = 0, it = 0; c0 < 144; c0 += 16, ++it) {
            const int t = t0 + c0, m = b * TT + t;
            LAS bf16_t* SMc = SM + (it & 1) * 1024;
            unsigned raw[20];
#pragma unroll
            for (int j = 0; j < 20; ++j) raw[j] = nA[j];
            if (tid < 128) *(LAS u32x4*)(SMc + (tid >> 3) * 64 + (tid & 7) * 8) = nS;
            if (c0 + 16 < 144) MP_LOADS(c0 + 16);
            LDS_BARRIER();
            if (tid < 384) {
                unsigned outv[16];
#pragma unroll
                for (int q = 0; q < 16; ++q) { float a0 = 0.f, a1 = 0.f;
#pragma unroll
                    for (int j = 0; j < 5; ++j) { a0 += cw[j][0] * bflo(raw[q + j]); a1 += cw[j][1] * bfhi(raw[q + j]); }
                    a0 = siluf_(a0); a1 = siluf_(a1);
                    if (sec < 2) { const float ss = half_sum32(a0 * a0 + a1 * a1); const float rn = rsqrtf(ss + EPS) * (sec == 0 ? 0.125f : 1.f); a0 *= rn; a1 *= rn; }
                    outv[q] = pk_bf16(a0, a1); }
#pragma unroll
                for (int q = 0; q < 16; ++q) *(unsigned*)(DNP + (size_t)sec * PANEL_EL + (size_t)(m + q) * 256 + cp) = outv[q];
            } else if (tid < 392) {
                const int j = tid - 384;
#pragma unroll
                for (int q = 0; q < 16; ++q) { const float da = bf2f(SMc[q * 64 + 32 + j]), db = bf2f(SMc[q * 64 + 40 + j]);
                    DNAB[(size_t)(m + q) * 16 + j] = nalog * softplusf_(da + dtb); DNAB[(size_t)(m + q) * 16 + 8 + j] = sigmoidf_(db); }
            }
            if (tid >= 256) {
                const int dir = t2 >> 7;
#pragma unroll 4
                for (int q = 0; q < 16; ++q) { const u32x4 z0 = *(const LAS u32x4*)(SMc + q * 64 + dir * 16), z1 = *(const LAS u32x4*)(SMc + q * 64 + dir * 16 + 8);
                    float logit = gb;
#pragma unroll
                    for (int e = 0; e < 4; ++e) { logit += bflo(z0[e]) * gw[2 * e] + bfhi(z0[e]) * gw[2 * e + 1] + bflo(z1[e]) * gw[8 + 2 * e] + bfhi(z1[e]) * gw[8 + 2 * e + 1]; }
                    const float ls = fminf(logit, 0.f) - __logf(1.f + __expf(-fabsf(logit)));
                    GDEC[(size_t)(m + q) * 256 + t2] = ls * 0.0625f; }
            }
        }
#undef MP_LOADS
        __syncthreads();
    }
}

__device__ __forceinline__ int blk_tok0(int dir, int blk) { return dir == 0 ? 16 * blk : (blk < 16 ? LC - 16 * (blk + 1) : TT - 16 * (blk - 15)); }
__device__ __forceinline__ void cvt8(const u32x4 r, LAS float* d) {
    *(LAS f32x4*)d = (f32x4){bflo(r[0]), bfhi(r[0]), bflo(r[1]), bfhi(r[1])}; *(LAS f32x4*)(d + 4) = (f32x4){bflo(r[2]), bfhi(r[2]), bflo(r[3]), bfhi(r[3])};
}
__device__ __forceinline__ void store_out16(const LAS float* LO, bf16_t* Og, int tcur, int lane) {
    if (lane < 32) { const int row = lane >> 1, half = lane & 1; const f32x4 o0 = *(const LAS f32x4*)(LO + row * 16 + half * 8), o1 = *(const LAS f32x4*)(LO + row * 16 + half * 8 + 4);
        *(u32x4*)(Og + (size_t)(tcur + row) * 16 + half * 8) = (u32x4){pk_bf16(o0[0], o0[1]), pk_bf16(o0[2], o0[3]), pk_bf16(o1[0], o1[1]), pk_bf16(o1[2], o1[3])}; }
}
template <int DIR>
__device__ __forceinline__ void scan_ret_chunk(KP p, LAS unsigned char* Lb, int idx, int l, int wv) {
    const int lane = tid_launder(wv) & 63, fr = lane & 15, kq = lane >> 4;
    constexpr int dir = DIR; const int h = (idx >> 1) & 3, b = idx >> 3;
    const bf16_t* P = (const bf16_t*)(p->ws + WS_P);
    const bf16_t* Qg = P + 3 * PANEL_EL + (size_t)b * TT * 256 + h * 64; const bf16_t* Kg = Qg + PANEL_EL; const bf16_t* Vg = Qg + 2 * PANEL_EL;
    bf16_t* Og = obuf(p->ws, 2 + dir) + (size_t)((b * 4 + h) * 4) * TT * 16;
    const float lg2 = log2f(sigmoidf_(p->in[I_RETD][(l * 2 + dir) * 4 + h]));
    const float g16 = exp2f(16.f * lg2);
    LAS bf16_t* QL = (LAS bf16_t*)Lb; LAS bf16_t* KL = QL + 16 * 72; LAS bf16_t* KT = KL + 16 * 72; LAS bf16_t* VT = KT + 64 * 32; LAS bf16_t* GL = VT + 64 * 32;
    for (int i = lane; i < (64 * 32 * 2 + 16 * 32) / 2; i += 64) ((LAS unsigned*)KT)[i] = 0u;
    f32x4 S[4][4];
#pragma unroll
    for (int a = 0; a < 4; ++a)
#pragma unroll
        for (int c = 0; c < 4; ++c) S[a][c] = (f32x4){0.f, 0.f, 0.f, 0.f};
    u32x4 rq[2], rk[2], rv[2];
    int tb = blk_tok0(dir, 0);
#define RC_LOAD(T0) do { _Pragma("unroll") for (int i = 0; i < 2; ++i) { const int q = lane + 64 * i, r = q >> 3, c8 = (q & 7) * 8; const size_t ro = (size_t)((T0) + (dir ? 15 - r : r)) * 256 + c8; \
        rq[i] = *(const u32x4*)(Qg + ro); rk[i] = *(const u32x4*)(Kg + ro); rv[i] = *(const u32x4*)(Vg + ro); } } while (0)
    RC_LOAD(tb);
    float rowsc[4];
#pragma unroll
    for (int i = 0; i < 4; ++i) rowsc[i] = exp2f(lg2 * (float)(4 * kq + i - 15));
    for (int blk = 0; blk < 144; ++blk) {
#pragma unroll
        for (int i = 0; i < 2; ++i) { const int q = lane + 64 * i, r = q >> 3, c8 = (q & 7) * 8;
            *(LAS u32x4*)(QL + r * 72 + c8) = rq[i]; *(LAS u32x4*)(KL + r * 72 + c8) = rk[i];
            const float vs = exp2f(lg2 * (float)(15 - r));
#pragma unroll
            for (int e = 0; e < 4; ++e) { KT[(c8 + 2 * e) * 32 + r] = (bf16_t)(rk[i][e] & 0xffffu); KT[(c8 + 2 * e + 1) * 32 + r] = (bf16_t)(rk[i][e] >> 16);
                const unsigned pv = pk_bf16(bflo(rv[i][e]) * vs, bfhi(rv[i][e]) * vs);
                VT[(c8 + 2 * e) * 32 + r] = (bf16_t)(pv & 0xffffu); VT[(c8 + 2 * e + 1) * 32 + r] = (bf16_t)(pv >> 16); } }
        const int tcur = tb;
        if (blk + 1 < 144) { tb = blk_tok0(dir, blk + 1); RC_LOAD(tb); }
        WAVE_LDS_SYNC();
        f32x4 G = (f32x4){0.f, 0.f, 0.f, 0.f};
#pragma unroll
        for (int kk = 0; kk < 2; ++kk) { const bf16x8 a = *(const LAS bf16x8*)(QL + fr * 72 + 32 * kk + 8 * kq), bb = *(const LAS bf16x8*)(KL + fr * 72 + 32 * kk + 8 * kq);
            G = __builtin_amdgcn_mfma_f32_16x16x32_bf16(a, bb, G, 0, 0, 0); }
#pragma unroll
        for (int i = 0; i < 4; ++i) { const int r = 4 * kq + i; GL[r * 32 + fr] = (bf16_t)(pk_bf16(fr <= r ? G[i] : 0.f, 0.f) & 0xffffu); }
#pragma unroll
        for (int a = 0; a < 4; ++a)
#pragma unroll
            for (int c = 0; c < 4; ++c) S[a][c] = S[a][c] * g16;
        WAVE_LDS_SYNC();
        const bf16x8 ag = *(const LAS bf16x8*)(GL + fr * 32 + 8 * kq);
        bf16x8 aq[2];
#pragma unroll
        for (int kk = 0; kk < 2; ++kk) { const u32x2 lo = *(const LAS u32x2*)(QL + fr * 72 + 32 * kk + 4 * kq), hi = *(const LAS u32x2*)(QL + fr * 72 + 32 * kk + 16 + 4 * kq);
            aq[kk] = __builtin_bit_cast(bf16x8, (u32x4){lo[0], lo[1], hi[0], hi[1]}); }
        bf16x8 bv[4], ak[4];
#pragma unroll
        for (int c = 0; c < 4; ++c) { bv[c] = *(const LAS bf16x8*)(VT + (16 * c + fr) * 32 + 8 * kq); ak[c] = *(const LAS bf16x8*)(KT + (16 * c + fr) * 32 + 8 * kq); }
        f32x4 acc[4];
#pragma unroll
        for (int c = 0; c < 4; ++c) { acc[c] = __builtin_amdgcn_mfma_f32_16x16x32_bf16(ag, bv[c], (f32x4){0.f, 0.f, 0.f, 0.f}, 0, 0, 0);
#pragma unroll
            for (int kk = 0; kk < 2; ++kk) { const f32x4 s0 = S[2 * kk][c], s1 = S[2 * kk + 1][c];
                const bf16x8 bs = __builtin_bit_cast(bf16x8, (u32x4){pk_bf16(s0[0], s0[1]), pk_bf16(s0[2], s0[3]), pk_bf16(s1[0], s1[1]), pk_bf16(s1[2], s1[3])});
                acc[c] = __builtin_amdgcn_mfma_f32_16x16x32_bf16(aq[kk], bs, acc[c], 0, 0, 0); } }
#pragma unroll
        for (int a = 0; a < 4; ++a)
#pragma unroll
            for (int c = 0; c < 4; ++c) S[a][c] = __builtin_amdgcn_mfma_f32_16x16x32_bf16(ak[a], bv[c], S[a][c], 0, 0, 0);
#pragma unroll
        for (int c = 0; c < 4; ++c)
#pragma unroll
            for (int i = 0; i < 4; ++i) { const int r = 4 * kq + i; Og[((size_t)c * TT + (size_t)(tcur + (dir ? 15 - r : r))) * 16 + fr] = (bf16_t)(pk_bf16(acc[c][i] * rowsc[i], 0.f) & 0xffffu); }
        WAVE_LDS_SYNC();
    }
#undef RC_LOAD
}
template <int DIR>
__device__ __forceinline__ void scan_gla_chunk(KP p, LAS unsigned char* Lb, int idx, int wv) {
    const int lane = tid_launder(wv) & 63, fr = lane & 15, kq = lane >> 4;
    constexpr int dir = DIR; const int h = (idx >> 1) & 3, b = idx >> 3;
    const bf16_t* P = (const bf16_t*)(p->ws + WS_P);
    const bf16_t* Qg = P + (size_t)b * TT * 256 + h * 32; const bf16_t* Kg = Qg + 128; const bf16_t* Vg = P + PANEL_EL + (size_t)b * TT * 256 + h * 64;
    const float* Ag = (const float*)(p->ws + WS_GDEC) + (size_t)b * TT * 256 + dir * 128 + h * 32;
    bf16_t* Og = obuf(p->ws, dir) + (size_t)((b * 4 + h) * 4) * TT * 16;
    LAS bf16_t* QL = (LAS bf16_t*)Lb; LAS bf16_t* KL = QL + 16 * 40; LAS bf16_t* KT = KL + 16 * 40; LAS bf16_t* VT = KT + 32 * 32; LAS bf16_t* GL = VT + 64 * 32; LAS float* EB = (LAS float*)(GL + 16 * 32);
    for (int i = lane; i < (32 * 32 + 64 * 32 + 16 * 32) / 2; i += 64) ((LAS unsigned*)KT)[i] = 0u;
    f32x4 S[2][4];
#pragma unroll
    for (int a = 0; a < 2; ++a)
#pragma unroll
        for (int c = 0; c < 4; ++c) S[a][c] = (f32x4){0.f, 0.f, 0.f, 0.f};
    const int sg = lane >> 4, dp = lane & 15;
    unsigned rq[4], rk[4]; f32x2 ra[4]; u32x4 rv[2];
    int tb = blk_tok0(dir, 0);
#define GC_LOAD(T0) do { _Pragma("unroll") for (int i = 0; i < 4; ++i) { const int r = 4 * sg + i; const size_t ro = (size_t)((T0) + (dir ? 15 - r : r)) * 256 + 2 * dp; \
            rq[i] = *(const unsigned*)(Qg + ro); rk[i] = *(const unsigned*)(Kg + ro); ra[i] = *(const f32x2*)(Ag + ro); } \
        _Pragma("unroll") for (int i = 0; i < 2; ++i) { const int q = lane + 64 * i, r = q >> 3, c8 = (q & 7) * 8; rv[i] = *(const u32x4*)(Vg + (size_t)((T0) + (dir ? 15 - r : r)) * 256 + c8); } } while (0)
    GC_LOAD(tb);
    for (int blk = 0; blk < 144; ++blk) {
        f32x2 bc[4]; bc[0] = ra[0]; bc[1] = bc[0] + ra[1]; bc[2] = bc[1] + ra[2]; bc[3] = bc[2] + ra[3];
        f32x2 inc = bc[3];
        { const float u0 = __shfl_up(inc[0], 16, 64), u1 = __shfl_up(inc[1], 16, 64); if (sg >= 1) { inc[0] += u0; inc[1] += u1; } }
        { const float u0 = __shfl_up(inc[0], 32, 64), u1 = __shfl_up(inc[1], 32, 64); if (sg >= 2) { inc[0] += u0; inc[1] += u1; } }
        const f32x2 excl = inc - bc[3];
        if (sg == 3) { EB[2 * dp] = __expf(inc[0]); EB[2 * dp + 1] = __expf(inc[1]); }
#pragma unroll
        for (int i = 0; i < 4; ++i) { const int r = 4 * sg + i; const f32x2 bb = bc[i] + excl;
            const float e0 = __expf(bb[0]), e1 = __expf(bb[1]), n0 = __expf(-bb[0]), n1 = __expf(-bb[1]);
            const unsigned qv = pk_bf16(bflo(rq[i]) * e0, bfhi(rq[i]) * e1), kv = pk_bf16(bflo(rk[i]) * n0, bfhi(rk[i]) * n1);
            *(LAS unsigned*)(QL + r * 40 + 2 * dp) = qv; *(LAS unsigned*)(KL + r * 40 + 2 * dp) = kv;
            KT[(2 * dp) * 32 + r] = (bf16_t)(kv & 0xffffu); KT[(2 * dp + 1) * 32 + r] = (bf16_t)(kv >> 16); }
#pragma unroll
        for (int i = 0; i < 2; ++i) { const int q = lane + 64 * i, r = q >> 3, c8 = (q & 7) * 8;
#pragma unroll
            for (int e = 0; e < 4; ++e) { VT[(c8 + 2 * e) * 32 + r] = (bf16_t)(rv[i][e] & 0xffffu); VT[(c8 + 2 * e + 1) * 32 + r] = (bf16_t)(rv[i][e] >> 16); } }
        const int tcur = tb;
        if (blk + 1 < 144) { tb = blk_tok0(dir, blk + 1); GC_LOAD(tb); }
        WAVE_LDS_SYNC();
        { const bf16x8 a = *(const LAS bf16x8*)(QL + fr * 40 + 8 * kq), bb = *(const LAS bf16x8*)(KL + fr * 40 + 8 * kq);
            const f32x4 G = __builtin_amdgcn_mfma_f32_16x16x32_bf16(a, bb, (f32x4){0.f, 0.f, 0.f, 0.f}, 0, 0, 0);
#pragma unroll
            for (int i = 0; i < 4; ++i) { const int r = 4 * kq + i; GL[r * 32 + fr] = (bf16_t)(pk_bf16(fr <= r ? G[i] : 0.f, 0.f) & 0xffffu); } }
        WAVE_LDS_SYNC();
        const bf16x8 ag = *(const LAS bf16x8*)(GL + fr * 32 + 8 * kq);
        const u32x2 qlo = *(const LAS u32x2*)(QL + fr * 40 + 4 * kq), qhi = *(const LAS u32x2*)(QL + fr * 40 + 16 + 4 * kq);
        const bf16x8 aq = __builtin_bit_cast(bf16x8, (u32x4){qlo[0], qlo[1], qhi[0], qhi[1]});
        bf16x8 bv[4], ak[2];
#pragma unroll
        for (int c = 0; c < 4; ++c) bv[c] = *(const LAS bf16x8*)(VT + (16 * c + fr) * 32 + 8 * kq);
#pragma unroll
        for (int a = 0; a < 2; ++a) ak[a] = *(const LAS bf16x8*)(KT + (16 * a + fr) * 32 + 8 * kq);
        const f32x4 eb0 = *(const LAS f32x4*)(EB + 4 * kq), eb1 = *(const LAS f32x4*)(EB + 16 + 4 * kq);
#pragma unroll
        for (int c = 0; c < 4; ++c) { f32x4 acc = __builtin_amdgcn_mfma_f32_16x16x32_bf16(ag, bv[c], (f32x4){0.f, 0.f, 0.f, 0.f}, 0, 0, 0);
            const f32x4 s0 = S[0][c], s1 = S[1][c];
            const bf16x8 bs = __builtin_bit_cast(bf16x8, (u32x4){pk_bf16(s0[0], s0[1]), pk_bf16(s0[2], s0[3]), pk_bf16(s1[0], s1[1]), pk_bf16(s1[2], s1[3])});
            acc = __builtin_amdgcn_mfma_f32_16x16x32_bf16(aq, bs, acc, 0, 0, 0);
            S[0][c] = __builtin_amdgcn_mfma_f32_16x16x32_bf16(ak[0], bv[c], S[0][c], 0, 0, 0) * eb0;
            S[1][c] = __builtin_amdgcn_mfma_f32_16x16x32_bf16(ak[1], bv[c], S[1][c], 0, 0, 0) * eb1;
#pragma unroll
            for (int i = 0; i < 4; ++i) { const int r = 4 * kq + i; Og[((size_t)c * TT + (size_t)(tcur + (dir ? 15 - r : r))) * 16 + fr] = (bf16_t)(pk_bf16(acc[i], 0.f) & 0xffffu); } }
        WAVE_LDS_SYNC();
    }
#undef GC_LOAD
}
__device__ __forceinline__ float oct_sum(float v) {
    v += __builtin_bit_cast(float, __builtin_amdgcn_update_dpp(0, __builtin_bit_cast(int, v), 0xB1, 0xF, 0xF, true));
    v += __builtin_bit_cast(float, __builtin_amdgcn_update_dpp(0, __builtin_bit_cast(int, v), 0x4E, 0xF, 0xF, true));
    v += __builtin_bit_cast(float, __builtin_amdgcn_update_dpp(0, __builtin_bit_cast(int, v), 0x141, 0xF, 0xF, true));
    return v;
}
__device__ __forceinline__ void scan_dn(KP p, LAS float* L, int idx, int wv, int noload) {
    const int lane = tid_launder(wv) & 63, vl = lane >> 3, dg = lane & 7;
    const int cq = idx & 7, dir = (idx >> 3) & 1, h = (idx >> 4) & 3, b = idx >> 6;
    const bf16_t* Qg = (const bf16_t*)(p->ws + WS_ABUF) + (size_t)b * TT * 256 + h * 64; const bf16_t* Kg = Qg + PANEL_EL; const bf16_t* Vg = Qg + 2 * PANEL_EL + cq * 8;
    const float* ABg = (const float*)(p->ws + WS_DNAB) + (size_t)b * TT * 16 + dir * 4 + h;
    bf16_t* Og = obuf(p->ws, 4 + dir) + (size_t)((b * 4 + h) * 8 + cq) * TT * 8;
    LAS float* LQ = L; LAS float* LK = L + 1024; LAS float* LV = L + 2048; LAS float* LAB = L + 2176; LAS float* LOP = L + 2208;
    f32x2 S[4];
#pragma unroll
    for (int i = 0; i < 4; ++i) S[i] = (f32x2){0.f, 0.f};
    const int lrow = lane >> 2, lseg = lane & 3;
    struct DnSet { u32x4 q0, q1, k0, k1, v; float a, b; };
    DnSet R0, R1;
#define DN_LOAD(R, BLK) do { if ((BLK) < 144 && !(noload && (BLK) >= 2)) { const int T0_ = blk_tok0(dir, (BLK)); const size_t ro = (size_t)(T0_ + lrow) * 256 + lseg * 16; R.q0 = *(const u32x4*)(Qg + ro); R.q1 = *(const u32x4*)(Qg + ro + 8); R.k0 = *(const u32x4*)(Kg + ro); R.k1 = *(const u32x4*)(Kg + ro + 8); \
        R.v = *(const u32x4*)(Vg + (size_t)(T0_ + (lane & 15)) * 256); R.a = ABg[(size_t)(T0_ + (lane & 15)) * 16]; R.b = ABg[(size_t)(T0_ + (lane & 15)) * 16 + 8]; } } while (0)
#define DN_RD(LS) do { nk0 = *(const LAS f32x4*)(LK + (LS) * 64 + dg * 8); nk1 = *(const LAS f32x4*)(LK + (LS) * 64 + dg * 8 + 4); nq0 = *(const LAS f32x4*)(LQ + (LS) * 64 + dg * 8); nq1 = *(const LAS f32x4*)(LQ + (LS) * 64 + dg * 8 + 4); \
            nv = LV[(LS) * 8 + vl]; na = LAB[(LS) * 2]; nb = LAB[(LS) * 2 + 1]; } while (0)
#define DN_BLOCK(R, BLK) do { \
        cvt8(R.q0, LQ + lrow * 64 + lseg * 16); cvt8(R.q1, LQ + lrow * 64 + lseg * 16 + 8); cvt8(R.k0, LK + lrow * 64 + lseg * 16); cvt8(R.k1, LK + lrow * 64 + lseg * 16 + 8); \
        if (lane < 16) { cvt8(R.v, LV + lane * 8); LAB[lane * 2] = R.a; LAB[lane * 2 + 1] = R.b; } \
        const int tcur = blk_tok0(dir, (BLK)); \
        DN_LOAD(R, (BLK) + 2); \
        WAVE_LDS_SYNC(); \
        f32x4 nk0, nk1, nq0, nq1; float nv, na, nb; \
        DN_RD(dir ? 15 : 0); \
        _Pragma("unroll") for (int s = 0; s < 16; ++s) { \
            const f32x2 ka = {nk0[0], nk0[1]}, kb = {nk0[2], nk0[3]}, kc = {nk1[0], nk1[1]}, kd = {nk1[2], nk1[3]}; \
            const f32x2 qa = {nq0[0], nq0[1]}, qb = {nq0[2], nq0[3]}, qc = {nq1[0], nq1[1]}, qd = {nq1[2], nq1[3]}; const float v = nv, a = na, bt = nb; \
            const int ls = dir ? 15 - s : s; \
            if (s < 15) { DN_RD(dir ? 14 - s : s + 1); } \
            const f32x2 r2 = (ka * S[0] + kb * S[1]) + (kc * S[2] + kd * S[3]);        \
            const float r = oct_sum(r2[0] + r2[1]); \
            const float c = bt * (v - a * r); \
            const f32x2 c2 = {c, c}, a2 = {a, a}; \
            S[0] = a2 * S[0] + ka * c2; S[1] = a2 * S[1] + kb * c2; S[2] = a2 * S[2] + kc * c2; S[3] = a2 * S[3] + kd * c2; \
            const f32x2 o2 = (qa * S[0] + qb * S[1]) + (qc * S[2] + qd * S[3]); \
            LOP[ls * 64 + lane] = o2[0] + o2[1]; \
            asm volatile("" ::: "memory"); } \
        WAVE_LDS_SYNC(); \
        { const int ts = lane >> 2, c0 = (lane & 3) * 2;                         \
            const f32x4 p0 = *(const LAS f32x4*)(LOP + ts * 64 + c0 * 8), p1 = *(const LAS f32x4*)(LOP + ts * 64 + c0 * 8 + 4), p2 = *(const LAS f32x4*)(LOP + ts * 64 + c0 * 8 + 8), p3 = *(const LAS f32x4*)(LOP + ts * 64 + c0 * 8 + 12); \
            const float oa = (p0[0] + p0[1]) + (p0[2] + p0[3]) + (p1[0] + p1[1]) + (p1[2] + p1[3]), ob = (p2[0] + p2[1]) + (p2[2] + p2[3]) + (p3[0] + p3[1]) + (p3[2] + p3[3]); \
            *(unsigned*)(Og + (size_t)(tcur + ts) * 8 + c0) = pk_bf16(oa, ob); } \
        WAVE_LDS_SYNC(); } while (0)
    DN_LOAD(R0, 0); DN_LOAD(R1, 1);
    for (int blk = 0; blk < 144; blk += 2) { DN_BLOCK(R0, blk); DN_BLOCK(R1, blk + 1); }
#undef DN_BLOCK
#undef DN_RD
#undef DN_LOAD
}
__device__ __forceinline__ bf16x8 packz(const f32x4 v) { return __builtin_bit_cast(bf16x8, (u32x4){pk_bf16(v[0], v[1]), pk_bf16(v[2], v[3]), 0u, 0u}); }
__device__ __forceinline__ bf16x8 ldaz(const LAS bf16_t* img, int fr, int kq) { const u32x2 lo = *(const LAS u32x2*)(img + fr * 32 + 4 * kq); return __builtin_bit_cast(bf16x8, (u32x4){lo[0], lo[1], 0u, 0u}); }
__device__ __forceinline__ void stz(LAS bf16_t* img, const f32x4 v, int fr, int kq) {
#pragma unroll
    for (int i = 0; i < 4; ++i) img[(4 * kq + i) * 32 + fr] = (bf16_t)(pk_bf16(v[i], 0.f) & 0xffffu);
}
__device__ __forceinline__ float row_scan16(float v) {
    v += __builtin_bit_cast(float, __builtin_amdgcn_update_dpp(0, __builtin_bit_cast(int, v), 0x111, 0xF, 0xF, true));
    v += __builtin_bit_cast(float, __builtin_amdgcn_update_dpp(0, __builtin_bit_cast(int, v), 0x112, 0xF, 0xF, true));
    v += __builtin_bit_cast(float, __builtin_amdgcn_update_dpp(0, __builtin_bit_cast(int, v), 0x114, 0xF, 0xF, true));
    v += __builtin_bit_cast(float, __builtin_amdgcn_update_dpp(0, __builtin_bit_cast(int, v), 0x118, 0xF, 0xF, true));
    return v;
}
constexpr int DN_SLOT = 13568, DN_NSLOT = 4;
__device__ __forceinline__ void lds_wait_ge(volatile LAS int* f, int need) { for (int it = 0; it < (1 << 22); ++it) { if (*f >= need) break; __builtin_amdgcn_s_sleep(1); } }
template <int DIR>
__device__ __forceinline__ void scan_dn_producer(KP p, LAS unsigned char* ring, LAS unsigned char* scratch, volatile LAS int* flags, int idx, int par, int wv) {
    const int lane = tid_launder(wv) & 63, fr = lane & 15, kq = lane >> 4;
    constexpr int dir = DIR; const int h = (idx >> 1) & 3, b = idx >> 3;
    const bf16_t* Qg = (const bf16_t*)(p->ws + WS_ABUF) + (size_t)b * TT * 256 + h * 64; const bf16_t* Kg = Qg + PANEL_EL; const bf16_t* Vg = Qg + 2 * PANEL_EL;
    const float* ABg = (const float*)(p->ws + WS_DNAB) + (size_t)b * TT * 16 + dir * 4 + h;
    LAS bf16_t* L0 = (LAS bf16_t*)scratch; LAS bf16_t* L1 = L0 + 16 * 32; LAS bf16_t* L2 = L1 + 16 * 32;
    for (int i = lane; i < (3 * 16 * 32) / 2; i += 64) ((LAS unsigned*)L0)[i] = 0u;
    for (int sl = par; sl < DN_NSLOT; sl += 2) { LAS unsigned* z = (LAS unsigned*)(ring + sl * DN_SLOT + 3 * 16 * 72 * 2); for (int i = lane; i < (64 * 32 + 2 * 16 * 32) / 2; i += 64) z[i] = 0u; }
    u32x4 rq[2], rk[2], rv[2]; float rla, rbe;
    int tb = blk_tok0(dir, par);
#define DC_LOAD(T0) do { _Pragma("unroll") for (int i = 0; i < 2; ++i) { const int q = lane + 64 * i, r = q >> 3, c8 = (q & 7) * 8; const size_t ro = (size_t)((T0) + (dir ? 15 - r : r)) * 256 + c8; \
            rq[i] = *(const u32x4*)(Qg + ro); rk[i] = *(const u32x4*)(Kg + ro); rv[i] = *(const u32x4*)(Vg + ro); } \
        { const size_t ao = (size_t)((T0) + (dir ? 15 - fr : fr)) * 16; rla = ABg[ao]; rbe = ABg[ao + 8]; } } while (0)
    DC_LOAD(tb);
    for (int blk = par; blk < 144; blk += 2) {
        LAS unsigned char* sl = ring + (blk % DN_NSLOT) * DN_SLOT;
        LAS bf16_t* QL = (LAS bf16_t*)sl; LAS bf16_t* KL = QL + 16 * 72; LAS bf16_t* VL = KL + 16 * 72; LAS bf16_t* KT = VL + 16 * 72; LAS bf16_t* TL = KT + 64 * 32; LAS bf16_t* PL = TL + 16 * 32; LAS float* GS = (LAS float*)(PL + 16 * 32);
        if (blk >= DN_NSLOT) lds_wait_ge(flags + 2, blk - DN_NSLOT + 1);
        const float gsc = row_scan16(rla), bec = rbe;
        const float g15 = __builtin_bit_cast(float, __builtin_amdgcn_readlane(__builtin_bit_cast(int, gsc), 15));
        if (lane < 16) { GS[lane] = gsc; GS[16 + lane] = bec; GS[32 + lane] = g15; }
#pragma unroll
        for (int i = 0; i < 2; ++i) { const int q = lane + 64 * i, r = q >> 3, c8 = (q & 7) * 8;
            *(LAS u32x4*)(QL + r * 72 + c8) = rq[i]; *(LAS u32x4*)(KL + r * 72 + c8) = rk[i]; *(LAS u32x4*)(VL + r * 72 + c8) = rv[i]; }
        WAVE_LDS_SYNC();
        const f32x4 gr = *(const LAS f32x4*)(GS + 4 * kq), br = *(const LAS f32x4*)(GS + 16 + 4 * kq);
#pragma unroll
        for (int i = 0; i < 2; ++i) { const int q = lane + 64 * i, r = q >> 3, c8 = (q & 7) * 8; const float ks = __expf(g15 - GS[r]);
#pragma unroll
            for (int e = 0; e < 4; ++e) { const unsigned kv = pk_bf16(bflo(rk[i][e]) * ks, bfhi(rk[i][e]) * ks); KT[(c8 + 2 * e) * 32 + r] = (bf16_t)(kv & 0xffffu); KT[(c8 + 2 * e + 1) * 32 + r] = (bf16_t)(kv >> 16); } }
        if (blk + 2 < 144) { tb = blk_tok0(dir, blk + 2); DC_LOAD(tb); }
        f32x4 KK = (f32x4){0.f, 0.f, 0.f, 0.f}, QK = (f32x4){0.f, 0.f, 0.f, 0.f};
#pragma unroll
        for (int kk = 0; kk < 2; ++kk) { const bf16x8 ak = *(const LAS bf16x8*)(KL + fr * 72 + 32 * kk + 8 * kq), aq = *(const LAS bf16x8*)(QL + fr * 72 + 32 * kk + 8 * kq);
            KK = __builtin_amdgcn_mfma_f32_16x16x32_bf16(ak, ak, KK, 0, 0, 0); QK = __builtin_amdgcn_mfma_f32_16x16x32_bf16(aq, ak, QK, 0, 0, 0); }
        f32x4 Lm, Pm;
#pragma unroll
        for (int i = 0; i < 4; ++i) { const int r = 4 * kq + i; const float e = __expf(fminf(gr[i] - gsc, 0.f)); Lm[i] = fr < r ? br[i] * e * KK[i] : 0.f; Pm[i] = fr <= r ? e * QK[i] : 0.f; }
        stz(L0, Lm, fr, kq); stz(PL, Pm, fr, kq);
        WAVE_LDS_SYNC();
        const bf16x8 aL = ldaz(L0, fr, kq);
        const f32x4 Lsq = __builtin_amdgcn_mfma_f32_16x16x32_bf16(aL, packz(Lm), (f32x4){0.f, 0.f, 0.f, 0.f}, 0, 0, 0);
        stz(L1, Lsq, fr, kq);
        WAVE_LDS_SYNC();
        const bf16x8 aL2 = ldaz(L1, fr, kq);
        const f32x4 Lq = __builtin_amdgcn_mfma_f32_16x16x32_bf16(aL2, packz(Lsq), (f32x4){0.f, 0.f, 0.f, 0.f}, 0, 0, 0);
        stz(L2, Lq, fr, kq);
        WAVE_LDS_SYNC();
        const bf16x8 aL4 = ldaz(L2, fr, kq);
        f32x4 Y = __builtin_amdgcn_mfma_f32_16x16x32_bf16(aL4, packz(Lq), (f32x4){0.f, 0.f, 0.f, 0.f}, 0, 0, 0);
#pragma unroll
        for (int i = 0; i < 4; ++i) Y[i] += (fr == 4 * kq + i) ? 1.f : 0.f;
        Y = __builtin_amdgcn_mfma_f32_16x16x32_bf16(aL4, packz(Y), Y, 0, 0, 0);
        Y = __builtin_amdgcn_mfma_f32_16x16x32_bf16(aL2, packz(Y), Y, 0, 0, 0);
        { const f32x4 nY = -Y; Y = __builtin_amdgcn_mfma_f32_16x16x32_bf16(aL, packz(nY), Y, 0, 0, 0); }
        stz(TL, Y, fr, kq);
        WAVE_LDS_SYNC();
        if (lane == 0) flags[par] = (blk >> 1) + 1;
    }
#undef DC_LOAD
}
template <int DIR>
__device__ __forceinline__ void scan_dn_consumer(KP p, LAS unsigned char* ring, volatile LAS int* flags, int idx, int wv) {
    const int lane = tid_launder(wv) & 63, fr = lane & 15, kq = lane >> 4;
    constexpr int dir = DIR; const int h = (idx >> 1) & 3, b = idx >> 3;
    bf16_t* Og = obuf(p->ws, 4 + dir) + (size_t)((b * 4 + h) * 4) * TT * 16;
    f32x4 S[4][4];
#pragma unroll
    for (int a = 0; a < 4; ++a)
#pragma unroll
        for (int c = 0; c < 4; ++c) S[a][c] = (f32x4){0.f, 0.f, 0.f, 0.f};
    for (int blk = 0; blk < 144; ++blk) {
        LAS unsigned char* sl = ring + (blk % DN_NSLOT) * DN_SLOT;
        LAS bf16_t* QL = (LAS bf16_t*)sl; LAS bf16_t* KL = QL + 16 * 72; LAS bf16_t* VL = KL + 16 * 72; LAS bf16_t* KT = VL + 16 * 72; LAS bf16_t* TL = KT + 64 * 32; LAS bf16_t* PL = TL + 16 * 32; LAS float* GS = (LAS float*)(PL + 16 * 32);
        lds_wait_ge(flags + (blk & 1), (blk >> 1) + 1);
        const f32x4 gr = *(const LAS f32x4*)(GS + 4 * kq), br = *(const LAS f32x4*)(GS + 16 + 4 * kq); const float g15 = GS[32];
        float vv[4][4];
#pragma unroll
        for (int c = 0; c < 4; ++c)
#pragma unroll
            for (int i = 0; i < 4; ++i) vv[c][i] = bf2f(VL[(4 * kq + i) * 72 + 16 * c + fr]);
        const bf16x8 aT = ldaz(TL, fr, kq), aP = ldaz(PL, fr, kq);
        bf16x8 akp[2], aqp[2], aKT[4];
#pragma unroll
        for (int kk = 0; kk < 2; ++kk) { const u32x2 klo = *(const LAS u32x2*)(KL + fr * 72 + 32 * kk + 4 * kq), khi = *(const LAS u32x2*)(KL + fr * 72 + 32 * kk + 16 + 4 * kq);
            const u32x2 qlo = *(const LAS u32x2*)(QL + fr * 72 + 32 * kk + 4 * kq), qhi = *(const LAS u32x2*)(QL + fr * 72 + 32 * kk + 16 + 4 * kq);
            akp[kk] = __builtin_bit_cast(bf16x8, (u32x4){klo[0], klo[1], khi[0], khi[1]}); aqp[kk] = __builtin_bit_cast(bf16x8, (u32x4){qlo[0], qlo[1], qhi[0], qhi[1]}); }
#pragma unroll
        for (int a = 0; a < 4; ++a) aKT[a] = ldaz(KT + (16 * a) * 32, fr, kq);
        WAVE_LDS_SYNC();
        if (lane == 0) flags[2] = blk + 1;
        f32x4 Gr;
#pragma unroll
        for (int i = 0; i < 4; ++i) Gr[i] = __expf(gr[i]);
        const float G15 = __expf(g15);
        const int tcur = blk_tok0(dir, blk);
#pragma unroll
        for (int c = 0; c < 4; ++c) {
            f32x4 KS = (f32x4){0.f, 0.f, 0.f, 0.f}, QS = (f32x4){0.f, 0.f, 0.f, 0.f};
#pragma unroll
            for (int kk = 0; kk < 2; ++kk) { const f32x4 s0 = S[2 * kk][c], s1 = S[2 * kk + 1][c];
                const bf16x8 bs = __builtin_bit_cast(bf16x8, (u32x4){pk_bf16(s0[0], s0[1]), pk_bf16(s0[2], s0[3]), pk_bf16(s1[0], s1[1]), pk_bf16(s1[2], s1[3])});
                KS = __builtin_amdgcn_mfma_f32_16x16x32_bf16(akp[kk], bs, KS, 0, 0, 0); QS = __builtin_amdgcn_mfma_f32_16x16x32_bf16(aqp[kk], bs, QS, 0, 0, 0); }
            f32x4 R;
#pragma unroll
            for (int i = 0; i < 4; ++i) R[i] = br[i] * (vv[c][i] - Gr[i] * KS[i]);
            const f32x4 U = __builtin_amdgcn_mfma_f32_16x16x32_bf16(aT, packz(R), (f32x4){0.f, 0.f, 0.f, 0.f}, 0, 0, 0);
            const bf16x8 bu = packz(U);
            const f32x4 O = __builtin_amdgcn_mfma_f32_16x16x32_bf16(aP, bu, Gr * QS, 0, 0, 0);
#pragma unroll
            for (int a = 0; a < 4; ++a) S[a][c] = __builtin_amdgcn_mfma_f32_16x16x32_bf16(aKT[a], bu, S[a][c] * G15, 0, 0, 0);
#pragma unroll
            for (int i = 0; i < 4; ++i) { const int r = 4 * kq + i; Og[((size_t)c * TT + (size_t)(tcur + (dir ? 15 - r : r))) * 16 + fr] = (bf16_t)(pk_bf16(O[i], 0.f) & 0xffffu); }
        }
    }
}
template <int DIR>
__device__ __forceinline__ void scan_s5(KP p, LAS unsigned char* Lb, int idx, int l, int wv) {
    const int lane = tid_launder(wv) & 63, fr = lane & 15, kq = lane >> 4;
    constexpr int dir = DIR; const int g = (idx >> 1) & 15, b = idx >> 5;
    const bf16_t* Ug = (const bf16_t*)(p->ws + WS_P) + 7 * PANEL_EL + (size_t)b * TT * 256 + g * 16;
    bf16_t* Og = obuf(p->ws, 6 + dir) + (size_t)(b * 16 + g) * TT * 16;
    LAS bf16_t* UL = (LAS bf16_t*)Lb; LAS float* BL = (LAS float*)(Lb + 1024); LAS unsigned* HB = (LAS unsigned*)(Lb + 1024 + 8192);
    for (int i = lane; i < 256; i += 64) ((LAS unsigned*)UL)[i] = 0u;
    const float dt = expf(p->in[I_S5DT][(l * 2 + dir) * 16 + g]);
    const float* LRE = p->in[I_S5LRE] + ((l * 2 + dir) * 16 + g) * 64; const float* LIM = p->in[I_S5LIM] + ((l * 2 + dir) * 16 + g) * 64;
    float lbr, lbi;
    { const float lre = LRE[lane], lim = LIM[lane]; float sn, cs; sincosf(lim * dt, &sn, &cs); const float mag = expf(lre * dt); lbr = mag * cs; lbi = mag * sn; }
    bf16x8 Bf[8];
#pragma unroll
    for (int pt = 0; pt < 4; ++pt) { const int ps = fr + 16 * pt;
        const float lre = LRE[ps], lim = LIM[ps]; float sn, cs; sincosf(lim * dt, &sn, &cs); const float mag = expf(lre * dt);
        const float nr = mag * cs - 1.f, ni = mag * sn, den = 1.f / (lre * lre + lim * lim);
        const float bsr = (nr * lre + ni * lim) * den, bsi = (ni * lre - nr * lim) * den;
        u32x4 wre = (u32x4){0u, 0u, 0u, 0u}, wim = (u32x4){0u, 0u, 0u, 0u};
        if (kq < 2) { const float* bre = p->in[I_S5BRE] + (size_t)((l * 16 + g) * 64 + ps) * 16 + 8 * kq; const float* bim = p->in[I_S5BIM] + (size_t)((l * 16 + g) * 64 + ps) * 16 + 8 * kq;
#pragma unroll
            for (int e = 0; e < 4; ++e) { const float r0 = bre[2 * e], r1 = bre[2 * e + 1], i0 = bim[2 * e], i1 = bim[2 * e + 1];
                wre[e] = pk_bf16(bsr * r0 - bsi * i0, bsr * r1 - bsi * i1); wim[e] = pk_bf16(bsr * i0 + bsi * r0, bsr * i1 + bsi * r1); } }
        Bf[pt] = __builtin_bit_cast(bf16x8, wre); Bf[4 + pt] = __builtin_bit_cast(bf16x8, wim); }
    bf16x8 Cf[4];
    { const float* cre = p->in[I_S5CRE] + (size_t)((l * 16 + g) * 16 + fr) * 64; const float* cim = p->in[I_S5CIM] + (size_t)((l * 16 + g) * 16 + fr) * 64;
#pragma unroll
        for (int kk = 0; kk < 4; ++kk) { const int p0 = 16 * kk + 4 * kq; const f32x4 r = *(const f32x4*)(cre + p0), im = *(const f32x4*)(cim + p0);
            const u32x4 w = (u32x4){pk_bf16(r[0], -im[0]), pk_bf16(r[1], -im[1]), pk_bf16(r[2], -im[2]), pk_bf16(r[3], -im[3])}; Cf[kk] = __builtin_bit_cast(bf16x8, w); } }
    float hre = 0.f, him = 0.f;
    u32x4 U0, U1, U2;
#define S5_LOAD(R, BLK) do { if ((BLK) < 144) R = *(const u32x4*)(Ug + (size_t)(blk_tok0(dir, (BLK)) + ((lane >> 1) & 15)) * 256 + (lane & 1) * 8); } while (0)
#define S5_BLOCK(R, BLK) do { \
        if (lane < 32) *(LAS u32x4*)(UL + (lane >> 1) * 32 + (lane & 1) * 8) = R; \
        const int tcur = blk_tok0(dir, (BLK)); \
        S5_LOAD(R, (BLK) + 3); \
        WAVE_LDS_SYNC(); \
        { const bf16x8 au = *(const LAS bf16x8*)(UL + fr * 32 + 8 * kq); \
            _Pragma("unroll") for (int nt = 0; nt < 8; ++nt) { const f32x4 d = __builtin_amdgcn_mfma_f32_16x16x32_bf16(au, Bf[nt], (f32x4){0.f, 0.f, 0.f, 0.f}, 0, 0, 0); \
                _Pragma("unroll") for (int i = 0; i < 4; ++i) BL[(4 * kq + i) * 128 + 16 * nt + fr] = d[i]; } } \
        WAVE_LDS_SYNC(); \
        float bur[16], bui[16]; \
        _Pragma("unroll") for (int s = 0; s < 16; ++s) { bur[s] = BL[s * 128 + lane]; bui[s] = BL[s * 128 + 64 + lane]; } \
        _Pragma("unroll") for (int s = 0; s < 16; ++s) { \
            const int ls = dir ? 15 - s : s; \
            const float bre = dir ? bur[15 - s] : bur[s], bim = dir ? bui[15 - s] : bui[s]; \
            const float nre = lbr * hre - lbi * him + bre, nim = lbr * him + lbi * hre + bim; \
            hre = nre; him = nim; \
            HB[ls * 68 + lane] = pk_bf16(nre, nim); } \
        WAVE_LDS_SYNC(); \
        f32x4 acc = (f32x4){0.f, 0.f, 0.f, 0.f}; \
        _Pragma("unroll") for (int kk = 0; kk < 4; ++kk) { const bf16x8 a = *(const LAS bf16x8*)(HB + fr * 68 + 16 * kk + 4 * kq); acc = __builtin_amdgcn_mfma_f32_16x16x32_bf16(a, Cf[kk], acc, 0, 0, 0); } \
        _Pragma("unroll") for (int i = 0; i < 4; ++i) Og[(size_t)(tcur + 4 * kq + i) * 16 + fr] = (bf16_t)(pk_bf16(acc[i], 0.f) & 0xffffu); \
        WAVE_LDS_SYNC(); } while (0)
    S5_LOAD(U0, 0); S5_LOAD(U1, 1); S5_LOAD(U2, 2);
    for (int blk = 0; blk < 144; blk += 3) { S5_BLOCK(U0, blk); S5_BLOCK(U1, blk + 1); S5_BLOCK(U2, blk + 2); }
#undef S5_BLOCK
#undef S5_LOAD
}
constexpr int S5_SLOT = 8192, NSLOT = 3;
template <int DIR>
__device__ __forceinline__ void scan_s5_producer(KP p, LAS unsigned char* ring, LAS unsigned char* scratch, volatile LAS int* flags, int idx, int l, int wv) {
    const int lane = tid_launder(wv) & 63, fr = lane & 15, kq = lane >> 4;
    constexpr int dir = DIR; const int g = (idx >> 1) & 15, b = idx >> 5;
    const bf16_t* Ug = (const bf16_t*)(p->ws + WS_P) + 7 * PANEL_EL + (size_t)b * TT * 256 + g * 16;
    LAS bf16_t* UL = (LAS bf16_t*)scratch;
    for (int i = lane; i < 256; i += 64) ((LAS unsigned*)UL)[i] = 0u;
    const float dt = expf(p->in[I_S5DT][(l * 2 + dir) * 16 + g]);
    const float* LRE = p->in[I_S5LRE] + ((l * 2 + dir) * 16 + g) * 64; const float* LIM = p->in[I_S5LIM] + ((l * 2 + dir) * 16 + g) * 64;
    bf16x8 Bf[8];
#pragma unroll
    for (int pt = 0; pt < 4; ++pt) { const int ps = fr + 16 * pt;
        const float lre = LRE[ps], lim = LIM[ps]; float sn, cs; sincosf(lim * dt, &sn, &cs); const float mag = expf(lre * dt);
        const float nr = mag * cs - 1.f, ni = mag * sn, den = 1.f / (lre * lre + lim * lim);
        const float bsr = (nr * lre + ni * lim) * den, bsi = (ni * lre - nr * lim) * den;
        u32x4 wre = (u32x4){0u, 0u, 0u, 0u}, wim = (u32x4){0u, 0u, 0u, 0u};
        if (kq < 2) { const float* bre = p->in[I_S5BRE] + (size_t)((l * 16 + g) * 64 + ps) * 16 + 8 * kq; const float* bim = p->in[I_S5BIM] + (size_t)((l * 16 + g) * 64 + ps) * 16 + 8 * kq;
#pragma unroll
            for (int e = 0; e < 4; ++e) { const float r0 = bre[2 * e], r1 = bre[2 * e + 1], i0 = bim[2 * e], i1 = bim[2 * e + 1];
                wre[e] = pk_bf16(bsr * r0 - bsi * i0, bsr * r1 - bsi * i1); wim[e] = pk_bf16(bsr * i0 + bsi * r0, bsr * i1 + bsi * r1); } }
        Bf[pt] = __builtin_bit_cast(bf16x8, wre); Bf[4 + pt] = __builtin_bit_cast(bf16x8, wim); }
    u32x4 U0, U1, U2;
#define S5_LOAD(R, BLK) do { if ((BLK) < 144) R = *(const u32x4*)(Ug + (size_t)(blk_tok0(dir, (BLK)) + ((lane >> 1) & 15)) * 256 + (lane & 1) * 8); } while (0)
#define S5_PBLOCK(R, BLK) do { \
        LAS float* BL = (LAS float*)(ring + ((BLK) % NSLOT) * S5_SLOT); \
        if ((BLK) >= NSLOT) lds_wait_ge(flags + 1, (BLK) - NSLOT + 1); \
        if (lane < 32) *(LAS u32x4*)(UL + (lane >> 1) * 32 + (lane & 1) * 8) = R; \
        S5_LOAD(R, (BLK) + 3); \
        WAVE_LDS_SYNC(); \
        { const bf16x8 au = *(const LAS bf16x8*)(UL + fr * 32 + 8 * kq); \
            _Pragma("unroll") for (int nt = 0; nt < 8; ++nt) { const f32x4 d = __builtin_amdgcn_mfma_f32_16x16x32_bf16(au, Bf[nt], (f32x4){0.f, 0.f, 0.f, 0.f}, 0, 0, 0); \
                _Pragma("unroll") for (int i = 0; i < 4; ++i) BL[(4 * kq + i) * 128 + 16 * nt + fr] = d[i]; } } \
        WAVE_LDS_SYNC(); \
        if (lane == 0) flags[0] = (BLK) + 1; } while (0)
    S5_LOAD(U0, 0); S5_LOAD(U1, 1); S5_LOAD(U2, 2);
    for (int blk = 0; blk < 144; blk += 3) { S5_PBLOCK(U0, blk); S5_PBLOCK(U1, blk + 1); S5_PBLOCK(U2, blk + 2); }
#undef S5_PBLOCK
#undef S5_LOAD
}
template <int DIR>
__device__ __forceinline__ void scan_s5_consumer(KP p, LAS unsigned char* ring, LAS unsigned char* priv, volatile LAS int* flags, int idx, int l, int wv) {
    const int lane = tid_launder(wv) & 63, fr = lane & 15, kq = lane >> 4;
    constexpr int dir = DIR; const int g = (idx >> 1) & 15, b = idx >> 5;
    bf16_t* Og = obuf(p->ws, 6 + dir) + (size_t)(b * 16 + g) * TT * 16;
    LAS unsigned* HB = (LAS unsigned*)priv;
    const float dt = expf(p->in[I_S5DT][(l * 2 + dir) * 16 + g]);
    float lbr, lbi;
    { const float lre = p->in[I_S5LRE][((l * 2 + dir) * 16 + g) * 64 + lane], lim = p->in[I_S5LIM][((l * 2 + dir) * 16 + g) * 64 + lane]; float sn, cs; sincosf(lim * dt, &sn, &cs); const float mag = expf(lre * dt); lbr = mag * cs; lbi = mag * sn; }
    bf16x8 Cf[4];
    { const float* cre = p->in[I_S5CRE] + (size_t)((l * 16 + g) * 16 + fr) * 64; const float* cim = p->in[I_S5CIM] + (size_t)((l * 16 + g) * 16 + fr) * 64;
#pragma unroll
        for (int kk = 0; kk < 4; ++kk) { const int p0 = 16 * kk + 4 * kq; const f32x4 r = *(const f32x4*)(cre + p0), im = *(const f32x4*)(cim + p0);
            const u32x4 w = (u32x4){pk_bf16(r[0], -im[0]), pk_bf16(r[1], -im[1]), pk_bf16(r[2], -im[2]), pk_bf16(r[3], -im[3])}; Cf[kk] = __builtin_bit_cast(bf16x8, w); } }
    float hre = 0.f, him = 0.f;
    for (int blk = 0; blk < 144; ++blk) {
        const LAS float* BL = (const LAS float*)(ring + (blk % NSLOT) * S5_SLOT);
        lds_wait_ge(flags, blk + 1);
        float bur[16], bui[16];
#pragma unroll
        for (int s = 0; s < 16; ++s) { bur[s] = BL[s * 128 + lane]; bui[s] = BL[s * 128 + 64 + lane]; }
        WAVE_LDS_SYNC();
        if (lane == 0) flags[1] = blk + 1;
        const int tcur = blk_tok0(dir, blk);
#pragma unroll
        for (int s = 0; s < 16; ++s) {
            const int ls = dir ? 15 - s : s;
            const float bre = dir ? bur[15 - s] : bur[s], bim = dir ? bui[15 - s] : bui[s];
            const float nre = lbr * hre - lbi * him + bre, nim = lbr * him + lbi * hre + bim;
            hre = nre; him = nim;
            HB[ls * 68 + lane] = pk_bf16(nre, nim);
        }
        WAVE_LDS_SYNC();
        f32x4 acc = (f32x4){0.f, 0.f, 0.f, 0.f};
#pragma unroll
        for (int kk = 0; kk < 4; ++kk) { const bf16x8 a = *(const LAS bf16x8*)(HB + fr * 68 + 16 * kk + 4 * kq); acc = __builtin_amdgcn_mfma_f32_16x16x32_bf16(a, Cf[kk], acc, 0, 0, 0); }
#pragma unroll
        for (int i = 0; i < 4; ++i) Og[(size_t)(tcur + 4 * kq + i) * 16 + fr] = (bf16_t)(pk_bf16(acc[i], 0.f) & 0xffffu);
        WAVE_LDS_SYNC();
    }
}
__device__ __forceinline__ void phase_scan(KP p, LAS unsigned char* lds, int l, int tm, int wv) {
    const int tid = tid_launder(wv), wave = __builtin_amdgcn_readfirstlane(tid >> 6);
    constexpr int S5_AREA = 2 * LDS_WAVE, S5_FL = NSLOT * S5_SLOT + 1024 + 4352;
    static_assert(S5_FL + 64 <= S5_AREA, "S5 LDS area");
    LAS unsigned char* chainL = lds + 6 * LDS_WAVE;
    LAS unsigned char* convL = lds + 7 * LDS_WAVE;
    LAS unsigned char* ring = lds + 2 * LDS_WAVE; LAS unsigned char* scratch = ring + DN_NSLOT * DN_SLOT; volatile LAS int* flags = (volatile LAS int*)(scratch + 2 * 3072);
    static_assert(2 * LDS_WAVE + DN_NSLOT * DN_SLOT + 2 * 3072 + 64 <= 6 * LDS_WAVE, "scan LDS map");
#define S5P(K, IDX) do { LAS unsigned char* a5 = lds + (K) * S5_AREA; volatile LAS int* f5 = (volatile LAS int*)(a5 + S5_FL); const int idx_ = (IDX); \
        if (idx_ & 1) scan_s5_producer<1>(p, a5, a5 + NSLOT * S5_SLOT, f5, idx_, l, wv); else scan_s5_producer<0>(p, a5, a5 + NSLOT * S5_SLOT, f5, idx_, l, wv); } while (0)
#define S5C(K, IDX) do { LAS unsigned char* a5 = lds + (K) * S5_AREA; volatile LAS int* f5 = (volatile LAS int*)(a5 + S5_FL); const int idx_ = (IDX); \
        if (idx_ & 1) scan_s5_consumer<1>(p, a5, a5 + NSLOT * S5_SLOT + 1024, f5, idx_, l, wv); else scan_s5_consumer<0>(p, a5, a5 + NSLOT * S5_SLOT + 1024, f5, idx_, l, wv); } while (0)
    for (int vb = bid_launder(); vb < NVB; vb += gridDim.x) {
        if (tid == 0) { flags[0] = 0; flags[1] = 0; flags[2] = 0; }
        if (tid < 3) { volatile LAS int* f5 = (volatile LAS int*)(lds + tid * S5_AREA + S5_FL); f5[0] = 0; f5[1] = 0; }
        __syncthreads();
        if (vb < 128) {
            if (wave == 0 || wave == 4) { const int par = wave >> 2; if (tm & 1) { if (vb & 1) scan_dn_producer<1>(p, ring, scratch + par * 3072, flags, vb, par, wv); else scan_dn_producer<0>(p, ring, scratch + par * 3072, flags, vb, par, wv); } }
            else if (wave == 1) { if (tm & 4) { if (vb & 1) scan_ret_chunk<1>(p, chainL, vb, l, wv); else scan_ret_chunk<0>(p, chainL, vb, l, wv); } }
            else if (wave == 2) { if (tm & 2) S5P(0, vb); }
            else if (wave == 3) { if (tm & 2) S5C(0, vb); }
            else if (wave == 6) { if (tm & 1) { if (vb & 1) scan_dn_consumer<1>(p, ring, flags, vb, wv); else scan_dn_consumer<0>(p, ring, flags, vb, wv); } }
            else if (wave == 7) convert_moe_wave(p, convL, l, vb, 256, wv);
        } else {
            const int i3 = 128 + (vb - 128) * 3;
            if (wave == 0) { if (tm & 2) S5P(0, i3); } else if (wave == 1) { if (tm & 2) S5C(0, i3); }
            else if (wave == 4) { if (tm & 2) S5P(1, i3 + 1); } else if (wave == 5) { if (tm & 2) S5C(1, i3 + 1); }
            else if (wave == 3) { if (tm & 2) S5P(2, i3 + 2); } else if (wave == 7) { if (tm & 2) S5C(2, i3 + 2); }
            else if (wave == 2) { if (tm & 8) { if ((vb - 128) & 1) scan_gla_chunk<1>(p, chainL, vb - 128, wv); else scan_gla_chunk<0>(p, chainL, vb - 128, wv); } }
            else if (wave == 6) convert_moe_wave(p, convL, l, 128 + (vb - 128), 256, wv);
        }
        __syncthreads();
    }
#undef S5P
#undef S5C
}

__device__ __forceinline__ float gelu_tanh(float y) { const float x = 0.7978845608028654f * (y + 0.044715f * y * y * y); const float th = 1.f - 2.f / (__expf(2.f * x) + 1.f); return 0.5f * y * (1.f + th); }
__device__ __forceinline__ void phase_mixpost(KP p, LAS unsigned char* lds, int l, int wv, int mode) {
    const int tid = tid_launder(wv), lane = tid & 63, wave = tid >> 6;
    const bf16_t* P = (const bf16_t*)(p->ws + WS_P); bf16_t* MIX = (bf16_t*)(p->ws + WS_ABUF);
    LAS float* YF = (LAS float*)lds; LAS bf16_t* YB = (LAS bf16_t*)(lds + 16384);
    bf16x8 bfr[2][8];
    { const float* gw = p->in[I_GLUW] + (size_t)l * 256 * 256;
#pragma unroll
        for (int nt = 0; nt < 2; ++nt)
#pragma unroll
            for (int kk = 0; kk < 8; ++kk) { const int n = wave * 32 + nt * 16 + (lane & 15), k0 = 32 * kk + 8 * (lane >> 4); u32x4 w;
#pragma unroll
                for (int j = 0; j < 4; ++j) w[j] = pk_bf16(gw[(size_t)(k0 + 2 * j) * 256 + n], gw[(size_t)(k0 + 2 * j + 1) * 256 + n]);
                bfr[nt][kk] = __builtin_bit_cast(bf16x8, w); } }
    const float* s5d = p->in[I_S5D] + l * 256; const float* glub = p->in[I_GLUB] + l * 256;
    for (int vb = bid_launder(); vb < NVB; vb += gridDim.x) {
        const int l32 = lane & 31, tkb = tid >> 5, c8 = (tid & 31) * 8, tkh = wave * 2 + (lane >> 5);
        unsigned nrf[12], nrb[12], nrg[12]; u32x4 nyf, nyb, nuu;
#define MX_LOADS(TILE) do { const int m0_ = vb * 144 + (TILE) * 16, tb0_ = (vb & 15) * 144 + (TILE) * 16; \
            const size_t offt = (size_t)(m0_ + tkh) * 256 + 2 * l32;                                                \
            const size_t ooft = ((size_t)((vb >> 4) * 16 + (l32 >> 3)) * TT + (size_t)(tb0_ + tkh)) * 16 + ((2 * l32) & 15);     \
            _Pragma("unroll") for (int ps = 0; ps < 12; ++ps) { const int mixer = ps >> 2, head = ps & 3; \
                const int ob = mixer == 0 ? 0 : (mixer == 1 ? 2 : 4), gp = mixer == 0 ? 2 : (mixer == 1 ? 6 : 11); \
                nrf[ps] = *(const unsigned*)(obuf(p->ws, ob) + ooft + (size_t)head * 4 * TT * 16); nrb[ps] = *(const unsigned*)(obuf(p->ws, ob + 1) + ooft + (size_t)head * 4 * TT * 16); \
                nrg[ps] = *(const unsigned*)(P + (size_t)gp * PANEL_EL + offt + head * 64); } \
            { const size_t offb = (size_t)(m0_ + tkb) * 256 + c8; const size_t yoff = ((size_t)((vb >> 4) * 16 + (c8 >> 4)) * TT + (size_t)(tb0_ + tkb)) * 16 + (c8 & 15); \
                nyf = *(const u32x4*)(obuf(p->ws, 6) + yoff); nyb = *(const u32x4*)(obuf(p->ws, 7) + yoff); nuu = *(const u32x4*)(P + (size_t)7 * PANEL_EL + offb); } } while (0)
        MX_LOADS(0);
        for (int tile = 0; tile < 9; ++tile) {
            const int m0 = vb * 144 + tile * 16;
            unsigned rfv[12], rbv[12], rgv[12];
#pragma unroll
            for (int ps = 0; ps < 12; ++ps) { rfv[ps] = nrf[ps]; rbv[ps] = nrb[ps]; rgv[ps] = nrg[ps]; }
            const u32x4 yf = nyf, yb = nyb, uu = nuu;
            if (tile + 1 < 9) MX_LOADS(tile + 1);
            if (mode & 1)
#pragma unroll
            for (int ps = 0; ps < 12; ++ps) {
                const int tk = tkh, mixer = ps >> 2, head = ps & 3;
                float o0 = bflo(rfv[ps]) + bflo(rbv[ps]), o1 = bfhi(rfv[ps]) + bfhi(rbv[ps]);
                if (mixer == 1) { const float mean = half_sum32(o0 + o1) * (1.f / 64.f); o0 -= mean; o1 -= mean; }
                const float var = half_sum32(o0 * o0 + o1 * o1) * (1.f / 64.f);
                const float rn = rsqrtf(var + EPS);
                o0 = o0 * rn * siluf_(bflo(rgv[ps])); o1 = o1 * rn * siluf_(bfhi(rgv[ps]));
                *(unsigned*)(MIX + (size_t)(m0 + tk) * 1024 + (mixer == 2 ? 768 : mixer * 256) + head * 64 + 2 * l32) = pk_bf16(o0, o1);
            }
            if (mode & 2) { const int tk = tkb;
                const f32x4 d0 = *(const f32x4*)(s5d + c8), d1 = *(const f32x4*)(s5d + c8 + 4);
                float y[8];
#pragma unroll
                for (int q = 0; q < 4; ++q) { y[2 * q] = bflo(yf[q]) + bflo(yb[q]) + (q < 2 ? d0[2 * q] : d1[2 * q - 4]) * bflo(uu[q]); y[2 * q + 1] = bfhi(yf[q]) + bfhi(yb[q]) + (q < 2 ? d0[2 * q + 1] : d1[2 * q - 3]) * bfhi(uu[q]); }
#pragma unroll
                for (int q = 0; q < 8; ++q) y[q] = gelu_tanh(y[q]);
                *(LAS f32x4*)(YF + tk * 256 + c8) = (f32x4){y[0], y[1], y[2], y[3]}; *(LAS f32x4*)(YF + tk * 256 + c8 + 4) = (f32x4){y[4], y[5], y[6], y[7]};
                *(LAS u32x4*)(YB + tk * 264 + c8) = (u32x4){pk_bf16(y[0], y[1]), pk_bf16(y[2], y[3]), pk_bf16(y[4], y[5]), pk_bf16(y[6], y[7])}; }
            LDS_BARRIER();
            if (mode & 2)
#pragma unroll
            for (int nt = 0; nt < 2; ++nt) { f32x4 acc = (f32x4){0.f, 0.f, 0.f, 0.f};
#pragma unroll
                for (int kk = 0; kk < 8; ++kk) { const bf16x8 a = *(const LAS bf16x8*)(YB + (lane & 15) * 264 + 32 * kk + 8 * (lane >> 4)); acc = __builtin_amdgcn_mfma_f32_16x16x32_bf16(a, bfr[nt][kk], acc, 0, 0, 0); }
                const int n = wave * 32 + nt * 16 + (lane & 15); const float gb = glub[n];
#pragma unroll
                for (int i = 0; i < 4; ++i) { const int tk = 4 * (lane >> 4) + i; const float yv = YF[tk * 256 + n];
                    MIX[(size_t)(m0 + tk) * 1024 + 512 + n] = (bf16_t)(pk_bf16(yv * sigmoidf_(acc[i] + gb), 0.f) & 0xffffu); } }
            LDS_BARRIER();
        }
#undef MX_LOADS
    }
}

__device__ __forceinline__ void phase_final(KP p, int wv) {
    const int tid = tid_launder(wv), lane = tid & 63, gw = bid_launder() * 8 + (tid >> 6), nw = gridDim.x * 8;
    const float* g = p->in[I_FNG];
    const bool poison = xb_ld((unsigned*)(p->ws + WS_CTL) + XB_TMO) != 0u;
    f32x4 xn[4];
    if (gw < NB * SEQ) {
#pragma unroll
        for (int j = 0; j < 4; ++j) xn[j] = *(const f32x4*)(p->out + (size_t)gw * D + 4 * lane + 256 * j); }
    for (int r = gw; r < NB * SEQ; r += nw) {
        float* xr = p->out + (size_t)r * D;
        f32x4 xv[4]; float ss = 0.f;
#pragma unroll
        for (int j = 0; j < 4; ++j) { xv[j] = xn[j]; ss += xv[j][0] * xv[j][0] + xv[j][1] * xv[j][1] + xv[j][2] * xv[j][2] + xv[j][3] * xv[j][3]; }
        if (r + nw < NB * SEQ) {
#pragma unroll
            for (int j = 0; j < 4; ++j) xn[j] = *(const f32x4*)(p->out + (size_t)(r + nw) * D + 4 * lane + 256 * j); }
        ss = wave_sum(ss);
        const float rstd = rsqrtf(ss * (1.f / 1024.f) + EPS);
#pragma unroll
        for (int j = 0; j < 4; ++j) { const f32x4 gv = *(const f32x4*)(g + 4 * lane + 256 * j); *(f32x4*)(xr + 4 * lane + 256 * j) = poison ? (f32x4){NAN, NAN, NAN, NAN} : xv[j] * rstd * gv; }
    }
}

__global__ void __launch_bounds__(512, 2) fwd_kernel(Params parg) {
    KP p = (KP)__builtin_amdgcn_kernarg_segment_ptr();
    extern __shared__ __attribute__((aligned(16))) unsigned char lds_raw[];
    LAS unsigned char* lds = (LAS unsigned char*)lds_raw;
    const int wv = __builtin_amdgcn_readfirstlane((int)threadIdx.x >> 6);
    if (tid_launder(wv) == 0) *(LAS u32x4*)(lds + LDS_BAR_OFF) = (u32x4){0u, 0u, 0u, 0u};
    __syncthreads();
    const unsigned bar_x = xcd_barrier_post((unsigned*)(p->ws + WS_CTL), (volatile LAS unsigned*)(lds + LDS_BAR_OFF), tid_launder(wv)).x;
#define NEXT_PHASE() do { p = kp_launder(p); XcdBarrier bb_; { unsigned* bp_ = (unsigned*)(p->ws + WS_CTL); asm volatile("" : "+s"(bp_)); unsigned bx_ = bar_x; asm volatile("" : "+s"(bx_)); \
        unsigned lo_ = LDS_BAR_OFF; asm volatile("" : "+s"(lo_)); bb_.bar = bp_; bb_.x = bx_; bb_.st = (volatile LAS unsigned*)(lds + lo_); } xcd_barrier(bb_, tid_launder(wv)); p = kp_launder(p); } while (0)
#define REP(bit) for (int rep_ = ((REPEAT_MASK) & (bit)) ? 1 : 0; rep_ >= 0; --rep_)
    REP(1) { phase_prologue(p, lds, wv); NEXT_PHASE(); }
    for (int xb_ = 0; xb_ < EXTRA_BARRIERS; ++xb_) NEXT_PHASE();
    for (int l = 0; l < 2; ++l) {
        const int last = l == 1;
        REP(2) { phase_prep<false>(p, lds, l, l == 0 ? p->in[I_X] : p->out, l == 0 ? p->in[I_CTX] : (const float*)(p->ws + WS_Z), 0, wv);
            NEXT_PHASE(); }
        REP(4) { Dsc1 S{(const bf16_t*)(p->ws + WS_ABUF), (const bf16_t*)(p->ws + WS_WIN) + (size_t)l * NWIN * 1024, (bf16_t*)(p->ws + WS_P), (int)gridDim.x, bid_launder()}; pg8::gemm_phase(lds, S, wv); NEXT_PHASE(); }
        REP(8) { phase_mixprep(p, lds, l, wv); NEXT_PHASE(); }
        REP(16) { phase_scan(p, lds, l, rep_ ? SCAN_PROBE : 15, wv); NEXT_PHASE(); }
        REP(32) { phase_mixpost(p, lds, l, wv, rep_ ? MIXPOST_PROBE : 3); NEXT_PHASE(); }
        REP(64) { Dsc2 S{(const bf16_t*)(p->ws + WS_ABUF), (const bf16_t*)(p->ws + WS_WOUT) + (size_t)l * 1024 * 1024, l == 0 ? p->in[I_X] : p->out, l == 0 ? p->in[I_CTX] : (const float*)(p->ws + WS_Z),
                          p->out, (float*)(p->ws + WS_Z), (const float*)(p->ws + WS_MOD) + (size_t)l * 17 * 6144, (int)gridDim.x, bid_launder(), last, rep_}; pg8::gemm_phase(lds, S, wv); NEXT_PHASE(); }
        REP(128) { phase_prep<true>(p, lds, l, p->out, (const float*)(p->ws + WS_Z), last, wv); NEXT_PHASE(); }
        REP(256) { phase_moe_offsets(p, lds, last, wv); NEXT_PHASE(); }
        REP(512) { const int ntl = __builtin_amdgcn_readfirstlane(((const int*)(p->ws + WS_TILE))[0]);
            Dsc3 S{(const bf16_t*)(p->ws + WS_ABUF), (const bf16_t*)(p->ws + WS_WGU), (bf16_t*)(p->ws + WS_P), (const int*)(p->ws + WS_LIST), (const float*)(p->ws + WS_SLOTW), (const int*)(p->ws + WS_TILE), (int)gridDim.x, bid_launder(), ntl, nullptr}; pg8::gemm_phase(lds, S, wv); NEXT_PHASE(); }
        REP(1024) { const int ntl = __builtin_amdgcn_readfirstlane(((const int*)(p->ws + WS_TILE))[0]);
            Dsc4 S{(const bf16_t*)(p->ws + WS_P), (const bf16_t*)(p->ws + WS_WDN), p->out, (float*)(p->ws + WS_Z), (const float*)(p->ws + WS_MOD) + (size_t)l * 17 * 6144, (const int*)(p->ws + WS_LIST), (const int*)(p->ws + WS_TILE), (int)gridDim.x, bid_launder(), ntl, rep_, nullptr}; pg8::gemm_phase(lds, S, wv); NEXT_PHASE(); }
    }
#undef REP
    if (PHASE_MASK & 2048) phase_final(p, wv);
#undef NEXT_PHASE
}

extern "C" void kernel_launch(void* const* d_in, const int* in_sizes, int n_in, void* d_out, int out_size, void* d_ws, size_t ws_size, hipStream_t stream) {
    static int grid = 0;
    if (grid == 0) {
        if (n_in != 31 || out_size != NB * SEQ * D || ws_size < WS_END) { fprintf(stderr, "kernel_launch: unexpected problem shape (n_in %d, out %d, ws %zu)\n", n_in, out_size, ws_size); grid = -1; return; }
        int dev = 0, cus = 0, per_cu = 0;
        if (hipGetDevice(&dev) != hipSuccess || hipDeviceGetAttribute(&cus, hipDeviceAttributeMultiprocessorCount, dev) != hipSuccess) { grid = -1; return; }
        if (hipFuncSetAttribute((const void*)fwd_kernel, hipFuncAttributeMaxDynamicSharedMemorySize, LDS_BYTES) != hipSuccess) { fprintf(stderr, "kernel_launch: hipFuncSetAttribute failed\n"); grid = -1; return; }
        if (hipOccupancyMaxActiveBlocksPerMultiprocessor(&per_cu, (const void*)fwd_kernel, 512, LDS_BYTES) != hipSuccess || per_cu < 1) fprintf(stderr, "kernel_launch: occupancy query reports %d\n", per_cu);
        (void)hipGetLastError();
        grid = cus > 256 ? 256 : cus;
    }
    if (grid < 0) return;
    (void)hipMemsetAsync((char*)d_ws + WS_CTL, 0, 65536, stream);
    Params p{};
    for (int i = 0; i < 31; ++i) p.in[i] = (const float*)d_in[i];
    p.out = (float*)d_out; p.ws = (unsigned char*)d_ws;
    hipLaunchKernelGGL(fwd_kernel, dim3(grid), dim3(512), LDS_BYTES, stream, p);
}
```

```cpp
#include <hip/hip_runtime.h>
#include <cstdio>
#include <cstdint>

#define LAS __attribute__((address_space(3)))
typedef unsigned short bf16_t;
typedef short bf16x8 __attribute__((ext_vector_type(8)));
typedef float f32x4 __attribute__((ext_vector_type(4)));
typedef float f32x2 __attribute__((ext_vector_type(2)));
typedef unsigned u32x4 __attribute__((ext_vector_type(4)));
typedef unsigned u32x2 __attribute__((ext_vector_type(2)));

constexpr int D = 1024, NB = 16, SEQ = 2048, LC = 256, TT = 2304, NTOK = NB * TT;
constexpr int DIN = 3120, NWIN = 3328, NPANEL = 13, NVB = 256;
constexpr float EPS = 1e-6f;
constexpr size_t PANEL_EL = (size_t)NTOK * 256;
constexpr int MAXTILES = 168, MAXSLOT = MAXTILES * 256;

constexpr size_t WS_CTL = 0;
constexpr size_t WS_MOD = 65536;
constexpr size_t WS_Z = WS_MOD + 1048576;
constexpr size_t WS_WIN = WS_Z + (size_t)NB * LC * D * 4;
constexpr size_t WS_WOUT = WS_WIN + (size_t)2 * NWIN * D * 2;
constexpr size_t WS_WGU = WS_WOUT + (size_t)2 * D * D * 2;
constexpr size_t WS_WDN = WS_WGU + (size_t)16 * 1024 * 1024 * 2;
constexpr size_t WS_P = WS_WDN + (size_t)16 * 1024 * 512 * 2;
constexpr size_t WS_ABUF = WS_P + NPANEL * PANEL_EL * 2;
constexpr size_t WS_GDEC = WS_ABUF + (size_t)NTOK * D * 2;
constexpr size_t WS_DNAB = WS_GDEC + (size_t)NTOK * 256 * 4;
constexpr size_t WS_O = WS_DNAB + (size_t)NTOK * 16 * 4;
constexpr size_t WS_ROUTE = WS_O + 4 * PANEL_EL * 2;
constexpr size_t WS_HIST = WS_ROUTE + (size_t)NTOK * 16;
constexpr size_t WS_LIST = WS_HIST + 256 * 32 * 4;
constexpr size_t WS_SLOTW = WS_LIST + 196608;
constexpr size_t WS_TILE = WS_SLOTW + 393216;
constexpr size_t WS_SMALL = WS_TILE + 4096;
constexpr size_t WS_RB8 = WS_SMALL + (size_t)NTOK * 64 * 2;
constexpr size_t WS_END = WS_RB8 + 65536;
static_assert(WS_END <= (size_t)512 * 1024 * 1024, "workspace");
static_assert((size_t)MAXSLOT * 4 <= 196608 && (size_t)MAXSLOT * 8 <= 393216 && (size_t)MAXSLOT * D * 2 <= NPANEL * PANEL_EL * 2, "moe buffers");

constexpr int LDS_WAVE = 18432;
constexpr int LDS_BAR_OFF = 8 * LDS_WAVE;
constexpr int LDS_BYTES = LDS_BAR_OFF + 256;

#ifndef SCAN_PROBE
#define SCAN_PROBE 15
#endif
#ifndef EXTRA_BARRIERS
#define EXTRA_BARRIERS 0
#endif
#ifndef MIXPOST_PROBE
#define MIXPOST_PROBE 3
#endif
#ifndef REPEAT_MASK
#define REPEAT_MASK 0
#endif
#ifndef PHASE_MASK
#define PHASE_MASK 0xFFFF
#endif
struct Params { const float* in[31]; float* out; unsigned char* ws; };
typedef const Params __attribute__((address_space(4)))* KP;
__device__ __forceinline__ KP kp_launder(KP p) { asm volatile("" : "+s"(p)); return p; }
__device__ __forceinline__ int bid_launder() { int b = blockIdx.x; asm volatile("" : "+s"(b)); return b; }
__device__ __forceinline__ int tid_launder(int wv) { unsigned m = ~0u; asm volatile("" : "+s"(wv), "+s"(m)); int t = wv * 64 + (int)__builtin_amdgcn_mbcnt_hi(m, __builtin_amdgcn_mbcnt_lo(m, 0u)); asm volatile("" : "+v"(t)); return t; }
enum { I_X = 0, I_C, I_CTX, I_CCTX, I_WADA, I_BADA, I_NORMG, I_WIN, I_WOUT, I_GKW, I_GKB, I_RETD, I_S5LRE, I_S5LIM, I_S5DT, I_S5BRE, I_S5BIM, I_S5CRE, I_S5CIM,
       I_S5D, I_GLUW, I_GLUB, I_CONVW, I_ALOG, I_DTB, I_RW, I_RB, I_WG, I_WU, I_WD, I_FNG };

__device__ __forceinline__ float bf2f(unsigned v) { return __uint_as_float(v << 16); }
__device__ __forceinline__ float bflo(unsigned v) { return __uint_as_float(v << 16); }
__device__ __forceinline__ float bfhi(unsigned v) { return __uint_as_float(v & 0xffff0000u); }
typedef __bf16 bf16v2 __attribute__((ext_vector_type(2)));
__device__ __forceinline__ unsigned pk_bf16(float lo, float hi) { const f32x2 v = {lo, hi}; return __builtin_bit_cast(unsigned, __builtin_convertvector(v, bf16v2)); }
__device__ __forceinline__ float sigmoidf_(float x) { return 1.f / (1.f + __expf(-x)); }
__device__ __forceinline__ float siluf_(float x) { return x / (1.f + __expf(-x)); }
__device__ __forceinline__ float softplusf_(float x) { return fmaxf(x, 0.f) + log1pf(__expf(-fabsf(x))); }
__device__ __forceinline__ float dpp_row_sum16(float v) {
    v += __builtin_bit_cast(float, __builtin_amdgcn_update_dpp(0, __builtin_bit_cast(int, v), 0xB1, 0xF, 0xF, true));
    v += __builtin_bit_cast(float, __builtin_amdgcn_update_dpp(0, __builtin_bit_cast(int, v), 0x4E, 0xF, 0xF, true));
    v += __builtin_bit_cast(float, __builtin_amdgcn_update_dpp(0, __builtin_bit_cast(int, v), 0x141, 0xF, 0xF, true));
    v += __builtin_bit_cast(float, __builtin_amdgcn_update_dpp(0, __builtin_bit_cast(int, v), 0x140, 0xF, 0xF, true));
    return v;
}
__device__ __forceinline__ float wave_sum(float v) {
    v = dpp_row_sum16(v); v += __shfl_xor(v, 16, 64); v += __shfl_xor(v, 32, 64);
    return v;
}
__device__ __forceinline__ float half_sum32(float v) {
    v = dpp_row_sum16(v); v += __shfl_xor(v, 16, 64);
    return v;
}
__device__ __forceinline__ float quad_sum(float v) {
    v += __builtin_bit_cast(float, __builtin_amdgcn_update_dpp(0, __builtin_bit_cast(int, v), 0xB1, 0xF, 0xF, true));
    v += __builtin_bit_cast(float, __builtin_amdgcn_update_dpp(0, __builtin_bit_cast(int, v), 0x4E, 0xF, 0xF, true));
    return v;
}
#define WAVE_LDS_SYNC() asm volatile("s_waitcnt lgkmcnt(0)" ::: "memory")
#define LDS_BARRIER() asm volatile("s_waitcnt lgkmcnt(0)\n\ts_barrier" ::: "memory")
__device__ __forceinline__ const float* res_row_c(const float* lat, const float* ctx, int m) { const int b = m / TT, t = m - b * TT; return t < LC ? ctx + (size_t)(b * LC + t) * D : lat + (size_t)(b * SEQ + t - LC) * D; }
__device__ __forceinline__ float* res_row(float* lat, float* ctx, int m) { const int b = m / TT, t = m - b * TT; return t < LC ? ctx + (size_t)(b * LC + t) * D : lat + (size_t)(b * SEQ + t - LC) * D; }

#define XB_TMO      128
#define XB_XCNT(j)  (256  + 64 * (j))
#define XB_XSUB(j)  (1280 + 64 * (j))
#define XB_XGEN(j)  (2304 + 64 * (j))
#define XB_TOP      3328
#define XB_TOPGEN   3392
#define XCD_BAR_WORDS 3456
#define XB_SPIN_CAP (1u << 18)

__device__ __forceinline__ unsigned xb_ld(unsigned* p)              { return __hip_atomic_load(p, __ATOMIC_RELAXED, __HIP_MEMORY_SCOPE_AGENT); }
__device__ __forceinline__ unsigned xb_add(unsigned* p, unsigned v) { return __hip_atomic_fetch_add(p, v, __ATOMIC_RELAXED, __HIP_MEMORY_SCOPE_AGENT); }
__device__ __forceinline__ unsigned xb_xcc_id() { return (unsigned)__builtin_amdgcn_s_getreg((3 << 11) | 20) & 0xFu; }
#define XB_SPIN(cond, bar) do { unsigned _sp = 0; while (cond) { __builtin_amdgcn_s_sleep(1); \
    if ((++_sp & 255u) == 0u) { if (xb_ld(&(bar)[XB_TMO])) break; if (_sp > XB_SPIN_CAP) { atomicAdd(&(bar)[XB_TMO], 1u); break; } } } } while (0)

struct XcdBarrier { unsigned* bar; unsigned x; volatile LAS unsigned* st; };

__device__ __forceinline__ XcdBarrier xcd_barrier_post(unsigned* bar, volatile LAS unsigned* st, int tid) {
    XcdBarrier b; b.bar = bar; b.x = xb_xcc_id(); b.st = st;
    if (tid == 0) (void)xb_add(&bar[XB_XCNT(b.x)], 1u);
    return b;
}
__device__ __forceinline__ void xcd_barrier_complete(unsigned* bar, unsigned x, unsigned& nloc, unsigned& nx) {
    const unsigned G = gridDim.x * gridDim.y * gridDim.z;
    unsigned sum, cnt, mine, sp = 0u;
    for (;;) {
        sum = 0u; cnt = 0u; mine = 0u;
#pragma unroll
        for (unsigned j = 0; j < 16; ++j) { const unsigned c = xb_ld(&bar[XB_XCNT(j)]); sum += c; cnt += (c > 0u) ? 1u : 0u; mine = (j == x) ? c : mine; }
        if (sum == G) break;
        __builtin_amdgcn_s_sleep(1);
        if ((++sp & 255u) == 0u) { if (xb_ld(&bar[XB_TMO])) break; if (sp > XB_SPIN_CAP) { atomicAdd(&bar[XB_TMO], 1u); break; } }
    }
    nloc = mine > 0u ? mine : 1u; nx = cnt > 0u ? cnt : 1u;
}
__device__ __forceinline__ void xcd_barrier(const XcdBarrier& b, int tid) {
    asm volatile("s_waitcnt vmcnt(0)" ::: "memory");
    __syncthreads();
    if (tid == 0) {
        unsigned* bar = b.bar;
        __builtin_amdgcn_s_waitcnt(0);
        unsigned nloc = b.st[0], nx = b.st[1];
        if (nloc == 0u) { xcd_barrier_complete(bar, b.x, nloc, nx); b.st[0] = nloc; b.st[1] = nx; }
        const unsigned old = xb_add(&bar[XB_XSUB(b.x)], 1u);
        const unsigned gen = old / nloc;
        if (old + 1u == (gen + 1u) * nloc) {
            __builtin_amdgcn_fence(__ATOMIC_RELEASE, "agent");
            asm volatile("s_waitcnt vmcnt(0)" ::: "memory");
            const unsigned og = xb_add(&bar[XB_TOP], 1u);
            const unsigned tg = og / nx;
            if (og + 1u == (tg + 1u) * nx) xb_add(&bar[XB_TOPGEN], 1u);
            else XB_SPIN(xb_ld(&bar[XB_TOPGEN]) == tg, bar);
            __builtin_amdgcn_fence(__ATOMIC_ACQUIRE, "agent");
            xb_add(&bar[XB_XGEN(b.x)], 1u);
            asm volatile("s_waitcnt vmcnt(0)" ::: "memory");
        } else {
            XB_SPIN(xb_ld(&bar[XB_XGEN(b.x)]) == gen, bar);
            __builtin_amdgcn_fence(__ATOMIC_ACQUIRE, "agent");
            asm volatile("s_waitcnt vmcnt(0)" ::: "memory");
        }
    }
    __syncthreads();
}

namespace pg8 {
constexpr int BM = 256, BK = 64, HALF = 128, HTB = HALF * BK * 2, STAGE_BYTES = 8 * HTB, NXCD = 8, WGM = 8;
__device__ __forceinline__ int lds_byte(int r, int c) { const int st = (r >> 4) * 2 + (c >> 5), rr = r & 15, cc = c & 31, ob = rr * 64 + cc * 2; return st * 1024 + (ob ^ (((ob >> 9) & 1) << 5)); }
__device__ __forceinline__ void stage_rc(int b, int& R, int& C) { const int st = b / 1024, sb = b % 1024, swz = sb ^ (((sb >> 9) & 1) << 5); R = (st >> 1) * 16 + swz / 64; C = (st & 1) * 32 + (swz % 64) / 2; }
__device__ __forceinline__ int perm32(int rho) { const int n = rho >> 4, i = rho & 15; return 8 * (i >> 2) + 4 * n + (i & 3); }

__device__ __forceinline__ bool static_order(int i, int G, int c, int nM, int nN, int& pm, int& pn) {
    const int nwg = nM * nN; const long L = (long)i * G + c; if (L >= nwg) return false;
    int wgid = (int)L; { const int q = nwg / NXCD, r = nwg % NXCD, xcd = wgid % NXCD, off = wgid / NXCD; wgid = (xcd < r ? xcd * (q + 1) : r * (q + 1) + (xcd - r) * q) + off; }
    const int nig = WGM * nN, gid = wgid / nig, fm = gid * WGM, gsz = (nM - fm) < WGM ? (nM - fm) : WGM;
    pm = fm + ((wgid % nig) % gsz); pn = (wgid % nig) / gsz; return true;
}

template <class DSC>
__device__ __forceinline__ void gemm_phase(LAS unsigned char* lds, const DSC& S, int wv) {
    const int tid = tid_launder(wv), wid = __builtin_amdgcn_readfirstlane(tid >> 6), lane = tid & 63, wr = wid >> 2, wc = wid & 3, fr = lane & 15, fq = lane >> 4;
    constexpr int K = DSC::K, nt = K / BK, LDB = DSC::LDB;
    int sR[2], sC[2]; unsigned voffB[2];
#pragma unroll
    for (int i = 0; i < 2; ++i) { int R, C; stage_rc(tid * 16 + i * 8192, R, C); sR[i] = R; sC[i] = C; const int Rb = DSC::PERM ? ((R & ~31) + perm32(R & 31)) : R; voffB[i] = (unsigned)(Rb * LDB + C) * 2u; }
    constexpr size_t kstep = (size_t)(BK * 2);
    constexpr size_t hstepB = (size_t)HALF * LDB * 2;
    const unsigned ldsw = (unsigned)wid * 1024u;
    const int aoff = lds_byte(wr * 64 + fr, fq * 8), boff = lds_byte(wc * 32 + fr, fq * 8);
#define PG8_SA(b, h) (((b) * 2 + (h)) * HTB)
#define PG8_SB(b, h) ((4 + (b) * 2 + (h)) * HTB)
#define PG8_STAGE(bufoff, gbase, voff) do { _Pragma("unroll") for (int _i = 0; _i < 2; ++_i) \
        __builtin_amdgcn_global_load_lds((const unsigned*)((const char*)(gbase) + (voff)[_i]), (LAS unsigned*)(lds + (bufoff) + ldsw + _i * 8192), 16, 0, 0); } while (0)
#define PG8_LDA(dst, b, h) do { _Pragma("unroll") for (int m = 0; m < 4; ++m) _Pragma("unroll") for (int k = 0; k < 2; ++k) dst[m][k] = *(const LAS bf16x8*)(lds + PG8_SA(b, h) + aoff + m * 2048 + k * 1024); } while (0)
#define PG8_LDB(dst, b, h) do { _Pragma("unroll") for (int n = 0; n < 2; ++n) _Pragma("unroll") for (int k = 0; k < 2; ++k) dst[n][k] = *(const LAS bf16x8*)(lds + PG8_SB(b, h) + boff + n * 2048 + k * 1024); } while (0)
#define PG8_MMA(ai, bj, At, Bt) do { __builtin_amdgcn_s_setprio(1); _Pragma("unroll") for (int m = 0; m < 4; ++m) _Pragma("unroll") for (int n = 0; n < 2; ++n) _Pragma("unroll") for (int k = 0; k < 2; ++k) \
        acc[ai][bj][m][n] = __builtin_amdgcn_mfma_f32_16x16x32_bf16(Bt[n][k], At[m][k], acc[ai][bj][m][n], 0, 0, 0); __builtin_amdgcn_s_setprio(0); } while (0)
#define PG8_WAIT_V(n) asm volatile("s_waitcnt vmcnt(" #n ")" ::: "memory")
#define PG8_WAIT_L(n) asm volatile("s_waitcnt lgkmcnt(" #n ")" ::: "memory")
#define PG8_BAR __builtin_amdgcn_s_barrier()
#define PG8_SCHED __builtin_amdgcn_sched_barrier(0)
    typename DSC::Unit cur, nxt; int ui = 0;
    S.begin(lds, tid);
    if (!S.next(0, cur)) return;
    f32x4 acc[2][2][4][2];
#pragma unroll
    for (int a = 0; a < 2; ++a)
#pragma unroll
        for (int b = 0; b < 2; ++b)
#pragma unroll
            for (int m = 0; m < 4; ++m)
#pragma unroll
                for (int n = 0; n < 2; ++n) acc[a][b][m][n] = (f32x4){0.f, 0.f, 0.f, 0.f};
    bf16x8 At[4][2], B0[2][2], B1[2][2];
    constexpr size_t hstepA = (size_t)HALF * 1024 * 2;
    unsigned va[2][2], vn[2][2];
#define PG8_STAGE_A(bufoff, h, gb, V) do { if constexpr (DSC::GATHER) { PG8_STAGE(bufoff, gb, V[h]); } else { PG8_STAGE(bufoff, (gb) + (h) * hstepA, V[0]); } } while (0)
    const char* cA = S.a_base(cur); S.a_off(cur, sR, sC, va);
    const char* cBl = S.b_lo(cur); const char* cBh = S.b_hi(cur);
    PG8_STAGE(PG8_SB(0, 0), cBl, voffB); PG8_STAGE_A(PG8_SA(0, 0), 0, cA, va); PG8_STAGE(PG8_SB(0, 1), cBl + hstepB, voffB); PG8_STAGE_A(PG8_SA(0, 1), 1, cA, va);
    if (wr == 1) PG8_BAR;
    PG8_WAIT_V(4); PG8_BAR;
    PG8_STAGE(PG8_SB(1, 0), cBl + kstep, voffB); PG8_STAGE_A(PG8_SA(1, 0), 0, cA + kstep, va); PG8_STAGE(PG8_SB(1, 1), cBl + hstepB + kstep, voffB);
    PG8_WAIT_V(6); PG8_BAR;
    for (;;) {
        const bool has_next = S.next(ui + 1, nxt);
        const char* nA; const char* nBl; const char* nBh;
        if (has_next) { nA = S.a_base(nxt); nBl = S.b_lo(nxt); nBh = S.b_hi(nxt); }
        else { nA = cA; nBl = cBl; nBh = cBh; }
        if constexpr (DSC::GATHER) {
#pragma unroll
            for (int h = 0; h < 2; ++h)
#pragma unroll
                for (int i = 0; i < 2; ++i) vn[h][i] = va[h][i];
            if (has_next) S.a_off(nxt, sR, sC, vn); }
        for (int t = 0; t < nt; t += 2) {
            const bool last = (t == nt - 2);
            const char* a1 = cA + (size_t)(t + 1) * kstep;
            const char* a2 = last ? nA : cA + (size_t)(t + 2) * kstep;
            const char* b2 = last ? nBl : ((t + 2) < nt / 2 ? cBl : cBh) + (size_t)(t + 2) * kstep;
            const char* a3 = a2 + kstep; const char* b3 = b2 + kstep;
            unsigned vs[2][2];
#pragma unroll
            for (int h = 0; h < 2; ++h)
#pragma unroll
                for (int i = 0; i < 2; ++i) vs[h][i] = (DSC::GATHER && last) ? vn[h][i] : va[h][i];
            PG8_LDB(B0, 0, 0); PG8_SCHED; PG8_LDA(At, 0, 0); PG8_STAGE_A(PG8_SA(1, 1), 1, a1, va);
            PG8_WAIT_L(8); PG8_BAR; PG8_WAIT_L(0); PG8_MMA(0, 0, At, B0); PG8_BAR; PG8_SCHED;
            PG8_LDB(B1, 0, 1); PG8_STAGE(PG8_SB(0, 0), b2, voffB);
            PG8_BAR; PG8_WAIT_L(0); PG8_MMA(0, 1, At, B1); PG8_BAR;
            PG8_LDA(At, 0, 1); PG8_STAGE_A(PG8_SA(0, 0), 0, a2, vs);
            PG8_BAR; PG8_WAIT_L(0); PG8_MMA(1, 0, At, B0); PG8_BAR; PG8_SCHED;
            PG8_STAGE(PG8_SB(0, 1), b2 + hstepB, voffB);
            PG8_WAIT_V(6); PG8_BAR; PG8_MMA(1, 1, At, B1); PG8_BAR;
            PG8_LDB(B0, 1, 0); PG8_SCHED; PG8_LDA(At, 1, 0); PG8_STAGE_A(PG8_SA(0, 1), 1, a2, vs);
            PG8_WAIT_L(8); PG8_BAR; PG8_WAIT_L(0); PG8_MMA(0, 0, At, B0); PG8_BAR; PG8_SCHED;
            PG8_LDB(B1, 1, 1); PG8_STAGE(PG8_SB(1, 0), b3, voffB);
            PG8_BAR; PG8_WAIT_L(0); PG8_MMA(0, 1, At, B1); PG8_BAR;
            PG8_LDA(At, 1, 1); PG8_STAGE_A(PG8_SA(1, 0), 0, a3, vs);
            PG8_BAR; PG8_WAIT_L(0); PG8_MMA(1, 0, At, B0); PG8_BAR; PG8_SCHED;
            PG8_STAGE(PG8_SB(1, 1), b3 + hstepB, voffB);
            PG8_WAIT_V(6); PG8_BAR; PG8_MMA(1, 1, At, B1); PG8_BAR;
        }
        S.epi(acc, cur, wr, wc, fr, fq);
        if (!has_next) break;
#pragma unroll
        for (int a = 0; a < 2; ++a)
#pragma unroll
            for (int b = 0; b < 2; ++b)
#pragma unroll
                for (int m = 0; m < 4; ++m)
#pragma unroll
                    for (int n = 0; n < 2; ++n) acc[a][b][m][n] = (f32x4){0.f, 0.f, 0.f, 0.f};
        cur = nxt; cA = nA; cBl = nBl; cBh = nBh; ++ui;
        if constexpr (DSC::GATHER) {
#pragma unroll
            for (int h = 0; h < 2; ++h)
#pragma unroll
                for (int i = 0; i < 2; ++i) va[h][i] = vn[h][i]; }
    }
    PG8_WAIT_V(0);
    if (wr == 0) PG8_BAR;
    PG8_BAR;
#undef PG8_SA
#undef PG8_SB
#undef PG8_STAGE
#undef PG8_STAGE_A
#undef PG8_LDA
#undef PG8_LDB
#undef PG8_MMA
#undef PG8_WAIT_V
#undef PG8_WAIT_L
#undef PG8_BAR
#undef PG8_SCHED
}
}

__device__ __forceinline__ void std_a_off(const int (&sR)[2], const int (&sC)[2], unsigned (&v)[2][2]) {
#pragma unroll
    for (int h = 0; h < 2; ++h)
#pragma unroll
        for (int i = 0; i < 2; ++i) v[h][i] = (unsigned)((sR[i] + 128 * h) * 1024 + sC[i]) * 2u;
}
struct Dsc1 {
    static constexpr int K = 1024, LDB = 1024; static constexpr bool PERM = true, GATHER = false;
    struct Unit { int pm, pn; };
    const bf16_t* A; const bf16_t* Bt; bf16_t* P; int G, c;
    __device__ __forceinline__ void begin(LAS unsigned char*, int) const {}
    __device__ __forceinline__ bool next(int i, Unit& u) const { return pg8::static_order(i, G, c, NTOK / 256, 12, u.pm, u.pn); }
    __device__ __forceinline__ const char* a_base(const Unit& u) const { return (const char*)A + (size_t)u.pm * 256 * 1024 * 2; }
    __device__ __forceinline__ void a_off(const Unit&, const int (&sR)[2], const int (&sC)[2], unsigned (&v)[2][2]) const { std_a_off(sR, sC, v); }
    __device__ __forceinline__ const char* b_lo(const Unit& u) const { return (const char*)Bt + (size_t)u.pn * 256 * 1024 * 2; }
    __device__ __forceinline__ const char* b_hi(const Unit& u) const { return b_lo(u); }
    __device__ __forceinline__ void epi(const f32x4 (&acc)[2][2][4][2], const Unit& u, int wr, int wc, int fr, int fq) const {
        bf16_t* base = P + (size_t)u.pn * PANEL_EL + (size_t)(u.pm * 256 + wr * 64 + fr) * 256 + wc * 32 + 8 * fq;
        const bool rope = (u.pn == 3 || u.pn == 4) && (u.pm % 9) != 0;
        float invf[2][4]; bool byrow[2][4];
#pragma unroll
        for (int bj = 0; bj < 2; ++bj)
#pragma unroll
            for (int j = 0; j < 4; ++j) { const int col = bj * 128 + wc * 32 + 8 * fq + 2 * j, i = (col & 63) >> 1; invf[bj][j] = exp2f(-(float)(i & 15) * (13.287712379549449f / 16.f)); byrow[bj][j] = i < 16; }
#pragma unroll
        for (int ai = 0; ai < 2; ++ai)
#pragma unroll
            for (int m = 0; m < 4; ++m) { bf16_t* rowp = base + (size_t)(ai * 128 + m * 16) * 256;
                const int pos = ((u.pm % 9) - 1) * 256 + wr * 64 + fr + ai * 128 + m * 16;
#pragma unroll
                for (int bj = 0; bj < 2; ++bj) { f32x4 v0 = acc[ai][bj][m][0], v1 = acc[ai][bj][m][1];
                    if (rope) { float x[8] = {v0[0], v0[1], v0[2], v0[3], v1[0], v1[1], v1[2], v1[3]};
#pragma unroll
                        for (int j = 0; j < 4; ++j) { const float ang = (float)(byrow[bj][j] ? (pos >> 6) : (pos & 63)) * invf[bj][j]; const float sn = __sinf(ang), cs = __cosf(ang);
                            const float t1 = x[2 * j], t2 = x[2 * j + 1]; x[2 * j] = t1 * cs - t2 * sn; x[2 * j + 1] = t1 * sn + t2 * cs; }
                        v0 = (f32x4){x[0], x[1], x[2], x[3]}; v1 = (f32x4){x[4], x[5], x[6], x[7]}; }
                    *(u32x4*)(rowp + bj * 128) = (u32x4){pk_bf16(v0[0], v0[1]), pk_bf16(v0[2], v0[3]), pk_bf16(v1[0], v1[1]), pk_bf16(v1[2], v1[3])}; } }
    }
};
struct Dsc2 {
    static constexpr int K = 1024, LDB = 1024; static constexpr bool PERM = false, GATHER = false;
    struct Unit { int pm, pn; };
    const bf16_t* A; const bf16_t* Bt; const float* lat_in; const float* ctx_in; float* lat_out; float* ctx_out; const float* mod; int G, c, last, dry;
    __device__ __forceinline__ void begin(LAS unsigned char*, int) const {}
    __device__ __forceinline__ bool next(int i, Unit& u) const {
        int pm, pn; if (!pg8::static_order(i, G, c, last ? 128 : 144, 4, pm, pn)) return false;
        u.pm = last ? (pm >> 3) * 9 + 1 + (pm & 7) : pm; u.pn = pn; return true; }
    __device__ __forceinline__ const char* a_base(const Unit& u) const { return (const char*)A + (size_t)u.pm * 256 * 1024 * 2; }
    __device__ __forceinline__ void a_off(const Unit&, const int (&sR)[2], const int (&sC)[2], unsigned (&v)[2][2]) const { std_a_off(sR, sC, v); }
    __device__ __forceinline__ const char* b_lo(const Unit& u) const { return (const char*)Bt + (size_t)u.pn * 256 * 1024 * 2; }
    __device__ __forceinline__ const char* b_hi(const Unit& u) const { return b_lo(u); }
    __device__ __forceinline__ void epi(const f32x4 (&acc)[2][2][4][2], const Unit& u, int wr, int wc, int fr, int fq) const {
        const int b = u.pm / 9, pp = u.pm - b * 9;
        const size_t ro = pp == 0 ? (size_t)b * LC * D : ((size_t)b * SEQ + (size_t)(pp - 1) * 256) * D;
        const float* inb = (pp == 0 ? ctx_in : lat_in) + ro; float* outb = (pp == 0 ? ctx_out : lat_out) + ro;
        const int col0 = u.pn * 256 + wc * 32 + 4 * fq, row0 = wr * 64 + fr;
        const float* gate = mod + (size_t)(pp == 0 ? 16 : b) * 6144 + 2 * 1024 + col0;
        f32x4 gv[2][2];
#pragma unroll
        for (int bj = 0; bj < 2; ++bj)
#pragma unroll
            for (int n = 0; n < 2; ++n) gv[bj][n] = *(const f32x4*)(gate + bj * 128 + n * 16);
#pragma unroll
        for (int ai = 0; ai < 2; ++ai)
#pragma unroll
            for (int m = 0; m < 4; ++m) { const size_t o = (size_t)(row0 + ai * 128 + m * 16) * D + col0;
#pragma unroll
                for (int bj = 0; bj < 2; ++bj)
#pragma unroll
                    for (int n = 0; n < 2; ++n) { const f32x4 x = *(const f32x4*)(inb + o + bj * 128 + n * 16);
                        if (!dry) *(f32x4*)(outb + o + bj * 128 + n * 16) = x + gv[bj][n] * acc[ai][bj][m][n]; else asm volatile("" :: "v"(x + gv[bj][n] * acc[ai][bj][m][n])); } }
    }
};
__device__ __forceinline__ void bucket_experts(int bk, int& elo, int& ehi) {
    const int gr = bk / 6, pr = bk - gr * 6;
    const int i = pr < 3 ? 0 : (pr < 5 ? 1 : 2), j = pr < 3 ? pr + 1 : (pr < 5 ? pr - 1 : 3);
    elo = gr * 4 + i; ehi = gr * 4 + j;
}
struct Dsc3 {
    static constexpr int K = 1024, LDB = 1024; static constexpr bool PERM = true, GATHER = true;
    struct Unit { int ti, pn, elo, ehi; };
    const bf16_t* A; const bf16_t* Wgu; bf16_t* ACT; const int* list; const float* slotw; const int* tile; int G, c, nt_; mutable LAS int* tbl;
    __device__ __forceinline__ void begin(LAS unsigned char* lds, int tid) const { LAS int* tb = (LAS int*)(lds + pg8::STAGE_BYTES); if (tid < MAXTILES) tb[tid] = tid < nt_ ? tile[8 + tid] : 0; __syncthreads(); tbl = tb; }
    __device__ __forceinline__ bool next(int i, Unit& u) const {
        if (!pg8::static_order(i, G, c, nt_, 8, u.ti, u.pn)) return false;
        const int bk = __builtin_amdgcn_readfirstlane(tbl[u.ti]); bucket_experts(bk, u.elo, u.ehi); return true; }
    __device__ __forceinline__ const char* a_base(const Unit&) const { return (const char*)A; }
    __device__ __forceinline__ void a_off(const Unit& u, const int (&sR)[2], const int (&sC)[2], unsigned (&v)[2][2]) const {
#pragma unroll
        for (int h = 0; h < 2; ++h)
#pragma unroll
            for (int i = 0; i < 2; ++i) { int tok = list[u.ti * 256 + sR[i] + 128 * h]; tok = tok < 0 ? 0 : tok; v[h][i] = (unsigned)(tok * 1024 + sC[i]) * 2u; }
    }
    __device__ __forceinline__ const char* b_lo(const Unit& u) const { const int e = u.pn < 4 ? u.elo : u.ehi; return (const char*)Wgu + ((size_t)e * 1024 + (size_t)(u.pn & 3) * 256) * 1024 * 2; }
    __device__ __forceinline__ const char* b_hi(const Unit& u) const { return b_lo(u); }
    __device__ __forceinline__ void epi(const f32x4 (&acc)[2][2][4][2], const Unit& u, int wr, int wc, int fr, int fq) const {
        const int slot0 = u.ti * 256 + wr * 64 + fr, wsel = u.pn < 4 ? 0 : 1;
        bf16_t* base = ACT + (size_t)slot0 * 1024 + (u.pn < 4 ? 0 : 512) + (u.pn & 3) * 128 + wc * 32 + 8 * fq;
#pragma unroll
        for (int ai = 0; ai < 2; ++ai)
#pragma unroll
            for (int m = 0; m < 4; ++m) { const int dr = ai * 128 + m * 16; const float w = slotw[(size_t)(slot0 + dr) * 2 + wsel];
                const f32x4 g0 = acc[ai][0][m][0], g1 = acc[ai][0][m][1], u0 = acc[ai][1][m][0], u1 = acc[ai][1][m][1];
                float r[8];
#pragma unroll
                for (int q = 0; q < 4; ++q) { r[q] = w * siluf_(g0[q]) * u0[q]; r[4 + q] = w * siluf_(g1[q]) * u1[q]; }
                *(u32x4*)(base + (size_t)dr * 1024) = (u32x4){pk_bf16(r[0], r[1]), pk_bf16(r[2], r[3]), pk_bf16(r[4], r[5]), pk_bf16(r[6], r[7])}; }
    }
};
struct Dsc4 {
    static constexpr int K = 1024, LDB = 512; static constexpr bool PERM = false, GATHER = false;
    struct Unit { int ti, pn, elo, ehi; };
    const bf16_t* A; const bf16_t* Wdn; float* lat; float* ctx; const float* mod; const int* list; const int* tile; int G, c, nt_, dry; mutable LAS int* tbl;
    __device__ __forceinline__ void begin(LAS unsigned char* lds, int tid) const { LAS int* tb = (LAS int*)(lds + pg8::STAGE_BYTES); if (tid < MAXTILES) tb[tid] = tid < nt_ ? tile[8 + tid] : 0; __syncthreads(); tbl = tb; }
    __device__ __forceinline__ bool next(int i, Unit& u) const {
        if (!pg8::static_order(i, G, c, nt_, 4, u.ti, u.pn)) return false;
        const int bk = __builtin_amdgcn_readfirstlane(tbl[u.ti]); bucket_experts(bk, u.elo, u.ehi); return true; }
    __device__ __forceinline__ const char* a_base(const Unit& u) const { return (const char*)A + (size_t)u.ti * 256 * 1024 * 2; }
    __device__ __forceinline__ void a_off(const Unit&, const int (&sR)[2], const int (&sC)[2], unsigned (&v)[2][2]) const { std_a_off(sR, sC, v); }
    __device__ __forceinline__ const char* b_lo(const Unit& u) const { return (const char*)Wdn + ((size_t)u.elo * 1024 + (size_t)u.pn * 256) * 512 * 2; }
    __device__ __forceinline__ const char* b_hi(const Unit& u) const { return (const char*)Wdn + ((size_t)u.ehi * 1024 + (size_t)u.pn * 256) * 512 * 2 - (size_t)(K / 128) * 128; }
    __device__ __forceinline__ void epi(const f32x4 (&acc)[2][2][4][2], const Unit& u, int wr, int wc, int fr, int fq) const {
        const int slot0 = u.ti * 256 + wr * 64 + fr, col0 = u.pn * 256 + wc * 32 + 4 * fq;
#pragma unroll
        for (int ai = 0; ai < 2; ++ai)
#pragma unroll
            for (int m = 0; m < 4; ++m) { const int tok = list[slot0 + ai * 128 + m * 16];
                if (tok >= 0) { const int b = tok / TT, t = tok - b * TT;
                    float* rp = (t < LC ? ctx + (size_t)(b * LC + t) * D : lat + (size_t)(b * SEQ + t - LC) * D) + col0;
                    const float* gate = mod + (size_t)(t < LC ? 16 : b) * 6144 + 5 * 1024 + col0;
#pragma unroll
                    for (int bj = 0; bj < 2; ++bj)
#pragma unroll
                        for (int n = 0; n < 2; ++n) { const f32x4 gv = *(const f32x4*)(gate + bj * 128 + n * 16); const f32x4 x = *(const f32x4*)(rp + bj * 128 + n * 16);
                            if (!dry) *(f32x4*)(rp + bj * 128 + n * 16) = x + gv * acc[ai][bj][m][n]; else asm volatile("" :: "v"(x + gv * acc[ai][bj][m][n])); } } }
    }
};

__device__ __forceinline__ void tr_tile(LAS float* tl, const float* src, int ld, int scol, float scale, bf16_t* dst, int lddst, int wv) {
    const int tid = tid_launder(wv), n = tid & 63, kq = tid >> 6;
#pragma unroll
    for (int i = 0; i < 8; ++i) { const int k = kq + 8 * i; tl[k * 65 + n] = scol >= 0 ? src[(size_t)k * ld + scol] * scale : 0.f; }
    __syncthreads();
    const int nn = tid >> 3, k8 = (tid & 7) * 8;
    u32x4 w;
#pragma unroll
    for (int j = 0; j < 4; ++j) w[j] = pk_bf16(tl[(k8 + 2 * j) * 65 + nn], tl[(k8 + 2 * j + 1) * 65 + nn]);
    *(u32x4*)(dst + (size_t)nn * lddst + k8) = w;
    __syncthreads();
}
__device__ __forceinline__ void convert_moe(KP p, LAS unsigned char* lds, int l, int wv) {
    LAS float* tl = (LAS float*)lds;
    bf16_t* WGU = (bf16_t*)(p->ws + WS_WGU); bf16_t* WDN = (bf16_t*)(p->ws + WS_WDN);
    const int n = tid_launder(wv) & 63;
    for (int idx = bid_launder(); idx < 4096 + 2048; idx += gridDim.x) {
        if (idx < 4096) { const int e = idx >> 8, rt = (idx >> 4) & 15, kt = idx & 15, q = rt >> 2, sub = rt & 3;
            const float* src = p->in[sub < 2 ? I_WG : I_WU] + ((size_t)(l * 16 + e) * 1024 + kt * 64) * 512;
            tr_tile(tl, src, 512, q * 128 + (sub & 1) * 64 + n, 1.f, WGU + ((size_t)e * 1024 + rt * 64) * 1024 + kt * 64, 1024, wv);
        } else { const int j = idx - 4096, e = j >> 7, ntile = (j >> 3) & 15, kt = j & 7;
            const float* src = p->in[I_WD] + ((size_t)(l * 16 + e) * 512 + kt * 64) * 1024;
            tr_tile(tl, src, 1024, ntile * 64 + n, 1.f, WDN + ((size_t)e * 1024 + ntile * 64) * 512 + kt * 64, 512, wv); }
    }
}
__device__ __forceinline__ void tr_tile_wave(LAS float* tl, const float* src, int ld, int scol4, float scale, bf16_t* dst, int lddst, int lane) {
    const int kq = lane >> 4, c4 = (lane & 15) * 4;
    f32x4 v[16];
#pragma unroll
    for (int i = 0; i < 16; ++i) v[i] = scol4 >= 0 ? *(const f32x4*)(src + (size_t)(kq + 4 * i) * ld + scol4) : (f32x4){0.f, 0.f, 0.f, 0.f};
#pragma unroll
    for (int i = 0; i < 16; ++i) { LAS float* t = tl + (kq + 4 * i) * 65 + c4; t[0] = v[i][0] * scale; t[1] = v[i][1] * scale; t[2] = v[i][2] * scale; t[3] = v[i][3] * scale; }
    WAVE_LDS_SYNC();
#pragma unroll 2
    for (int k8 = 0; k8 < 64; k8 += 8) { u32x4 w;
#pragma unroll
        for (int j = 0; j < 4; ++j) w[j] = pk_bf16(tl[(k8 + 2 * j) * 65 + lane], tl[(k8 + 2 * j + 1) * 65 + lane]);
        *(u32x4*)(dst + (size_t)lane * lddst + k8) = w; }
    WAVE_LDS_SYNC();
}
__device__ __forceinline__ void convert_moe_wave(KP p, LAS unsigned char* Lb, int l, int cvi, int ncv, int wv) {
    const int lane = tid_launder(wv) & 63;
    LAS float* tl = (LAS float*)Lb;
    bf16_t* WGU = (bf16_t*)(p->ws + WS_WGU); bf16_t* WDN = (bf16_t*)(p->ws + WS_WDN);
    for (int idx = cvi; idx < 4096 + 2048 + (l == 0 ? 832 + 256 : 0); idx += ncv) {
        if (idx >= 4096 + 2048) {
            bf16_t* WIN = (bf16_t*)(p->ws + WS_WIN); bf16_t* WOUT = (bf16_t*)(p->ws + WS_WOUT); const int r = idx - 6144;
            if (r < 832) { const int ntile = r >> 4, kt = r & 15, np = ntile * 64 + (lane & 15) * 4;
                int scol; if (np < 768) scol = np; else if (np < 3072) scol = np + 32; else { const int j = np - 3072; scol = j < 32 ? 768 + j : (j < 48 ? 3104 + (j - 32) : -1); }
                const float scale = np < 128 ? 0.17677669529663687f : ((np >= 768 && np < 1024) ? 0.125f : 1.f);
                tr_tile_wave(tl, p->in[I_WIN] + ((size_t)1024 + kt * 64) * DIN, DIN, scol, scale, WIN + ((size_t)NWIN + ntile * 64) * 1024 + kt * 64, 1024, lane);
            } else { const int j = r - 832, ntile = j >> 4, kt = j & 15;
                tr_tile_wave(tl, p->in[I_WOUT] + ((size_t)1024 + kt * 64) * 1024, 1024, ntile * 64 + (lane & 15) * 4, 1.f, WOUT + ((size_t)1024 + ntile * 64) * 1024 + kt * 64, 1024, lane); }
        } else if (idx < 4096) { const int e = idx >> 8, rt = (idx >> 4) & 15, kt = idx & 15, q = rt >> 2, sub = rt & 3;
            const float* src = p->in[sub < 2 ? I_WG : I_WU] + ((size_t)(l * 16 + e) * 1024 + kt * 64) * 512;
            tr_tile_wave(tl, src, 512, q * 128 + (sub & 1) * 64 + (lane & 15) * 4, 1.f, WGU + ((size_t)e * 1024 + rt * 64) * 1024 + kt * 64, 1024, lane);
        } else { const int j = idx - 4096, e = j >> 7, ntile = (j >> 3) & 15, kt = j & 7;
            const float* src = p->in[I_WD] + ((size_t)(l * 16 + e) * 512 + kt * 64) * 1024;
            tr_tile_wave(tl, src, 1024, ntile * 64 + (lane & 15) * 4, 1.f, WDN + ((size_t)e * 1024 + ntile * 64) * 512 + kt * 64, 512, lane); }
    }
}
__device__ __forceinline__ void phase_prologue(KP p, LAS unsigned char* lds, int wv) {
    const int tid = tid_launder(wv), lane = tid & 63, wave = tid >> 6;
    {
        LAS float* SC = (LAS float*)lds; LAS float* RED = (LAS float*)(lds + 17 * 1024 * 4);
        { float cv[34];
#pragma unroll
            for (int q = 0; q < 34; ++q) { const int i = tid + 512 * q, r = i >> 10, k = i & 1023; cv[q] = r < 16 ? p->in[I_C][r * 1024 + k] : p->in[I_CCTX][k]; }
#pragma unroll
            for (int q = 0; q < 34; ++q) SC[tid + 512 * q] = siluf_(cv[q]); }
        __syncthreads();
        float* MOD = (float*)(p->ws + WS_MOD);
        for (int unit = bid_launder(); unit < 192; unit += gridDim.x) {
            const int l = unit / 96, cg = unit - l * 96;
            const float* W = p->in[I_WADA] + (size_t)l * 1024 * 6144 + cg * 64 + lane;
            float acc[17];
#pragma unroll
            for (int r = 0; r < 17; ++r) acc[r] = 0.f;
            for (int k0 = wave * 128; k0 < wave * 128 + 128; k0 += 16) {
                float wk[16];
#pragma unroll
                for (int q = 0; q < 16; ++q) wk[q] = W[(size_t)(k0 + q) * 6144];
#pragma unroll
                for (int q4 = 0; q4 < 4; ++q4) {
#pragma unroll
                    for (int r = 0; r < 17; ++r) { const f32x4 s = *(const LAS f32x4*)(SC + r * 1024 + k0 + 4 * q4); acc[r] += s[0] * wk[4 * q4] + s[1] * wk[4 * q4 + 1] + s[2] * wk[4 * q4 + 2] + s[3] * wk[4 * q4 + 3]; }
                    asm volatile("" ::: "memory"); }
            }
#pragma unroll
            for (int r = 0; r < 17; ++r) RED[(wave * 17 + r) * 64 + lane] = acc[r];
            __syncthreads();
            for (int i = tid; i < 17 * 64; i += 512) { const int r = i >> 6, cc = i & 63; float s = 0.f;
#pragma unroll
                for (int w = 0; w < 8; ++w) s += RED[(w * 17 + r) * 64 + cc];
                MOD[(size_t)(l * 17 + r) * 6144 + cg * 64 + cc] = s + p->in[I_BADA][l * 6144 + cg * 64 + cc]; }
            __syncthreads();
        }
        __syncthreads();
    }
    {
        LAS float* tl = (LAS float*)lds;
        bf16_t* WIN = (bf16_t*)(p->ws + WS_WIN); bf16_t* WOUT = (bf16_t*)(p->ws + WS_WOUT);
        const int n = tid & 63;
        for (int idx0 = bid_launder(); idx0 < 832 + 256; idx0 += gridDim.x) {
            const int idx = idx0 < 832 ? idx0 : 1664 + (idx0 - 832);
            if (idx < 1664) { const int l = idx / 832, r = idx - l * 832, ntile = r >> 4, kt = r & 15, np = ntile * 64 + n;
                int scol; if (np < 768) scol = np; else if (np < 3072) scol = np + 32; else { const int j = np - 3072; scol = j < 32 ? 768 + j : (j < 48 ? 3104 + (j - 32) : -1); }
                const float scale = np < 128 ? 0.17677669529663687f : ((np >= 768 && np < 1024) ? 0.125f : 1.f);
                tr_tile(tl, p->in[I_WIN] + ((size_t)l * 1024 + kt * 64) * DIN, DIN, scol, scale, WIN + ((size_t)l * NWIN + ntile * 64) * 1024 + kt * 64, 1024, wv);
            } else { const int j = idx - 1664, l = j >> 8, ntile = (j >> 4) & 15, kt = j & 15;
                tr_tile(tl, p->in[I_WOUT] + ((size_t)l * 1024 + kt * 64) * 1024, 1024, ntile * 64 + n, 1.f, WOUT + ((size_t)l * 1024 + ntile * 64) * 1024 + kt * 64, 1024, wv); }
        }
    }
}

__device__ __forceinline__ void route16(const float (&lg)[16], const float* rb, int& bucket, float& wlo, float& whi) {
    float bestgs = -INFINITY, bs1 = 0.f, bs2 = 0.f; int bestg = 0, bi1 = 0, bi2 = 1;
#pragma unroll
    for (int g = 0; g < 4; ++g) {
        float sc[4], sl[4];
#pragma unroll
        for (int j = 0; j < 4; ++j) { sc[j] = sigmoidf_(lg[4 * g + j]); sl[j] = sc[j] + rb[4 * g + j]; }
        int i1 = 0; float v1 = sl[0], s1 = sc[0];
#pragma unroll
        for (int j = 1; j < 4; ++j) if (sl[j] > v1) { v1 = sl[j]; s1 = sc[j]; i1 = j; }
        int i2 = 0; float v2 = -INFINITY, s2 = 0.f;
#pragma unroll
        for (int j = 0; j < 4; ++j) if (j != i1 && sl[j] > v2) { v2 = sl[j]; s2 = sc[j]; i2 = j; }
        const float gs = v1 + v2;
        if (gs > bestgs) { bestgs = gs; bestg = g; bi1 = i1; bi2 = i2; bs1 = s1; bs2 = s2; }
    }
    const int lo = bi1 < bi2 ? bi1 : bi2, hi = bi1 < bi2 ? bi2 : bi1;
    const float slo = bi1 < bi2 ? bs1 : bs2, shi = bi1 < bi2 ? bs2 : bs1;
    const int pr = lo == 0 ? hi - 1 : (lo == 1 ? hi + 1 : 5);
    bucket = bestg * 6 + pr; const float inv = 1.f / (bs1 + bs2); wlo = slo * inv; whi = shi * inv;
}
template <bool ROUTER>
__device__ __forceinline__ void phase_prep(KP p, LAS unsigned char* lds, int l, const float* lat, const float* ctx, int latent_only, int wv) {
    const int tid = tid_launder(wv), lane = tid & 63, wave = tid >> 6, fr = lane & 15, kq = lane >> 4;
    const float* MOD = (const float*)(p->ws + WS_MOD) + (size_t)l * 17 * 6144;
    const float* g = p->in[I_NORMG] + (l * 2 + (ROUTER ? 1 : 0)) * 1024;
    bf16_t* H = (bf16_t*)(p->ws + WS_ABUF);
    constexpr int NT = ROUTER ? 1 : 3, AST = 1032;
    LAS bf16_t* AH = (LAS bf16_t*)lds; LAS bf16_t* AL = AH + 16 * AST; LAS float* PART = (LAS float*)(lds + 2 * 16 * AST * 2); LAS float* LG = PART + 8 * NT * 256; LAS int* hist = (LAS int*)(LG + 256);
    bf16x8 Bh[NT][4], Bl[4];
    if (ROUTER) {
#pragma unroll
        for (int kk = 0; kk < 4; ++kk) { const int k0 = 128 * wave + 32 * kk + 8 * kq; u32x4 wh, wl;
#pragma unroll
            for (int e = 0; e < 4; ++e) { const float w0 = p->in[I_RW][(size_t)(k0 + 2 * e) * 16 + fr], w1 = p->in[I_RW][(size_t)(k0 + 2 * e + 1) * 16 + fr];
                const unsigned hh = pk_bf16(w0, w1); wh[e] = hh; wl[e] = pk_bf16(w0 - bflo(hh), w1 - bfhi(hh)); }
            Bh[0][kk] = __builtin_bit_cast(bf16x8, wh); Bl[kk] = __builtin_bit_cast(bf16x8, wl); }
    } else {
        const bf16_t* WS_ = (const bf16_t*)(p->ws + WS_WIN) + ((size_t)l * NWIN + 3072) * 1024;
#pragma unroll
        for (int nt = 0; nt < NT; ++nt)
#pragma unroll
            for (int kk = 0; kk < 4; ++kk) { Bh[nt][kk] = *(const bf16x8*)(WS_ + (size_t)(16 * nt + fr) * 1024 + 128 * wave + 32 * kk + 8 * kq); }
#pragma unroll
        for (int kk = 0; kk < 4; ++kk) Bl[kk] = Bh[0][kk];
    }
    const int n_per = latent_only ? 128 : 144, ngrp = n_per / 16;
    for (int vb = bid_launder(); vb < NVB; vb += gridDim.x) {
        if (ROUTER) { if (tid < 32) hist[tid] = 0; }
        const int mbase = latent_only ? (vb >> 4) * TT + LC + (vb & 15) * 128 : vb * 144;
        f32x4 xn[2][4];
#pragma unroll
        for (int r = 0; r < 2; ++r) { const float* xr0 = res_row_c(lat, ctx, mbase + 2 * wave + r);
#pragma unroll
            for (int j = 0; j < 4; ++j) xn[r][j] = *(const f32x4*)(xr0 + 4 * lane + 256 * j); }
        for (int grp = 0; grp < ngrp; ++grp) {
            f32x4 xv[2][4];
#pragma unroll
            for (int r = 0; r < 2; ++r)
#pragma unroll
                for (int j = 0; j < 4; ++j) xv[r][j] = xn[r][j];
            if (grp + 1 < ngrp) {
#pragma unroll
                for (int r = 0; r < 2; ++r) { const float* xrn = res_row_c(lat, ctx, mbase + 16 * (grp + 1) + 2 * wave + r);
#pragma unroll
                    for (int j = 0; j < 4; ++j) xn[r][j] = *(const f32x4*)(xrn + 4 * lane + 256 * j); } }
#pragma unroll
            for (int r = 0; r < 2; ++r) {
                const int m = mbase + 16 * grp + 2 * wave + r, b = m / TT, t = m - b * TT, rb = t < LC ? 16 : b;
                float ss = 0.f;
#pragma unroll
                for (int j = 0; j < 4; ++j) ss += xv[r][j][0] * xv[r][j][0] + xv[r][j][1] * xv[r][j][1] + xv[r][j][2] * xv[r][j][2] + xv[r][j][3] * xv[r][j][3];
                ss = wave_sum(ss);
                const float rstd = rsqrtf(ss * (1.f / 1024.f) + EPS);
                const float* sh = MOD + (size_t)rb * 6144 + (ROUTER ? 3 : 0) * 1024; const float* sc = sh + 1024;
#pragma unroll
                for (int j = 0; j < 4; ++j) { const int idx = 4 * lane + 256 * j;
                    const f32x4 gv = *(const f32x4*)(g + idx), shv = *(const f32x4*)(sh + idx), scv = *(const f32x4*)(sc + idx);
                    const f32x4 hv = xv[r][j] * rstd * gv * (1.f + scv) + shv;
                    const unsigned h0 = pk_bf16(hv[0], hv[1]), h1 = pk_bf16(hv[2], hv[3]);
                    *(u32x2*)(H + (size_t)m * 1024 + idx) = (u32x2){h0, h1};
                    *(LAS u32x2*)(AH + (2 * wave + r) * AST + idx) = (u32x2){h0, h1};
                    if (ROUTER) *(LAS u32x2*)(AL + (2 * wave + r) * AST + idx) = (u32x2){pk_bf16(hv[0] - bflo(h0), hv[1] - bfhi(h0)), pk_bf16(hv[2] - bflo(h1), hv[3] - bfhi(h1))}; }
            }
            LDS_BARRIER();
            { f32x4 acc[NT];
#pragma unroll
                for (int nt = 0; nt < NT; ++nt) acc[nt] = (f32x4){0.f, 0.f, 0.f, 0.f};
#pragma unroll
                for (int kk = 0; kk < 4; ++kk) { const bf16x8 ah = *(const LAS bf16x8*)(AH + fr * AST + 128 * wave + 32 * kk + 8 * kq);
#pragma unroll
                    for (int nt = 0; nt < NT; ++nt) acc[nt] = __builtin_amdgcn_mfma_f32_16x16x32_bf16(ah, Bh[nt][kk], acc[nt], 0, 0, 0);
                    if (ROUTER) { const bf16x8 al = *(const LAS bf16x8*)(AL + fr * AST + 128 * wave + 32 * kk + 8 * kq);
                        acc[0] = __builtin_amdgcn_mfma_f32_16x16x32_bf16(ah, Bl[kk], acc[0], 0, 0, 0); acc[0] = __builtin_amdgcn_mfma_f32_16x16x32_bf16(al, Bh[0][kk], acc[0], 0, 0, 0); } }
#pragma unroll
                for (int nt = 0; nt < NT; ++nt)
#pragma unroll
                    for (int i = 0; i < 4; ++i) PART[(wave * NT + nt) * 256 + (4 * kq + i) * 16 + fr] = acc[nt][i]; }
            LDS_BARRIER();
            for (int e2 = tid; e2 < NT * 256; e2 += 512) { const int nt = e2 >> 8, e = e2 & 255; float sacc = 0.f;
#pragma unroll
                for (int w = 0; w < 8; ++w) sacc += PART[(w * NT + nt) * 256 + e];
                if (ROUTER) LG[e] = sacc;
                else ((bf16_t*)(p->ws + WS_SMALL))[(size_t)(mbase + 16 * grp + (e >> 4)) * 64 + 16 * nt + (e & 15)] = (bf16_t)(pk_bf16(sacc, 0.f) & 0xffffu); }
            if (ROUTER) {
                LDS_BARRIER();
                if (tid < 16) { float lg[16];
#pragma unroll
                    for (int q = 0; q < 4; ++q) { const f32x4 v = *(const LAS f32x4*)(LG + tid * 16 + 4 * q); lg[4 * q] = v[0]; lg[4 * q + 1] = v[1]; lg[4 * q + 2] = v[2]; lg[4 * q + 3] = v[3]; }
                    int bucket; float wlo, whi; route16(lg, p->in[I_RB], bucket, wlo, whi);
                    *(f32x4*)(p->ws + WS_ROUTE + (size_t)(mbase + 16 * grp + tid) * 16) = (f32x4){__int_as_float(bucket), wlo, whi, 0.f};
                    ((unsigned char*)(p->ws + WS_RB8))[vb * 256 + 16 * grp + tid] = (unsigned char)bucket;
                    __hip_atomic_fetch_add(hist + bucket, 1, __ATOMIC_RELAXED, __HIP_MEMORY_SCOPE_WORKGROUP); }
            }
        }
        if (ROUTER) { __syncthreads(); if (tid < 32) ((int*)(p->ws + WS_HIST))[vb * 32 + tid] = tid < 24 ? hist[tid] : 0; }
        __syncthreads();
    }
}

__device__ __forceinline__ void phase_moe_offsets(KP p, LAS unsigned char* lds, int latent_only, int wv) {
    const int tid = tid_launder(wv), lane = tid & 63, wave = tid >> 6;
    LAS int* PT = (LAS int*)lds; LAS int* tot = PT + 384; LAS int* tbase = tot + 32; LAS int* wsum = tbase + 32;
    const int* HIST = (const int*)(p->ws + WS_HIST); int* LIST = (int*)(p->ws + WS_LIST); f32x2* SLOTW = (f32x2*)(p->ws + WS_SLOTW); int* TILE = (int*)(p->ws + WS_TILE);
    const int n_per = latent_only ? 128 : 144;
    for (int j = bid_launder(); j < 24; j += gridDim.x) {
        if (tid < 384) { const int jj = tid % 24, pi = tid / 24; int sacc = 0; for (int w = pi * 16; w < pi * 16 + 16; ++w) sacc += HIST[w * 32 + jj]; PT[pi * 24 + jj] = sacc; }
        __syncthreads();
        if (tid < 24) { int sacc = 0; for (int i = 0; i < 16; ++i) sacc += PT[i * 24 + tid]; tot[tid] = sacc; }
        __syncthreads();
        if (tid == 0) { int run = 0; for (int q = 0; q < 24; ++q) { tbase[q] = run; run += (tot[q] + 255) >> 8; } tbase[24] = run; }
        __syncthreads();
        const int base = tbase[j] * 256, cnt = tot[j], ntile = (cnt + 255) >> 8;
        if (j == 0) { if (tid == 0) TILE[0] = tbase[24]; if (tid < 24) { const int nq = (tot[tid] + 255) >> 8; for (int i = 0; i < nq; ++i) TILE[8 + tbase[tid] + i] = tid; } }
        const int rvb = tid >> 1, half = n_per >> 1, i0 = (tid & 1) * half, nd = half >> 2;
        const int m0t = latent_only ? (rvb >> 4) * TT + LC + (rvb & 15) * 128 + i0 : rvb * 144 + i0;
        const unsigned* rb = (const unsigned*)(p->ws + WS_RB8 + rvb * 256 + i0);
        unsigned bwa[18];
#pragma unroll
        for (int q = 0; q < 18; ++q) bwa[q] = q < nd ? rb[q] : 0xffffffffu;
        int mycnt = 0;
#pragma unroll
        for (int q = 0; q < 18; ++q)
#pragma unroll
            for (int e = 0; e < 4; ++e) mycnt += ((int)((bwa[q] >> (8 * e)) & 0xffu) == j) ? 1 : 0;
        int incl = mycnt;
#pragma unroll
        for (int o = 1; o < 64; o <<= 1) { const int v = __shfl_up(incl, o, 64); if (lane >= o) incl += v; }
        if (lane == 63) wsum[wave] = incl;
        __syncthreads();
        int woff = 0;
#pragma unroll
        for (int w = 0; w < 8; ++w) woff += (w < wave) ? wsum[w] : 0;
        int pos = base + woff + incl - mycnt;
        int mt[8]; int nm = 0;
#pragma unroll
        for (int q = 0; q < 8; ++q) mt[q] = 0;
#pragma unroll 1
        for (int g3 = 0; g3 < 3; ++g3) {
#pragma unroll 1
            for (int q = 0; q < 6; ++q) { const int qq = g3 * 6 + q; unsigned w4 = 0xffffffffu;
#pragma unroll
                for (int z = 0; z < 18; ++z) w4 = (z == qq) ? bwa[z] : w4;
#pragma unroll 1
                for (int e = 0; e < 4; ++e) { const int m = m0t + 4 * qq + e; const int bk = (int)((w4 >> (8 * e)) & 0xffu);
                    if (bk == j) {
                        if (nm < 8) { mt[0] = nm == 0 ? m : mt[0]; mt[1] = nm == 1 ? m : mt[1]; mt[2] = nm == 2 ? m : mt[2]; mt[3] = nm == 3 ? m : mt[3]; mt[4] = nm == 4 ? m : mt[4]; mt[5] = nm == 5 ? m : mt[5]; mt[6] = nm == 6 ? m : mt[6]; mt[7] = nm == 7 ? m : mt[7]; }
                        else { const f32x4 r = *(const f32x4*)(p->ws + WS_ROUTE + (size_t)m * 16); LIST[pos + nm] = m; SLOTW[pos + nm] = (f32x2){r[1], r[2]}; }
                        ++nm; } } } }
        { f32x4 rr[8];
#pragma unroll
            for (int q = 0; q < 8; ++q) rr[q] = *(const f32x4*)(p->ws + WS_ROUTE + (size_t)mt[q] * 16);
#pragma unroll
            for (int q = 0; q < 8; ++q) if (q < nm) { LIST[pos + q] = mt[q]; SLOTW[pos + q] = (f32x2){rr[q][1], rr[q][2]}; } }
        for (int sidx = base + cnt + tid; sidx < base + ntile * 256; sidx += 512) { LIST[sidx] = -1; SLOTW[sidx] = (f32x2){0.f, 0.f}; }
        __syncthreads();
    }
}

__device__ __forceinline__ bf16_t* obuf(unsigned char* ws, int k) {
    const int panel = k == 4 ? 8 : (k == 5 ? 9 : (k == 6 ? 10 : 12));
    return k < 4 ? (bf16_t*)(ws + WS_O) + (size_t)k * PANEL_EL : (bf16_t*)(ws + WS_P) + (size_t)panel * PANEL_EL;
}
__device__ __forceinline__ void phase_mixprep(KP p, LAS unsigned char* lds, int l, int wv) {
    const int tid = tid_launder(wv);
    bf16_t* P = (bf16_t*)(p->ws + WS_P); bf16_t* DNP = (bf16_t*)(p->ws + WS_ABUF);
    float* GDEC = (float*)(p->ws + WS_GDEC); float* DNAB = (float*)(p->ws + WS_DNAB);
    const bf16_t* SMALL = (const bf16_t*)(p->ws + WS_SMALL);
    LAS bf16_t* SM = (LAS bf16_t*)lds;
    float cw[5][2] = {{0.f, 0.f}, {0.f, 0.f}, {0.f, 0.f}, {0.f, 0.f}, {0.f, 0.f}};
    const int sec = tid >> 7, cp = (tid & 127) * 2;
    if (tid < 384) {
#pragma unroll
        for (int j = 0; j < 5; ++j) { cw[j][0] = p->in[I_CONVW][(l * 5 + j) * 768 + sec * 256 + cp]; cw[j][1] = p->in[I_CONVW][(l * 5 + j) * 768 + sec * 256 + cp + 1]; }
    }
    float nalog = 0.f, dtb = 0.f;
    if (tid >= 384 && tid < 392) { nalog = -__expf(p->in[I_ALOG][l * 8 + tid - 384]); dtb = p->in[I_DTB][l * 8 + tid - 384]; }
    float gw[16], gb = 0.f;
#pragma unroll
    for (int r = 0; r < 16; ++r) gw[r] = 0.f;
    const int t2 = tid & 255;
    if (tid >= 256) { const int dir = t2 >> 7, c = t2 & 127;
#pragma unroll
        for (int r = 0; r < 16; ++r) gw[r] = p->in[I_GKW][((l * 2 + dir) * 16 + r) * 128 + c];
        gb = p->in[I_GKB][(l * 2 + dir) * 128 + c]; }
    for (int vb = bid_launder(); vb < NVB; vb += gridDim.x) {
        const int b = vb >> 4, t0 = (vb & 15) * 144;
        unsigned nA[20]; u32x4 nS = (u32x4){0u, 0u, 0u, 0u};
#define MP_LOADS(C0) do { const int t_ = t0 + (C0), m_ = b * TT + t_, lo_ = t_ < LC ? 0 : LC, hi_ = t_ < LC ? LC : TT; \
            if (tid < 384) { const bf16_t* src = P + (size_t)(8 + sec) * PANEL_EL + cp; \
                _Pragma("unroll") for (int j = 0; j < 20; ++j) { const int tt = t_ - 2 + j; nA[j] = (tt >= lo_ && tt < hi_) ? *(const unsigned*)(src + (size_t)(b * TT + tt) * 256) : 0u; } } \
            if (tid < 128) nS = *(const u32x4*)(SMALL + (size_t)(m_ + (tid >> 3)) * 64 + (tid & 7) * 8); } while (0)
        MP_LOADS(0);
        for (int c0 = 0, it = 0; c0 < 144; c0 += 16, ++it) {
            const int t = t0 + c0, m = b * TT + t;
            LAS bf16_t* SMc = SM + (it & 1) * 1024;
            unsigned raw[20];
#pragma unroll
            for (int j = 0; j < 20; ++j) raw[j] = nA[j];
            if (tid < 128) *(LAS u32x4*)(SMc + (tid >> 3) * 64 + (tid & 7) * 8) = nS;
            if (c0 + 16 < 144) MP_LOADS(c0 + 16);
            LDS_BARRIER();
            if (tid < 384) {
                unsigned outv[16];
#pragma unroll
                for (int q = 0; q < 16; ++q) { float a0 = 0.f, a1 = 0.f;
#pragma unroll
                    for (int j = 0; j < 5; ++j) { a0 += cw[j][0] * bflo(raw[q + j]); a1 += cw[j][1] * bfhi(raw[q + j]); }
                    a0 = siluf_(a0); a1 = siluf_(a1);
                    if (sec < 2) { const float ss = half_sum32(a0 * a0 + a1 * a1); const float rn = rsqrtf(ss + EPS) * (sec == 0 ? 0.125f : 1.f); a0 *= rn; a1 *= rn; }
                    outv[q] = pk_bf16(a0, a1); }
#pragma unroll
                for (int q = 0; q < 16; ++q) *(unsigned*)(DNP + (size_t)sec * PANEL_EL + (size_t)(m + q) * 256 + cp) = outv[q];
            } else if (tid < 392) {
                const int j = tid - 384;
#pragma unroll
                for (int q = 0; q < 16; ++q) { const float da = bf2f(SMc[q * 64 + 32 + j]), db = bf2f(SMc[q * 64 + 40 + j]);
                    DNAB[(size_t)(m + q) * 16 + j] = nalog * softplusf_(da + dtb); DNAB[(size_t)(m + q) * 16 + 8 + j] = sigmoidf_(db); }
            }
            if (tid >= 256) {
                const int dir = t2 >> 7;
#pragma unroll 4
                for (int q = 0; q < 16; ++q) { const u32x4 z0 = *(const LAS u32x4*)(SMc + q * 64 + dir * 16), z1 = *(const LAS u32x4*)(SMc + q * 64 + dir * 16 + 8);
                    float logit = gb;
#pragma unroll
                    for (int e = 0; e < 4; ++e) { logit += bflo(z0[e]) * gw[2 * e] + bfhi(z0[e]) * gw[2 * e + 1] + bflo(z1[e]) * gw[8 + 2 * e] + bfhi(z1[e]) * gw[8 + 2 * e + 1]; }
                    const float ls = fminf(logit, 0.f) - __logf(1.f + __expf(-fabsf(logit)));
                    GDEC[(size_t)(m + q) * 256 + t2] = ls * 0.0625f; }
            }
        }
#undef MP_LOADS
        __syncthreads();
    }
}

__device__ __forceinline__ int blk_tok0(int dir, int blk) { return dir == 0 ? 16 * blk : (blk < 16 ? LC - 16 * (blk + 1) : TT - 16 * (blk - 15)); }
__device__ __forceinline__ void cvt8(const u32x4 r, LAS float* d) {
    *(LAS f32x4*)d = (f32x4){bflo(r[0]), bfhi(r[0]), bflo(r[1]), bfhi(r[1])}; *(LAS f32x4*)(d + 4) = (f32x4){bflo(r[2]), bfhi(r[2]), bflo(r[3]), bfhi(r[3])};
}
__device__ __forceinline__ void store_out16(const LAS float* LO, bf16_t* Og, int tcur, int lane) {
    if (lane < 32) { const int row = lane >> 1, half = lane & 1; const f32x4 o0 = *(const LAS f32x4*)(LO + row * 16 + half * 8), o1 = *(const LAS f32x4*)(LO + row * 16 + half * 8 + 4);
        *(u32x4*)(Og + (size_t)(tcur + row) * 16 + half * 8) = (u32x4){pk_bf16(o0[0], o0[1]), pk_bf16(o0[2], o0[3]), pk_bf16(o1[0], o1[1]), pk_bf16(o1[2], o1[3])}; }
}
template <int DIR>
__device__ __forceinline__ void scan_ret_chunk(KP p, LAS unsigned char* Lb, int idx, int l, int wv) {
    const int lane = tid_launder(wv) & 63, fr = lane & 15, kq = lane >> 4;
    constexpr int dir = DIR; const int h = (idx >> 1) & 3, b = idx >> 3;
    const bf16_t* P = (const bf16_t*)(p->ws + WS_P);
    const bf16_t* Qg = P + 3 * PANEL_EL + (size_t)b * TT * 256 + h * 64; const bf16_t* Kg = Qg + PANEL_EL; const bf16_t* Vg = Qg + 2 * PANEL_EL;
    bf16_t* Og = obuf(p->ws, 2 + dir) + (size_t)((b * 4 + h) * 4) * TT * 16;
    const float lg2 = log2f(sigmoidf_(p->in[I_RETD][(l * 2 + dir) * 4 + h]));
    const float g16 = exp2f(16.f * lg2);
    LAS bf16_t* QL = (LAS bf16_t*)Lb; LAS bf16_t* KL = QL + 16 * 72; LAS bf16_t* KT = KL + 16 * 72; LAS bf16_t* VT = KT + 64 * 32; LAS bf16_t* GL = VT + 64 * 32;
    for (int i = lane; i < (64 * 32 * 2 + 16 * 32) / 2; i += 64) ((LAS unsigned*)KT)[i] = 0u;
    f32x4 S[4][4];
#pragma unroll
    for (int a = 0; a < 4; ++a)
#pragma unroll
        for (int c = 0; c < 4; ++c) S[a][c] = (f32x4){0.f, 0.f, 0.f, 0.f};
    u32x4 rq[2], rk[2], rv[2];
    int tb = blk_tok0(dir, 0);
#define RC_LOAD(T0) do { _Pragma("unroll") for (int i = 0; i < 2; ++i) { const int q = lane + 64 * i, r = q >> 3, c8 = (q & 7) * 8; const size_t ro = (size_t)((T0) + (dir ? 15 - r : r)) * 256 + c8; \
        rq[i] = *(const u32x4*)(Qg + ro); rk[i] = *(const u32x4*)(Kg + ro); rv[i] = *(const u32x4*)(Vg + ro); } } while (0)
    RC_LOAD(tb);
    float rowsc[4];
#pragma unroll
    for (int i = 0; i < 4; ++i) rowsc[i] = exp2f(lg2 * (float)(4 * kq + i - 15));
    for (int blk = 0; blk < 144; ++blk) {
#pragma unroll
        for (int i = 0; i < 2; ++i) { const int q = lane + 64 * i, r = q >> 3, c8 = (q & 7) * 8;
            *(LAS u32x4*)(QL + r * 72 + c8) = rq[i]; *(LAS u32x4*)(KL + r * 72 + c8) = rk[i];
            const float vs = exp2f(lg2 * (float)(15 - r));
#pragma unroll
            for (int e = 0; e < 4; ++e) { KT[(c8 + 2 * e) * 32 + r] = (bf16_t)(rk[i][e] & 0xffffu); KT[(c8 + 2 * e + 1) * 32 + r] = (bf16_t)(rk[i][e] >> 16);
                const unsigned pv = pk_bf16(bflo(rv[i][e]) * vs, bfhi(rv[i][e]) * vs);
                VT[(c8 + 2 * e) * 32 + r] = (bf16_t)(pv & 0xffffu); VT[(c8 + 2 * e + 1) * 32 + r] = (bf16_t)(pv >> 16); } }
        const int tcur = tb;
        if (blk + 1 < 144) { tb = blk_tok0(dir, blk + 1); RC_LOAD(tb); }
        WAVE_LDS_SYNC();
        f32x4 G = (f32x4){0.f, 0.f, 0.f, 0.f};
#pragma unroll
        for (int kk = 0; kk < 2; ++kk) { const bf16x8 a = *(const LAS bf16x8*)(QL + fr * 72 + 32 * kk + 8 * kq), bb = *(const LAS bf16x8*)(KL + fr * 72 + 32 * kk + 8 * kq);
            G = __builtin_amdgcn_mfma_f32_16x16x32_bf16(a, bb, G, 0, 0, 0); }
#pragma unroll
        for (int i = 0; i < 4; ++i) { const int r = 4 * kq + i; GL[r * 32 + fr] = (bf16_t)(pk_bf16(fr <= r ? G[i] : 0.f, 0.f) & 0xffffu); }
#pragma unroll
        for (int a = 0; a < 4; ++a)
#pragma unroll
            for (int c = 0; c < 4; ++c) S[a][c] = S[a][c] * g16;
        WAVE_LDS_SYNC();
        const bf16x8 ag = *(const LAS bf16x8*)(GL + fr * 32 + 8 * kq);
        bf16x8 aq[2];
#pragma unroll
        for (int kk = 0; kk < 2; ++kk) { const u32x2 lo = *(const LAS u32x2*)(QL + fr * 72 + 32 * kk + 4 * kq), hi = *(const LAS u32x2*)(QL + fr * 72 + 32 * kk + 16 + 4 * kq);
            aq[kk] = __builtin_bit_cast(bf16x8, (u32x4){lo[0], lo[1], hi[0], hi[1]}); }
        bf16x8 bv[4], ak[4];
#pragma unroll
        for (int c = 0; c < 4; ++c) { bv[c] = *(const LAS bf16x8*)(VT + (16 * c + fr) * 32 + 8 * kq); ak[c] = *(const LAS bf16x8*)(KT + (16 * c + fr) * 32 + 8 * kq); }
        f32x4 acc[4];
#pragma unroll
        for (int c = 0; c < 4; ++c) { acc[c] = __builtin_amdgcn_mfma_f32_16x16x32_bf16(ag, bv[c], (f32x4){0.f, 0.f, 0.f, 0.f}, 0, 0, 0);
#pragma unroll
            for (int kk = 0; kk < 2; ++kk) { const f32x4 s0 = S[2 * kk][c], s1 = S[2 * kk + 1][c];
                const bf16x8 bs = __builtin_bit_cast(bf16x8, (u32x4){pk_bf16(s0[0], s0[1]), pk_bf16(s0[2], s0[3]), pk_bf16(s1[0], s1[1]), pk_bf16(s1[2], s1[3])});
                acc[c] = __builtin_amdgcn_mfma_f32_16x16x32_bf16(aq[kk], bs, acc[c], 0, 0, 0); } }
#pragma unroll
        for (int a = 0; a < 4; ++a)
#pragma unroll
            for (int c = 0; c < 4; ++c) S[a][c] = __builtin_amdgcn_mfma_f32_16x16x32_bf16(ak[a], bv[c], S[a][c], 0, 0, 0);
#pragma unroll
        for (int c = 0; c < 4; ++c)
#pragma unroll
            for (int i = 0; i < 4; ++i) { const int r = 4 * kq + i; Og[((size_t)c * TT + (size_t)(tcur + (dir ? 15 - r : r))) * 16 + fr] = (bf16_t)(pk_bf16(acc[c][i] * rowsc[i], 0.f) & 0xffffu); }
        WAVE_LDS_SYNC();
    }
#undef RC_LOAD
}
template <int DIR>
__device__ __forceinline__ void scan_gla_chunk(KP p, LAS unsigned char* Lb, int idx, int wv) {
    const int lane = tid_launder(wv) & 63, fr = lane & 15, kq = lane >> 4;
    constexpr int dir = DIR; const int h = (idx >> 1) & 3, b = idx >> 3;
    const bf16_t* P = (const bf16_t*)(p->ws + WS_P);
    const bf16_t* Qg = P + (size_t)b * TT * 256 + h * 32; const bf16_t* Kg = Qg + 128; const bf16_t* Vg = P + PANEL_EL + (size_t)b * TT * 256 + h * 64;
    const float* Ag = (const float*)(p->ws + WS_GDEC) + (size_t)b * TT * 256 + dir * 128 + h * 32;
    bf16_t* Og = obuf(p->ws, dir) + (size_t)((b * 4 + h) * 4) * TT * 16;
    LAS bf16_t* QL = (LAS bf16_t*)Lb; LAS bf16_t* KL = QL + 16 * 40; LAS bf16_t* KT = KL + 16 * 40; LAS bf16_t* VT = KT + 32 * 32; LAS bf16_t* GL = VT + 64 * 32; LAS float* EB = (LAS float*)(GL + 16 * 32);
    for (int i = lane; i < (32 * 32 + 64 * 32 + 16 * 32) / 2; i += 64) ((LAS unsigned*)KT)[i] = 0u;
    f32x4 S[2][4];
#pragma unroll
    for (int a = 0; a < 2; ++a)
#pragma unroll
        for (int c = 0; c < 4; ++c) S[a][c] = (f32x4){0.f, 0.f, 0.f, 0.f};
    const int sg = lane >> 4, dp = lane & 15;
    unsigned rq[4], rk[4]; f32x2 ra[4]; u32x4 rv[2];
    int tb = blk_tok0(dir, 0);
#define GC_LOAD(T0) do { _Pragma("unroll") for (int i = 0; i < 4; ++i) { const int r = 4 * sg + i; const size_t ro = (size_t)((T0) + (dir ? 15 - r : r)) * 256 + 2 * dp; \
            rq[i] = *(const unsigned*)(Qg + ro); rk[i] = *(const unsigned*)(Kg + ro); ra[i] = *(const f32x2*)(Ag + ro); } \
        _Pragma("unroll") for (int i = 0; i < 2; ++i) { const int q = lane + 64 * i, r = q >> 3, c8 = (q & 7) * 8; rv[i] = *(const u32x4*)(Vg + (size_t)((T0) + (dir ? 15 - r : r)) * 256 + c8); } } while (0)
    GC_LOAD(tb);
    for (int blk = 0; blk < 144; ++blk) {
        f32x2 bc[4]; bc[0] = ra[0]; bc[1] = bc[0] + ra[1]; bc[2] = bc[1] + ra[2]; bc[3] = bc[2] + ra[3];
        f32x2 inc = bc[3];
        { const float u0 = __shfl_up(inc[0], 16, 64), u1 = __shfl_up(inc[1], 16, 64); if (sg >= 1) { inc[0] += u0; inc[1] += u1; } }
        { const float u0 = __shfl_up(inc[0], 32, 64), u1 = __shfl_up(inc[1], 32, 64); if (sg >= 2) { inc[0] += u0; inc[1] += u1; } }
        const f32x2 excl = inc - bc[3];
        if (sg == 3) { EB[2 * dp] = __expf(inc[0]); EB[2 * dp + 1] = __expf(inc[1]); }
#pragma unroll
        for (int i = 0; i < 4; ++i) { const int r = 4 * sg + i; const f32x2 bb = bc[i] + excl;
            const float e0 = __expf(bb[0]), e1 = __expf(bb[1]), n0 = __expf(-bb[0]), n1 = __expf(-bb[1]);
            const unsigned qv = pk_bf16(bflo(rq[i]) * e0, bfhi(rq[i]) * e1), kv = pk_bf16(bflo(rk[i]) * n0, bfhi(rk[i]) * n1);
            *(LAS unsigned*)(QL + r * 40 + 2 * dp) = qv; *(LAS unsigned*)(KL + r * 40 + 2 * dp) = kv;
            KT[(2 * dp) * 32 + r] = (bf16_t)(kv & 0xffffu); KT[(2 * dp + 1) * 32 + r] = (bf16_t)(kv >> 16); }
#pragma unroll
        for (int i = 0; i < 2; ++i) { const int q = lane + 64 * i, r = q >> 3, c8 = (q & 7) * 8;
#pragma unroll
            for (int e = 0; e < 4; ++e) { VT[(c8 + 2 * e) * 32 + r] = (bf16_t)(rv[i][e] & 0xffffu); VT[(c8 + 2 * e + 1) * 32 + r] = (bf16_t)(rv[i][e] >> 16); } }
        const int tcur = tb;
        if (blk + 1 < 144) { tb = blk_tok0(dir, blk + 1); GC_LOAD(tb); }
        WAVE_LDS_SYNC();
        { const bf16x8 a = *(const LAS bf16x8*)(QL + fr * 40 + 8 * kq), bb = *(const LAS bf16x8*)(KL + fr * 40 + 8 * kq);
            const f32x4 G = __builtin_amdgcn_mfma_f32_16x16x32_bf16(a, bb, (f32x4){0.f, 0.f, 0.f, 0.f}, 0, 0, 0);
#pragma unroll
            for (int i = 0; i < 4; ++i) { const int r = 4 * kq + i; GL[r * 32 + fr] = (bf16_t)(pk_bf16(fr <= r ? G[i] : 0.f, 0.f) & 0xffffu); } }
        WAVE_LDS_SYNC();
        const bf16x8 ag = *(const LAS bf16x8*)(GL + fr * 32 + 8 * kq);
        const u32x2 qlo = *(const LAS u32x2*)(QL + fr * 40 + 4 * kq), qhi = *(const LAS u32x2*)(QL + fr * 40 + 16 + 4 * kq);
        const bf16x8 aq = __builtin_bit_cast(bf16x8, (u32x4){qlo[0], qlo[1], qhi[0], qhi[1]});
        bf16x8 bv[4], ak[2];
#pragma unroll
        for (int c = 0; c < 4; ++c) bv[c] = *(const LAS bf16x8*)(VT + (16 * c + fr) * 32 + 8 * kq);
#pragma unroll
        for (int a = 0; a < 2; ++a) ak[a] = *(const LAS bf16x8*)(KT + (16 * a + fr) * 32 + 8 * kq);
        const f32x4 eb0 = *(const LAS f32x4*)(EB + 4 * kq), eb1 = *(const LAS f32x4*)(EB + 16 + 4 * kq);
#pragma unroll
        for (int c = 0; c < 4; ++c) { f32x4 acc = __builtin_amdgcn_mfma_f32_16x16x32_bf16(ag, bv[c], (f32x4){0.f, 0.f, 0.f, 0.f}, 0, 0, 0);
            const f32x4 s0 = S[0][c], s1 = S[1][c];
            const bf16x8 bs = __builtin_bit_cast(bf16x8, (u32x4){pk_bf16(s0[0], s0[1]), pk_bf16(s0[2], s0[3]), pk_bf16(s1[0], s1[1]), pk_bf16(s1[2], s1[3])});
            acc = __builtin_amdgcn_mfma_f32_16x16x32_bf16(aq, bs, acc, 0, 0, 0);
            S[0][c] = __builtin_amdgcn_mfma_f32_16x16x32_bf16(ak[0], bv[c], S[0][c], 0, 0, 0) * eb0;
            S[1][c] = __builtin_amdgcn_mfma_f32_16x16x32_bf16(ak[1], bv[c], S[1][c], 0, 0, 0) * eb1;
#pragma unroll
            for (int i = 0; i < 4; ++i) { const int r = 4 * kq + i; Og[((size_t)c * TT + (size_t)(tcur + (dir ? 15 - r : r))) * 16 + fr] = (bf16_t)(pk_bf16(acc[i], 0.f) & 0xffffu); } }
        WAVE_LDS_SYNC();
    }
#undef GC_LOAD
}
__device__ __forceinline__ float oct_sum(float v) {
    v += __builtin_bit_cast(float, __builtin_amdgcn_update_dpp(0, __builtin_bit_cast(int, v), 0xB1, 0xF, 0xF, true));
    v += __builtin_bit_cast(float, __builtin_amdgcn_update_dpp(0, __builtin_bit_cast(int, v), 0x4E, 0xF, 0xF, true));
    v += __builtin_bit_cast(float, __builtin_amdgcn_update_dpp(0, __builtin_bit_cast(int, v), 0x141, 0xF, 0xF, true));
    return v;
}
__device__ __forceinline__ void scan_dn(KP p, LAS float* L, int idx, int wv, int noload) {
    const int lane = tid_launder(wv) & 63, vl = lane >> 3, dg = lane & 7;
    const int cq = idx & 7, dir = (idx >> 3) & 1, h = (idx >> 4) & 3, b = idx >> 6;
    const bf16_t* Qg = (const bf16_t*)(p->ws + WS_ABUF) + (size_t)b * TT * 256 + h * 64; const bf16_t* Kg = Qg + PANEL_EL; const bf16_t* Vg = Qg + 2 * PANEL_EL + cq * 8;
    const float* ABg = (const float*)(p->ws + WS_DNAB) + (size_t)b * TT * 16 + dir * 4 + h;
    bf16_t* Og = obuf(p->ws, 4 + dir) + (size_t)((b * 4 + h) * 8 + cq) * TT * 8;
    LAS float* LQ = L; LAS float* LK = L + 1024; LAS float* LV = L + 2048; LAS float* LAB = L + 2176; LAS float* LOP = L + 2208;
    f32x2 S[4];
#pragma unroll
    for (int i = 0; i < 4; ++i) S[i] = (f32x2){0.f, 0.f};
    const int lrow = lane >> 2, lseg = lane & 3;
    struct DnSet { u32x4 q0, q1, k0, k1, v; float a, b; };
    DnSet R0, R1;
#define DN_LOAD(R, BLK) do { if ((BLK) < 144 && !(noload && (BLK) >= 2)) { const int T0_ = blk_tok0(dir, (BLK)); const size_t ro = (size_t)(T0_ + lrow) * 256 + lseg * 16; R.q0 = *(const u32x4*)(Qg + ro); R.q1 = *(const u32x4*)(Qg + ro + 8); R.k0 = *(const u32x4*)(Kg + ro); R.k1 = *(const u32x4*)(Kg + ro + 8); \
        R.v = *(const u32x4*)(Vg + (size_t)(T0_ + (lane & 15)) * 256); R.a = ABg[(size_t)(T0_ + (lane & 15)) * 16]; R.b = ABg[(size_t)(T0_ + (lane & 15)) * 16 + 8]; } } while (0)
#define DN_RD(LS) do { nk0 = *(const LAS f32x4*)(LK + (LS) * 64 + dg * 8); nk1 = *(const LAS f32x4*)(LK + (LS) * 64 + dg * 8 + 4); nq0 = *(const LAS f32x4*)(LQ + (LS) * 64 + dg * 8); nq1 = *(const LAS f32x4*)(LQ + (LS) * 64 + dg * 8 + 4); \
            nv = LV[(LS) * 8 + vl]; na = LAB[(LS) * 2]; nb = LAB[(LS) * 2 + 1]; } while (0)
#define DN_BLOCK(R, BLK) do { \
        cvt8(R.q0, LQ + lrow * 64 + lseg * 16); cvt8(R.q1, LQ + lrow * 64 + lseg * 16 + 8); cvt8(R.k0, LK + lrow * 64 + lseg * 16); cvt8(R.k1, LK + lrow * 64 + lseg * 16 + 8); \
        if (lane < 16) { cvt8(R.v, LV + lane * 8); LAB[lane * 2] = R.a; LAB[lane * 2 + 1] = R.b; } \
        const int tcur = blk_tok0(dir, (BLK)); \
        DN_LOAD(R, (BLK) + 2); \
        WAVE_LDS_SYNC(); \
        f32x4 nk0, nk1, nq0, nq1; float nv, na, nb; \
        DN_RD(dir ? 15 : 0); \
        _Pragma("unroll") for (int s = 0; s < 16; ++s) { \
            const f32x2 ka = {nk0[0], nk0[1]}, kb = {nk0[2], nk0[3]}, kc = {nk1[0], nk1[1]}, kd = {nk1[2], nk1[3]}; \
            const f32x2 qa = {nq0[0], nq0[1]}, qb = {nq0[2], nq0[3]}, qc = {nq1[0], nq1[1]}, qd = {nq1[2], nq1[3]}; const float v = nv, a = na, bt = nb; \
            const int ls = dir ? 15 - s : s; \
            if (s < 15) { DN_RD(dir ? 14 - s : s + 1); } \
            const f32x2 r2 = (ka * S[0] + kb * S[1]) + (kc * S[2] + kd * S[3]);        \
            const float r = oct_sum(r2[0] + r2[1]); \
            const float c = bt * (v - a * r); \
            const f32x2 c2 = {c, c}, a2 = {a, a}; \
            S[0] = a2 * S[0] + ka * c2; S[1] = a2 * S[1] + kb * c2; S[2] = a2 * S[2] + kc * c2; S[3] = a2 * S[3] + kd * c2; \
            const f32x2 o2 = (qa * S[0] + qb * S[1]) + (qc * S[2] + qd * S[3]); \
            LOP[ls * 64 + lane] = o2[0] + o2[1]; \
            asm volatile("" ::: "memory"); } \
        WAVE_LDS_SYNC(); \
        { const int ts = lane >> 2, c0 = (lane & 3) * 2;                         \
            const f32x4 p0 = *(const LAS f32x4*)(LOP + ts * 64 + c0 * 8), p1 = *(const LAS f32x4*)(LOP + ts * 64 + c0 * 8 + 4), p2 = *(const LAS f32x4*)(LOP + ts * 64 + c0 * 8 + 8), p3 = *(const LAS f32x4*)(LOP + ts * 64 + c0 * 8 + 12); \
            const float oa = (p0[0] + p0[1]) + (p0[2] + p0[3]) + (p1[0] + p1[1]) + (p1[2] + p1[3]), ob = (p2[0] + p2[1]) + (p2[2] + p2[3]) + (p3[0] + p3[1]) + (p3[2] + p3[3]); \
            *(unsigned*)(Og + (size_t)(tcur + ts) * 8 + c0) = pk_bf16(oa, ob); } \
        WAVE_LDS_SYNC(); } while (0)
    DN_LOAD(R0, 0); DN_LOAD(R1, 1);
    for (int blk = 0; blk < 144; blk += 2) { DN_BLOCK(R0, blk); DN_BLOCK(R1, blk + 1); }
#undef DN_BLOCK
#undef DN_RD
#undef DN_LOAD
}
__device__ __forceinline__ bf16x8 packz(const f32x4 v) { return __builtin_bit_cast(bf16x8, (u32x4){pk_bf16(v[0], v[1]), pk_bf16(v[2], v[3]), 0u, 0u}); }
__device__ __forceinline__ bf16x8 ldaz(const LAS bf16_t* img, int fr, int kq) { const u32x2 lo = *(const LAS u32x2*)(img + fr * 32 + 4 * kq); return __builtin_bit_cast(bf16x8, (u32x4){lo[0], lo[1], 0u, 0u}); }
__device__ __forceinline__ void stz(LAS bf16_t* img, const f32x4 v, int fr, int kq) {
#pragma unroll
    for (int i = 0; i < 4; ++i) img[(4 * kq + i) * 32 + fr] = (bf16_t)(pk_bf16(v[i], 0.f) & 0xffffu);
}
__device__ __forceinline__ float row_scan16(float v) {
    v += __builtin_bit_cast(float, __builtin_amdgcn_update_dpp(0, __builtin_bit_cast(int, v), 0x111, 0xF, 0xF, true));
    v += __builtin_bit_cast(float, __builtin_amdgcn_update_dpp(0, __builtin_bit_cast(int, v), 0x112, 0xF, 0xF, true));
    v += __builtin_bit_cast(float, __builtin_amdgcn_update_dpp(0, __builtin_bit_cast(int, v), 0x114, 0xF, 0xF, true));
    v += __builtin_bit_cast(float, __builtin_amdgcn_update_dpp(0, __builtin_bit_cast(int, v), 0x118, 0xF, 0xF, true));
    return v;
}
constexpr int DN_SLOT = 13568, DN_NSLOT = 4;
__device__ __forceinline__ void lds_wait_ge(volatile LAS int* f, int need) { for (int it = 0; it < (1 << 22); ++it) { if (*f >= need) break; __builtin_amdgcn_s_sleep(1); } asm volatile("" ::: "memory"); }
template <int DIR>
__device__ __forceinline__ void scan_dn_producer(KP p, LAS unsigned char* ring, LAS unsigned char* scratch, volatile LAS int* flags, int idx, int par, int wv) {
    const int lane = tid_launder(wv) & 63, fr = lane & 15, kq = lane >> 4;
    constexpr int dir = DIR; const int h = (idx >> 1) & 3, b = idx >> 3;
    const bf16_t* Qg = (const bf16_t*)(p->ws + WS_ABUF) + (size_t)b * TT * 256 + h * 64; const bf16_t* Kg = Qg + PANEL_EL; const bf16_t* Vg = Qg + 2 * PANEL_EL;
    const float* ABg = (const float*)(p->ws + WS_DNAB) + (size_t)b * TT * 16 + dir * 4 + h;
    LAS bf16_t* L0 = (LAS bf16_t*)scratch; LAS bf16_t* L1 = L0 + 16 * 32; LAS bf16_t* L2 = L1 + 16 * 32;
    for (int i = lane; i < (3 * 16 * 32) / 2; i += 64) ((LAS unsigned*)L0)[i] = 0u;
    for (int sl = par; sl < DN_NSLOT; sl += 2) { LAS unsigned* z = (LAS unsigned*)(ring + sl * DN_SLOT + 3 * 16 * 72 * 2); for (int i = lane; i < (64 * 32 + 2 * 16 * 32) / 2; i += 64) z[i] = 0u; }
    u32x4 rq[2], rk[2], rv[2]; float rla, rbe;
    int tb = blk_tok0(dir, par);
#define DC_LOAD(T0) do { _Pragma("unroll") for (int i = 0; i < 2; ++i) { const int q = lane + 64 * i, r = q >> 3, c8 = (q & 7) * 8; const size_t ro = (size_t)((T0) + (dir ? 15 - r : r)) * 256 + c8; \
            rq[i] = *(const u32x4*)(Qg + ro); rk[i] = *(const u32x4*)(Kg + ro); rv[i] = *(const u32x4*)(Vg + ro); } \
        { const size_t ao = (size_t)((T0) + (dir ? 15 - fr : fr)) * 16; rla = ABg[ao]; rbe = ABg[ao + 8]; } } while (0)
    DC_LOAD(tb);
    for (int blk = par; blk < 144; blk += 2) {
        LAS unsigned char* sl = ring + (blk % DN_NSLOT) * DN_SLOT;
        LAS bf16_t* QL = (LAS bf16_t*)sl; LAS bf16_t* KL = QL + 16 * 72; LAS bf16_t* VL = KL + 16 * 72; LAS bf16_t* KT = VL + 16 * 72; LAS bf16_t* TL = KT + 64 * 32; LAS bf16_t* PL = TL + 16 * 32; LAS float* GS = (LAS float*)(PL + 16 * 32);
        if (blk >= DN_NSLOT) lds_wait_ge(flags + 2, blk - DN_NSLOT + 1);
        const float gsc = row_scan16(rla), bec = rbe;
        const float g15 = __builtin_bit_cast(float, __builtin_amdgcn_readlane(__builtin_bit_cast(int, gsc), 15));
        if (lane < 16) { GS[lane] = gsc; GS[16 + lane] = bec; GS[32 + lane] = g15; }
#pragma unroll
        for (int i = 0; i < 2; ++i) { const int q = lane + 64 * i, r = q >> 3, c8 = (q & 7) * 8;
            *(LAS u32x4*)(QL + r * 72 + c8) = rq[i]; *(LAS u32x4*)(KL + r * 72 + c8) = rk[i]; *(LAS u32x4*)(VL + r * 72 + c8) = rv[i]; }
        WAVE_LDS_SYNC();
        const f32x4 gr = *(const LAS f32x4*)(GS + 4 * kq), br = *(const LAS f32x4*)(GS + 16 + 4 * kq);
#pragma unroll
        for (int i = 0; i < 2; ++i) { const int q = lane + 64 * i, r = q >> 3, c8 = (q & 7) * 8; const float ks = __expf(g15 - GS[r]);
#pragma unroll
            for (int e = 0; e < 4; ++e) { const unsigned kv = pk_bf16(bflo(rk[i][e]) * ks, bfhi(rk[i][e]) * ks); KT[(c8 + 2 * e) * 32 + r] = (bf16_t)(kv & 0xffffu); KT[(c8 + 2 * e + 1) * 32 + r] = (bf16_t)(kv >> 16); } }
        if (blk + 2 < 144) { tb = blk_tok0(dir, blk + 2); DC_LOAD(tb); }
        f32x4 KK = (f32x4){0.f, 0.f, 0.f, 0.f}, QK = (f32x4){0.f, 0.f, 0.f, 0.f};
#pragma unroll
        for (int kk = 0; kk < 2; ++kk) { const bf16x8 ak = *(const LAS bf16x8*)(KL + fr * 72 + 32 * kk + 8 * kq), aq = *(const LAS bf16x8*)(QL + fr * 72 + 32 * kk + 8 * kq);
            KK = __builtin_amdgcn_mfma_f32_16x16x32_bf16(ak, ak, KK, 0, 0, 0); QK = __builtin_amdgcn_mfma_f32_16x16x32_bf16(aq, ak, QK, 0, 0, 0); }
        f32x4 Lm, Pm;
#pragma unroll
        for (int i = 0; i < 4; ++i) { const int r = 4 * kq + i; const float e = __expf(fminf(gr[i] - gsc, 0.f)); Lm[i] = fr < r ? br[i] * e * KK[i] : 0.f; Pm[i] = fr <= r ? e * QK[i] : 0.f; }
        stz(L0, Lm, fr, kq); stz(PL, Pm, fr, kq);
        WAVE_LDS_SYNC();
        const bf16x8 aL = ldaz(L0, fr, kq);
        const f32x4 Lsq = __builtin_amdgcn_mfma_f32_16x16x32_bf16(aL, packz(Lm), (f32x4){0.f, 0.f, 0.f, 0.f}, 0, 0, 0);
        stz(L1, Lsq, fr, kq);
        WAVE_LDS_SYNC();
        const bf16x8 aL2 = ldaz(L1, fr, kq);
        const f32x4 Lq = __builtin_amdgcn_mfma_f32_16x16x32_bf16(aL2, packz(Lsq), (f32x4){0.f, 0.f, 0.f, 0.f}, 0, 0, 0);
        stz(L2, Lq, fr, kq);
        WAVE_LDS_SYNC();
        const bf16x8 aL4 = ldaz(L2, fr, kq);
        f32x4 Y = __builtin_amdgcn_mfma_f32_16x16x32_bf16(aL4, packz(Lq), (f32x4){0.f, 0.f, 0.f, 0.f}, 0, 0, 0);
#pragma unroll
        for (int i = 0; i < 4; ++i) Y[i] += (fr == 4 * kq + i) ? 1.f : 0.f;
        Y = __builtin_amdgcn_mfma_f32_16x16x32_bf16(aL4, packz(Y), Y, 0, 0, 0);
        Y = __builtin_amdgcn_mfma_f32_16x16x32_bf16(aL2, packz(Y), Y, 0, 0, 0);
        { const f32x4 nY = -Y; Y = __builtin_amdgcn_mfma_f32_16x16x32_bf16(aL, packz(nY), Y, 0, 0, 0); }
        stz(TL, Y, fr, kq);
        WAVE_LDS_SYNC();
        if (lane == 0) flags[par] = (blk >> 1) + 1;
    }
#undef DC_LOAD
}
template <int DIR>
__device__ __forceinline__ void scan_dn_consumer(KP p, LAS unsigned char* ring, volatile LAS int* flags, int idx, int wv) {
    const int lane = tid_launder(wv) & 63, fr = lane & 15, kq = lane >> 4;
    constexpr int dir = DIR; const int h = (idx >> 1) & 3, b = idx >> 3;
    bf16_t* Og = obuf(p->ws, 4 + dir) + (size_t)((b * 4 + h) * 4) * TT * 16;
    f32x4 S[4][4];
#pragma unroll
    for (int a = 0; a < 4; ++a)
#pragma unroll
        for (int c = 0; c < 4; ++c) S[a][c] = (f32x4){0.f, 0.f, 0.f, 0.f};
    for (int blk = 0; blk < 144; ++blk) {
        LAS unsigned char* sl = ring + (blk % DN_NSLOT) * DN_SLOT;
        LAS bf16_t* QL = (LAS bf16_t*)sl; LAS bf16_t* KL = QL + 16 * 72; LAS bf16_t* VL = KL + 16 * 72; LAS bf16_t* KT = VL + 16 * 72; LAS bf16_t* TL = KT + 64 * 32; LAS bf16_t* PL = TL + 16 * 32; LAS float* GS = (LAS float*)(PL + 16 * 32);
        lds_wait_ge(flags + (blk & 1), (blk >> 1) + 1);
        const f32x4 gr = *(const LAS f32x4*)(GS + 4 * kq), br = *(const LAS f32x4*)(GS + 16 + 4 * kq); const float g15 = GS[32];
        float vv[4][4];
#pragma unroll
        for (int c = 0; c < 4; ++c)
#pragma unroll
            for (int i = 0; i < 4; ++i) vv[c][i] = bf2f(VL[(4 * kq + i) * 72 + 16 * c + fr]);
        const bf16x8 aT = ldaz(TL, fr, kq), aP = ldaz(PL, fr, kq);
        bf16x8 akp[2], aqp[2], aKT[4];
#pragma unroll
        for (int kk = 0; kk < 2; ++kk) { const u32x2 klo = *(const LAS u32x2*)(KL + fr * 72 + 32 * kk + 4 * kq), khi = *(const LAS u32x2*)(KL + fr * 72 + 32 * kk + 16 + 4 * kq);
            const u32x2 qlo = *(const LAS u32x2*)(QL + fr * 72 + 32 * kk + 4 * kq), qhi = *(const LAS u32x2*)(QL + fr * 72 + 32 * kk + 16 + 4 * kq);
            akp[kk] = __builtin_bit_cast(bf16x8, (u32x4){klo[0], klo[1], khi[0], khi[1]}); aqp[kk] = __builtin_bit_cast(bf16x8, (u32x4){qlo[0], qlo[1], qhi[0], qhi[1]}); }
#pragma unroll
        for (int a = 0; a < 4; ++a) aKT[a] = ldaz(KT + (16 * a) * 32, fr, kq);
        WAVE_LDS_SYNC();
        if (lane == 0) flags[2] = blk + 1;
        f32x4 Gr;
#pragma unroll
        for (int i = 0; i < 4; ++i) Gr[i] = __expf(gr[i]);
        const float G15 = __expf(g15);
        const int tcur = blk_tok0(dir, blk);
#pragma unroll
        for (int c = 0; c < 4; ++c) {
            f32x4 KS = (f32x4){0.f, 0.f, 0.f, 0.f}, QS = (f32x4){0.f, 0.f, 0.f, 0.f};
#pragma unroll
            for (int kk = 0; kk < 2; ++kk) { const f32x4 s0 = S[2 * kk][c], s1 = S[2 * kk + 1][c];
                const bf16x8 bs = __builtin_bit_cast(bf16x8, (u32x4){pk_bf16(s0[0], s0[1]), pk_bf16(s0[2], s0[3]), pk_bf16(s1[0], s1[1]), pk_bf16(s1[2], s1[3])});
                KS = __builtin_amdgcn_mfma_f32_16x16x32_bf16(akp[kk], bs, KS, 0, 0, 0); QS = __builtin_amdgcn_mfma_f32_16x16x32_bf16(aqp[kk], bs, QS, 0, 0, 0); }
            f32x4 R;
#pragma unroll
            for (int i = 0; i < 4; ++i) R[i] = br[i] * (vv[c][i] - Gr[i] * KS[i]);
            const f32x4 U = __builtin_amdgcn_mfma_f32_16x16x32_bf16(aT, packz(R), (f32x4){0.f, 0.f, 0.f, 0.f}, 0, 0, 0);
            const bf16x8 bu = packz(U);
            const f32x4 O = __builtin_amdgcn_mfma_f32_16x16x32_bf16(aP, bu, Gr * QS, 0, 0, 0);
#pragma unroll
            for (int a = 0; a < 4; ++a) S[a][c] = __builtin_amdgcn_mfma_f32_16x16x32_bf16(aKT[a], bu, S[a][c] * G15, 0, 0, 0);
#pragma unroll
            for (int i = 0; i < 4; ++i) { const int r = 4 * kq + i; Og[((size_t)c * TT + (size_t)(tcur + (dir ? 15 - r : r))) * 16 + fr] = (bf16_t)(pk_bf16(O[i], 0.f) & 0xffffu); }
        }
    }
}
template <int DIR>
__device__ __forceinline__ void scan_s5(KP p, LAS unsigned char* Lb, int idx, int l, int wv) {
    const int lane = tid_launder(wv) & 63, fr = lane & 15, kq = lane >> 4;
    constexpr int dir = DIR; const int g = (idx >> 1) & 15, b = idx >> 5;
    const bf16_t* Ug = (const bf16_t*)(p->ws + WS_P) + 7 * PANEL_EL + (size_t)b * TT * 256 + g * 16;
    bf16_t* Og = obuf(p->ws, 6 + dir) + (size_t)(b * 16 + g) * TT * 16;
    LAS bf16_t* UL = (LAS bf16_t*)Lb; LAS float* BL = (LAS float*)(Lb + 1024); LAS unsigned* HB = (LAS unsigned*)(Lb + 1024 + 8192);
    for (int i = lane; i < 256; i += 64) ((LAS unsigned*)UL)[i] = 0u;
    const float dt = expf(p->in[I_S5DT][(l * 2 + dir) * 16 + g]);
    const float* LRE = p->in[I_S5LRE] + ((l * 2 + dir) * 16 + g) * 64; const float* LIM = p->in[I_S5LIM] + ((l * 2 + dir) * 16 + g) * 64;
    float lbr, lbi;
    { const float lre = LRE[lane], lim = LIM[lane]; float sn, cs; sincosf(lim * dt, &sn, &cs); const float mag = expf(lre * dt); lbr = mag * cs; lbi = mag * sn; }
    bf16x8 Bf[8];
#pragma unroll
    for (int pt = 0; pt < 4; ++pt) { const int ps = fr + 16 * pt;
        const float lre = LRE[ps], lim = LIM[ps]; float sn, cs; sincosf(lim * dt, &sn, &cs); const float mag = expf(lre * dt);
        const float nr = mag * cs - 1.f, ni = mag * sn, den = 1.f / (lre * lre + lim * lim);
        const float bsr = (nr * lre + ni * lim) * den, bsi = (ni * lre - nr * lim) * den;
        u32x4 wre = (u32x4){0u, 0u, 0u, 0u}, wim = (u32x4){0u, 0u, 0u, 0u};
        if (kq < 2) { const float* bre = p->in[I_S5BRE] + (size_t)((l * 16 + g) * 64 + ps) * 16 + 8 * kq; const float* bim = p->in[I_S5BIM] + (size_t)((l * 16 + g) * 64 + ps) * 16 + 8 * kq;
#pragma unroll
            for (int e = 0; e < 4; ++e) { const float r0 = bre[2 * e], r1 = bre[2 * e + 1], i0 = bim[2 * e], i1 = bim[2 * e + 1];
                wre[e] = pk_bf16(bsr * r0 - bsi * i0, bsr * r1 - bsi * i1); wim[e] = pk_bf16(bsr * i0 + bsi * r0, bsr * i1 + bsi * r1); } }
        Bf[pt] = __builtin_bit_cast(bf16x8, wre); Bf[4 + pt] = __builtin_bit_cast(bf16x8, wim); }
    bf16x8 Cf[4];
    { const float* cre = p->in[I_S5CRE] + (size_t)((l * 16 + g) * 16 + fr) * 64; const float* cim = p->in[I_S5CIM] + (size_t)((l * 16 + g) * 16 + fr) * 64;
#pragma unroll
        for (int kk = 0; kk < 4; ++kk) { const int p0 = 16 * kk + 4 * kq; const f32x4 r = *(const f32x4*)(cre + p0), im = *(const f32x4*)(cim + p0);
            const u32x4 w = (u32x4){pk_bf16(r[0], -im[0]), pk_bf16(r[1], -im[1]), pk_bf16(r[2], -im[2]), pk_bf16(r[3], -im[3])}; Cf[kk] = __builtin_bit_cast(bf16x8, w); } }
    float hre = 0.f, him = 0.f;
    u32x4 U0, U1, U2;
#define S5_LOAD(R, BLK) do { if ((BLK) < 144) R = *(const u32x4*)(Ug + (size_t)(blk_tok0(dir, (BLK)) + ((lane >> 1) & 15)) * 256 + (lane & 1) * 8); } while (0)
#define S5_BLOCK(R, BLK) do { \
        if (lane < 32) *(LAS u32x4*)(UL + (lane >> 1) * 32 + (lane & 1) * 8) = R; \
        const int tcur = blk_tok0(dir, (BLK)); \
        S5_LOAD(R, (BLK) + 3); \
        WAVE_LDS_SYNC(); \
        { const bf16x8 au = *(const LAS bf16x8*)(UL + fr * 32 + 8 * kq); \
            _Pragma("unroll") for (int nt = 0; nt < 8; ++nt) { const f32x4 d = __builtin_amdgcn_mfma_f32_16x16x32_bf16(au, Bf[nt], (f32x4){0.f, 0.f, 0.f, 0.f}, 0, 0, 0); \
                _Pragma("unroll") for (int i = 0; i < 4; ++i) BL[(4 * kq + i) * 128 + 16 * nt + fr] = d[i]; } } \
        WAVE_LDS_SYNC(); \
        float bur[16], bui[16]; \
        _Pragma("unroll") for (int s = 0; s < 16; ++s) { bur[s] = BL[s * 128 + lane]; bui[s] = BL[s * 128 + 64 + lane]; } \
        _Pragma("unroll") for (int s = 0; s < 16; ++s) { \
            const int ls = dir ? 15 - s : s; \
            const float bre = dir ? bur[15 - s] : bur[s], bim = dir ? bui[15 - s] : bui[s]; \
            const float nre = lbr * hre - lbi * him + bre, nim = lbr * him + lbi * hre + bim; \
            hre = nre; him = nim; \
            HB[ls * 68 + lane] = pk_bf16(nre, nim); } \
        WAVE_LDS_SYNC(); \
        f32x4 acc = (f32x4){0.f, 0.f, 0.f, 0.f}; \
        _Pragma("unroll") for (int kk = 0; kk < 4; ++kk) { const bf16x8 a = *(const LAS bf16x8*)(HB + fr * 68 + 16 * kk + 4 * kq); acc = __builtin_amdgcn_mfma_f32_16x16x32_bf16(a, Cf[kk], acc, 0, 0, 0); } \
        _Pragma("unroll") for (int i = 0; i < 4; ++i) Og[(size_t)(tcur + 4 * kq + i) * 16 + fr] = (bf16_t)(pk_bf16(acc[i], 0.f) & 0xffffu); \
        WAVE_LDS_SYNC(); } while (0)
    S5_LOAD(U0, 0); S5_LOAD(U1, 1); S5_LOAD(U2, 2);
    for (int blk = 0; blk < 144; blk += 3) { S5_BLOCK(U0, blk); S5_BLOCK(U1, blk + 1); S5_BLOCK(U2, blk + 2); }
#undef S5_BLOCK
#undef S5_LOAD
}
constexpr int S5_SLOT = 8192, NSLOT = 3;
template <int DIR>
__device__ __forceinline__ void scan_s5_producer(KP p, LAS unsigned char* ring, LAS unsigned char* scratch, volatile LAS int* flags, int idx, int l, int wv) {
    const int lane = tid_launder(wv) & 63, fr = lane & 15, kq = lane >> 4;
    constexpr int dir = DIR; const int g = (idx >> 1) & 15, b = idx >> 5;
    const bf16_t* Ug = (const bf16_t*)(p->ws + WS_P) + 7 * PANEL_EL + (size_t)b * TT * 256 + g * 16;
    LAS bf16_t* UL = (LAS bf16_t*)scratch;
    for (int i = lane; i < 256; i += 64) ((LAS unsigned*)UL)[i] = 0u;
    const float dt = expf(p->in[I_S5DT][(l * 2 + dir) * 16 + g]);
    const float* LRE = p->in[I_S5LRE] + ((l * 2 + dir) * 16 + g) * 64; const float* LIM = p->in[I_S5LIM] + ((l * 2 + dir) * 16 + g) * 64;
    bf16x8 Bf[8];
#pragma unroll
    for (int pt = 0; pt < 4; ++pt) { const int ps = fr + 16 * pt;
        const float lre = LRE[ps], lim = LIM[ps]; float sn, cs; sincosf(lim * dt, &sn, &cs); const float mag = expf(lre * dt);
        const float nr = mag * cs - 1.f, ni = mag * sn, den = 1.f / (lre * lre + lim * lim);
        const float bsr = (nr * lre + ni * lim) * den, bsi = (ni * lre - nr * lim) * den;
        u32x4 wre = (u32x4){0u, 0u, 0u, 0u}, wim = (u32x4){0u, 0u, 0u, 0u};
        if (kq < 2) { const float* bre = p->in[I_S5BRE] + (size_t)((l * 16 + g) * 64 + ps) * 16 + 8 * kq; const float* bim = p->in[I_S5BIM] + (size_t)((l * 16 + g) * 64 + ps) * 16 + 8 * kq;
#pragma unroll
            for (int e = 0; e < 4; ++e) { const float r0 = bre[2 * e], r1 = bre[2 * e + 1], i0 = bim[2 * e], i1 = bim[2 * e + 1];
                wre[e] = pk_bf16(bsr * r0 - bsi * i0, bsr * r1 - bsi * i1); wim[e] = pk_bf16(bsr * i0 + bsi * r0, bsr * i1 + bsi * r1); } }
        Bf[pt] = __builtin_bit_cast(bf16x8, wre); Bf[4 + pt] = __builtin_bit_cast(bf16x8, wim); }
    u32x4 U0, U1, U2;
#define S5_LOAD(R, BLK) do { if ((BLK) < 144) R = *(const u32x4*)(Ug + (size_t)(blk_tok0(dir, (BLK)) + ((lane >> 1) & 15)) * 256 + (lane & 1) * 8); } while (0)
#define S5_PBLOCK(R, BLK) do { \
        LAS float* BL = (LAS float*)(ring + ((BLK) % NSLOT) * S5_SLOT); \
        if ((BLK) >= NSLOT) lds_wait_ge(flags + 1, (BLK) - NSLOT + 1); \
        if (lane < 32) *(LAS u32x4*)(UL + (lane >> 1) * 32 + (lane & 1) * 8) = R; \
        S5_LOAD(R, (BLK) + 3); \
        WAVE_LDS_SYNC(); \
        { const bf16x8 au = *(const LAS bf16x8*)(UL + fr * 32 + 8 * kq); \
            _Pragma("unroll") for (int nt = 0; nt < 8; ++nt) { const f32x4 d = __builtin_amdgcn_mfma_f32_16x16x32_bf16(au, Bf[nt], (f32x4){0.f, 0.f, 0.f, 0.f}, 0, 0, 0); \
                _Pragma("unroll") for (int i = 0; i < 4; ++i) BL[(4 * kq + i) * 128 + 16 * nt + fr] = d[i]; } } \
        WAVE_LDS_SYNC(); \
        if (lane == 0) flags[0] = (BLK) + 1; } while (0)
    S5_LOAD(U0, 0); S5_LOAD(U1, 1); S5_LOAD(U2, 2);
    for (int blk = 0; blk < 144; blk += 3) { S5_PBLOCK(U0, blk); S5_PBLOCK(U1, blk + 1); S5_PBLOCK(U2, blk + 2); }
#undef S5_PBLOCK
#undef S5_LOAD
}
template <int DIR>
__device__ __forceinline__ void scan_s5_consumer(KP p, LAS unsigned char* ring, LAS unsigned char* priv, volatile LAS int* flags, int idx, int l, int wv) {
    const int lane = tid_launder(wv) & 63, fr = lane & 15, kq = lane >> 4;
    constexpr int dir = DIR; const int g = (idx >> 1) & 15, b = idx >> 5;
    bf16_t* Og = obuf(p->ws, 6 + dir) + (size_t)(b * 16 + g) * TT * 16;
    LAS unsigned* HB = (LAS unsigned*)priv;
    const float dt = expf(p->in[I_S5DT][(l * 2 + dir) * 16 + g]);
    float lbr, lbi;
    { const float lre = p->in[I_S5LRE][((l * 2 + dir) * 16 + g) * 64 + lane], lim = p->in[I_S5LIM][((l * 2 + dir) * 16 + g) * 64 + lane]; float sn, cs; sincosf(lim * dt, &sn, &cs); const float mag = expf(lre * dt); lbr = mag * cs; lbi = mag * sn; }
    bf16x8 Cf[4];
    { const float* cre = p->in[I_S5CRE] + (size_t)((l * 16 + g) * 16 + fr) * 64; const float* cim = p->in[I_S5CIM] + (size_t)((l * 16 + g) * 16 + fr) * 64;
#pragma unroll
        for (int kk = 0; kk < 4; ++kk) { const int p0 = 16 * kk + 4 * kq; const f32x4 r = *(const f32x4*)(cre + p0), im = *(const f32x4*)(cim + p0);
            const u32x4 w = (u32x4){pk_bf16(r[0], -im[0]), pk_bf16(r[1], -im[1]), pk_bf16(r[2], -im[2]), pk_bf16(r[3], -im[3])}; Cf[kk] = __builtin_bit_cast(bf16x8, w); } }
    float hre = 0.f, him = 0.f;
    for (int blk = 0; blk < 144; ++blk) {
        const LAS float* BL = (const LAS float*)(ring + (blk % NSLOT) * S5_SLOT);
        lds_wait_ge(flags, blk + 1);
        float bur[16], bui[16];
#pragma unroll
        for (int s = 0; s < 16; ++s) { bur[s] = BL[s * 128 + lane]; bui[s] = BL[s * 128 + 64 + lane]; }
        WAVE_LDS_SYNC();
        if (lane == 0) flags[1] = blk + 1;
        const int tcur = blk_tok0(dir, blk);
#pragma unroll
        for (int s = 0; s < 16; ++s) {
            const int ls = dir ? 15 - s : s;
            const float bre = dir ? bur[15 - s] : bur[s], bim = dir ? bui[15 - s] : bui[s];
            const float nre = lbr * hre - lbi * him + bre, nim = lbr * him + lbi * hre + bim;
            hre = nre; him = nim;
            HB[ls * 68 + lane] = pk_bf16(nre, nim);
        }
        WAVE_LDS_SYNC();
        f32x4 acc = (f32x4){0.f, 0.f, 0.f, 0.f};
#pragma unroll
        for (int kk = 0; kk < 4; ++kk) { const bf16x8 a = *(const LAS bf16x8*)(HB + fr * 68 + 16 * kk + 4 * kq); acc = __builtin_amdgcn_mfma_f32_16x16x32_bf16(a, Cf[kk], acc, 0, 0, 0); }
#pragma unroll
        for (int i = 0; i < 4; ++i) Og[(size_t)(tcur + 4 * kq + i) * 16 + fr] = (bf16_t)(pk_bf16(acc[i], 0.f) & 0xffffu);
        WAVE_LDS_SYNC();
    }
}
__device__ __forceinline__ void phase_scan(KP p, LAS unsigned char* lds, int l, int tm, int wv) {
    const int tid = tid_launder(wv), wave = __builtin_amdgcn_readfirstlane(tid >> 6);
    constexpr int S5_AREA = 2 * LDS_WAVE, S5_FL = NSLOT * S5_SLOT + 1024 + 4352;
    static_assert(S5_FL + 64 <= S5_AREA, "S5 LDS area");
    LAS unsigned char* chainL = lds + 6 * LDS_WAVE;
    LAS unsigned char* convL = lds + 7 * LDS_WAVE;
    LAS unsigned char* ring = lds + 2 * LDS_WAVE; LAS unsigned char* scratch = ring + DN_NSLOT * DN_SLOT; volatile LAS int* flags = (volatile LAS int*)(scratch + 2 * 3072);
    static_assert(2 * LDS_WAVE + DN_NSLOT * DN_SLOT + 2 * 3072 + 64 <= 6 * LDS_WAVE, "scan LDS map");
#define S5P(K, IDX) do { LAS unsigned char* a5 = lds + (K) * S5_AREA; volatile LAS int* f5 = (volatile LAS int*)(a5 + S5_FL); const int idx_ = (IDX); \
        if (idx_ & 1) scan_s5_producer<1>(p, a5, a5 + NSLOT * S5_SLOT, f5, idx_, l, wv); else scan_s5_producer<0>(p, a5, a5 + NSLOT * S5_SLOT, f5, idx_, l, wv); } while (0)
#define S5C(K, IDX) do { LAS unsigned char* a5 = lds + (K) * S5_AREA; volatile LAS int* f5 = (volatile LAS int*)(a5 + S5_FL); const int idx_ = (IDX); \
        if (idx_ & 1) scan_s5_consumer<1>(p, a5, a5 + NSLOT * S5_SLOT + 1024, f5, idx_, l, wv); else scan_s5_consumer<0>(p, a5, a5 + NSLOT * S5_SLOT + 1024, f5, idx_, l, wv); } while (0)
    for (int vb = bid_launder(); vb < NVB; vb += gridDim.x) {
        if (tid == 0) { flags[0] = 0; flags[1] = 0; flags[2] = 0; }
        if (tid < 3) { volatile LAS int* f5 = (volatile LAS int*)(lds + tid * S5_AREA + S5_FL); f5[0] = 0; f5[1] = 0; }
        __syncthreads();
        if (vb < 128) {
            if (wave == 0 || wave == 4) { const int par = wave >> 2; if (tm & 1) { if (vb & 1) scan_dn_producer<1>(p, ring, scratch + par * 3072, flags, vb, par, wv); else scan_dn_producer<0>(p, ring, scratch + par * 3072, flags, vb, par, wv); } }
            else if (wave == 1) { if (tm & 4) { if (vb & 1) scan_ret_chunk<1>(p, chainL, vb, l, wv); else scan_ret_chunk<0>(p, chainL, vb, l, wv); } }
            else if (wave == 2) { if (tm & 2) S5P(0, vb); }
            else if (wave == 3) { if (tm & 2) S5C(0, vb); }
            else if (wave == 6) { if (tm & 1) { if (vb & 1) scan_dn_consumer<1>(p, ring, flags, vb, wv); else scan_dn_consumer<0>(p, ring, flags, vb, wv); } }
            else if (wave == 7) convert_moe_wave(p, convL, l, vb, 256, wv);
        } else {
            const int i3 = 128 + (vb - 128) * 3;
            if (wave == 0) { if (tm & 2) S5P(0, i3); } else if (wave == 1) { if (tm & 2) S5C(0, i3); }
            else if (wave == 4) { if (tm & 2) S5P(1, i3 + 1); } else if (wave == 5) { if (tm & 2) S5C(1, i3 + 1); }
            else if (wave == 3) { if (tm & 2) S5P(2, i3 + 2); } else if (wave == 7) { if (tm & 2) S5C(2, i3 + 2); }
            else if (wave == 2) { if (tm & 8) { if ((vb - 128) & 1) scan_gla_chunk<1>(p, chainL, vb - 128, wv); else scan_gla_chunk<0>(p, chainL, vb - 128, wv); } }
            else if (wave == 6) convert_moe_wave(p, convL, l, 128 + (vb - 128), 256, wv);
        }
        __syncthreads();
    }
#undef S5P
#undef S5C
}

__device__ __forceinline__ float gelu_tanh(float y) { const float x = 0.7978845608028654f * (y + 0.044715f * y * y * y); const float th = 1.f - 2.f / (__expf(2.f * x) + 1.f); return 0.5f * y * (1.f + th); }
__device__ __forceinline__ void phase_mixpost(KP p, LAS unsigned char* lds, int l, int wv, int mode) {
    const int tid = tid_launder(wv), lane = tid & 63, wave = tid >> 6;
    const bf16_t* P = (const bf16_t*)(p->ws + WS_P); bf16_t* MIX = (bf16_t*)(p->ws + WS_ABUF);
    LAS float* YF = (LAS float*)lds; LAS bf16_t* YB = (LAS bf16_t*)(lds + 16384);
    bf16x8 bfr[2][8];
    { const float* gw = p->in[I_GLUW] + (size_t)l * 256 * 256;
#pragma unroll
        for (int nt = 0; nt < 2; ++nt)
#pragma unroll
            for (int kk = 0; kk < 8; ++kk) { const int n = wave * 32 + nt * 16 + (lane & 15), k0 = 32 * kk + 8 * (lane >> 4); u32x4 w;
#pragma unroll
                for (int j = 0; j < 4; ++j) w[j] = pk_bf16(gw[(size_t)(k0 + 2 * j) * 256 + n], gw[(size_t)(k0 + 2 * j + 1) * 256 + n]);
                bfr[nt][kk] = __builtin_bit_cast(bf16x8, w); } }
    const float* s5d = p->in[I_S5D] + l * 256; const float* glub = p->in[I_GLUB] + l * 256;
    for (int vb = bid_launder(); vb < NVB; vb += gridDim.x) {
        const int l32 = lane & 31, tkb = tid >> 5, c8 = (tid & 31) * 8, tkh = wave * 2 + (lane >> 5);
        unsigned nrf[12], nrb[12], nrg[12]; u32x4 nyf, nyb, nuu;
#define MX_LOADS(TILE) do { const int m0_ = vb * 144 + (TILE) * 16, tb0_ = (vb & 15) * 144 + (TILE) * 16; \
            const size_t offt = (size_t)(m0_ + tkh) * 256 + 2 * l32;                                                \
            const size_t ooft = ((size_t)((vb >> 4) * 16 + (l32 >> 3)) * TT + (size_t)(tb0_ + tkh)) * 16 + ((2 * l32) & 15);     \
            _Pragma("unroll") for (int ps = 0; ps < 12; ++ps) { const int mixer = ps >> 2, head = ps & 3; \
                const int ob = mixer == 0 ? 0 : (mixer == 1 ? 2 : 4), gp = mixer == 0 ? 2 : (mixer == 1 ? 6 : 11); \
                nrf[ps] = *(const unsigned*)(obuf(p->ws, ob) + ooft + (size_t)head * 4 * TT * 16); nrb[ps] = *(const unsigned*)(obuf(p->ws, ob + 1) + ooft + (size_t)head * 4 * TT * 16); \
                nrg[ps] = *(const unsigned*)(P + (size_t)gp * PANEL_EL + offt + head * 64); } \
            { const size_t offb = (size_t)(m0_ + tkb) * 256 + c8; const size_t yoff = ((size_t)((vb >> 4) * 16 + (c8 >> 4)) * TT + (size_t)(tb0_ + tkb)) * 16 + (c8 & 15); \
                nyf = *(const u32x4*)(obuf(p->ws, 6) + yoff); nyb = *(const u32x4*)(obuf(p->ws, 7) + yoff); nuu = *(const u32x4*)(P + (size_t)7 * PANEL_EL + offb); } } while (0)
        MX_LOADS(0);
        for (int tile = 0; tile < 9; ++tile) {
            const int m0 = vb * 144 + tile * 16;
            unsigned rfv[12], rbv[12], rgv[12];
#pragma unroll
            for (int ps = 0; ps < 12; ++ps) { rfv[ps] = nrf[ps]; rbv[ps] = nrb[ps]; rgv[ps] = nrg[ps]; }
            const u32x4 yf = nyf, yb = nyb, uu = nuu;
            if (tile + 1 < 9) MX_LOADS(tile + 1);
            if (mode & 1)
#pragma unroll
            for (int ps = 0; ps < 12; ++ps) {
                const int tk = tkh, mixer = ps >> 2, head = ps & 3;
                float o0 = bflo(rfv[ps]) + bflo(rbv[ps]), o1 = bfhi(rfv[ps]) + bfhi(rbv[ps]);
                if (mixer == 1) { const float mean = half_sum32(o0 + o1) * (1.f / 64.f); o0 -= mean; o1 -= mean; }
                const float var = half_sum32(o0 * o0 + o1 * o1) * (1.f / 64.f);
                const float rn = rsqrtf(var + EPS);
                o0 = o0 * rn * siluf_(bflo(rgv[ps])); o1 = o1 * rn * siluf_(bfhi(rgv[ps]));
                *(unsigned*)(MIX + (size_t)(m0 + tk) * 1024 + (mixer == 2 ? 768 : mixer * 256) + head * 64 + 2 * l32) = pk_bf16(o0, o1);
            }
            if (mode & 2) { const int tk = tkb;
                const f32x4 d0 = *(const f32x4*)(s5d + c8), d1 = *(const f32x4*)(s5d + c8 + 4);
                float y[8];
#pragma unroll
                for (int q = 0; q < 4; ++q) { y[2 * q] = bflo(yf[q]) + bflo(yb[q]) + (q < 2 ? d0[2 * q] : d1[2 * q - 4]) * bflo(uu[q]); y[2 * q + 1] = bfhi(yf[q]) + bfhi(yb[q]) + (q < 2 ? d0[2 * q + 1] : d1[2 * q - 3]) * bfhi(uu[q]); }
#pragma unroll
                for (int q = 0; q < 8; ++q) y[q] = gelu_tanh(y[q]);
                *(LAS f32x4*)(YF + tk * 256 + c8) = (f32x4){y[0], y[1], y[2], y[3]}; *(LAS f32x4*)(YF + tk * 256 + c8 + 4) = (f32x4){y[4], y[5], y[6], y[7]};
                *(LAS u32x4*)(YB + tk * 264 + c8) = (u32x4){pk_bf16(y[0], y[1]), pk_bf16(y[2], y[3]), pk_bf16(y[4], y[5]), pk_bf16(y[6], y[7])}; }
            LDS_BARRIER();
            if (mode & 2)
#pragma unroll
            for (int nt = 0; nt < 2; ++nt) { f32x4 acc = (f32x4){0.f, 0.f, 0.f, 0.f};
#pragma unroll
                for (int kk = 0; kk < 8; ++kk) { const bf16x8 a = *(const LAS bf16x8*)(YB + (lane & 15) * 264 + 32 * kk + 8 * (lane >> 4)); acc = __builtin_amdgcn_mfma_f32_16x16x32_bf16(a, bfr[nt][kk], acc, 0, 0, 0); }
                const int n = wave * 32 + nt * 16 + (lane & 15); const float gb = glub[n];
#pragma unroll
                for (int i = 0; i < 4; ++i) { const int tk = 4 * (lane >> 4) + i; const float yv = YF[tk * 256 + n];
                    MIX[(size_t)(m0 + tk) * 1024 + 512 + n] = (bf16_t)(pk_bf16(yv * sigmoidf_(acc[i] + gb), 0.f) & 0xffffu); } }
            LDS_BARRIER();
        }
#undef MX_LOADS
    }
}

__device__ __forceinline__ void phase_final(KP p, int wv) {
    const int tid = tid_launder(wv), lane = tid & 63, gw = bid_launder() * 8 + (tid >> 6), nw = gridDim.x * 8;
    const float* g = p->in[I_FNG];
    const bool poison = xb_ld((unsigned*)(p->ws + WS_CTL) + XB_TMO) != 0u;
    f32x4 xn[4];
    if (gw < NB * SEQ) {
#pragma unroll
        for (int j = 0; j < 4; ++j) xn[j] = *(const f32x4*)(p->out + (size_t)gw * D + 4 * lane + 256 * j); }
    for (int r = gw; r < NB * SEQ; r += nw) {
        float* xr = p->out + (size_t)r * D;
        f32x4 xv[4]; float ss = 0.f;
#pragma unroll
        for (int j = 0; j < 4; ++j) { xv[j] = xn[j]; ss += xv[j][0] * xv[j][0] + xv[j][1] * xv[j][1] + xv[j][2] * xv[j][2] + xv[j][3] * xv[j][3]; }
        if (r + nw < NB * SEQ) {
#pragma unroll
            for (int j = 0; j < 4; ++j) xn[j] = *(const f32x4*)(p->out + (size_t)(r + nw) * D + 4 * lane + 256 * j); }
        ss = wave_sum(ss);
        const float rstd = rsqrtf(ss * (1.f / 1024.f) + EPS);
#pragma unroll
        for (int j = 0; j < 4; ++j) { const f32x4 gv = *(const f32x4*)(g + 4 * lane + 256 * j); *(f32x4*)(xr + 4 * lane + 256 * j) = poison ? (f32x4){NAN, NAN, NAN, NAN} : xv[j] * rstd * gv; }
    }
}

__global__ void __launch_bounds__(512, 2) fwd_kernel(Params parg) {
    KP p = (KP)__builtin_amdgcn_kernarg_segment_ptr();
    extern __shared__ __attribute__((aligned(16))) unsigned char lds_raw[];
    LAS unsigned char* lds = (LAS unsigned char*)lds_raw;
    const int wv = __builtin_amdgcn_readfirstlane((int)threadIdx.x >> 6);
    if (tid_launder(wv) == 0) *(LAS u32x4*)(lds + LDS_BAR_OFF) = (u32x4){0u, 0u, 0u, 0u};
    __syncthreads();
    const unsigned bar_x = xcd_barrier_post((unsigned*)(p->ws + WS_CTL), (volatile LAS unsigned*)(lds + LDS_BAR_OFF), tid_launder(wv)).x;
#define NEXT_PHASE() do { p = kp_launder(p); XcdBarrier bb_; { unsigned* bp_ = (unsigned*)(p->ws + WS_CTL); asm volatile("" : "+s"(bp_)); unsigned bx_ = bar_x; asm volatile("" : "+s"(bx_)); \
        unsigned lo_ = LDS_BAR_OFF; asm volatile("" : "+s"(lo_)); bb_.bar = bp_; bb_.x = bx_; bb_.st = (volatile LAS unsigned*)(lds + lo_); } xcd_barrier(bb_, tid_launder(wv)); p = kp_launder(p); } while (0)
#define REP(bit) for (int rep_ = ((REPEAT_MASK) & (bit)) ? 1 : 0; rep_ >= 0; --rep_)
    REP(1) { phase_prologue(p, lds, wv); NEXT_PHASE(); }
    for (int xb_ = 0; xb_ < EXTRA_BARRIERS; ++xb_) NEXT_PHASE();
    for (int l = 0; l < 2; ++l) {
        const int last = l == 1;
        REP(2) { phase_prep<false>(p, lds, l, l == 0 ? p->in[I_X] : p->out, l == 0 ? p->in[I_CTX] : (const float*)(p->ws + WS_Z), 0, wv);
            NEXT_PHASE(); }
        REP(4) { Dsc1 S{(const bf16_t*)(p->ws + WS_ABUF), (const bf16_t*)(p->ws + WS_WIN) + (size_t)l * NWIN * 1024, (bf16_t*)(p->ws + WS_P), (int)gridDim.x, bid_launder()}; pg8::gemm_phase(lds, S, wv); NEXT_PHASE(); }
        REP(8) { phase_mixprep(p, lds, l, wv); NEXT_PHASE(); }
        REP(16) { phase_scan(p, lds, l, rep_ ? SCAN_PROBE : 15, wv); NEXT_PHASE(); }
        REP(32) { phase_mixpost(p, lds, l, wv, rep_ ? MIXPOST_PROBE : 3); NEXT_PHASE(); }
        REP(64) { Dsc2 S{(const bf16_t*)(p->ws + WS_ABUF), (const bf16_t*)(p->ws + WS_WOUT) + (size_t)l * 1024 * 1024, l == 0 ? p->in[I_X] : p->out, l == 0 ? p->in[I_CTX] : (const float*)(p->ws + WS_Z),
                          p->out, (float*)(p->ws + WS_Z), (const float*)(p->ws + WS_MOD) + (size_t)l * 17 * 6144, (int)gridDim.x, bid_launder(), last, rep_}; pg8::gemm_phase(lds, S, wv); NEXT_PHASE(); }
        REP(128) { phase_prep<true>(p, lds, l, p->out, (const float*)(p->ws + WS_Z), last, wv); NEXT_PHASE(); }
        REP(256) { phase_moe_offsets(p, lds, last, wv); NEXT_PHASE(); }
        REP(512) { const int ntl = __builtin_amdgcn_readfirstlane(((const int*)(p->ws + WS_TILE))[0]);
            Dsc3 S{(const bf16_t*)(p->ws + WS_ABUF), (const bf16_t*)(p->ws + WS_WGU), (bf16_t*)(p->ws + WS_P), (const int*)(p->ws + WS_LIST), (const float*)(p->ws + WS_SLOTW), (const int*)(p->ws + WS_TILE), (int)gridDim.x, bid_launder(), ntl, nullptr}; pg8::gemm_phase(lds, S, wv); NEXT_PHASE(); }
        REP(1024) { const int ntl = __builtin_amdgcn_readfirstlane(((const int*)(p->ws + WS_TILE))[0]);
            Dsc4 S{(const bf16_t*)(p->ws + WS_P), (const bf16_t*)(p->ws + WS_WDN), p->out, (float*)(p->ws + WS_Z), (const float*)(p->ws + WS_MOD) + (size_t)l * 17 * 6144, (const int*)(p->ws + WS_LIST), (const int*)(p->ws + WS_TILE), (int)gridDim.x, bid_launder(), ntl, rep_, nullptr}; pg8::gemm_phase(lds, S, wv); NEXT_PHASE(); }
    }
#undef REP
    if (PHASE_MASK & 2048) phase_final(p, wv);
#undef NEXT_PHASE
}

extern "C" void kernel_launch(void* const* d_in, const int* in_sizes, int n_in, void* d_out, int out_size, void* d_ws, size_t ws_size, hipStream_t stream) {
    static int grid = 0;
    if (grid == 0) {
        if (n_in != 31 || out_size != NB * SEQ * D || ws_size < WS_END) { fprintf(stderr, "kernel_launch: unexpected problem shape (n_in %d, out %d, ws %zu)\n", n_in, out_size, ws_size); grid = -1; return; }
        int dev = 0, cus = 0, per_cu = 0;
        if (hipGetDevice(&dev) != hipSuccess || hipDeviceGetAttribute(&cus, hipDeviceAttributeMultiprocessorCount, dev) != hipSuccess) { grid = -1; return; }
        if (hipFuncSetAttribute((const void*)fwd_kernel, hipFuncAttributeMaxDynamicSharedMemorySize, LDS_BYTES) != hipSuccess) { fprintf(stderr, "kernel_launch: hipFuncSetAttribute failed\n"); grid = -1; return; }
        if (hipOccupancyMaxActiveBlocksPerMultiprocessor(&per_cu, (const void*)fwd_kernel, 512, LDS_BYTES) != hipSuccess || per_cu < 1) fprintf(stderr, "kernel_launch: occupancy query reports %d\n", per_cu);
        (void)hipGetLastError();
        grid = cus > 256 ? 256 : cus;
    }
    if (grid < 0) return;
    (void)hipMemsetAsync((char*)d_ws + WS_CTL, 0, 65536, stream);
    Params p{};
    for (int i = 0; i < 31; ++i) p.in[i] = (const float*)d_in[i];
    p.out = (float*)d_out; p.ws = (unsigned char*)d_ws;
    hipLaunchKernelGGL(fwd_kernel, dim3(grid), dim3(512), LDS_BYTES, stream, p);
}
```
